# Optimizing an MI355X kernel written in HIP

```python
import math
import numpy as np
import jax
import jax.numpy as jnp
from jax import lax

D_MODEL = 1024
BATCH = 4
SEQ = 8192
DEPTH = 4

GRID_W = 64
CTX_LEN = 256
EPS = 1e-6
ROPE_BASE = 10000.0

NA_HEADS = 8
NA_DH = 64
NA_WIN_H = 8
NA_WIN_W = 16
GDN_HEADS = 4
GDN_DK = 128
GDN_DV = 128
GDN_CONV = 3
GDN_CHUNK = 64
MLA_HEADS = 8
MLA_NOPE = 64
MLA_ROPE = 32
MLA_V = 64
MLA_Q_RANK = 256
MLA_KV_RANK = 128
MLA_QBLOCK = 128
ML_HEADS = 4
ML_DK = 64
ML_DV = 128
ML_CHUNK = 64
N_BRANCH = 4
BRANCH_W = 512
N_EXPERTS = 32
TOP_K = 4
D_FF = 1024
SWIGLU_ALPHA = 1.702
SWIGLU_LIMIT = 7.0
MOE_BLOCK = 256

IN_SPLITS = (
    NA_HEADS * NA_DH, NA_HEADS * NA_DH, NA_HEADS * NA_DH,
    GDN_HEADS * (2 * GDN_DK + GDN_DV), GDN_HEADS * GDN_DV,
    2 * GDN_HEADS, 2 * GDN_HEADS,
    MLA_Q_RANK, MLA_KV_RANK + MLA_ROPE,
    ML_HEADS * ML_DK, ML_HEADS * ML_DK, ML_HEADS * ML_DV, ML_HEADS * ML_DV,
    2 * ML_HEADS, 2 * ML_HEADS,
)
D_IN = sum(IN_SPLITS)

kernel_name = 'hybrid_diffusion_parallel_mixers_moe'


def rmsnorm(x, g):
    xf = x.astype(jnp.float32)
    y = xf * lax.rsqrt(jnp.mean(xf * xf, axis=-1, keepdims=True) + EPS)
    return (y * g.astype(jnp.float32)).astype(x.dtype)


def l2norm(x):
    xf = x.astype(jnp.float32)
    return (xf * lax.rsqrt(jnp.sum(xf * xf, axis=-1, keepdims=True) + EPS)).astype(x.dtype)


def softmax_f32(s, dtype):
    return jax.nn.softmax(s.astype(jnp.float32), axis=-1).astype(dtype)


def to_heads(t, n_heads):
    b, s, _ = t.shape
    return t.reshape(b, s, n_heads, -1).transpose(0, 2, 1, 3)


def from_heads(t):
    b, h, s, d = t.shape
    return t.transpose(0, 2, 1, 3).reshape(b, s, h * d)


def flip_t(t):
    return jnp.flip(t, axis=2)


def short_conv(x, w):
    k = w.shape[0]
    pad = k // 2
    s = x.shape[1]
    xp = jnp.pad(x, ((0, 0), (pad, pad), (0, 0)))
    y = xp[:, 0:s] * w[0]
    for j in range(1, k):
        y = y + xp[:, j:j + s] * w[j]
    return y


def rope2d(x):
    s = x.shape[-2]
    half = x.shape[-1] // 2
    t = jnp.arange(s)
    inv = ROPE_BASE ** (-jnp.arange(0, half, 2, dtype=jnp.float32) / half)

    def rot(xa, pos):
        ang = pos.astype(jnp.float32)[:, None] * inv
        cos, sin = jnp.cos(ang).astype(x.dtype), jnp.sin(ang).astype(x.dtype)
        x1, x2 = jnp.split(xa, 2, axis=-1)
        return jnp.concatenate([x1 * cos - x2 * sin, x2 * cos + x1 * sin], axis=-1)

    return jnp.concatenate([rot(x[..., :half], t // GRID_W), rot(x[..., half:], t % GRID_W)], axis=-1)


def context_attention(q, k, v):
    s = jnp.einsum('bhqd,bhkd->bhqk', q, k) * (q.shape[-1] ** -0.5)
    return from_heads(jnp.einsum('bhqk,bhkd->bhqd', softmax_f32(s, v.dtype), v))


def neighborhood_attention(q, k, v, k_ctx, v_ctx, rpb):
    b, s, _ = q.shape
    rows = s // GRID_W
    wh, ww = min(NA_WIN_H, rows), NA_WIN_W
    grid = lambda t: t.reshape(b, rows, GRID_W, NA_HEADS, NA_DH)
    qg = jnp.moveaxis(grid(q) * (NA_DH ** -0.5), 1, 0)
    kg, vg = grid(k), grid(v)
    cols = np.arange(GRID_W)
    c0 = np.clip(cols - ww // 2, 0, GRID_W - ww)
    col_idx = c0[:, None] + np.arange(ww)[None, :]
    rpb_cols = rpb[:, :, col_idx - cols[:, None] + (NA_WIN_W - 1)]

    def row_block(args):
        r, q_r = args
        r0 = jnp.clip(r - wh // 2, 0, rows - wh)
        k_r = lax.dynamic_slice_in_dim(kg, r0, wh, axis=1)[:, :, col_idx]
        v_r = lax.dynamic_slice_in_dim(vg, r0, wh, axis=1)[:, :, col_idx]
        bias = jnp.take(rpb_cols, r0 + jnp.arange(wh) - r + (NA_WIN_H - 1), axis=1)
        s_win = jnp.einsum('bchd,bacwhd->bhcaw', q_r, k_r) + bias.transpose(0, 2, 1, 3)
        s_ctx = jnp.einsum('bchd,bhjd->bhcj', q_r, k_ctx)
        p = softmax_f32(jnp.concatenate([s_win.reshape(b, NA_HEADS, GRID_W, wh * ww), s_ctx], axis=-1), v.dtype)
        p_win = p[..., :wh * ww].reshape(b, NA_HEADS, GRID_W, wh, ww)
        return (jnp.einsum('bhcaw,bacwhd->bchd', p_win, v_r)
                + jnp.einsum('bhcj,bhjd->bchd', p[..., wh * ww:], v_ctx))

    o = lax.map(row_block, (jnp.arange(rows), qg))
    return jnp.moveaxis(o, 0, 1).reshape(b, s, NA_HEADS * NA_DH)


def mla_expand(pq, pkv, q_norm_g, w_uq, kv_norm_g, w_ukv, rotate):
    q = to_heads(rmsnorm(pq, q_norm_g) @ w_uq, MLA_HEADS)
    kv = to_heads(rmsnorm(pkv[..., :MLA_KV_RANK], kv_norm_g) @ w_ukv, MLA_HEADS)
    q_nope, q_pe = q[..., :MLA_NOPE], q[..., MLA_NOPE:]
    k_nope, v = kv[..., :MLA_NOPE], kv[..., MLA_NOPE:]
    k_pe = pkv[..., MLA_KV_RANK:]
    if rotate:
        q_pe, k_pe = rope2d(q_pe), rope2d(k_pe)
    return q_nope, q_pe, k_nope, k_pe, v


def mla_scores(qn, qp, kn, kp):
    s = jnp.einsum('bhqd,bhkd->bhqk', qn, kn) + jnp.einsum('bhqr,bkr->bhqk', qp, kp)
    return s * ((MLA_NOPE + MLA_ROPE) ** -0.5)


def mla_latent_attention(qn, qp, kn, kp, v):
    b, h, s, _ = qn.shape
    nb = s // MLA_QBLOCK
    blocks = lambda t: jnp.moveaxis(t.reshape(b, h, nb, MLA_QBLOCK, t.shape[-1]), 2, 0)

    def q_block(args):
        qn_b, qp_b = args
        return jnp.einsum('bhqk,bhkd->bhqd', softmax_f32(mla_scores(qn_b, qp_b, kn, kp), v.dtype), v)

    o = lax.map(q_block, (blocks(qn), blocks(qp)))
    return from_heads(jnp.moveaxis(o, 0, 2).reshape(b, h, s, MLA_V))


def gdn_prep(p_qkv, p_a, p_b, conv_w, a_log, dt_bias):
    b, s, _ = p_a.shape
    qkv = jax.nn.silu(short_conv(p_qkv, conv_w))
    q, k, v = jnp.split(qkv, [GDN_HEADS * GDN_DK, 2 * GDN_HEADS * GDN_DK], axis=-1)
    q = l2norm(to_heads(q, GDN_HEADS)) * (GDN_DK ** -0.5)
    k = l2norm(to_heads(k, GDN_HEADS))
    v = to_heads(v, GDN_HEADS)
    a = p_a.reshape(b, s, 2, GDN_HEADS).astype(jnp.float32)
    log_alpha = -jnp.exp(a_log.astype(jnp.float32)) * jax.nn.softplus(a + dt_bias.astype(jnp.float32))
    beta = jax.nn.sigmoid(p_b.reshape(b, s, 2, GDN_HEADS).astype(jnp.float32))
    return q, k, v, log_alpha.transpose(2, 0, 3, 1), beta.transpose(2, 0, 3, 1)


def gdn_scan(q, k, v, log_a, beta, state):
    f32 = jnp.float32
    q, k, v, log_a, beta = (t.astype(f32) for t in (q, k, v, log_a, beta))
    b, h, s, dk = q.shape
    dv = v.shape[-1]
    L = GDN_CHUNK
    nc = s // L
    chunk = lambda t: t.reshape(b, h, nc, L, *t.shape[3:])
    q, k, v, log_a, beta = (chunk(t) for t in (q, k, v, log_a, beta))
    g = jnp.cumsum(log_a, axis=-1)
    idx = jnp.arange(L)
    decay = jnp.exp(jnp.where(idx[:, None] >= idx[None, :], g[..., :, None] - g[..., None, :], -jnp.inf))
    strict = jnp.where(idx[:, None] > idx[None, :], decay, 0.0)
    a_mat = jnp.eye(L, dtype=f32) + beta[..., :, None] * strict * jnp.einsum('bhnid,bhnjd->bhnij', k, k)
    rhs = jnp.concatenate([beta[..., None] * v, (beta * jnp.exp(g))[..., None] * k], axis=-1)
    sol = lax.linalg.triangular_solve(a_mat, rhs, left_side=True, lower=True, unit_diagonal=True)
    u0, w = sol[..., :dv], sol[..., dv:]
    qk = decay * jnp.einsum('bhnid,bhnjd->bhnij', q, k)
    g_end = g[..., -1]
    k_end = jnp.exp(g_end[..., None] - g)[..., None] * k
    q_dec = jnp.exp(g)[..., None] * q

    def step(S, xs):
        u0_c, w_c, qk_c, k_end_c, q_dec_c, e_end = xs
        u = u0_c - jnp.einsum('bhlk,bhvk->bhlv', w_c, S)
        o = jnp.einsum('bhlk,bhvk->bhlv', q_dec_c, S) + jnp.einsum('bhij,bhjv->bhiv', qk_c, u)
        S = e_end[..., None, None] * S + jnp.einsum('bhlv,bhlk->bhvk', u, k_end_c)
        return S, o

    xs = tuple(jnp.moveaxis(t, 2, 0) for t in (u0, w, qk, k_end, q_dec, jnp.exp(g_end)))
    state, o = lax.scan(step, state, xs)
    return jnp.moveaxis(o, 0, 2).reshape(b, h, s, dv), state


def gdn_output(o, p_g, norm_g):
    b, s, _ = p_g.shape
    y = rmsnorm(o.transpose(0, 2, 1, 3), norm_g) * jax.nn.silu(p_g.reshape(b, s, GDN_HEADS, GDN_DV).astype(jnp.float32))
    return y.reshape(b, s, GDN_HEADS * GDN_DV).astype(p_g.dtype)


def mlstm_prep(pq, pk, pv, p_i, p_f, b_if):
    b, s, _ = p_i.shape
    q = to_heads(pq, ML_HEADS) * (ML_DK ** -0.5)
    k = to_heads(pk, ML_HEADS)
    v = to_heads(pv, ML_HEADS)
    b_if = b_if.astype(jnp.float32)
    i_pre = p_i.reshape(b, s, 2, ML_HEADS).astype(jnp.float32) + b_if[:, 0]
    log_f = jax.nn.log_sigmoid(p_f.reshape(b, s, 2, ML_HEADS).astype(jnp.float32) + b_if[:, 1])
    return q, k, v, i_pre.transpose(2, 0, 3, 1), log_f.transpose(2, 0, 3, 1)


def mlstm_scan(q, k, v, i_pre, log_f, state):
    f32 = jnp.float32
    q, k, v, i_pre, log_f = (t.astype(f32) for t in (q, k, v, i_pre, log_f))
    b, h, s, dk = q.shape
    dv = v.shape[-1]
    L = ML_CHUNK
    nc = s // L
    chunk = lambda t: t.reshape(b, h, nc, L, *t.shape[3:])
    q, k, v, i_pre, log_f = (chunk(t) for t in (q, k, v, i_pre, log_f))
    fcum = jnp.cumsum(log_f, axis=-1)
    idx = jnp.arange(L)
    d_log = jnp.where(idx[:, None] >= idx[None, :],
                      fcum[..., :, None] - fcum[..., None, :] + i_pre[..., None, :], -jnp.inf)
    qk = jnp.einsum('bhnid,bhnjd->bhnij', q, k)
    f_end = fcum[..., -1]
    w_log = f_end[..., None] - fcum + i_pre
    d_max = jnp.max(d_log, axis=-1)
    w_max = jnp.max(w_log, axis=-1)

    def step(carry, xs):
        C, n, m = carry
        q_c, k_c, v_c, fc_c, dl_c, qk_c, fe_c, wl_c, dm_c, wm_c = xs
        m_q = jnp.maximum(fc_c + m[..., None], dm_c)
        inter = jnp.exp(fc_c + m[..., None] - m_q)
        intra = jnp.exp(dl_c - m_q[..., None]) * qk_c
        num = inter[..., None] * jnp.einsum('bhlk,bhvk->bhlv', q_c, C) + jnp.einsum('bhij,bhjv->bhiv', intra, v_c)
        den = inter * jnp.einsum('bhlk,bhk->bhl', q_c, n) + jnp.sum(intra, axis=-1)
        h_c = num / jnp.maximum(jnp.abs(den), jnp.exp(-m_q))[..., None]
        m_new = jnp.maximum(fe_c + m, wm_c)
        dec = jnp.exp(fe_c + m - m_new)
        wk = jnp.exp(wl_c - m_new[..., None])
        C = dec[..., None, None] * C + jnp.einsum('bhlv,bhlk->bhvk', wk[..., None] * v_c, k_c)
        n = dec[..., None] * n + jnp.einsum('bhl,bhlk->bhk', wk, k_c)
        return (C, n, m_new), h_c

    xs = tuple(jnp.moveaxis(t, 2, 0) for t in (q, k, v, fcum, d_log, qk, f_end, w_log, d_max, w_max))
    state, o = lax.scan(step, state, xs)
    return jnp.moveaxis(o, 0, 2).reshape(b, h, s, dv), state


def mlstm_output(o, p_o, norm_g):
    b, s, _ = p_o.shape
    y = rmsnorm(o.transpose(0, 2, 1, 3), norm_g) * jax.nn.sigmoid(p_o.reshape(b, s, ML_HEADS, ML_DV).astype(jnp.float32))
    return y.reshape(b, s, ML_HEADS * ML_DV).astype(p_o.dtype)


def bidirectional(scan_fn, state0, ctx_in, lat_in):
    o_ctx, o_lat = 0.0, 0.0
    for d in range(2):
        c_in = ctx_in[:3] + (ctx_in[3][d], ctx_in[4][d])
        l_in = lat_in[:3] + (lat_in[3][d], lat_in[4][d])
        if d == 1:
            c_in = tuple(flip_t(t) for t in c_in)
            l_in = tuple(flip_t(t) for t in l_in)
        oc, st = scan_fn(*c_in, state0)
        ol, _ = scan_fn(*l_in, st)
        if d == 1:
            oc, ol = flip_t(oc), flip_t(ol)
        o_ctx = o_ctx + oc
        o_lat = o_lat + ol
    return o_ctx, o_lat


def merge(h, ys, w_mg, b_mg, w_bo, w_out):
    z = jnp.einsum('btnw,nwd->btnd', jnp.stack(ys, axis=2), w_bo)
    g = jax.nn.sigmoid(h @ w_mg + b_mg).reshape(*h.shape[:-1], N_BRANCH, D_MODEL)
    return jnp.sum(g * z, axis=2) @ w_out


def token_mixer(h_lat, h_ctx, w_in, na_rpb, gdn_conv_w, gdn_a_log, gdn_dt_bias, gdn_norm_g,
                mla_q_norm_g, mla_w_uq, mla_kv_norm_g, mla_w_ukv, ml_b_if, ml_norm_g,
                w_mg, b_mg, w_bo, w_out, with_ctx_out):
    bsz = h_lat.shape[0]
    cuts = np.cumsum(IN_SPLITS)[:-1].tolist()
    pl = jnp.split(h_lat @ w_in, cuts, axis=-1)
    pc = jnp.split(h_ctx @ w_in, cuts, axis=-1)
    k_ctx_na, v_ctx_na = to_heads(pc[1], NA_HEADS), to_heads(pc[2], NA_HEADS)
    ya_lat = neighborhood_attention(pl[0], pl[1], pl[2], k_ctx_na, v_ctx_na, na_rpb)
    gdn_in = lambda p: gdn_prep(p[3], p[5], p[6], gdn_conv_w, gdn_a_log, gdn_dt_bias)
    s0 = jnp.zeros((bsz, GDN_HEADS, GDN_DV, GDN_DK), jnp.float32)
    ob_ctx, ob_lat = bidirectional(gdn_scan, s0, gdn_in(pc), gdn_in(pl))
    cq = mla_expand(pc[7], pc[8], mla_q_norm_g, mla_w_uq, mla_kv_norm_g, mla_w_ukv, False)
    lq = mla_expand(pl[7], pl[8], mla_q_norm_g, mla_w_uq, mla_kv_norm_g, mla_w_ukv, True)
    kn_all = jnp.concatenate([cq[2], lq[2]], axis=2)
    kp_all = jnp.concatenate([cq[3], lq[3]], axis=1)
    v_all = jnp.concatenate([cq[4], lq[4]], axis=2)
    yc_lat = mla_latent_attention(lq[0], lq[1], kn_all, kp_all, v_all)
    ml_in = lambda p: mlstm_prep(p[9], p[10], p[11], p[13], p[14], ml_b_if)
    st0 = (jnp.zeros((bsz, ML_HEADS, ML_DV, ML_DK), jnp.float32),
           jnp.zeros((bsz, ML_HEADS, ML_DK), jnp.float32),
           jnp.zeros((bsz, ML_HEADS), jnp.float32))
    od_ctx, od_lat = bidirectional(mlstm_scan, st0, ml_in(pc), ml_in(pl))
    out_lat = merge(h_lat, [ya_lat, gdn_output(ob_lat, pl[4], gdn_norm_g), yc_lat,
                            mlstm_output(od_lat, pl[12], ml_norm_g)], w_mg, b_mg, w_bo, w_out)
    if not with_ctx_out:
        return out_lat, None
    ya_ctx = context_attention(to_heads(pc[0], NA_HEADS), k_ctx_na, v_ctx_na)
    yc_ctx = from_heads(jnp.einsum('bhqk,bhkd->bhqd',
                                   softmax_f32(mla_scores(cq[0], cq[1], cq[2], cq[3]), cq[4].dtype), cq[4]))
    out_ctx = merge(h_ctx, [ya_ctx, gdn_output(ob_ctx, pc[4], gdn_norm_g), yc_ctx,
                            mlstm_output(od_ctx, pc[12], ml_norm_g)], w_mg, b_mg, w_bo, w_out)
    return out_lat, out_ctx


def moe_ffn(t, router_w, router_b, w_gu, b_gu, w_dn, b_dn):
    n, d = t.shape
    logits = t.astype(jnp.float32) @ router_w.astype(jnp.float32) + router_b.astype(jnp.float32)
    top_v, top_i = lax.top_k(logits, TOP_K)
    top_w = jax.nn.softmax(top_v, axis=-1).astype(t.dtype)
    nk = n * TOP_K
    e_flat = top_i.reshape(nk)
    w_flat = top_w.reshape(nk)
    tok_flat = jnp.arange(nk, dtype=jnp.int32) // TOP_K
    order = jnp.argsort(e_flat, stable=True)
    e_s, tok_s, w_s = e_flat[order], tok_flat[order], w_flat[order]
    counts = jnp.bincount(e_flat, length=N_EXPERTS)
    padded = (counts + MOE_BLOCK - 1) // MOE_BLOCK * MOE_BLOCK
    pad_end = jnp.cumsum(padded)
    dest = (pad_end - padded)[e_s] + jnp.arange(nk) - (jnp.cumsum(counts) - counts)[e_s]
    n_blocks = -(-nk // MOE_BLOCK) + N_EXPERTS
    buf = jnp.zeros((n_blocks * MOE_BLOCK, d), t.dtype).at[dest].set(t[tok_s])
    block_e = jnp.minimum(jnp.searchsorted(pad_end, jnp.arange(n_blocks) * MOE_BLOCK, side='right'), N_EXPERTS - 1)

    def expert_block(args):
        xb, e = args
        gu = xb @ w_gu[e] + b_gu[e]
        gate = jnp.minimum(gu[:, :D_FF], SWIGLU_LIMIT)
        up = jnp.clip(gu[:, D_FF:], -SWIGLU_LIMIT, SWIGLU_LIMIT)
        return ((up + 1.0) * gate * jax.nn.sigmoid(SWIGLU_ALPHA * gate)) @ w_dn[e] + b_dn[e]

    y = lax.map(expert_block, (buf.reshape(n_blocks, MOE_BLOCK, d), block_e)).reshape(-1, d)
    return jax.ops.segment_sum(y[dest] * w_s[:, None], tok_s, num_segments=n)


def setup_inputs(seed: int = 0) -> dict:
    key = jax.random.key(seed)
    ks = iter(jax.random.split(key, 40))
    L, D = DEPTH, D_MODEL

    def nrm(shape, scale):
        return jax.random.normal(next(ks), shape, jnp.float32) * scale

    def gain(shape):
        return 1.0 + nrm(shape, 0.02)

    dt = jnp.exp(jax.random.uniform(next(ks), (L, 2, GDN_HEADS), jnp.float32, math.log(1e-3), math.log(1e-1)))
    gdn_dt_bias = dt + jnp.log(-jnp.expm1(-dt))
    gdn_a_log = jnp.log(jax.random.uniform(next(ks), (L, 2, GDN_HEADS), jnp.float32, 1.0, 16.0))
    ml_b_if = jnp.stack([nrm((L, 2, ML_HEADS), 0.1), 3.0 + nrm((L, 2, ML_HEADS), 0.5)], axis=2)
    return {
        'x': nrm((BATCH, SEQ, D), 1.0),
        'c': nrm((BATCH, D), 1.0),
        'ctx': nrm((BATCH, CTX_LEN, D), 1.0),
        'c_ctx': nrm((D,), 1.0),
        'w_ada': nrm((L, D, 6 * D), 0.5 * D ** -0.5),
        'b_ada': nrm((L, 6 * D), 0.02),
        'norm1_g': gain((L, D)),
        'norm2_g': gain((L, D)),
        'w_in': nrm((L, D, D_IN), D ** -0.5),
        'na_rpb': nrm((L, NA_HEADS, 2 * NA_WIN_H - 1, 2 * NA_WIN_W - 1), 0.1),
        'gdn_conv_w': nrm((L, GDN_CONV, GDN_HEADS * (2 * GDN_DK + GDN_DV)), GDN_CONV ** -0.5),
        'gdn_a_log': gdn_a_log,
        'gdn_dt_bias': gdn_dt_bias,
        'gdn_norm_g': gain((L, GDN_DV)),
        'mla_q_norm_g': gain((L, MLA_Q_RANK)),
        'mla_w_uq': nrm((L, MLA_Q_RANK, MLA_HEADS * (MLA_NOPE + MLA_ROPE)), MLA_Q_RANK ** -0.5),
        'mla_kv_norm_g': gain((L, MLA_KV_RANK)),
        'mla_w_ukv': nrm((L, MLA_KV_RANK, MLA_HEADS * (MLA_NOPE + MLA_V)), MLA_KV_RANK ** -0.5),
        'ml_b_if': ml_b_if,
        'ml_norm_g': gain((L, ML_DV)),
        'w_mg': nrm((L, D, N_BRANCH * D), D ** -0.5),
        'b_mg': nrm((L, N_BRANCH * D), 0.02),
        'w_bo': nrm((L, N_BRANCH, BRANCH_W, D), BRANCH_W ** -0.5),
        'w_out': nrm((L, D, D), D ** -0.5),
        'router_w': nrm((L, D, N_EXPERTS), D ** -0.5),
        'router_b': nrm((L, N_EXPERTS), 0.01),
        'w_gu': nrm((L, N_EXPERTS, D, 2 * D_FF), D ** -0.5),
        'b_gu': nrm((L, N_EXPERTS, 2 * D_FF), 0.01),
        'w_dn': nrm((L, N_EXPERTS, D_FF, D), D_FF ** -0.5),
        'b_dn': nrm((L, N_EXPERTS, D), 0.01),
        'final_g': gain((D,)),
    }


def reference(x, c, ctx, c_ctx, w_ada, b_ada, norm1_g, norm2_g, w_in, na_rpb, gdn_conv_w, gdn_a_log,
              gdn_dt_bias, gdn_norm_g, mla_q_norm_g, mla_w_uq, mla_kv_norm_g, mla_w_ukv, ml_b_if, ml_norm_g,
              w_mg, b_mg, w_bo, w_out, router_w, router_b, w_gu, b_gu, w_dn, b_dn, final_g):
    silu_c = jax.nn.silu(c)
    silu_cc = jax.nn.silu(c_ctx)
    for l in range(DEPTH):
        with_ctx_out = l < DEPTH - 1
        mod_lat = (silu_c @ w_ada[l] + b_ada[l])[:, None, :]
        mod_ctx = silu_cc @ w_ada[l] + b_ada[l]
        sh1, sc1, g1, sh2, sc2, g2 = jnp.split(mod_lat, 6, axis=-1)
        csh1, csc1, cg1, csh2, csc2, cg2 = jnp.split(mod_ctx, 6, axis=-1)
        h_lat = rmsnorm(x, norm1_g[l]) * (1.0 + sc1) + sh1
        h_ctx = rmsnorm(ctx, norm1_g[l]) * (1.0 + csc1) + csh1
        m_lat, m_ctx = token_mixer(h_lat, h_ctx, w_in[l], na_rpb[l], gdn_conv_w[l], gdn_a_log[l], gdn_dt_bias[l],
                                   gdn_norm_g[l], mla_q_norm_g[l], mla_w_uq[l], mla_kv_norm_g[l], mla_w_ukv[l],
                                   ml_b_if[l], ml_norm_g[l], w_mg[l], b_mg[l], w_bo[l], w_out[l], with_ctx_out)
        x = x + g1 * m_lat
        h2_lat = rmsnorm(x, norm2_g[l]) * (1.0 + sc2) + sh2
        if with_ctx_out:
            ctx = ctx + cg1 * m_ctx
            h2_ctx = rmsnorm(ctx, norm2_g[l]) * (1.0 + csc2) + csh2
            n_ctx = h2_ctx.shape[0] * h2_ctx.shape[1]
            tokens = jnp.concatenate([h2_ctx.reshape(-1, D_MODEL), h2_lat.reshape(-1, D_MODEL)], axis=0)
            f = moe_ffn(tokens, router_w[l], router_b[l], w_gu[l], b_gu[l], w_dn[l], b_dn[l])
            ctx = ctx + cg2 * f[:n_ctx].reshape(ctx.shape)
            f_lat = f[n_ctx:].reshape(x.shape)
        else:
            f_lat = moe_ffn(h2_lat.reshape(-1, D_MODEL), router_w[l], router_b[l], w_gu[l], b_gu[l],
                            w_dn[l], b_dn[l]).reshape(x.shape)
        x = x + g2 * f_lat
    return rmsnorm(x, final_g)
```

```cpp
#include <hip/hip_runtime.h>
#include <cstdio>
#include <cstdint>

#ifndef MK_N_LAUNCHES
#define MK_N_LAUNCHES 1
#endif

#ifndef PROBE_DUP
#define PROBE_DUP -1
#endif
#define NREP(k) ((PROBE_DUP == (k)) ? 2 : 1)
#define GAS __attribute__((address_space(1)))
#define LAS __attribute__((address_space(3)))
typedef unsigned short bf16;
typedef short bf16x8 __attribute__((ext_vector_type(8)));
typedef short s16x4 __attribute__((ext_vector_type(4)));
typedef float f32x4 __attribute__((ext_vector_type(4)));
typedef float f32x2 __attribute__((ext_vector_type(2)));
typedef float f32x16 __attribute__((ext_vector_type(16)));
typedef unsigned u32x4 __attribute__((ext_vector_type(4)));
typedef unsigned u32x2 __attribute__((ext_vector_type(2)));
typedef int i32x4 __attribute__((ext_vector_type(4)));
typedef __bf16 bf16x2_t __attribute__((ext_vector_type(2)));

constexpr int D = 1024, NB = 4, SEQ = 8192, CTX = 256, TB = SEQ + CTX, T = NB * TB, DEPTH = 4;
constexpr int DIN = 5568, LDP = 5632, NGATE = 4096, NIN = LDP + NGATE;
constexpr int NE = 32, TOPK = 4, DFF = 1024;
constexpr int NSLOT = 143360;
constexpr int NWAVES = 8, NTHR = 512;
constexpr int PC_NAQ = 0, PC_NAK = 512, PC_NAV = 1024, PC_GQKV = 1536, PC_GG = 3072, PC_MQ = 3600, PC_MKV = 3856, PC_MKPE = 3984,
              PC_LQ = 4016, PC_LK = 4272, PC_LV = 4528, PC_LO = 5040;

constexpr size_t MiB = (size_t)1 << 20;
constexpr size_t OFF_CTL = 0, CTL_BYTES = 1 * MiB;
constexpr size_t OFF_MOD = 1 * MiB;
constexpr size_t OFF_X = 2 * MiB;
constexpr size_t OFF_H = 134 * MiB;
constexpr size_t OFF_SH = OFF_H + 40 * MiB;
constexpr size_t OFF_SX = 200 * MiB + 300 * MiB;
constexpr size_t OFF_R1 = 200 * MiB;
constexpr size_t OFF_R2 = 563 * MiB;
constexpr size_t OFF_R3 = 843 * MiB;
constexpr size_t OFF_GQKV = 1123 * MiB;
constexpr size_t OFF_GATES = 1222 * MiB;
constexpr size_t OFF_GDNG = 1227 * MiB;
constexpr size_t OFF_MLG = 1230 * MiB;
constexpr size_t OFF_AQ = 1233 * MiB;
constexpr size_t OFF_QKVR = 1258 * MiB;
constexpr size_t OFF_KM = 1374 * MiB;
constexpr size_t OFF_VTM = 1424 * MiB;
constexpr size_t OFF_VTN = 1457 * MiB;
constexpr size_t OFF_OGD = 1490 * MiB;
constexpr size_t OFF_OML = 1622 * MiB;
constexpr size_t OFF_Y = 1754 * MiB;
constexpr size_t OFF_TOPW = 1886 * MiB;
constexpr size_t OFF_TOPE = OFF_TOPW + 768 * 1024;
constexpr size_t OFF_POS = OFF_TOPE + 768 * 1024;
constexpr size_t OFF_SLOT = OFF_POS + 768 * 1024;
constexpr size_t OFF_WIN = 1889 * MiB;
constexpr size_t OFF_CMIN = OFF_WIN + 40 * MiB;
constexpr size_t OFF_WUQKV = 1965 * MiB;
constexpr size_t OFF_WBO = 1971 * MiB;
constexpr size_t OFF_CMBO = OFF_WBO + 10 * MiB;
constexpr size_t OFF_WOUT4 = 1987 * MiB;
constexpr size_t OFF_WGU = 2019 * MiB;
constexpr size_t OFF_CMGU = OFF_WGU + 260 * MiB;
constexpr size_t OFF_WDN = 2531 * MiB;
constexpr size_t OFF_GC = 2787 * MiB;
constexpr size_t OFF_MC = 2791 * MiB;
constexpr size_t OFF_GF = 2794 * MiB;
constexpr size_t OFF_Y8 = 3200 * MiB;
constexpr size_t OFF_SY = 3270 * MiB;
constexpr size_t WS_END = 3272 * MiB;
constexpr int CW_BAR = 4096, CW_CNT = 8192  , CW_TST = 8448  ;

constexpr int RING_BYTES = 131072, MISC_OFF = RING_BYTES, LDS_BYTES = 147456;

__device__ __forceinline__ unsigned cvtpk(float lo, float hi) { f32x2 v = {lo, hi}; bf16x2_t b = __builtin_convertvector(v, bf16x2_t); return __builtin_bit_cast(unsigned, b); }
__device__ __forceinline__ float bflo(unsigned w) { return __uint_as_float(w << 16); }
__device__ __forceinline__ float bfhi(unsigned w) { return __uint_as_float(w & 0xffff0000u); }
__device__ __forceinline__ float bf2f(bf16 b) { return __uint_as_float(((unsigned)b) << 16); }
__device__ __forceinline__ float fexp2(float x) { return __builtin_amdgcn_exp2f(x); }
__device__ __forceinline__ float fexp(float x) { return __builtin_amdgcn_exp2f(x * 1.4426950408889634f); }
__device__ __forceinline__ float frcp(float x) { return __builtin_amdgcn_rcpf(x); }
__device__ __forceinline__ float fsigmoid(float x) { return frcp(1.0f + fexp(-x)); }
__device__ __forceinline__ float wave_sum(float v) {
#pragma unroll
    for (int o = 1; o < 64; o <<= 1) v += __shfl_xor(v, o);
    return v;
}
#define LDS_BAR() do { asm volatile("s_waitcnt lgkmcnt(0)" ::: "memory"); __builtin_amdgcn_s_barrier(); asm volatile("" ::: "memory"); } while (0)
__device__ __forceinline__ int ltid() { int t = threadIdx.x; asm volatile("" : "+v"(t)); return t; }
__device__ __forceinline__ float wave_max(float v) {
#pragma unroll
    for (int o = 1; o < 64; o <<= 1) v = fmaxf(v, __shfl_xor(v, o));
    return v;
}
__device__ __forceinline__ unsigned q8x4(const f32x4 x) {
    const int a = (int)__builtin_rintf(x.x), b = (int)__builtin_rintf(x.y), c = (int)__builtin_rintf(x.z), d = (int)__builtin_rintf(x.w);
    return ((unsigned)a & 0xffu) | (((unsigned)b & 0xffu) << 8) | (((unsigned)c & 0xffu) << 16) | (((unsigned)d & 0xffu) << 24);
}
template <int CTRL> __device__ __forceinline__ float dppf(float v) { return __int_as_float(__builtin_amdgcn_update_dpp(0, __float_as_int(v), CTRL, 0xf, 0xf, true)); }
__device__ __forceinline__ float row16_sum(float v) { v += dppf<0xB1>(v); v += dppf<0x4E>(v); v += dppf<0x141>(v); v += dppf<0x140>(v); return v; }
__device__ __forceinline__ void unpack8(const u32x4 w, float (&f)[8]) { f[0] = bflo(w.x); f[1] = bfhi(w.x); f[2] = bflo(w.y); f[3] = bfhi(w.y); f[4] = bflo(w.z); f[5] = bfhi(w.z); f[6] = bflo(w.w); f[7] = bfhi(w.w); }
__device__ __forceinline__ u32x4 pack8(const float (&f)[8]) { u32x4 w; w.x = cvtpk(f[0], f[1]); w.y = cvtpk(f[2], f[3]); w.z = cvtpk(f[4], f[5]); w.w = cvtpk(f[6], f[7]); return w; }

#define XB_TMO      128
#define XB_XCNT(j)  (256  + 64 * (j))
#define XB_XSUB(j)  (1280 + 64 * (j))
#define XB_XGEN(j)  (2304 + 64 * (j))
#define XB_TOP      3328
#define XB_TOPGEN   3392
#define XCD_BAR_WORDS 3456
#define XB_SPIN_CAP (1u << 25)
__device__ __forceinline__ unsigned xb_ld(unsigned* p)              { return __hip_atomic_load(p, __ATOMIC_RELAXED, __HIP_MEMORY_SCOPE_AGENT); }
__device__ __forceinline__ unsigned xb_add(unsigned* p, unsigned v) { return __hip_atomic_fetch_add(p, v, __ATOMIC_RELAXED, __HIP_MEMORY_SCOPE_AGENT); }
__device__ __forceinline__ unsigned xb_xcc_id() { return (unsigned)__builtin_amdgcn_s_getreg((3 << 11) | 20) & 0xFu; }
#define XB_SPIN(cond, bar) do { unsigned _sp = 0; while (cond) { __builtin_amdgcn_s_sleep(1); \
    if ((++_sp & 255u) == 0u) { if (xb_ld(&(bar)[XB_TMO])) break; if (_sp > XB_SPIN_CAP) { atomicAdd(&(bar)[XB_TMO], 1u); break; } } } } while (0)
struct XcdBarrier { unsigned* bar; unsigned x; volatile LAS unsigned* st; };
__device__ __forceinline__ XcdBarrier xcd_barrier_post(unsigned* bar, volatile LAS unsigned* st) {
    XcdBarrier b; b.bar = bar; b.x = xb_xcc_id(); b.st = st;
    if (threadIdx.x == 0) (void)xb_add(&bar[XB_XCNT(b.x)], 1u);
    return b;
}
__device__ __forceinline__ void xcd_barrier_complete(unsigned* bar, unsigned x, unsigned& nloc, unsigned& nx) {
    const unsigned G = gridDim.x * gridDim.y * gridDim.z;
    unsigned sum, cnt, mine, sp = 0u;
    for (;;) {
        sum = 0u; cnt = 0u; mine = 0u;
#pragma unroll
        for (unsigned j = 0; j < 16; ++j) { const unsigned c = xb_ld(&bar[XB_XCNT(j)]); sum += c; cnt += (c > 0u) ? 1u : 0u; mine = (j == x) ? c : mine; }
        if (sum == G) break;
        __builtin_amdgcn_s_sleep(1);
        if ((++sp & 255u) == 0u) { if (xb_ld(&bar[XB_TMO])) break; if (sp > XB_SPIN_CAP) { atomicAdd(&bar[XB_TMO], 1u); break; } }
    }
    nloc = mine > 0u ? mine : 1u; nx = cnt > 0u ? cnt : 1u;
}
__device__ __forceinline__ void xcd_barrier(const XcdBarrier& b) {
    asm volatile("s_waitcnt vmcnt(0)" ::: "memory");
    __syncthreads();
    if (threadIdx.x == 0) {
        unsigned* bar = b.bar;
        __builtin_amdgcn_s_waitcnt(0);
        unsigned nloc = b.st[0], nx = b.st[1];
        if (nloc == 0u) { xcd_barrier_complete(bar, b.x, nloc, nx); b.st[0] = nloc; b.st[1] = nx; }
        const unsigned old = xb_add(&bar[XB_XSUB(b.x)], 1u);
        const unsigned gen = old / nloc;
        if (old + 1u == (gen + 1u) * nloc) {
            __builtin_amdgcn_fence(__ATOMIC_RELEASE, "agent");
            asm volatile("s_waitcnt vmcnt(0)" ::: "memory");
            const unsigned og = xb_add(&bar[XB_TOP], 1u);
            const unsigned tg = og / nx;
            if (og + 1u == (tg + 1u) * nx) xb_add(&bar[XB_TOPGEN], 1u);
            else XB_SPIN(xb_ld(&bar[XB_TOPGEN]) == tg, bar);
            __builtin_amdgcn_fence(__ATOMIC_ACQUIRE, "agent");
            xb_add(&bar[XB_XGEN(b.x)], 1u);
            asm volatile("s_waitcnt vmcnt(0)" ::: "memory");
        } else {
            XB_SPIN(xb_ld(&bar[XB_XGEN(b.x)]) == gen, bar);
            __builtin_amdgcn_fence(__ATOMIC_ACQUIRE, "agent");
            asm volatile("s_waitcnt vmcnt(0)" ::: "memory");
        }
    }
    __syncthreads();
}

namespace pg8 {
constexpr int BM = 256, BK = 64, HALF = 128, HTB = HALF * BK * 2, STAGE_BYTES = 8 * HTB, NXCD = 8, WGM = 8;
__device__ __forceinline__ int lds_byte(int r, int c) { const int st = (r >> 4) * 2 + (c >> 5), rr = r & 15, cc = c & 31, ob = rr * 64 + cc * 2; return st * 1024 + (ob ^ (((ob >> 9) & 1) << 5)); }
__device__ __forceinline__ void stage_rc(int b, int& R, int& C) { const int st = b / 1024, sb = b % 1024, swz = sb ^ (((sb >> 9) & 1) << 5); R = (st >> 1) * 16 + swz / 64; C = (st & 1) * 32 + (swz % 64) / 2; }
__device__ __forceinline__ int perm32(int rho) { const int n = rho >> 4, i = rho & 15; return 8 * (i >> 2) + 4 * n + (i & 3); }
struct Unit { int pm, pn, aux; };
struct Order {
    int nM, nN, nwg, G, c, br, skipctx;
    __device__ void init(int nM_, int nN_, int G_, int c_, int br_ = 1, int skipctx_ = 0) { nM = nM_; nN = nN_; nwg = nM * nN; G = G_; c = c_; br = br_; skipctx = skipctx_; }
    __device__ bool next(int i, Unit& u) const {
        const int it = i / br, ia = i - it * br;
        const long L = (long)it * G + c; if (L >= nwg) return false;
        int wgid = (int)L; { const int q = nwg / NXCD, r = nwg % NXCD, xcd = wgid % NXCD, off = wgid / NXCD; wgid = (xcd < r ? xcd * (q + 1) : r * (q + 1) + (xcd - r) * q) + off; }
        const int nig = WGM * nN, gid = wgid / nig, fm = gid * WGM, gsz = (nM - fm) < WGM ? (nM - fm) : WGM;
        u.pm = fm + ((wgid % nig) % gsz); u.pn = (wgid % nig) / gsz + ia * nN; u.aux = ia;
        if (skipctx) u.pm += (u.pm >> 5) + 1;
        return true;
    }
};
template <class Prob, class Epi>
__device__ __forceinline__ void gemm_phase(LAS unsigned char* lds, const Prob& P, const Order& S, const Epi& E) {
    const int tid = ltid(), wid = __builtin_amdgcn_readfirstlane(tid >> 6), lane = tid & 63, wr = wid >> 2, wc = wid & 3, fr = lane & 15, fq = lane >> 4;
    const int nt = P.nt;
    unsigned voffA[2], voffB[2];
#pragma unroll
    for (int i = 0; i < 2; ++i) { int R, C; stage_rc(tid * 16 + i * 8192, R, C); const int Rb = Epi::PERM ? ((R & ~31) + perm32(R & 31)) : R;
        voffA[i] = (unsigned)R * P.lda + (unsigned)C * 2u; voffB[i] = (unsigned)Rb * P.ldb + (unsigned)C * 2u; }
    const size_t kstep = (size_t)(BK * 2);
    const size_t hA = (size_t)HALF * P.lda, hB = (size_t)HALF * P.ldb;
    const unsigned ldsw = (unsigned)wid * 1024u;
    const int aoff = lds_byte(wr * 64 + fr, fq * 8), boff = lds_byte(wc * 32 + fr, fq * 8);
#define PG8_SA(b, h) (((b) * 2 + (h)) * HTB)
#define PG8_SB(b, h) ((4 + (b) * 2 + (h)) * HTB)
#define PG8_STAGE(bufoff, gbase, voff) do { _Pragma("unroll") for (int _i = 0; _i < 2; ++_i) \
        __builtin_amdgcn_global_load_lds((const unsigned*)((const char*)(gbase) + (voff)[_i]), (LAS unsigned*)(lds + (bufoff) + ldsw + _i * 8192), 16, 0, 0); } while (0)
#define PG8_LDA(dst, b, h) do { _Pragma("unroll") for (int m = 0; m < 4; ++m) _Pragma("unroll") for (int k = 0; k < 2; ++k) dst[m][k] = *(const LAS bf16x8*)(lds + PG8_SA(b, h) + aoff + m * 2048 + k * 1024); } while (0)
#define PG8_LDB(dst, b, h) do { _Pragma("unroll") for (int n = 0; n < 2; ++n) _Pragma("unroll") for (int k = 0; k < 2; ++k) dst[n][k] = *(const LAS bf16x8*)(lds + PG8_SB(b, h) + boff + n * 2048 + k * 1024); } while (0)
#define PG8_MMA(ai, bj, At, Bt) do { __builtin_amdgcn_s_setprio(1); _Pragma("unroll") for (int m = 0; m < 4; ++m) _Pragma("unroll") for (int n = 0; n < 2; ++n) _Pragma("unroll") for (int k = 0; k < 2; ++k) { \
        if constexpr (Epi::I8) acc[ai][bj][m][n] = __builtin_bit_cast(f32x4, __builtin_amdgcn_mfma_i32_16x16x64_i8(__builtin_bit_cast(i32x4, Bt[n][k]), __builtin_bit_cast(i32x4, At[m][k]), __builtin_bit_cast(i32x4, acc[ai][bj][m][n]), 0, 0, 0)); \
        else acc[ai][bj][m][n] = __builtin_amdgcn_mfma_f32_16x16x32_bf16(Bt[n][k], At[m][k], acc[ai][bj][m][n], 0, 0, 0); } __builtin_amdgcn_s_setprio(0); } while (0)
#define PG8_WAIT_V(n) asm volatile("s_waitcnt vmcnt(" #n ")" ::: "memory")
#define PG8_WAIT_L(n) asm volatile("s_waitcnt lgkmcnt(" #n ")" ::: "memory")
#define PG8_BAR __builtin_amdgcn_s_barrier()
#define PG8_SCHED __builtin_amdgcn_sched_barrier(0)
    Unit cur, nxt; int ui = 0;
    if (!S.next(0, cur)) return;
    f32x4 acc[2][2][4][2];
#pragma unroll
    for (int a = 0; a < 2; ++a)
#pragma unroll
        for (int b = 0; b < 2; ++b)
#pragma unroll
            for (int m = 0; m < 4; ++m)
#pragma unroll
                for (int n = 0; n < 2; ++n) acc[a][b][m][n] = (f32x4){0.f, 0.f, 0.f, 0.f};
    bf16x8 At[4][2], B0[2][2], B1[2][2];
    const char* cA; const char* cB; P.setup(cur, cA, cB);
    PG8_STAGE(PG8_SB(0, 0), cB, voffB); PG8_STAGE(PG8_SB(0, 1), cB + hB, voffB); PG8_STAGE(PG8_SA(0, 0), cA, voffA); PG8_STAGE(PG8_SA(0, 1), cA + hA, voffA);
    if (wr == 1) PG8_BAR;
    PG8_WAIT_V(2); PG8_BAR;
    PG8_STAGE(PG8_SB(1, 0), cB + kstep, voffB); PG8_STAGE(PG8_SA(1, 0), cA + kstep, voffA); PG8_STAGE(PG8_SB(1, 1), cB + hB + kstep, voffB);
    PG8_WAIT_V(6); PG8_BAR;
    for (;;) {
        const bool has_next = S.next(ui + 1, nxt);
        const char* nA = cA; const char* nB = cB;
        if (has_next) P.setup(nxt, nA, nB);
        for (int t = 0; t < nt; t += 2) {
            const bool last = (t == nt - 2);
            const char* a1 = cA + (size_t)(t + 1) * kstep;
            const char* a2 = last ? nA : cA + (size_t)(t + 2) * kstep; const char* b2 = last ? nB : cB + (size_t)(t + 2) * kstep;
            const char* a3 = a2 + kstep; const char* b3 = b2 + kstep;
            PG8_LDB(B0, 0, 0); PG8_LDB(B1, 0, 1); PG8_SCHED; PG8_LDA(At, 0, 0); PG8_STAGE(PG8_SA(1, 1), a1 + hA, voffA);
            PG8_WAIT_V(8); PG8_WAIT_L(0); PG8_BAR; PG8_MMA(0, 0, At, B0); PG8_MMA(0, 1, At, B1); PG8_BAR; PG8_SCHED;
            PG8_LDA(At, 0, 1); PG8_STAGE(PG8_SB(0, 0), b2, voffB); PG8_STAGE(PG8_SB(0, 1), b2 + hB, voffB); PG8_STAGE(PG8_SA(0, 0), a2, voffA);
            PG8_WAIT_V(8); PG8_WAIT_L(0); PG8_BAR; PG8_MMA(1, 0, At, B0); PG8_MMA(1, 1, At, B1); PG8_BAR; PG8_SCHED;
            PG8_LDB(B0, 1, 0); PG8_LDB(B1, 1, 1); PG8_SCHED; PG8_LDA(At, 1, 0); PG8_STAGE(PG8_SA(0, 1), a2 + hA, voffA);
            PG8_WAIT_V(8); PG8_WAIT_L(0); PG8_BAR; PG8_MMA(0, 0, At, B0); PG8_MMA(0, 1, At, B1); PG8_BAR; PG8_SCHED;
            PG8_LDA(At, 1, 1); PG8_STAGE(PG8_SB(1, 0), b3, voffB); PG8_STAGE(PG8_SB(1, 1), b3 + hB, voffB); PG8_STAGE(PG8_SA(1, 0), a3, voffA);
            PG8_WAIT_V(8); PG8_WAIT_L(0); PG8_BAR; PG8_MMA(1, 0, At, B0); PG8_MMA(1, 1, At, B1); PG8_BAR; PG8_SCHED;
        }
        if (wr == 0) PG8_BAR;
        E(acc, cur, wr, wc, fr, fq);
        if (!has_next) break;
#pragma unroll
        for (int a = 0; a < 2; ++a)
#pragma unroll
            for (int b = 0; b < 2; ++b)
#pragma unroll
                for (int m = 0; m < 4; ++m)
#pragma unroll
                    for (int n = 0; n < 2; ++n) acc[a][b][m][n] = (f32x4){0.f, 0.f, 0.f, 0.f};
        cur = nxt; cA = nA; cB = nB; ++ui;
        if (wr == 1) PG8_BAR;
    }
    PG8_WAIT_V(0);
    PG8_BAR;
#undef PG8_SA
#undef PG8_SB
#undef PG8_STAGE
#undef PG8_LDA
#undef PG8_LDB
#undef PG8_MMA
#undef PG8_WAIT_V
#undef PG8_WAIT_L
#undef PG8_BAR
#undef PG8_SCHED
}
}

struct ProbPlain { const char* A; const char* B; unsigned lda, ldb; int nt;
    __device__ __forceinline__ void setup(pg8::Unit& u, const char*& a, const char*& b) const { a = A + (size_t)u.pm * 256 * lda; b = B + (size_t)u.pn * 256 * ldb; } };
struct ProbBO { const char* A; const char* B; unsigned lda, ldb; int nt;
    __device__ __forceinline__ void setup(pg8::Unit& u, const char*& a, const char*& b) const { a = A + (size_t)u.pm * 256 * lda + (size_t)(u.pn >> 2) * 512; b = B + (size_t)u.pn * 256 * ldb; } };
struct ProbMoE { const char* A; const char* B; unsigned lda, ldb; int nt; const int* tstart; size_t bstride;
    __device__ __forceinline__ void setup(pg8::Unit& u, const char*& a, const char*& b) const {
        int e = 0;
#pragma unroll 1
        for (int j = 1; j < NE; ++j) e += (u.pm >= tstart[j]) ? 1 : 0;
        u.aux = e; a = A + (size_t)u.pm * 256 * lda; b = B + (size_t)e * bstride + (size_t)u.pn * 256 * ldb; } };

__device__ __forceinline__ f32x4 i2f4(const f32x4 a) { const i32x4 i = __builtin_bit_cast(i32x4, a); return (f32x4){(float)i.x, (float)i.y, (float)i.z, (float)i.w}; }
typedef const f32x4 (&AccRef)[2][2][4][2];
struct EpiIn {
    static constexpr bool PERM = true, I8 = false;
    bf16* Pb; bf16* Gb; float* gates; const float* bmg;
    __device__ __forceinline__ void operator()(AccRef acc, const pg8::Unit& u, int wr, int wc, int fr, int fq) const {
        const int row0 = u.pm * 256 + wr * 64 + fr;
        if (u.pn < 22) {
            const int col0 = u.pn * 256 + wc * 32 + 8 * fq;
#pragma unroll
            for (int ai = 0; ai < 2; ++ai)
#pragma unroll
                for (int m = 0; m < 4; ++m) { const int row = row0 + ai * 128 + m * 16; bf16* rowp = Pb + (size_t)row * LDP + col0;
#pragma unroll
                    for (int bj = 0; bj < 2; ++bj) { const f32x4 v0 = acc[ai][bj][m][0], v1 = acc[ai][bj][m][1];
                        u32x4 w; w.x = cvtpk(v0[0], v0[1]); w.y = cvtpk(v0[2], v0[3]); w.z = cvtpk(v1[0], v1[1]); w.w = cvtpk(v1[2], v1[3]);
                        *(u32x4*)(rowp + bj * 128) = w;
                        if (bj == 0 && u.pn == 14 && wc == 0 && fq < 2) { float* g = gates + (size_t)row * 32 + 8 * fq; *(f32x4*)g = v0; *(f32x4*)(g + 4) = v1; }
                        if (bj == 1 && u.pn == 21 && wc == 1 && fq >= 2) { float* g = gates + (size_t)row * 32 + 16 + 8 * (fq - 2); *(f32x4*)g = v0; *(f32x4*)(g + 4) = v1; } } }
        } else {
            const int col0 = (u.pn - 22) * 256 + wc * 32 + 8 * fq;
            f32x4 bv[2][2];
#pragma unroll
            for (int bj = 0; bj < 2; ++bj)
#pragma unroll
                for (int n = 0; n < 2; ++n) bv[bj][n] = *(const f32x4*)(bmg + col0 + bj * 128 + 4 * n);
#pragma unroll
            for (int ai = 0; ai < 2; ++ai)
#pragma unroll
                for (int m = 0; m < 4; ++m) { bf16* rowp = Gb + (size_t)(row0 + ai * 128 + m * 16) * NGATE + col0;
#pragma unroll
                    for (int bj = 0; bj < 2; ++bj) { f32x4 v0 = acc[ai][bj][m][0] + bv[bj][0], v1 = acc[ai][bj][m][1] + bv[bj][1];
#pragma unroll
                        for (int j = 0; j < 4; ++j) { v0[j] = fsigmoid(v0[j]); v1[j] = fsigmoid(v1[j]); }
                        u32x4 w; w.x = cvtpk(v0[0], v0[1]); w.y = cvtpk(v0[2], v0[3]); w.z = cvtpk(v1[0], v1[1]); w.w = cvtpk(v1[2], v1[3]);
                        *(u32x4*)(rowp + bj * 128) = w; } }
        }
    }
};
struct EpiStore {
    static constexpr bool PERM = true, I8 = false;
    bf16* O; int ldc; const float* bias; int bias_stride;
    __device__ __forceinline__ void operator()(AccRef acc, const pg8::Unit& u, int wr, int wc, int fr, int fq) const {
        const int row0 = u.pm * 256 + wr * 64 + fr, col0 = u.pn * 256 + wc * 32 + 8 * fq;
        f32x4 bv[2][2];
#pragma unroll
        for (int bj = 0; bj < 2; ++bj)
#pragma unroll
            for (int n = 0; n < 2; ++n) bv[bj][n] = bias ? *(const f32x4*)(bias + (size_t)u.aux * bias_stride + col0 + bj * 128 + 4 * n) : (f32x4){0.f, 0.f, 0.f, 0.f};
#pragma unroll
        for (int ai = 0; ai < 2; ++ai)
#pragma unroll
            for (int m = 0; m < 4; ++m) { bf16* rowp = O + (size_t)(row0 + ai * 128 + m * 16) * ldc + col0;
#pragma unroll
                for (int bj = 0; bj < 2; ++bj) { const f32x4 v0 = acc[ai][bj][m][0] + bv[bj][0], v1 = acc[ai][bj][m][1] + bv[bj][1];
                    u32x4 w; w.x = cvtpk(v0[0], v0[1]); w.y = cvtpk(v0[2], v0[3]); w.z = cvtpk(v1[0], v1[1]); w.w = cvtpk(v1[2], v1[3]);
                    *(u32x4*)(rowp + bj * 128) = w; } }
    }
};
struct EpiBO {
    static constexpr bool PERM = true, I8 = true;
    bf16* Z; const bf16* G; const float* sY; const float* cmB;
    __device__ __forceinline__ void operator()(AccRef acc, const pg8::Unit& u, int wr, int wc, int fr, int fq) const {
        const int row0 = u.pm * 256 + wr * 64 + fr, colg = u.pn * 256 + wc * 32 + 8 * fq, colz = (u.pn & 3) * 256 + wc * 32 + 8 * fq;
        const bool first = u.aux == 0;
        f32x4 sw[2][2];
#pragma unroll
        for (int bj = 0; bj < 2; ++bj)
#pragma unroll
            for (int n = 0; n < 2; ++n) sw[bj][n] = *(const f32x4*)(cmB + colg + bj * 128 + 4 * n) * (1.0f / 127.0f);
#pragma unroll
        for (int ai = 0; ai < 2; ++ai)
#pragma unroll
            for (int m = 0; m < 4; ++m) { const int row = row0 + ai * 128 + m * 16; const float sa = sY[row * 4 + u.aux];
#pragma unroll
                for (int bj = 0; bj < 2; ++bj) { const u32x4 gw = *(const u32x4*)(G + (size_t)row * NGATE + colg + bj * 128); float g[8]; unpack8(gw, g);
                    bf16* zp = Z + (size_t)row * D + colz + bj * 128;
                    float z[8];
                    if (first) {
#pragma unroll
                        for (int j = 0; j < 8; ++j) z[j] = 0.f;
                    } else unpack8(*(const u32x4*)zp, z);
                    const f32x4 v0 = i2f4(acc[ai][bj][m][0]) * sw[bj][0] * sa, v1 = i2f4(acc[ai][bj][m][1]) * sw[bj][1] * sa;
#pragma unroll
                    for (int j = 0; j < 4; ++j) { z[j] += v0[j] * g[j]; z[4 + j] += v1[j] * g[4 + j]; }
                    *(u32x4*)zp = pack8(z); } }
    }
};
struct EpiOut {
    static constexpr bool PERM = false, I8 = false;
    float* X; const float* modl;
    __device__ __forceinline__ void operator()(AccRef acc, const pg8::Unit& u, int wr, int wc, int fr, int fq) const {
        const int row0 = u.pm * 256 + wr * 64 + fr, col0 = u.pn * 256 + wc * 32 + 4 * fq;
        const int mv = (u.pm % 33 == 0) ? 4 : u.pm / 33;
        const float* g1 = modl + mv * 6144 + 2048;
        f32x4 gv[2][2];
#pragma unroll
        for (int bj = 0; bj < 2; ++bj)
#pragma unroll
            for (int n = 0; n < 2; ++n) gv[bj][n] = *(const f32x4*)(g1 + col0 + bj * 128 + n * 16);
#pragma unroll
        for (int ai = 0; ai < 2; ++ai)
#pragma unroll
            for (int m = 0; m < 4; ++m) { float* rowp = X + (size_t)(row0 + ai * 128 + m * 16) * D + col0;
#pragma unroll
                for (int bj = 0; bj < 2; ++bj)
#pragma unroll
                    for (int n = 0; n < 2; ++n) { f32x4* p = (f32x4*)(rowp + bj * 128 + n * 16); *p = *p + gv[bj][n] * acc[ai][bj][m][n]; } }
    }
};
struct EpiMoE1 {
    static constexpr bool PERM = true, I8 = false;
    bf16* ACT; const float* bgu;
    __device__ __forceinline__ void operator()(AccRef acc, const pg8::Unit& u, int wr, int wc, int fr, int fq) const {
        const int row0 = u.pm * 256 + wr * 64 + fr, c0 = u.pn * 128 + wc * 32 + 8 * fq;
        const float* bg = bgu + (size_t)u.aux * 2048 + c0;
        f32x4 bgt[2], bup[2];
#pragma unroll
        for (int n = 0; n < 2; ++n) { bgt[n] = *(const f32x4*)(bg + 4 * n); bup[n] = *(const f32x4*)(bg + 1024 + 4 * n); }
#pragma unroll
        for (int ai = 0; ai < 2; ++ai)
#pragma unroll
            for (int m = 0; m < 4; ++m) { float o[8];
#pragma unroll
                for (int n = 0; n < 2; ++n)
#pragma unroll
                    for (int j = 0; j < 4; ++j) { const float gate = fminf(acc[ai][0][m][n][j] + bgt[n][j], 7.0f); const float up = fminf(fmaxf(acc[ai][1][m][n][j] + bup[n][j], -7.0f), 7.0f);
                        o[4 * n + j] = (up + 1.0f) * gate * fsigmoid(1.702f * gate); }
                *(u32x4*)(ACT + (size_t)(row0 + ai * 128 + m * 16) * DFF + c0) = pack8(o); }
    }
};

struct EpiIn8 {
    static constexpr bool PERM = true, I8 = true;
    bf16* Pb; bf16* Gb; float* gates; const float* bmg; const float* sA; const float* cmB;
    __device__ __forceinline__ void operator()(AccRef acc, const pg8::Unit& u, int wr, int wc, int fr, int fq) const {
        const int row0 = u.pm * 256 + wr * 64 + fr, cb0 = u.pn * 256 + wc * 32 + 8 * fq;
        f32x4 sw[2][2];
#pragma unroll
        for (int bj = 0; bj < 2; ++bj)
#pragma unroll
            for (int n = 0; n < 2; ++n) sw[bj][n] = *(const f32x4*)(cmB + cb0 + bj * 128 + 4 * n) * (1.0f / 127.0f);
        if (u.pn < 22) {
#pragma unroll
            for (int ai = 0; ai < 2; ++ai)
#pragma unroll
                for (int m = 0; m < 4; ++m) { const int row = row0 + ai * 128 + m * 16; bf16* rowp = Pb + (size_t)row * LDP + cb0; const float sa = sA[row];
#pragma unroll
                    for (int bj = 0; bj < 2; ++bj) { const f32x4 v0 = i2f4(acc[ai][bj][m][0]) * sw[bj][0] * sa, v1 = i2f4(acc[ai][bj][m][1]) * sw[bj][1] * sa;
                        u32x4 w; w.x = cvtpk(v0[0], v0[1]); w.y = cvtpk(v0[2], v0[3]); w.z = cvtpk(v1[0], v1[1]); w.w = cvtpk(v1[2], v1[3]);
                        *(u32x4*)(rowp + bj * 128) = w;
                        if (bj == 0 && u.pn == 14 && wc == 0 && fq < 2) { float* g = gates + (size_t)row * 32 + 8 * fq; *(f32x4*)g = v0; *(f32x4*)(g + 4) = v1; }
                        if (bj == 1 && u.pn == 21 && wc == 1 && fq >= 2) { float* g = gates + (size_t)row * 32 + 16 + 8 * (fq - 2); *(f32x4*)g = v0; *(f32x4*)(g + 4) = v1; } } }
        } else {
            const int col0 = cb0 - LDP;
            f32x4 bv[2][2];
#pragma unroll
            for (int bj = 0; bj < 2; ++bj)
#pragma unroll
                for (int n = 0; n < 2; ++n) bv[bj][n] = *(const f32x4*)(bmg + col0 + bj * 128 + 4 * n);
#pragma unroll
            for (int ai = 0; ai < 2; ++ai)
#pragma unroll
                for (int m = 0; m < 4; ++m) { const int row = row0 + ai * 128 + m * 16; bf16* rowp = Gb + (size_t)row * NGATE + col0; const float sa = sA[row];
#pragma unroll
                    for (int bj = 0; bj < 2; ++bj) { f32x4 v0 = i2f4(acc[ai][bj][m][0]) * sw[bj][0] * sa + bv[bj][0], v1 = i2f4(acc[ai][bj][m][1]) * sw[bj][1] * sa + bv[bj][1];
#pragma unroll
                        for (int j = 0; j < 4; ++j) { v0[j] = fsigmoid(v0[j]); v1[j] = fsigmoid(v1[j]); }
                        u32x4 w; w.x = cvtpk(v0[0], v0[1]); w.y = cvtpk(v0[2], v0[3]); w.z = cvtpk(v1[0], v1[1]); w.w = cvtpk(v1[2], v1[3]);
                        *(u32x4*)(rowp + bj * 128) = w; } }
        }
    }
};
struct EpiMoE18 {
    static constexpr bool PERM = true, I8 = true;
    bf16* ACT; const float* bgu; const float* sA; const float* cmB;
    __device__ __forceinline__ void operator()(AccRef acc, const pg8::Unit& u, int wr, int wc, int fr, int fq) const {
        const int row0 = u.pm * 256 + wr * 64 + fr, c0 = u.pn * 128 + wc * 32 + 8 * fq;
        const float* bg = bgu + (size_t)u.aux * 2048 + c0;
        const float* cm = cmB + (size_t)u.aux * 2048 + u.pn * 256 + wc * 32 + 8 * fq;
        f32x4 bgt[2], bup[2], sg[2], su[2];
#pragma unroll
        for (int n = 0; n < 2; ++n) { bgt[n] = *(const f32x4*)(bg + 4 * n); bup[n] = *(const f32x4*)(bg + 1024 + 4 * n); sg[n] = *(const f32x4*)(cm + 4 * n) * (1.0f / 127.0f); su[n] = *(const f32x4*)(cm + 128 + 4 * n) * (1.0f / 127.0f); }
#pragma unroll
        for (int ai = 0; ai < 2; ++ai)
#pragma unroll
            for (int m = 0; m < 4; ++m) { const int row = row0 + ai * 128 + m * 16; const float sa = sA[row]; float o[8];
#pragma unroll
                for (int n = 0; n < 2; ++n) { const f32x4 ga = i2f4(acc[ai][0][m][n]) * sg[n] * sa + bgt[n], ua = i2f4(acc[ai][1][m][n]) * su[n] * sa + bup[n];
#pragma unroll
                    for (int j = 0; j < 4; ++j) { const float gate = fminf(ga[j], 7.0f); const float up = fminf(fmaxf(ua[j], -7.0f), 7.0f);
                        o[4 * n + j] = (up + 1.0f) * gate * fsigmoid(1.702f * gate); } }
                *(u32x4*)(ACT + (size_t)row * DFF + c0) = pack8(o); }
    }
};

struct AttnJob {
    const bf16* Q; int qpitch;
    const bf16* K; int kpitch;
    const bf16* VT;
    bf16* O; int opitch;
    int ntiles; float c;
    int s0_first_n, s0_jump;
    int kr_lo, r_w, c_q;
    const LAS float* bias;
};
template <int DQK, bool NA>
__device__ __forceinline__ void attn_unit(LAS unsigned char* lds, const AttnJob& J) {
    constexpr int KPB = (DQK == 96) ? 208 : 144, VPB = 136, NS = DQK / 16, KCH = DQK / 8;
    constexpr int KBUF = 64 * KPB, VBUF = 64 * VPB;
    const int tid = ltid(), wid = __builtin_amdgcn_readfirstlane(tid >> 6), lane = tid & 63, r = lane & 31, h = lane >> 5;
    LAS unsigned char* kb0 = lds; LAS unsigned char* vb0 = lds + 2 * KBUF;
    bf16x8 qf[NS];
    { const bf16* qrow = J.Q + (size_t)(wid * 32 + r) * J.qpitch + 8 * h;
#pragma unroll
      for (int s = 0; s < NS; ++s) qf[s] = *(const bf16x8*)(qrow + 16 * s); }
    f32x16 o0, o1;
#pragma unroll
    for (int i = 0; i < 16; ++i) { o0[i] = 0.f; o1[i] = 0.f; }
    float mrun = -1e30f, lsum = 0.f;
    const int k0r = tid / KCH, k0c = tid % KCH, k1r = (tid + 512) / KCH, k1c = (tid + 512) % KCH;
    const bool k1 = (tid + 512) < 64 * KCH;
    const int vd = tid >> 3, vc = tid & 7;
    u32x4 kr0, kr1, vr;
    auto s0_of = [&](int j) { return j < J.s0_first_n ? 64 * j : J.s0_jump + 64 * (j - J.s0_first_n); };
    auto gload = [&](int j) { const int s0 = s0_of(j);
        kr0 = *(const u32x4*)(J.K + (size_t)(s0 + k0r) * J.kpitch + 8 * k0c);
        if (k1) kr1 = *(const u32x4*)(J.K + (size_t)(s0 + k1r) * J.kpitch + 8 * k1c);
        vr = *(const u32x4*)(J.VT + (size_t)vd * TB + s0 + 8 * vc); };
    auto lstore = [&](int buf) {
        *(LAS u32x4*)(kb0 + buf * KBUF + k0r * KPB + 16 * k0c) = kr0;
        if (k1) *(LAS u32x4*)(kb0 + buf * KBUF + k1r * KPB + 16 * k1c) = kr1;
        LAS unsigned char* vp = vb0 + buf * VBUF + vd * VPB + 16 * vc;
        *(LAS u32x2*)vp = (u32x2){vr.x, vr.y}; *(LAS u32x2*)(vp + 8) = (u32x2){vr.z, vr.w}; };
    gload(0); lstore(0);
    __syncthreads();
    const int r0w = NA ? min(max(J.r_w - 4, 0), 120) : 0;
    const int c0 = NA ? min(max(J.c_q - 8, 0), 48) : 0;
    for (int j = 0; j < J.ntiles; ++j) {
        const int buf = j & 1;
        if (j + 1 < J.ntiles) gload(j + 1);
        bool active = true; int dr = 0;
        if (NA && j >= 4) { const int kr = J.kr_lo + j - 4; active = (kr >= r0w) && (kr < r0w + 8); dr = kr - J.r_w + 7; }
        if (active) {
            f32x16 s0v, s1v;
#pragma unroll
            for (int i = 0; i < 16; ++i) { s0v[i] = 0.f; s1v[i] = 0.f; }
            const LAS unsigned char* kp = kb0 + buf * KBUF + r * KPB + 16 * h;
#pragma unroll
            for (int s = 0; s < NS; ++s) {
                const bf16x8 a0 = *(const LAS bf16x8*)(kp + 32 * s), a1 = *(const LAS bf16x8*)(kp + 32 * KPB + 32 * s);
                s0v = __builtin_amdgcn_mfma_f32_32x32x16_bf16(a0, qf[s], s0v, 0, 0, 0);
                s1v = __builtin_amdgcn_mfma_f32_32x32x16_bf16(a1, qf[s], s1v, 0, 0, 0);
            }
            float mx;
            if (NA && j >= 4) {
                const LAS float* bp = J.bias + dr * 31 + 15 - J.c_q;
#pragma unroll
                for (int i = 0; i < 16; ++i) { const int kc = (i & 3) + 8 * (i >> 2) + 4 * h;
                    { const bool ok = (unsigned)(kc - c0) < 16u; const float bz = bp[ok ? kc : c0]; s0v[i] = ok ? s0v[i] * J.c + bz : -1e30f; }
                    { const int kc1 = kc + 32; const bool ok = (unsigned)(kc1 - c0) < 16u; const float bz = bp[ok ? kc1 : c0]; s1v[i] = ok ? s1v[i] * J.c + bz : -1e30f; } }
                mx = -1e30f;
#pragma unroll
                for (int i = 0; i < 16; ++i) mx = fmaxf(mx, fmaxf(s0v[i], s1v[i]));
                mx = fmaxf(mx, __shfl_xor(mx, 32));
            } else {
                float ma = fmaxf(s0v[0], s1v[0]), mb = fmaxf(s0v[1], s1v[1]);
#pragma unroll
                for (int i = 2; i < 16; i += 2) { ma = fmaxf(fmaxf(ma, s0v[i]), s1v[i]); mb = fmaxf(fmaxf(mb, s0v[i + 1]), s1v[i + 1]); }
                mx = fmaxf(ma, mb); mx = fmaxf(mx, __shfl_xor(mx, 32)) * J.c;
            }
            if (__any(mx > mrun + 8.0f)) {
                const float mnew = fmaxf(mrun, mx), alpha = fexp2(mrun - mnew); mrun = mnew; lsum *= alpha;
#pragma unroll
                for (int i = 0; i < 16; ++i) { o0[i] *= alpha; o1[i] *= alpha; }
            }
            float ps = 0.f;
            if (NA && j >= 4) {
#pragma unroll
                for (int i = 0; i < 16; ++i) { s0v[i] = fexp2(s0v[i] - mrun); s1v[i] = fexp2(s1v[i] - mrun); ps += s0v[i] + s1v[i]; }
            } else {
                const float nm = -mrun;
#pragma unroll
                for (int i = 0; i < 16; ++i) { s0v[i] = fexp2(__builtin_fmaf(s0v[i], J.c, nm)); s1v[i] = fexp2(__builtin_fmaf(s1v[i], J.c, nm)); ps += s0v[i] + s1v[i]; }
            }
            lsum += ps;
            bf16x8 pf[4];
#pragma unroll
            for (int st = 0; st < 4; ++st) { u32x4 w;
#pragma unroll
                for (int q = 0; q < 4; ++q) { const int i = 8 * (st & 1) + 2 * q; w[q] = (st < 2) ? cvtpk(s0v[i], s0v[i + 1]) : cvtpk(s1v[i], s1v[i + 1]); }
                pf[st] = __builtin_bit_cast(bf16x8, w); }
            const LAS unsigned char* vp = vb0 + buf * VBUF + r * VPB + 8 * h;
#pragma unroll
            for (int st = 0; st < 4; ++st) {
                const u32x2 a0l = *(const LAS u32x2*)(vp + 32 * st), a0h = *(const LAS u32x2*)(vp + 32 * st + 16);
                const u32x2 a1l = *(const LAS u32x2*)(vp + 32 * VPB + 32 * st), a1h = *(const LAS u32x2*)(vp + 32 * VPB + 32 * st + 16);
                const bf16x8 va0 = __builtin_bit_cast(bf16x8, (u32x4){a0l.x, a0l.y, a0h.x, a0h.y}), va1 = __builtin_bit_cast(bf16x8, (u32x4){a1l.x, a1l.y, a1h.x, a1h.y});
                o0 = __builtin_amdgcn_mfma_f32_32x32x16_bf16(va0, pf[st], o0, 0, 0, 0);
                o1 = __builtin_amdgcn_mfma_f32_32x32x16_bf16(va1, pf[st], o1, 0, 0, 0);
            }
        }
        if (j + 1 < J.ntiles) lstore(buf ^ 1);
        __syncthreads();
    }
    lsum += __shfl_xor(lsum, 32);
    const float inv = frcp(lsum);
    bf16* orow = J.O + (size_t)(wid * 32 + r) * J.opitch + 4 * h;
#pragma unroll
    for (int g = 0; g < 4; ++g) {
        *(u32x2*)(orow + 8 * g) = (u32x2){cvtpk(o0[4 * g] * inv, o0[4 * g + 1] * inv), cvtpk(o0[4 * g + 2] * inv, o0[4 * g + 3] * inv)};
        *(u32x2*)(orow + 32 + 8 * g) = (u32x2){cvtpk(o1[4 * g] * inv, o1[4 * g + 1] * inv), cvtpk(o1[4 * g + 2] * inv, o1[4 * g + 3] * inv)};
    }
}

template <int DQK>
__device__ __forceinline__ void attn_unit_dense(LAS unsigned char* lds, const AttnJob& J) {
    constexpr int KPB = (DQK == 96) ? 208 : 144, VPB = 264, NS = DQK / 16, KCH = DQK / 8, NKC = 128 * KCH / 512;
    constexpr int KBUF = 128 * KPB, VBUF = 64 * VPB;
    const int tid = ltid(), wid = __builtin_amdgcn_readfirstlane(tid >> 6), lane = tid & 63, r = lane & 31, h = lane >> 5;
    LAS unsigned char* kb0 = lds; LAS unsigned char* vb0 = lds + 2 * KBUF;
    bf16x8 qf[NS];
    { const bf16* qrow = J.Q + (size_t)(wid * 32 + r) * J.qpitch + 8 * h;
#pragma unroll
      for (int s = 0; s < NS; ++s) qf[s] = *(const bf16x8*)(qrow + 16 * s); }
    f32x16 o0, o1;
#pragma unroll
    for (int i = 0; i < 16; ++i) { o0[i] = 0.f; o1[i] = 0.f; }
    float mrun = -1e30f, lsum = 0.f;
    u32x4 kr[NKC], vr[2];
    const int vd = tid >> 3, vc = tid & 7;
    auto gload = [&](int j) { const int s0 = 128 * j;
#pragma unroll
        for (int q = 0; q < NKC; ++q) { const int ch = tid + 512 * q; kr[q] = *(const u32x4*)(J.K + (size_t)(s0 + ch / KCH) * J.kpitch + 8 * (ch % KCH)); }
        vr[0] = *(const u32x4*)(J.VT + (size_t)vd * TB + s0 + 8 * vc); vr[1] = *(const u32x4*)(J.VT + (size_t)vd * TB + s0 + 64 + 8 * vc); };
    auto lstore = [&](int buf) {
#pragma unroll
        for (int q = 0; q < NKC; ++q) { const int ch = tid + 512 * q; *(LAS u32x4*)(kb0 + buf * KBUF + (ch / KCH) * KPB + 16 * (ch % KCH)) = kr[q]; }
        LAS unsigned char* vp = vb0 + buf * VBUF + vd * VPB + 16 * vc;
        *(LAS u32x2*)vp = (u32x2){vr[0].x, vr[0].y}; *(LAS u32x2*)(vp + 8) = (u32x2){vr[0].z, vr[0].w};
        *(LAS u32x2*)(vp + 128) = (u32x2){vr[1].x, vr[1].y}; *(LAS u32x2*)(vp + 136) = (u32x2){vr[1].z, vr[1].w}; };
    const int nst = J.ntiles >> 1;
    const int grp = wid >> 2;
    gload(0); lstore(0);
    __syncthreads();
    if (nst > 1) gload(1);
    if (grp == 1) LDS_BAR();
    for (int j = 0; j < nst; ++j) {
        const int buf = j & 1;
        f32x16 sv[4];
#pragma unroll
        for (int bk = 0; bk < 4; ++bk)
#pragma unroll
            for (int i = 0; i < 16; ++i) sv[bk][i] = 0.f;
        const LAS unsigned char* kp = kb0 + buf * KBUF + r * KPB + 16 * h;
        { bf16x8 ka[2][4];
#pragma unroll
          for (int bk = 0; bk < 4; ++bk) ka[0][bk] = *(const LAS bf16x8*)(kp + bk * 32 * KPB);
#pragma unroll
          for (int s = 0; s < NS; ++s) {
              if (s + 1 < NS) {
#pragma unroll
                  for (int bk = 0; bk < 4; ++bk) ka[(s + 1) & 1][bk] = *(const LAS bf16x8*)(kp + bk * 32 * KPB + 32 * (s + 1)); }
              __builtin_amdgcn_sched_barrier(0);
#pragma unroll
              for (int bk = 0; bk < 4; ++bk) sv[bk] = __builtin_amdgcn_mfma_f32_32x32x16_bf16(ka[s & 1][bk], qf[s], sv[bk], 0, 0, 0);
              __builtin_amdgcn_sched_barrier(0); } }
        if (grp == 1 && j + 1 < nst) lstore(buf ^ 1);
        LDS_BAR();
        if (grp == 1 && j + 2 < nst) gload(j + 2);
        float ma = fmaxf(sv[0][0], sv[1][0]), mb = fmaxf(sv[2][0], sv[3][0]);
#pragma unroll
        for (int i = 1; i < 16; ++i) { ma = fmaxf(fmaxf(ma, sv[0][i]), sv[1][i]); mb = fmaxf(fmaxf(mb, sv[2][i]), sv[3][i]); }
        float mx = fmaxf(ma, mb) * J.c;
        { auto rr = __builtin_amdgcn_permlane32_swap(__float_as_uint(mx), __float_as_uint(mx), false, false); mx = fmaxf(__uint_as_float(rr[0]), __uint_as_float(rr[1])); }
        if (__any(mx > mrun + 8.0f)) {
            const float mnew = fmaxf(mrun, mx), alpha = fexp2(mrun - mnew); mrun = mnew; lsum *= alpha;
#pragma unroll
            for (int i = 0; i < 16; ++i) { o0[i] *= alpha; o1[i] *= alpha; }
        }
        const float nm = -mrun; float ps = 0.f;
#pragma unroll
        for (int bk = 0; bk < 4; ++bk)
#pragma unroll
            for (int i = 0; i < 16; ++i) { sv[bk][i] = fexp2(__builtin_fmaf(sv[bk][i], J.c, nm)); ps += sv[bk][i]; }
        lsum += ps;
        const LAS unsigned char* vp = vb0 + buf * VBUF + r * VPB + 8 * h;
        { u32x2 vf[2][4];
#pragma unroll
          for (int q = 0; q < 4; ++q) vf[0][q] = *(const LAS u32x2*)(vp + (q >> 1) * 32 * VPB + 16 * (q & 1));
#pragma unroll
          for (int st = 0; st < 8; ++st) { u32x4 w;
#pragma unroll
              for (int q = 0; q < 4; ++q) { const int i = 8 * (st & 1) + 2 * q; w[q] = cvtpk(sv[st >> 1][i], sv[st >> 1][i + 1]); }
              const bf16x8 pf = __builtin_bit_cast(bf16x8, w);
              if (st + 1 < 8) {
#pragma unroll
                  for (int q = 0; q < 4; ++q) vf[(st + 1) & 1][q] = *(const LAS u32x2*)(vp + (q >> 1) * 32 * VPB + 32 * (st + 1) + 16 * (q & 1)); }
              __builtin_amdgcn_sched_barrier(0);
              const bf16x8 va0 = __builtin_bit_cast(bf16x8, (u32x4){vf[st & 1][0].x, vf[st & 1][0].y, vf[st & 1][1].x, vf[st & 1][1].y}), va1 = __builtin_bit_cast(bf16x8, (u32x4){vf[st & 1][2].x, vf[st & 1][2].y, vf[st & 1][3].x, vf[st & 1][3].y});
              o0 = __builtin_amdgcn_mfma_f32_32x32x16_bf16(va0, pf, o0, 0, 0, 0);
              o1 = __builtin_amdgcn_mfma_f32_32x32x16_bf16(va1, pf, o1, 0, 0, 0);
              __builtin_amdgcn_sched_barrier(0); } }
        if (grp == 0 && j + 1 < nst) lstore(buf ^ 1);
        LDS_BAR();
        if (grp == 0 && j + 2 < nst) gload(j + 2);
    }
    if (grp == 0) LDS_BAR();
    __syncthreads();
    { auto rr = __builtin_amdgcn_permlane32_swap(__float_as_uint(lsum), __float_as_uint(lsum), false, false); lsum = __uint_as_float(rr[0]) + __uint_as_float(rr[1]); }
    const float inv = frcp(lsum);
    bf16* orow = J.O + (size_t)(wid * 32 + r) * J.opitch + 4 * h;
#pragma unroll
    for (int g = 0; g < 4; ++g) {
        *(u32x2*)(orow + 8 * g) = (u32x2){cvtpk(o0[4 * g] * inv, o0[4 * g + 1] * inv), cvtpk(o0[4 * g + 2] * inv, o0[4 * g + 3] * inv)};
        *(u32x2*)(orow + 32 + 8 * g) = (u32x2){cvtpk(o1[4 * g] * inv, o1[4 * g + 1] * inv), cvtpk(o1[4 * g + 2] * inv, o1[4 * g + 3] * inv)};
    }
}

struct Params { const float* in[31]; float* out; unsigned char* ws; int ph_lo, ph_hi; };
typedef const __attribute__((address_space(4))) unsigned char* kaptr_t;
struct PView {
    kaptr_t ka; unsigned char* ws; float* out; int bid, G;
    struct InArr { kaptr_t ka; __device__ __forceinline__ const float* operator[](int i) const { return *(const float* const __attribute__((address_space(4)))*)(ka + 8 * i); } } in;
};
__device__ __forceinline__ PView pview() {
    kaptr_t k = (kaptr_t)__builtin_amdgcn_kernarg_segment_ptr(); asm volatile("" : "+s"(k));
    PView v; v.ka = k; v.in.ka = k; v.out = *(float* const __attribute__((address_space(4)))*)(k + 248); v.ws = *(unsigned char* const __attribute__((address_space(4)))*)(k + 256);
    int b = blockIdx.x, g = gridDim.x; asm volatile("" : "+s"(b), "+s"(g)); v.bid = b; v.G = g; return v;
}
enum { I_X = 0, I_C, I_CTX, I_CCTX, I_WADA, I_BADA, I_N1G, I_N2G, I_WIN, I_RPB, I_CONVW, I_ALOG, I_DTB, I_GNG, I_MQG, I_WUQ, I_MKVG, I_WUKV, I_BIF, I_MLG,
       I_WMG, I_BMG, I_WBO, I_WOUT, I_RW, I_RB, I_WGU, I_BGU, I_WDN, I_BDN, I_FG };

__device__ __forceinline__ void transpose_item(const float* W, int N, int k0, int n0, bf16* dst_row0, int ldd, LAS float* scr, int lane) {
#pragma unroll 8
    for (int i = 0; i < 32; ++i) { const int kk = 2 * i + (lane >> 5); scr[kk * 33 + (lane & 31)] = W[(size_t)(k0 + kk) * N + n0 + (lane & 31)]; }
    asm volatile("s_waitcnt lgkmcnt(0)" ::: "memory");
    const int c = lane & 7;
#pragma unroll
    for (int j = 0; j < 4; ++j) { const int n = (lane >> 3) + 8 * j; const LAS float* s = scr + (8 * c) * 33 + n;
        u32x4 o; o.x = cvtpk(s[0 * 33], s[1 * 33]); o.y = cvtpk(s[2 * 33], s[3 * 33]); o.z = cvtpk(s[4 * 33], s[5 * 33]); o.w = cvtpk(s[6 * 33], s[7 * 33]);
        *(u32x4*)(dst_row0 + (size_t)n * ldd + k0 + 8 * c) = o; }
    asm volatile("s_waitcnt lgkmcnt(0)" ::: "memory");
}
__device__ __forceinline__ void transpose_item8(const float* W, int N, int k0, int n0, signed char* dst_row0, int ldd, const float* cm_row0, LAS float* scr, int lane) {
#pragma unroll 8
    for (int i = 0; i < 32; ++i) { const int kk = 2 * i + (lane >> 5); scr[kk * 33 + (lane & 31)] = W[(size_t)(k0 + kk) * N + n0 + (lane & 31)]; }
    asm volatile("s_waitcnt lgkmcnt(0)" ::: "memory");
    const int c = lane & 7;
#pragma unroll
    for (int j = 0; j < 4; ++j) { const int n = (lane >> 3) + 8 * j; const LAS float* s = scr + (8 * c) * 33 + n;
        const float cm = cm_row0[n], inv = cm > 0.f ? 127.0f / cm : 0.f;
        unsigned w0 = 0u, w1 = 0u;
#pragma unroll
        for (int e = 0; e < 4; ++e) { const int q0 = (int)__builtin_rintf(s[e * 33] * inv), q1 = (int)__builtin_rintf(s[(4 + e) * 33] * inv); w0 |= ((unsigned)q0 & 0xffu) << (8 * e); w1 |= ((unsigned)q1 & 0xffu) << (8 * e); }
        *(u32x2*)(dst_row0 + (size_t)n * ldd + k0 + 8 * c) = (u32x2){w0, w1}; }
    asm volatile("s_waitcnt lgkmcnt(0)" ::: "memory");
}
struct TJob { int cnt, K, N; };
__device__ __forceinline__ void phase_prologue(const PView& p, LAS unsigned char* lds, int bid, int G) {
    const int tid = ltid(), wid = __builtin_amdgcn_readfirstlane(tid >> 6), lane = tid & 63;
    unsigned char* ws = p.ws;
    LAS float* scr = (LAS float*)(lds + wid * 16384);
    const int gw = bid * NWAVES + wid, NGW = G * NWAVES;
    constexpr int I0 = 4 * 16 * 174, I1 = 4 * 16 * 128, I2 = 16 * 8 * 32, I3 = 16 * 16 * 32, I4 = 4 * 4 * 24, I5 = 4 * 2 * 32, I6 = 128 * 16 * 64, I7 = 128 * 16 * 32;
    constexpr int NIT = I0 + I1 + I2 + I3 + I4 + I5 + I6 + I7;
    for (int it = gw; it < NIT; it += NGW) {
        int r = it;
        if (r < I0 + I1) continue; r -= I0 + I1;
        if (r < I2) continue; r -= I2;
        if (r < I3) { const int c = r / (16 * 32), q = r % (16 * 32), kb = q / 32, nb = q % 32, l = c >> 2, rep = c & 3;
            transpose_item(p.in[I_WOUT] + (size_t)l * 1024 * 1024, 1024, 64 * kb, 32 * nb, (bf16*)(ws + OFF_WOUT4) + ((size_t)l * 1024 + 32 * nb) * 4096 + rep * 1024, 4096, scr, lane); continue; } r -= I3;
        if (r < I4) { const int l = r / (4 * 24), q = r % (4 * 24), kb = q / 24, nb = q % 24;
            transpose_item(p.in[I_WUQ] + (size_t)l * 256 * 768, 768, 64 * kb, 32 * nb, (bf16*)(ws + OFF_WUQKV) + ((size_t)l * 1792 + 32 * nb) * 384, 384, scr, lane); continue; } r -= I4;
        if (r < I5) { const int l = r / (2 * 32), q = r % (2 * 32), kb = q / 32, nb = q % 32;
            transpose_item(p.in[I_WUKV] + (size_t)l * 128 * 1024, 1024, 64 * kb, 32 * nb, (bf16*)(ws + OFF_WUQKV) + ((size_t)l * 1792 + 768 + 32 * nb) * 384 + 256, 384, scr, lane); continue; } r -= I5;
        if (r < I6) { continue; } r -= I6;
        { const int c = r / (16 * 32), q = r % (16 * 32), kb = q / 32, nb = q % 32;
            transpose_item(p.in[I_WDN] + (size_t)c * 1024 * 1024, 1024, 64 * kb, 32 * nb, (bf16*)(ws + OFF_WDN) + ((size_t)c * 1024 + 32 * nb) * 1024, 1024, scr, lane); }
    }
    { const int gt = bid * NTHR + tid, NT_ = G * NTHR;
      for (int i = gt; i < 4 * 64 * 64; i += NT_) { const int l = i / (64 * 64), q = i % (64 * 64), rr = q / 64, cc = q % 64;
          *(u32x4*)((signed char*)(ws + OFF_WIN) + ((size_t)l * NIN + DIN + rr) * 1024 + 16 * cc) = (u32x4){0u, 0u, 0u, 0u}; }
      for (int i = gt; i < 4 * 64; i += NT_) ((float*)(ws + OFF_CMIN))[(size_t)(i >> 6) * NIN + DIN + (i & 63)] = 0.f;
      for (int i = gt; i < 4 * 768 * 16; i += NT_) { const int l = i / (768 * 16), q = i % (768 * 16), rr = q / 16, cc = q % 16;
          *(u32x4*)((bf16*)(ws + OFF_WUQKV) + ((size_t)l * 1792 + rr) * 384 + 256 + 8 * cc) = (u32x4){0u, 0u, 0u, 0u}; }
      for (int i = gt; i < 4 * 1024 * 32; i += NT_) { const int l = i / (1024 * 32), q = i % (1024 * 32), rr = q / 32, cc = q % 32;
          *(u32x4*)((bf16*)(ws + OFF_WUQKV) + ((size_t)l * 1792 + 768 + rr) * 384 + 8 * cc) = (u32x4){0u, 0u, 0u, 0u}; } }
    __syncthreads();
    { LAS float* sc = (LAS float*)lds;
      for (int i = tid; i < 5 * 1024; i += NTHR) { const float v = (i < 4096) ? p.in[I_C][i] : p.in[I_CCTX][i - 4096]; sc[i] = v * fsigmoid(v); }
      LAS float* part = (LAS float*)(lds + 32768);
      __syncthreads();
      for (int item = bid; item < 4 * 96; item += G) { const int l = item / 96, cb = item % 96, col = cb * 64 + lane;
          const float* w = p.in[I_WADA] + (size_t)l * 1024 * 6144 + col;
          float a0 = 0.f, a1 = 0.f, a2 = 0.f, a3 = 0.f, a4 = 0.f;
#pragma unroll 8
          for (int k = wid * 128; k < wid * 128 + 128; ++k) { const float wv = w[(size_t)k * 6144];
              a0 += sc[k] * wv; a1 += sc[1024 + k] * wv; a2 += sc[2048 + k] * wv; a3 += sc[3072 + k] * wv; a4 += sc[4096 + k] * wv; }
          LAS float* pp = part + (wid * 64 + lane) * 5; pp[0] = a0; pp[1] = a1; pp[2] = a2; pp[3] = a3; pp[4] = a4;
          __syncthreads();
          if (tid < 320) { const int c = tid % 64, rr = tid / 64; float s = 0.f;
#pragma unroll
              for (int w8 = 0; w8 < 8; ++w8) s += part[(w8 * 64 + c) * 5 + rr];
              ((float*)(ws + OFF_MOD))[((size_t)l * 5 + rr) * 6144 + cb * 64 + c] = s + p.in[I_BADA][l * 6144 + cb * 64 + c]; }
          __syncthreads(); } }
    { LAS float* part = (LAS float*)(lds + 65536);
      LAS unsigned char* t8 = lds;
      constexpr int NI0 = 4 * 174, NI1 = 4 * 128, NI2 = 128 * 64, NI3 = 16 * 32;
      const int n = lane & 31, k2 = lane >> 5;
      for (int item = bid; item < NI3; item += G) { const int c = item >> 5, cb = item & 31, n0 = 32 * cb;
          const float* w = p.in[I_WBO] + (size_t)c * 512 * 1024; float* cmd = (float*)(ws + OFF_CMBO) + (size_t)c * 1024; signed char* dst = (signed char*)(ws + OFF_WBO) + (size_t)c * 1024 * 512;
          float x[8][4]; float m = 0.f;
#pragma unroll
          for (int i = 0; i < 8; ++i)
#pragma unroll
              for (int e = 0; e < 4; ++e) { x[i][e] = w[(size_t)(64 * i + 8 * wid + 4 * k2 + e) * 1024 + n0 + n]; m = fmaxf(m, fabsf(x[i][e])); }
          part[(wid * 2 + k2) * 32 + n] = m;
          __syncthreads();
          if (tid < 32) { float mm = part[tid];
#pragma unroll
              for (int q = 1; q < 16; ++q) mm = fmaxf(mm, part[q * 32 + tid]);
              part[512 + tid] = mm; cmd[n0 + tid] = mm; }
          __syncthreads();
          { const float cm = part[512 + n], inv = cm > 0.f ? 127.0f / cm : 0.f;
#pragma unroll
            for (int i = 0; i < 8; ++i) *(LAS unsigned*)(t8 + n * 516 + 64 * i + 8 * wid + 4 * k2) = q8x4((f32x4){x[i][0], x[i][1], x[i][2], x[i][3]} * inv); }
          __syncthreads();
#pragma unroll
          for (int q = 0; q < 2; ++q) { const int ch = tid + 512 * q, rr = ch >> 5, cc = ch & 31; const LAS unsigned* s = (const LAS unsigned*)(t8 + rr * 516 + 16 * cc);
              *(u32x4*)(dst + (size_t)(n0 + rr) * 512 + 16 * cc) = (u32x4){s[0], s[1], s[2], s[3]}; }
          __syncthreads(); }
      for (int item = bid; item < NI0 + NI1 + NI2; item += G) {
          const float* w; int N, n0; float* cmd; signed char* dst; int drow0;
          if (item < NI0) { const int l = item / 174, cb = item % 174; N = DIN; n0 = 32 * cb; w = p.in[I_WIN] + (size_t)l * 1024 * DIN; drow0 = n0; cmd = (float*)(ws + OFF_CMIN) + (size_t)l * NIN; dst = (signed char*)(ws + OFF_WIN) + (size_t)l * NIN * 1024; }
          else if (item < NI0 + NI1) { const int r = item - NI0, l = r / 128, cb = r % 128; N = NGATE; n0 = 32 * cb; w = p.in[I_WMG] + (size_t)l * 1024 * NGATE; drow0 = LDP + n0; cmd = (float*)(ws + OFF_CMIN) + (size_t)l * NIN; dst = (signed char*)(ws + OFF_WIN) + (size_t)l * NIN * 1024; }
          else { const int r = item - NI0 - NI1, c = r / 64, cb = r % 64; N = 2048; n0 = 32 * cb; w = p.in[I_WGU] + (size_t)c * 1024 * 2048; const int j = n0 & 1023; drow0 = (j >> 7) * 256 + ((n0 >= 1024) ? 128 : 0) + (j & 127);
                 cmd = (float*)(ws + OFF_CMGU) + (size_t)c * 2048; dst = (signed char*)(ws + OFF_WGU) + (size_t)c * 2048 * 1024; }
          float x[16][4]; float m = 0.f;
#pragma unroll
          for (int i = 0; i < 16; ++i)
#pragma unroll
              for (int e = 0; e < 4; ++e) { x[i][e] = w[(size_t)(64 * i + 8 * wid + 4 * k2 + e) * N + n0 + n]; }
#pragma unroll
          for (int i = 0; i < 16; ++i)
#pragma unroll
              for (int e = 0; e < 4; ++e) m = fmaxf(m, fabsf(x[i][e]));
          part[(wid * 2 + k2) * 32 + n] = m;
          __syncthreads();
          if (tid < 32) { float mm = part[tid];
#pragma unroll
              for (int q = 1; q < 16; ++q) mm = fmaxf(mm, part[q * 32 + tid]);
              part[512 + tid] = mm; cmd[drow0 + tid] = mm; }
          __syncthreads();
          { const float cm = part[512 + n], inv = cm > 0.f ? 127.0f / cm : 0.f;
#pragma unroll
            for (int i = 0; i < 16; ++i) *(LAS unsigned*)(t8 + n * 1028 + 64 * i + 8 * wid + 4 * k2) = q8x4((f32x4){x[i][0], x[i][1], x[i][2], x[i][3]} * inv); }
          __syncthreads();
#pragma unroll
          for (int q = 0; q < 4; ++q) { const int ch = tid + 512 * q, rr = ch >> 6, cc = ch & 63; const LAS unsigned* s = (const LAS unsigned*)(t8 + rr * 1028 + 16 * cc);
              *(u32x4*)(dst + (size_t)(drow0 + rr) * 1024 + 16 * cc) = (u32x4){s[0], s[1], s[2], s[3]}; }
          __syncthreads(); } }
}

__device__ __forceinline__ int tok_mv(int tk) { const int b = tk / TB, s = tk - b * TB; return s < CTX ? 4 : b; }
template <int MODE>
__device__ __forceinline__ void phase_norm1(const PView& p, int l, int bid, int G, bool dummy = false) {
    const int tid = ltid(), wid = __builtin_amdgcn_readfirstlane(tid >> 6), lane = tid & 63;
    unsigned char* ws = p.ws;
    float* X = (float*)(ws + OFF_X); signed char* H8 = (signed char*)(ws + OFF_H); float* SH = (float*)(ws + OFF_SH);
    float* Xw = dummy ? (float*)(ws + OFF_GF) : X;
    const float* MOD = (const float*)(ws + OFF_MOD);
    const bf16* YS = (const bf16*)(ws + OFF_R3);
    const float* TW = (const float*)(ws + OFF_TOPW); const int* SL = (const int*)(ws + OFF_SLOT);
    for (int tp = bid * NWAVES + wid; tp < T / 2; tp += G * NWAVES) {
        const int tk0 = 2 * tp, b = tk0 / TB, s = tk0 - b * TB, mv = s < CTX ? 4 : b;
        if (MODE == 2 && s < CTX) continue;
        f32x4 v[2][4];
        if (l == 0) { const float* src = (s < CTX) ? p.in[I_CTX] + ((size_t)b * CTX + s) * D : p.in[I_X] + ((size_t)b * SEQ + (s - CTX)) * D;
#pragma unroll
            for (int u = 0; u < 2; ++u)
#pragma unroll
                for (int j = 0; j < 4; ++j) v[u][j] = *(const f32x4*)(src + u * D + 256 * j + 4 * lane);
        } else {
            float w[2][4]; int sl[2][4];
#pragma unroll
            for (int u = 0; u < 2; ++u)
#pragma unroll
                for (int k = 0; k < 4; ++k) { w[u][k] = TW[(tk0 + u) * 4 + k]; sl[u][k] = SL[(tk0 + u) * 4 + k]; }
#pragma unroll
            for (int u = 0; u < 2; ++u)
#pragma unroll
                for (int j = 0; j < 4; ++j) v[u][j] = *(const f32x4*)(X + (size_t)(tk0 + u) * D + 256 * j + 4 * lane);
            u32x2 y[2][4][4];
#pragma unroll
            for (int u = 0; u < 2; ++u)
#pragma unroll
                for (int k = 0; k < 4; ++k)
#pragma unroll
                    for (int j = 0; j < 4; ++j) y[u][k][j] = *(const u32x2*)(YS + (size_t)sl[u][k] * D + 256 * j + 4 * lane);
            const float* g2 = MOD + ((size_t)(l - 1) * 5 + mv) * 6144 + 5120;
#pragma unroll
            for (int j = 0; j < 4; ++j) { const f32x4 g2v = *(const f32x4*)(g2 + 256 * j + 4 * lane);
#pragma unroll
                for (int u = 0; u < 2; ++u) { f32x4 f = (f32x4){0.f, 0.f, 0.f, 0.f};
#pragma unroll
                    for (int k = 0; k < 4; ++k) f += w[u][k] * (f32x4){bflo(y[u][k][j].x), bfhi(y[u][k][j].x), bflo(y[u][k][j].y), bfhi(y[u][k][j].y)};
                    v[u][j] += g2v * f; } }
        }
        if (MODE != 2) {
#pragma unroll
            for (int u = 0; u < 2; ++u)
#pragma unroll
                for (int j = 0; j < 4; ++j) *(f32x4*)(Xw + (size_t)(tk0 + u) * D + 256 * j + 4 * lane) = v[u][j];
        }
        float rstd[2];
#pragma unroll
        for (int u = 0; u < 2; ++u) { float ss = 0.f;
#pragma unroll
            for (int j = 0; j < 4; ++j) ss += v[u][j].x * v[u][j].x + v[u][j].y * v[u][j].y + v[u][j].z * v[u][j].z + v[u][j].w * v[u][j].w;
            rstd[u] = __builtin_amdgcn_rsqf(wave_sum(ss) * (1.f / D) + 1e-6f); }
        if (MODE == 2) {
            float* o = p.out + ((size_t)b * SEQ + (s - CTX)) * D;
#pragma unroll
            for (int j = 0; j < 4; ++j) { const f32x4 g = *(const f32x4*)(p.in[I_FG] + 256 * j + 4 * lane);
#pragma unroll
                for (int u = 0; u < 2; ++u) *(f32x4*)(o + u * D + 256 * j + 4 * lane) = v[u][j] * rstd[u] * g; }
        } else {
            const float* ng = p.in[I_N1G] + l * D; const float* md = MOD + ((size_t)l * 5 + mv) * 6144;
            float am[2] = {0.f, 0.f};
#pragma unroll
            for (int j = 0; j < 4; ++j) { const int c = 256 * j + 4 * lane; const f32x4 g = *(const f32x4*)(ng + c), sh = *(const f32x4*)(md + c), sc = *(const f32x4*)(md + 1024 + c);
#pragma unroll
                for (int u = 0; u < 2; ++u) { v[u][j] = v[u][j] * rstd[u] * g * (sc + 1.0f) + sh;
                    am[u] = fmaxf(am[u], fmaxf(fmaxf(fabsf(v[u][j].x), fabsf(v[u][j].y)), fmaxf(fabsf(v[u][j].z), fabsf(v[u][j].w)))); } }
#pragma unroll
            for (int u = 0; u < 2; ++u) { const float amax = wave_max(am[u]), inv = amax > 0.f ? 127.0f / amax : 0.f;
                if (lane == 0) SH[tk0 + u] = amax * (1.0f / 127.0f);
#pragma unroll
                for (int j = 0; j < 4; ++j) *(unsigned*)(H8 + (size_t)(tk0 + u) * D + 256 * j + 4 * lane) = q8x4(v[u][j] * inv); }
        }
    }
}

__device__ __forceinline__ void phase_router(const PView& p, int l, LAS unsigned char* lds, int bid, int G, bool dummy = false) {
    const int tid = ltid(), wid = __builtin_amdgcn_readfirstlane(tid >> 6), lane = tid & 63;
    unsigned char* ws = p.ws;
    const float* X = (const float*)(ws + OFF_X); signed char* H8 = (signed char*)(ws + OFF_H); float* SH = (float*)(ws + OFF_SH);
    const float* MOD = (const float*)(ws + OFF_MOD);
    float* TW = (float*)(ws + OFF_TOPW); int* TE = (int*)(ws + OFF_TOPE); int* PS = (int*)(ws + OFF_POS);
    unsigned* gcnt = (unsigned*)(ws + OFF_CTL) + CW_CNT + l * 32 + (dummy ? 1024 : 0);
    LAS float* rw = (LAS float*)lds;
    LAS int* hist = (LAS int*)(lds + MISC_OFF + 64);
    LAS int* base = hist + 32;
    LAS int* lrec = base + 32;
    { const float* rg = p.in[I_RW] + (size_t)l * 1024 * 32;
      for (int i = tid; i < 1024 * 32; i += NTHR) rw[(i & 31) * 1024 + (i >> 5)] = rg[i]; }
    constexpr int TPB = 132;
    for (int item = bid; item < T / TPB; item += G) {
        if (tid < 32) hist[tid] = 0;
        __syncthreads();
        for (int tp = wid; tp < TPB / 2; tp += NWAVES) {
            const int ti0 = 2 * tp, tk0 = item * TPB + ti0, mv = tok_mv(tk0);
            f32x4 hv[2][4];
            const float* ng = p.in[I_N2G] + l * D; const float* md = MOD + ((size_t)l * 5 + mv) * 6144;
#pragma unroll
            for (int t2 = 0; t2 < 2; ++t2) { const int tk = tk0 + t2;
                f32x4 v[4]; float ss = 0.f;
#pragma unroll
                for (int j = 0; j < 4; ++j) { v[j] = *(const f32x4*)(X + (size_t)tk * D + 256 * j + 4 * lane); ss += v[j].x * v[j].x + v[j].y * v[j].y + v[j].z * v[j].z + v[j].w * v[j].w; }
                const float rstd = __builtin_amdgcn_rsqf(wave_sum(ss) * (1.f / D) + 1e-6f);
                float am = 0.f;
#pragma unroll
                for (int j = 0; j < 4; ++j) { const int c = 256 * j + 4 * lane; const f32x4 g = *(const f32x4*)(ng + c), sh = *(const f32x4*)(md + 3072 + c), sc = *(const f32x4*)(md + 4096 + c);
                    hv[t2][j] = v[j] * rstd * g * (sc + 1.0f) + sh;
                    am = fmaxf(am, fmaxf(fmaxf(fabsf(hv[t2][j].x), fabsf(hv[t2][j].y)), fmaxf(fabsf(hv[t2][j].z), fabsf(hv[t2][j].w)))); }
                { const float amax = wave_max(am), inv = amax > 0.f ? 127.0f / amax : 0.f;
                  if (lane == 0) SH[tk] = amax * (1.0f / 127.0f);
#pragma unroll
                  for (int j = 0; j < 4; ++j) *(unsigned*)(H8 + (size_t)tk * D + 256 * j + 4 * lane) = q8x4(hv[t2][j] * inv); }
                }
            float A16[2][16];
#pragma unroll
            for (int cq = 0; cq < 4; ++cq) { float acc[2][8];
#pragma unroll
                for (int q = 0; q < 8; ++q) { acc[0][q] = 0.f; acc[1][q] = 0.f; }
#pragma unroll
                for (int j = 0; j < 4; ++j) { const int c = 256 * j + 4 * lane;
#pragma unroll
                    for (int q = 0; q < 8; ++q) { const int e = 4 * cq + (q & 3) + 16 * (q >> 2); const f32x4 w = *(const LAS f32x4*)(rw + e * 1024 + c);
                        acc[0][q] += hv[0][j].x * w.x + hv[0][j].y * w.y + hv[0][j].z * w.z + hv[0][j].w * w.w;
                        acc[1][q] += hv[1][j].x * w.x + hv[1][j].y * w.y + hv[1][j].z * w.z + hv[1][j].w * w.w; } }
#pragma unroll
                for (int t2 = 0; t2 < 2; ++t2)
#pragma unroll
                    for (int q = 0; q < 4; ++q) { auto rr = __builtin_amdgcn_permlane32_swap(__float_as_uint(acc[t2][q]), __float_as_uint(acc[t2][q + 4]), false, false); A16[t2][4 * cq + q] = __uint_as_float(rr[0]) + __uint_as_float(rr[1]); }
                asm volatile("" ::: "memory"); }
            const int myE = lane >> 1; const float rbias = p.in[I_RB][l * 32 + myE];
            const bool b3 = (lane & 8) != 0, b2 = (lane & 4) != 0, b1 = (lane & 2) != 0;
#pragma unroll
            for (int t2 = 0; t2 < 2; ++t2) {
                float B8[8], C4[4], D2[2];
#pragma unroll
                for (int e = 0; e < 8; ++e) { auto rr = __builtin_amdgcn_permlane16_swap(__float_as_uint(A16[t2][e]), __float_as_uint(A16[t2][e + 8]), false, false); B8[e] = __uint_as_float(rr[0]) + __uint_as_float(rr[1]); }
#pragma unroll
                for (int e = 0; e < 4; ++e) { const float keep = b3 ? B8[e + 4] : B8[e], send = b3 ? B8[e] : B8[e + 4]; C4[e] = keep + dppf<0x140>(send); }
#pragma unroll
                for (int e = 0; e < 2; ++e) { const float keep = b2 ? C4[e + 2] : C4[e], send = b2 ? C4[e] : C4[e + 2]; D2[e] = keep + dppf<0x141>(send); }
                float v; { const float keep = b1 ? D2[1] : D2[0], send = b1 ? D2[0] : D2[1]; v = keep + dppf<0x1B>(send); }
                v += dppf<0xB1>(v); v += rbias;
                int cnt = 0;
#pragma unroll
                for (int e = 0; e < 32; ++e) { const float s = __int_as_float(__builtin_amdgcn_readlane(__float_as_int(v), 2 * e)); cnt += ((s > v) || (s == v && e < myE)) ? 1 : 0; }
                const bool sel = (cnt < 4) && ((lane & 1) == 0);
                const unsigned long long top = __ballot(sel && cnt == 0);
                const float m0 = __int_as_float(__builtin_amdgcn_readlane(__float_as_int(v), (int)__builtin_ctzll(top)));
                const float ex = sel ? fexp(v - m0) : 0.f;
                float tot = row16_sum(ex); { auto rr = __builtin_amdgcn_permlane16_swap(__float_as_uint(tot), __float_as_uint(tot), false, false); tot = __uint_as_float(rr[0]) + __uint_as_float(rr[1]); }
                { auto rr = __builtin_amdgcn_permlane32_swap(__float_as_uint(tot), __float_as_uint(tot), false, false); tot = __uint_as_float(rr[0]) + __uint_as_float(rr[1]); }
                if (sel) { const int tk = tk0 + t2, ti = ti0 + t2;
                    TW[tk * 4 + cnt] = ex / tot; TE[tk * 4 + cnt] = myE;
                    const int rk = atomicAdd((int*)&hist[myE], 1); lrec[ti * 4 + cnt] = (myE << 16) | rk; }
            }
        }
        __syncthreads();
        if (tid < 32) base[tid] = (int)__hip_atomic_fetch_add(gcnt + tid, (unsigned)hist[tid], __ATOMIC_RELAXED, __HIP_MEMORY_SCOPE_AGENT);
        __syncthreads();
        for (int i = tid; i < TPB * 4; i += NTHR) { const int rec = lrec[i]; PS[(size_t)item * TPB * 4 + i] = base[rec >> 16] + (rec & 0xffff); }
        __syncthreads();
    }
}

__device__ __forceinline__ void phase_gather(const PView& p, int l, LAS unsigned char* lds, int bid, int G) {
    const int tid = ltid(), wid = __builtin_amdgcn_readfirstlane(tid >> 6), lane = tid & 63;
    unsigned char* ws = p.ws;
    const unsigned* gcnt = (const unsigned*)(ws + OFF_CTL) + CW_CNT + l * 32;
    int* tst = (int*)(ws + OFF_CTL) + CW_TST + l * 64;
    LAS int* off = (LAS int*)(lds + MISC_OFF + 64);
    if (tid == 0) { int acc = 0; for (int e = 0; e < 32; ++e) { off[e] = acc * 256; if (bid == 0) tst[e] = acc; acc += ((int)gcnt[e] + 255) >> 8; } if (bid == 0) tst[32] = acc; }
    __syncthreads();
    const signed char* H8 = (const signed char*)(ws + OFF_H); signed char* XG = (signed char*)(ws + OFF_R1); const float* SH = (const float*)(ws + OFF_SH); float* SX = (float*)(ws + OFF_SX);
    const int* TE = (const int*)(ws + OFF_TOPE); const int* PS = (const int*)(ws + OFF_POS); int* SL = (int*)(ws + OFF_SLOT);
    for (int tk = bid * NWAVES + wid; tk < T; tk += G * NWAVES) {
        int dst[4];
#pragma unroll
        for (int k = 0; k < 4; ++k) dst[k] = off[TE[tk * 4 + k]] + PS[tk * 4 + k];
        const u32x4 r0 = ((const u32x4*)(H8 + (size_t)tk * D))[lane]; const float sc = SH[tk];
        if (lane < 4) { const int d = dst[0] * (lane == 0) + dst[1] * (lane == 1) + dst[2] * (lane == 2) + dst[3] * (lane == 3); SL[tk * 4 + lane] = d; SX[d] = sc; }
#pragma unroll
        for (int k = 0; k < 4; ++k) ((u32x4*)(XG + (size_t)dst[k] * D))[lane] = r0;
    }
}

template <class SrcFn>
__device__ __forceinline__ void transpose64x128(LAS unsigned char* lds, int tid, SrcFn srcp, bf16* dst_hd0  ) {
    LAS bf16* tl = (LAS bf16*)lds;
#pragma unroll
    for (int q = 0; q < 2; ++q) { const int ch = tid + 512 * q, ti = ch >> 4, cc = ch & 15; *(LAS u32x4*)(tl + ti * 136 + 8 * cc) = *(const u32x4*)srcp(ti, cc); }
    __syncthreads();
#pragma unroll
    for (int q = 0; q < 2; ++q) { const int hd = tid & 127, c8 = (tid >> 7) + 4 * q; unsigned w[4];
#pragma unroll
        for (int e = 0; e < 4; ++e) { const unsigned lo = tl[(8 * c8 + 2 * e) * 136 + hd], hi = tl[(8 * c8 + 2 * e + 1) * 136 + hd]; w[e] = lo | (hi << 16); }
        *(u32x4*)(dst_hd0 + (size_t)hd * TB + 8 * c8) = (u32x4){w[0], w[1], w[2], w[3]}; }
    __syncthreads();
}
__device__ __forceinline__ void phase_prep(const PView& p, int l, LAS unsigned char* lds, int bid, int G) {
    const int tid = ltid(), wid = __builtin_amdgcn_readfirstlane(tid >> 6), lane = tid & 63;
    unsigned char* ws = p.ws;
    const bf16* P = (const bf16*)(ws + OFF_R1);
    bf16* GQ = (bf16*)(ws + OFF_GQKV); const float* GT = (const float*)(ws + OFF_GATES);
    bf16* AQ = (bf16*)(ws + OFF_AQ); bf16* VTN = (bf16*)(ws + OFF_VTN);
    const float* cw = p.in[I_CONVW] + (size_t)l * 3 * 1536;
    { const int NT_ = G * NTHR, NCH = T * 192;
      for (int ch0 = bid * NTHR + tid; ch0 < NCH; ch0 += 4 * NT_) {
          u32x4 r0[4], rm[4], rp[4];
#pragma unroll
          for (int u = 0; u < 4; ++u) { const int ch = ch0 + u * NT_;
              if (ch < NCH) { const int tk = ch / 192, cc = ch - tk * 192, b = tk / TB, s = tk - b * TB; const bool c_ = s < CTX; const int lo = c_ ? 0 : CTX, hi = c_ ? CTX : TB;
                  const bf16* pr = P + (size_t)tk * LDP + PC_GQKV + 8 * cc;
                  r0[u] = *(const u32x4*)pr;
                  rm[u] = (s - 1 >= lo) ? *(const u32x4*)(pr - LDP) : (u32x4){0u, 0u, 0u, 0u};
                  rp[u] = (s + 1 < hi) ? *(const u32x4*)(pr + LDP) : (u32x4){0u, 0u, 0u, 0u}; } }
#pragma unroll
          for (int u = 0; u < 4; ++u) { const int ch = ch0 + u * NT_;
              if (ch < NCH) { const int tk = ch / 192, cc = ch - tk * 192;
                  float xm[8], x0[8], xp[8]; unpack8(r0[u], x0); unpack8(rm[u], xm); unpack8(rp[u], xp);
                  float y[8]; float ss = 0.f;
#pragma unroll
                  for (int i = 0; i < 8; ++i) { const int c = 8 * cc + i; const float z = xm[i] * cw[c] + x0[i] * cw[1536 + c] + xp[i] * cw[3072 + c]; y[i] = z * fsigmoid(z); ss += y[i] * y[i]; }
                  ss = row16_sum(ss);
                  if (cc < 128) { const float sc = __builtin_amdgcn_rsqf(ss + 1e-6f) * ((cc < 64) ? 0.08838834764831845f : 1.0f);
#pragma unroll
                      for (int i = 0; i < 8; ++i) y[i] *= sc; }
                  *(u32x4*)(GQ + (size_t)tk * 1536 + 8 * cc) = pack8(y); } } } }
    { float* GC = (float*)(ws + OFF_GC); float* MC = (float*)(ws + OFF_MC);
      for (int it = (wid * 64 + lane) * G + bid; it < (T / 64) * 16; it += G * NTHR) {
          const int tile = it >> 4, sq = it & 15, dh = sq & 7, d = dh >> 2, hh = dh & 3, tk0 = tile * 64;
          const bool isg = sq < 8;
          const float c0_ = isg ? p.in[I_DTB][l * 8 + dh] : p.in[I_BIF][((l * 2 + d) * 2 + 1) * 4 + hh];
          const float c1_ = isg ? -__expf(p.in[I_ALOG][l * 8 + dh]) : p.in[I_BIF][((l * 2 + d) * 2 + 0) * 4 + hh];
          float run = 0.f;
#pragma unroll 8
          for (int n = 0; n < 64; ++n) { const int tk = tk0 + (d ? 63 - n : n); const float* g = GT + (size_t)tk * 32;
              if (isg) { const float a = g[dh] + c0_; const float sp = (a > 20.f) ? a : __logf(1.0f + __expf(a)); run += c1_ * sp;
                  GC[(size_t)tk * 24 + dh] = run; GC[(size_t)tk * 24 + 8 + dh] = fsigmoid(g[8 + dh]); }
              else { const float y = -(g[24 + dh] + c0_); run -= (y > 20.f) ? y : __logf(1.0f + __expf(y));
                  MC[(size_t)tk * 16 + dh] = run; MC[(size_t)tk * 16 + 8 + dh] = g[16 + dh] + c1_; } } } }
    for (int tk = bid * NWAVES + wid; tk < T; tk += G * NWAVES) {
        float x[8]; float ss = 0.f;
        if (lane < 48) { unpack8(*(const u32x4*)(P + (size_t)tk * LDP + PC_MQ + 8 * lane), x); for (int i = 0; i < 8; ++i) ss += x[i] * x[i]; }
        else { for (int i = 0; i < 8; ++i) x[i] = 0.f; }
        ss = row16_sum(ss); { auto rr = __builtin_amdgcn_permlane16_swap(__float_as_uint(ss), __float_as_uint(ss), false, false); ss = __uint_as_float(rr[0]) + __uint_as_float(rr[1]); }
        if (lane < 48) { const bool isq = lane < 32; const float rs = __builtin_amdgcn_rsqf(ss * (isq ? (1.f / 256.f) : (1.f / 128.f)) + 1e-6f);
            const float* g = isq ? p.in[I_MQG] + l * 256 + 8 * lane : p.in[I_MKVG] + l * 128 + 8 * (lane - 32);
#pragma unroll
            for (int i = 0; i < 8; ++i) x[i] *= rs * g[i];
            *(u32x4*)(AQ + (size_t)tk * 384 + 8 * lane) = pack8(x); } }
    for (int it = bid; it < (T / 64) * 4; it += G) { const int tile = it >> 2, hp = it & 3, tk0 = tile * 64, b = tk0 / TB, s0 = tk0 - b * TB;
        transpose64x128(lds, tid, [&](int ti, int cc) { return P + (size_t)(tk0 + ti) * LDP + PC_NAV + hp * 128 + 8 * cc; }, VTN + ((size_t)b * 512 + hp * 128) * TB + s0); }
}

__device__ __forceinline__ void rope16(float (&x)[16], float pos) {
#pragma unroll
    for (int i = 0; i < 8; ++i) { const float inv = fexp2(-1.6609640474436813f * (float)i);
        const float rev = pos * inv * 0.15915494309189535f; const float fr = rev - floorf(rev);
        const float sn = __builtin_amdgcn_sinf(fr), cs = __builtin_amdgcn_cosf(fr);
        const float a = x[i], bb = x[i + 8]; x[i] = a * cs - bb * sn; x[i + 8] = bb * cs + a * sn; }
}
__device__ __forceinline__ void phase_mlapost(const PView& p, int l, LAS unsigned char* lds, int bid, int G, bool dummy = false) {
    const int tid = ltid();
    unsigned char* ws = p.ws;
    const bf16* P = (const bf16*)(ws + OFF_R1); bf16* QR = (bf16*)(ws + OFF_QKVR); bf16* KM = (bf16*)(ws + OFF_KM); bf16* VTM = (bf16*)(ws + OFF_VTM);
    const int gt = bid * NTHR + tid, NT_ = G * NTHR;
    for (int it = gt; it < NB * SEQ * 16; it += NT_) { const int tl_ = it >> 4, hh = (it >> 1) & 7, g = it & 1, b = tl_ / SEQ, t = tl_ - b * SEQ; const size_t tk = (size_t)b * TB + CTX + t;
        bf16* q = QR + tk * 1792 + hh * 96 + 64 + 16 * g;
        float x[16]; { float a[8], c[8]; unpack8(*(const u32x4*)q, a); unpack8(*(const u32x4*)(q + 8), c); for (int i = 0; i < 8; ++i) { x[i] = a[i]; x[8 + i] = c[i]; } }
        rope16(x, (float)(g == 0 ? (t >> 6) : (t & 63)));
        float a[8], c[8]; for (int i = 0; i < 8; ++i) { a[i] = x[i]; c[i] = x[8 + i]; }
        bf16* qo = dummy ? (bf16*)(ws + OFF_GF) + tk * 1792 + hh * 96 + 64 + 16 * g : q;
        *(u32x4*)qo = pack8(a); *(u32x4*)(qo + 8) = pack8(c); }
    for (int it = gt; it < T * 96; it += NT_) { const int tk = it / 96, q = it - tk * 96, hh = q / 12, cc = q - hh * 12, b = tk / TB, s = tk - b * TB;
        bf16* dst = KM + (((size_t)b * 8 + hh) * TB + s) * 96 + 8 * cc;
        if (cc < 8) { *(u32x4*)dst = *(const u32x4*)(QR + (size_t)tk * 1792 + 768 + hh * 128 + 8 * cc); }
        else { const int g = (cc - 8) >> 1, hf = (cc - 8) & 1;
            const bf16* sp = P + (size_t)tk * LDP + PC_MKPE + 16 * g;
            float x[16]; { float a[8], c[8]; unpack8(*(const u32x4*)sp, a); unpack8(*(const u32x4*)(sp + 8), c); for (int i = 0; i < 8; ++i) { x[i] = a[i]; x[8 + i] = c[i]; } }
            if (s >= CTX) { const int t = s - CTX; rope16(x, (float)(g == 0 ? (t >> 6) : (t & 63))); }
            float o[8]; for (int i = 0; i < 8; ++i) o[i] = x[8 * hf + i];
            *(u32x4*)dst = pack8(o); } }
    for (int it = bid; it < (T / 64) * 4; it += G) { const int tile = it >> 2, hp = it & 3, tk0 = tile * 64, b = tk0 / TB, s0 = tk0 - b * TB;
        transpose64x128(lds, tid, [&](int ti, int cc) { return QR + (size_t)(tk0 + ti) * 1792 + 768 + (2 * hp + (cc >> 3)) * 128 + 64 + 8 * (cc & 7); }, VTM + ((size_t)b * 512 + hp * 128) * TB + s0); }
}

__device__ __forceinline__ void phase_attn(const PView& p, int l, LAS unsigned char* lds, int bid, int G) {
    const int tid = ltid(), wid = __builtin_amdgcn_readfirstlane(tid >> 6), lane = tid & 63;
    unsigned char* ws = p.ws;
    const bf16* P = (const bf16*)(ws + OFF_R1); const bf16* QR = (const bf16*)(ws + OFF_QKVR); const bf16* KM = (const bf16*)(ws + OFF_KM);
    const bf16* VTM = (const bf16*)(ws + OFF_VTM); const bf16* VTN = (const bf16*)(ws + OFF_VTN); bf16* Y = (bf16*)(ws + OFF_Y);
    LAS float* btab = (LAS float*)(lds + 90112);
    for (int i = tid; i < 8 * 465; i += NTHR) btab[i] = p.in[I_RPB][(size_t)l * 8 * 465 + i] * 1.4426950408889634f;
    __syncthreads();
    const float c_mla = 0.10206207261596577f * 1.4426950408889634f, c_na = 0.125f * 1.4426950408889634f;
    for (int u = bid; u < 2112; u += G) {
        AttnJob J; J.bias = btab; J.kr_lo = 0; J.r_w = 0; J.c_q = 0; J.s0_first_n = 1 << 30; J.s0_jump = 0;
        if (u < 1024) {
            const int b = u >> 8, hh = u & 7, qb = (u >> 3) & 31; const size_t tq = (size_t)b * TB + CTX + qb * 256;
            J.Q = QR + tq * 1792 + hh * 96; J.qpitch = 1792; J.K = KM + ((size_t)b * 8 + hh) * TB * 96; J.kpitch = 96; J.VT = VTM + ((size_t)b * 8 + hh) * 64 * TB;
            J.O = Y + tq * 2048 + 1024 + hh * 64; J.opitch = 2048; J.ntiles = TB / 64; J.c = c_mla;
            attn_unit_dense<96>(lds, J);
        } else if (u < 2048) {
            const int v = u - 1024, b = v >> 8, hh = v & 7, rq = (v >> 3) & 31; const size_t tq = (size_t)b * TB + CTX + rq * 256;
            const int kr_lo = min(max(4 * rq - 4, 0), 120), kr_hi = min(max(4 * rq + 3 - 4, 0), 120) + 7;
            J.Q = P + tq * LDP + PC_NAQ + hh * 64; J.qpitch = LDP; J.K = P + (size_t)b * TB * LDP + PC_NAK + hh * 64; J.kpitch = LDP; J.VT = VTN + ((size_t)b * 8 + hh) * 64 * TB;
            J.O = Y + tq * 2048 + hh * 64; J.opitch = 2048; J.ntiles = 4 + (kr_hi - kr_lo + 1); J.c = c_na;
            J.s0_first_n = 4; J.s0_jump = CTX + kr_lo * 64; J.kr_lo = kr_lo; J.r_w = 4 * rq + (wid >> 1); J.c_q = 32 * (wid & 1) + (lane & 31); J.bias = btab + hh * 465;
            attn_unit<64, true>(lds, J);
        } else if (u < 2080) {
            const int v = u - 2048, b = v >> 3, hh = v & 7; const size_t tq = (size_t)b * TB;
            J.Q = QR + tq * 1792 + hh * 96; J.qpitch = 1792; J.K = KM + ((size_t)b * 8 + hh) * TB * 96; J.kpitch = 96; J.VT = VTM + ((size_t)b * 8 + hh) * 64 * TB;
            J.O = Y + tq * 2048 + 1024 + hh * 64; J.opitch = 2048; J.ntiles = 4; J.c = c_mla;
            attn_unit_dense<96>(lds, J);
        } else {
            const int v = u - 2080, b = v >> 3, hh = v & 7; const size_t tq = (size_t)b * TB;
            J.Q = P + tq * LDP + PC_NAQ + hh * 64; J.qpitch = LDP; J.K = P + (size_t)b * TB * LDP + PC_NAK + hh * 64; J.kpitch = LDP; J.VT = VTN + ((size_t)b * 8 + hh) * 64 * TB;
            J.O = Y + tq * 2048 + hh * 64; J.opitch = 2048; J.ntiles = 4; J.c = c_na;
            attn_unit<64, false>(lds, J);
        }
    }
}


__device__ __forceinline__ unsigned lds_u16(const LAS unsigned char* p) { return (unsigned)*(const LAS unsigned short*)p; }
__device__ __forceinline__ void mlstm_chunk_item(const PView& p, LAS unsigned char* lds, int chain, int vq) {
    const int tid = ltid(), wid = __builtin_amdgcn_readfirstlane(tid >> 6), lane = tid & 63, r = lane & 31, h = lane >> 5;
    const int b = chain >> 3, hh = (chain >> 1) & 3, dir = chain & 1, dh = dir * 4 + hh;
    unsigned char* ws = p.ws;
    const bf16* P = (const bf16*)(ws + OFF_R1); const float* MC = (const float*)(ws + OFF_MC);
    float* OM = (float*)(ws + OFF_OML) + (size_t)dir * T * 512;
    constexpr int KT = 0, QT = 9216, VT_ = 18432, FC = 23552, AO_ = FC + 256, BO_ = AO_ + 256, CHB = 24576;
    constexpr int CBO = 2 * CHB, CBS = 4608, NSO = CBO + 2 * CBS;
    for (int i = tid; i < (2 * CBS + 512) / 4; i += NTHR) ((LAS unsigned*)(lds + CBO))[i] = 0u;
    f32x16 cacc;
#pragma unroll
    for (int i = 0; i < 16; ++i) cacc[i] = 0.f;
    const int srow = tid >> 3, sc8 = tid & 7, vrow = tid >> 2, vc = tid & 3;
    struct Stg { u32x4 k, q, v; float fc, ip, fm, vfc, vip; };
    Stg sA, sB; sA.fc = sA.ip = sA.fm = sA.vfc = sA.vip = 0.f; sB = sA;
    auto s0_of = [&](int c) { return (dir == 0) ? 64 * c : (c < 4 ? 192 - 64 * c : TB - 64 - 64 * (c - 4)); };
    auto gload = [&](Stg& g, int c) { const size_t tk0 = (size_t)b * TB + s0_of(c);
        const size_t tkr = tk0 + (dir ? 63 - srow : srow);
        g.k = *(const u32x4*)(P + tkr * LDP + PC_LK + hh * 64 + 8 * sc8); g.q = *(const u32x4*)(P + tkr * LDP + PC_LQ + hh * 64 + 8 * sc8);
        g.fm = MC[(tk0 + (dir ? 32 : 31)) * 16 + dh];
        if (tid < 256) { const size_t tkv = tk0 + (dir ? 63 - vrow : vrow); g.v = *(const u32x4*)(P + tkv * LDP + PC_LV + hh * 128 + vq * 32 + 8 * vc); g.vfc = MC[tkv * 16 + dh]; g.vip = MC[tkv * 16 + 8 + dh]; }
        if (tid < 64) { const size_t tkg = tk0 + (dir ? 63 - tid : tid); g.fc = MC[tkg * 16 + dh]; g.ip = MC[tkg * 16 + 8 + dh]; } };
    auto lstore = [&](const Stg& g, int nb) { LAS unsigned char* cb = lds + nb * CHB;
        *(LAS u32x4*)(cb + KT + srow * 144 + 16 * sc8) = g.k;
        { float q8[8]; unpack8(g.q, q8);
#pragma unroll
          for (int e = 0; e < 8; ++e) q8[e] *= 0.125f;
          *(LAS u32x4*)(cb + QT + srow * 144 + 16 * sc8) = pack8(q8); }
        if (tid < 256) { float v8[8]; unpack8(g.v, v8); const float bj = __expf(g.vip - g.vfc + g.fm);
#pragma unroll
            for (int e = 0; e < 8; ++e) v8[e] *= bj;
            *(LAS u32x4*)(cb + VT_ + vrow * 80 + 16 * vc) = pack8(v8); }
        if (tid < 64) { ((LAS float*)(cb + FC))[tid] = g.fc; ((LAS float*)(cb + AO_))[tid] = __expf(g.fc - g.fm); ((LAS float*)(cb + BO_))[tid] = __expf(g.ip - g.fc + g.fm); }
        if (tid == 64) ((LAS float*)(cb + FC + 768))[0] = g.fm; };
    gload(sA, 0); lstore(sA, 0); gload(sB, 1);
    __syncthreads();
    auto compute = [&](const int c, const int cur) {
        const int nxt = cur ^ 1;
        const LAS unsigned char* cb = lds + cur * CHB;
        const LAS float* fcS = (const LAS float*)(cb + FC); const LAS float* aS = (const LAS float*)(cb + AO_); const LAS float* bS = (const LAS float*)(cb + BO_);
        const float fend = fcS[63], dec = __expf(fend), cw = __expf(fend - fcS[192]);
        if (wid < 2) {
            const int ib = wid, i = 32 * ib + r;
            bf16x8 qf[4];
#pragma unroll
            for (int s = 0; s < 4; ++s) qf[s] = *(const LAS bf16x8*)(cb + QT + i * 144 + 32 * s + 16 * h);
            f32x16 s0v, s1v, nacc, iacc;
#pragma unroll
            for (int q = 0; q < 16; ++q) { s0v[q] = 0.f; s1v[q] = 0.f; nacc[q] = 0.f; iacc[q] = 0.f; }
#pragma unroll
            for (int s = 0; s < 4; ++s) { const bf16x8 a0 = *(const LAS bf16x8*)(cb + KT + r * 144 + 32 * s + 16 * h); s0v = __builtin_amdgcn_mfma_f32_32x32x16_bf16(a0, qf[s], s0v, 0, 0, 0); }
            float den = 0.f;
            if (ib == 0) {
#pragma unroll
                for (int g4 = 0; g4 < 4; ++g4) { const f32x4 B0 = *(const LAS f32x4*)(bS + 8 * g4 + 4 * h);
#pragma unroll
                    for (int q = 0; q < 4; ++q) { const int reg = 4 * g4 + q, j0 = 8 * g4 + 4 * h + q; const float p0 = (j0 <= r) ? s0v[reg] : 0.f; s0v[reg] = p0; den += p0 * B0[q]; } }
            } else {
#pragma unroll
                for (int s = 0; s < 4; ++s) { const bf16x8 a1 = *(const LAS bf16x8*)(cb + KT + (32 + r) * 144 + 32 * s + 16 * h); s1v = __builtin_amdgcn_mfma_f32_32x32x16_bf16(a1, qf[s], s1v, 0, 0, 0); }
#pragma unroll
                for (int g4 = 0; g4 < 4; ++g4) { const f32x4 B0 = *(const LAS f32x4*)(bS + 8 * g4 + 4 * h), B1 = *(const LAS f32x4*)(bS + 32 + 8 * g4 + 4 * h);
#pragma unroll
                    for (int q = 0; q < 4; ++q) { const int reg = 4 * g4 + q, j0 = 8 * g4 + 4 * h + q; den += s0v[reg] * B0[q];
                        const float p1 = (j0 <= r) ? s1v[reg] : 0.f; s1v[reg] = p1; den += p1 * B1[q]; } }
            }
#pragma unroll
            for (int st = 0; st < 4; ++st) { if (st < 2 || ib == 1) {
                u32x4 pw;
#pragma unroll
                for (int q = 0; q < 4; ++q) { const int reg = 8 * (st & 1) + 2 * q; pw[q] = (st < 2) ? cvtpk(s0v[reg], s0v[reg + 1]) : cvtpk(s1v[reg], s1v[reg + 1]); }
                u32x4 vw;
#pragma unroll
                for (int q = 0; q < 4; ++q) { const int t0 = 16 * st + 8 * (q >> 1) + 4 * h + 2 * (q & 1);
                    vw[q] = lds_u16(cb + VT_ + t0 * 80 + 2 * r) | (lds_u16(cb + VT_ + (t0 + 1) * 80 + 2 * r) << 16); }
                nacc = __builtin_amdgcn_mfma_f32_32x32x16_bf16(__builtin_bit_cast(bf16x8, vw), __builtin_bit_cast(bf16x8, pw), nacc, 0, 0, 0); } }
            const LAS unsigned char* cbt = lds + CBO + cur * CBS; const LAS float* nS = (const LAS float*)(lds + NSO + cur * 256);
            float dint = 0.f;
#pragma unroll
            for (int s = 0; s < 4; ++s) { const bf16x8 ca = *(const LAS bf16x8*)(cbt + r * 144 + 32 * s + 16 * h); iacc = __builtin_amdgcn_mfma_f32_32x32x16_bf16(ca, qf[s], iacc, 0, 0, 0);
                float q8[8]; unpack8(__builtin_bit_cast(u32x4, qf[s]), q8); const f32x4 n0 = *(const LAS f32x4*)(nS + 16 * s + 8 * h), n1 = *(const LAS f32x4*)(nS + 16 * s + 8 * h + 4);
                dint += q8[0] * n0.x + q8[1] * n0.y + q8[2] * n0.z + q8[3] * n0.w + q8[4] * n1.x + q8[5] * n1.y + q8[6] * n1.z + q8[7] * n1.w; }
            { auto rr = __builtin_amdgcn_permlane32_swap(__float_as_uint(den), __float_as_uint(den), false, false); den = __uint_as_float(rr[0]) + __uint_as_float(rr[1]); }
            { auto rr = __builtin_amdgcn_permlane32_swap(__float_as_uint(dint), __float_as_uint(dint), false, false); dint = __uint_as_float(rr[0]) + __uint_as_float(rr[1]); }
            const float ai = aS[i], egi = __expf(fcS[i]), dtot = ai * den + egi * dint, inv = 1.0f / fmaxf(fabsf(dtot), 1.0f), ka = ai * inv, ke_ = egi * inv;
            const size_t tko = (size_t)b * TB + s0_of(c) + (dir ? 63 - i : i);
            float* op = OM + tko * 512 + hh * 128 + vq * 32 + 4 * h;
#pragma unroll
            for (int g4 = 0; g4 < 4; ++g4) { f32x4 o;
#pragma unroll
                for (int q = 0; q < 4; ++q) o[q] = nacc[4 * g4 + q] * ka + iacc[4 * g4 + q] * ke_;
                *(f32x4*)(op + 8 * g4) = o; }
        } else if (wid < 4) {
            const int cbk = wid - 2;
            f32x16 tacc;
#pragma unroll
            for (int q = 0; q < 16; ++q) tacc[q] = 0.f;
#pragma unroll
            for (int s = 0; s < 4; ++s) { const int t0 = 16 * s + 8 * h;
                u32x4 vw, kw;
#pragma unroll
                for (int q = 0; q < 4; ++q) { const int ta = t0 + 2 * q;
                    vw[q] = lds_u16(cb + VT_ + ta * 80 + 2 * r) | (lds_u16(cb + VT_ + (ta + 1) * 80 + 2 * r) << 16);
                    kw[q] = lds_u16(cb + KT + ta * 144 + 2 * (r + 32 * cbk)) | (lds_u16(cb + KT + (ta + 1) * 144 + 2 * (r + 32 * cbk)) << 16); }
                tacc = __builtin_amdgcn_mfma_f32_32x32x16_bf16(__builtin_bit_cast(bf16x8, vw), __builtin_bit_cast(bf16x8, kw), tacc, 0, 0, 0); }
            LAS unsigned char* cbn = lds + CBO + nxt * CBS;
#pragma unroll
            for (int q = 0; q < 16; ++q) { cacc[q] = dec * cacc[q] + cw * tacc[q]; const int v = (q & 3) + 8 * (q >> 2) + 4 * h; *(LAS unsigned short*)(cbn + v * 144 + 2 * (r + 32 * cbk)) = (unsigned short)(cvtpk(cacc[q], 0.f) & 0xffffu); }
        } else if (wid == 4) {
            float s0 = 0.f, s1 = 0.f;
#pragma unroll 8
            for (int j = 0; j < 64; j += 2) { s0 += bS[j] * bf2f((bf16)lds_u16(cb + KT + j * 144 + 2 * lane)); s1 += bS[j + 1] * bf2f((bf16)lds_u16(cb + KT + (j + 1) * 144 + 2 * lane)); }
            const LAS float* nc = (const LAS float*)(lds + NSO + cur * 256); LAS float* nn = (LAS float*)(lds + NSO + nxt * 256);
            nn[lane] = dec * nc[lane] + cw * (s0 + s1);
        }
    };
    for (int c = 0; c < TB / 64; c += 2) {
        gload(sA, min(c + 2, TB / 64 - 1)); compute(c, 0); lstore(sB, 1); LDS_BAR();
        gload(sB, min(c + 3, TB / 64 - 1)); compute(c + 1, 1); lstore(sA, 0); LDS_BAR();
    }
}

constexpr int GF_WM = 0, GF_QD = 16384, GF_QK = 32768, GF_KE = 40960, GF_U0 = 57344, GF_EE = 90112, GF_ITEM = 90368, NCHUNK = TB / 64;
__device__ __forceinline__ int chunk_s0(int dir, int c) { return (dir == 0) ? 64 * c : (c < 4 ? 192 - 64 * c : TB - 64 - 64 * (c - 4)); }
__device__ __forceinline__ void phase_gdnpre(const PView& p, int l, LAS unsigned char* lds, int bid, int G) {
    const int tid = ltid(), wid = __builtin_amdgcn_readfirstlane(tid >> 6), lane = tid & 63, r = lane & 31, h = lane >> 5;
    unsigned char* ws = p.ws;
    const bf16* GQ = (const bf16*)(ws + OFF_GQKV); const float* GC = (const float*)(ws + OFF_GC);
    constexpr int KO = 0, QO = 17408, VO = 34816, AO = 52224, GSO = 69632, BSO = GSO + 256, XO = 70400, UO = 87808;
    const LAS float* gS = (const LAS float*)(lds + GSO); const LAS float* bS = (const LAS float*)(lds + BSO);
    for (int it = bid; it < 32 * NCHUNK; it += G) {
        const int chain = it / NCHUNK, c = it % NCHUNK, b = chain >> 3, hh = (chain >> 1) & 3, dir = chain & 1, dh = dir * 4 + hh;
        const size_t tk0 = (size_t)b * TB + chunk_s0(dir, c);
        unsigned char* gf = ws + OFF_GF + (size_t)it * GF_ITEM;
#pragma unroll
        for (int rep = 0; rep < 6; ++rep) { const int ch = tid + 512 * rep, tile = ch >> 10, row = (ch & 1023) >> 4, c8 = ch & 15;
            const size_t tk = tk0 + (dir ? 63 - row : row);
            const int col = (tile == 0 ? 512 : (tile == 1 ? 0 : 1024)) + hh * 128 + 8 * c8;
            *(LAS u32x4*)(lds + tile * 17408 + row * 272 + 16 * c8) = *(const u32x4*)(GQ + tk * 1536 + col); }
        if (tid < 64) { const size_t tk = tk0 + (dir ? 63 - tid : tid); const float gg = GC[tk * 24 + dh], bb = GC[tk * 24 + 8 + dh];
            ((LAS float*)(lds + GSO))[tid] = gg; ((LAS float*)(lds + BSO))[tid] = bb; ((LAS float*)(lds + BSO + 256))[tid] = bb * __expf(gg); }
        __syncthreads();
        { const int w4 = wid & 3, jb = w4 >> 1, ib = w4 & 1, i = 32 * ib + r;
          f32x16 acc;
#pragma unroll
          for (int q = 0; q < 16; ++q) acc[q] = 0.f;
          const LAS unsigned char* bsrc = lds + ((wid < 4) ? KO : QO) + i * 272 + 16 * h;
#pragma unroll
          for (int s = 0; s < 8; ++s) { const bf16x8 a = *(const LAS bf16x8*)(lds + KO + (32 * jb + r) * 272 + 32 * s + 16 * h), bq = *(const LAS bf16x8*)(bsrc + 32 * s);
              acc = __builtin_amdgcn_mfma_f32_32x32x16_bf16(a, bq, acc, 0, 0, 0); }
          const float gi = gS[i], bi = bS[i];
          if (wid < 4) {
#pragma unroll
              for (int g4 = 0; g4 < 4; ++g4) { const int j0 = 32 * jb + 8 * g4 + 4 * h; const f32x4 gj = *(const LAS f32x4*)(gS + j0); f32x4 o;
#pragma unroll
                  for (int q = 0; q < 4; ++q) o[q] = (i > j0 + q) ? bi * __expf(gi - gj[q]) * acc[4 * g4 + q] : 0.f;
                  *(LAS f32x4*)(lds + AO + i * 272 + 4 * j0) = o; }
          } else {
#pragma unroll
              for (int g4 = 0; g4 < 4; ++g4) { const int j0 = 32 * jb + 8 * g4 + 4 * h; const f32x4 gj = *(const LAS f32x4*)(gS + j0);
#pragma unroll
                  for (int q = 0; q < 4; ++q) acc[4 * g4 + q] = (i >= j0 + q) ? __expf(gi - gj[q]) * acc[4 * g4 + q] : 0.f; }
#pragma unroll
              for (int s2 = 0; s2 < 2; ++s2) { u32x4 w;
#pragma unroll
                  for (int q = 0; q < 4; ++q) w[q] = cvtpk(acc[8 * s2 + 2 * q], acc[8 * s2 + 2 * q + 1]);
                  *(u32x4*)(gf + GF_QK + (size_t)((ib * 4 + 2 * jb + s2) * 64 + lane) * 16) = w; }
          } }
        __syncthreads();
        constexpr int TO = UO;
        if (wid == 0) {
            float t[32];
#pragma unroll
            for (int i = 0; i < 32; ++i) {
                float acc0 = (i == r) ? 1.0f : 0.0f, acc1 = 0.f;
#pragma unroll
                for (int j4 = 0; j4 < (i + 3) / 4; ++j4) { const f32x4 a4 = *(const LAS f32x4*)(lds + AO + (32 * h + i) * 272 + (32 * h + 4 * j4) * 4);
#pragma unroll
                    for (int q = 0; q < 4; ++q) if (4 * j4 + q < i) { if (q & 1) acc1 -= a4[q] * t[4 * j4 + q]; else acc0 -= a4[q] * t[4 * j4 + q]; } }
                t[i] = acc0 + acc1;
                *(LAS unsigned short*)(lds + TO + h * 2048 + i * 64 + 2 * r) = (unsigned short)(cvtpk(t[i], 0.f) & 0xffffu);
                if ((i & 3) == 3) asm volatile("" ::: "memory");
            }
        } else if (wid >= 4) {
            const int w4 = wid - 4; const float gend = gS[63];
#pragma unroll
            for (int k = 0; k < 4; ++k) { const int f = w4 * 4 + k, ib = f >> 3, s = f & 7, i = 32 * ib + r;
                float q8[8]; unpack8(*(const LAS u32x4*)(lds + QO + i * 272 + 32 * s + 16 * h), q8); const float e = __expf(gS[i]);
#pragma unroll
                for (int q = 0; q < 8; ++q) q8[q] *= e;
                *(u32x4*)(gf + GF_QD + (size_t)(f * 64 + lane) * 16) = pack8(q8); }
#pragma unroll
            for (int k = 0; k < 4; ++k) { const int f = w4 * 4 + k, db = f >> 2, st = f & 3, dk = 32 * db + r;
                u32x4 w;
#pragma unroll
                for (int q = 0; q < 4; ++q) { const int t0 = 16 * st + 8 * (q >> 1) + 4 * h + 2 * (q & 1);
                    const float ka = bf2f((bf16)lds_u16(lds + KO + t0 * 272 + 2 * dk)) * __expf(gend - gS[t0]), kb = bf2f((bf16)lds_u16(lds + KO + (t0 + 1) * 272 + 2 * dk)) * __expf(gend - gS[t0 + 1]);
                    w[q] = cvtpk(ka, kb); }
                *(u32x4*)(gf + GF_KE + (size_t)(f * 64 + lane) * 16) = w; }
            if (tid == 256) *(float*)(gf + GF_EE) = __expf(gend);
        }
        __syncthreads();
        { const bool isv = wid < 4; const int c = 32 * (wid & 3) + r;
          const LAS unsigned char* srcp = lds + (isv ? VO : KO) + 2 * c; const LAS float* fS = (const LAS float*)(lds + (isv ? BSO : BSO + 256));
          f32x16 x0, x1;
#pragma unroll
          for (int q = 0; q < 16; ++q) { x0[q] = 0.f; const int tok = 32 + (q & 3) + 8 * (q >> 2) + 4 * h; x1[q] = fS[tok] * bf2f((bf16)lds_u16(srcp + tok * 272)); }
#pragma unroll
          for (int s = 0; s < 2; ++s) { u32x4 rw_;
#pragma unroll
              for (int q = 0; q < 4; ++q) { const int t0 = 16 * s + 8 * h + 2 * q; rw_[q] = cvtpk(fS[t0] * bf2f((bf16)lds_u16(srcp + t0 * 272)), fS[t0 + 1] * bf2f((bf16)lds_u16(srcp + (t0 + 1) * 272))); }
              const bf16x8 ta = *(const LAS bf16x8*)(lds + TO + r * 64 + 32 * s + 16 * h);
              x0 = __builtin_amdgcn_mfma_f32_32x32x16_bf16(ta, __builtin_bit_cast(bf16x8, rw_), x0, 0, 0, 0); }
#pragma unroll
          for (int s2 = 0; s2 < 2; ++s2) { u32x4 xb, aw;
#pragma unroll
              for (int q = 0; q < 4; ++q) xb[q] = cvtpk(x0[8 * s2 + 2 * q], x0[8 * s2 + 2 * q + 1]);
              const f32x4 a0 = *(const LAS f32x4*)(lds + AO + (32 + r) * 272 + (16 * s2 + 4 * h) * 4), a1 = *(const LAS f32x4*)(lds + AO + (32 + r) * 272 + (16 * s2 + 8 + 4 * h) * 4);
              aw[0] = cvtpk(-a0.x, -a0.y); aw[1] = cvtpk(-a0.z, -a0.w); aw[2] = cvtpk(-a1.x, -a1.y); aw[3] = cvtpk(-a1.z, -a1.w);
              x1 = __builtin_amdgcn_mfma_f32_32x32x16_bf16(__builtin_bit_cast(bf16x8, aw), __builtin_bit_cast(bf16x8, xb), x1, 0, 0, 0); }
          f32x16 y1;
#pragma unroll
          for (int q = 0; q < 16; ++q) y1[q] = 0.f;
#pragma unroll
          for (int s2 = 0; s2 < 2; ++s2) { u32x4 rb;
#pragma unroll
              for (int q = 0; q < 4; ++q) rb[q] = cvtpk(x1[8 * s2 + 2 * q], x1[8 * s2 + 2 * q + 1]);
              const u32x2 t0 = *(const LAS u32x2*)(lds + TO + 2048 + r * 64 + (16 * s2 + 4 * h) * 2), t1 = *(const LAS u32x2*)(lds + TO + 2048 + r * 64 + (16 * s2 + 8 + 4 * h) * 2);
              y1 = __builtin_amdgcn_mfma_f32_32x32x16_bf16(__builtin_bit_cast(bf16x8, (u32x4){t0.x, t0.y, t1.x, t1.y}), __builtin_bit_cast(bf16x8, rb), y1, 0, 0, 0); }
          if (isv) {
              f32x4* d0 = (f32x4*)(gf + GF_U0 + (size_t)((wid * 2 + 0) * 64 + lane) * 64); f32x4* d1 = (f32x4*)(gf + GF_U0 + (size_t)((wid * 2 + 1) * 64 + lane) * 64);
#pragma unroll
              for (int q = 0; q < 4; ++q) { d0[q] = (f32x4){x0[4 * q], x0[4 * q + 1], x0[4 * q + 2], x0[4 * q + 3]}; d1[q] = (f32x4){y1[4 * q], y1[4 * q + 1], y1[4 * q + 2], y1[4 * q + 3]}; }
          } else {
              const int dk = 32 * (wid - 4) + r;
#pragma unroll
              for (int q = 0; q < 16; ++q) { const int tok = (q & 3) + 8 * (q >> 2) + 4 * h;
                  *(LAS unsigned short*)(lds + XO + tok * 272 + 2 * dk) = (unsigned short)(cvtpk(-x0[q], 0.f) & 0xffffu);
                  *(LAS unsigned short*)(lds + XO + (32 + tok) * 272 + 2 * dk) = (unsigned short)(cvtpk(-y1[q], 0.f) & 0xffffu); }
          } }
        __syncthreads();
#pragma unroll
        for (int k = 0; k < 2; ++k) { const int f = wid * 2 + k, tb = f >> 3, s = f & 7;
            *(u32x4*)(gf + GF_WM + (size_t)(f * 64 + lane) * 16) = *(const LAS u32x4*)(lds + XO + (32 * tb + r) * 272 + 32 * s + 16 * h); }
        __syncthreads();
    }
}

__device__ __forceinline__ void gdn_seq_item(const PView& p, LAS unsigned char* lds, int chain, int vq) {
    const int tid = ltid(), wid = __builtin_amdgcn_readfirstlane(tid >> 6), lane = tid & 63, r = lane & 31, h = lane >> 5;
    const int b = chain >> 3, hh = (chain >> 1) & 3, dir = chain & 1;
    unsigned char* ws = p.ws;
    const unsigned char* gfc = ws + OFF_GF + (size_t)chain * NCHUNK * GF_ITEM;
    constexpr int SBS = 8704, UFO = 17408;
    for (int i = tid; i < SBS / 4; i += NTHR) ((LAS unsigned*)lds)[i] = 0u;
    __syncthreads();
    if (wid < 2) {
        u32x4 wm[3][8]; f32x4 uu[3][4];
#define LD_A(SET, C) do { const unsigned char* gf_ = gfc + (size_t)(C) * GF_ITEM; \
            _Pragma("unroll") for (int s = 0; s < 8; ++s) wm[SET][s] = *(const u32x4*)(gf_ + GF_WM + (size_t)((wid * 8 + s) * 64 + lane) * 16); \
            const f32x4* up_ = (const f32x4*)(gf_ + GF_U0 + (size_t)((vq * 2 + wid) * 64 + lane) * 64); \
            _Pragma("unroll") for (int q = 0; q < 4; ++q) uu[SET][q] = up_[q]; } while (0)
#define ST_A(SET, C) do { const LAS unsigned char* sb_ = lds + ((C) & 1) * SBS; f32x16 acc_; \
            _Pragma("unroll") for (int q = 0; q < 4; ++q) { acc_[4 * q] = uu[SET][q].x; acc_[4 * q + 1] = uu[SET][q].y; acc_[4 * q + 2] = uu[SET][q].z; acc_[4 * q + 3] = uu[SET][q].w; } \
            _Pragma("unroll") for (int s = 0; s < 8; ++s) { const bf16x8 sf_ = *(const LAS bf16x8*)(sb_ + r * 272 + 32 * s + 16 * h); \
                acc_ = __builtin_amdgcn_mfma_f32_32x32x16_bf16(__builtin_bit_cast(bf16x8, wm[SET][s]), sf_, acc_, 0, 0, 0); } \
            _Pragma("unroll") for (int s2 = 0; s2 < 2; ++s2) { u32x4 w_; _Pragma("unroll") for (int q = 0; q < 4; ++q) w_[q] = cvtpk(acc_[8 * s2 + 2 * q], acc_[8 * s2 + 2 * q + 1]); \
                *(LAS u32x4*)(lds + UFO + ((2 * wid + s2) * 64 + lane) * 16) = w_; } \
            LDS_BAR(); LDS_BAR(); } while (0)
        LD_A(0, 0); LD_A(1, 1);
        for (int c = 0; c < NCHUNK; c += 3) { LD_A(2, c + 2); ST_A(0, c); LD_A(0, min(c + 3, NCHUNK - 1)); ST_A(1, c + 1); LD_A(1, min(c + 4, NCHUNK - 1)); ST_A(2, c + 2); }
#undef LD_A
#undef ST_A
    } else if (wid < 4) {
        const int ib = wid - 2;
        char* OGu = (char*)((float*)(ws + OFF_OGD) + (size_t)dir * T * 512 + hh * 128 + vq * 32);
        const int ostep = dir ? -2048 : 2048, ot0 = 32 * ib + 4 * h;
        u32x4 qd[3][8], qk[3][4];
#define LD_B(SET, C) do { const unsigned char* gf_ = gfc + (size_t)(C) * GF_ITEM; \
            _Pragma("unroll") for (int s = 0; s < 8; ++s) qd[SET][s] = *(const u32x4*)(gf_ + GF_QD + (size_t)((ib * 8 + s) * 64 + lane) * 16); \
            _Pragma("unroll") for (int s = 0; s < 4; ++s) qk[SET][s] = *(const u32x4*)(gf_ + GF_QK + (size_t)((ib * 4 + s) * 64 + lane) * 16); } while (0)
#define ST_B(SET, C) do { const LAS unsigned char* sb_ = lds + ((C) & 1) * SBS; f32x16 acc_; \
            _Pragma("unroll") for (int q = 0; q < 16; ++q) acc_[q] = 0.f; \
            _Pragma("unroll") for (int s = 0; s < 8; ++s) { const bf16x8 sf_ = *(const LAS bf16x8*)(sb_ + r * 272 + 32 * s + 16 * h); \
                acc_ = __builtin_amdgcn_mfma_f32_32x32x16_bf16(__builtin_bit_cast(bf16x8, qd[SET][s]), sf_, acc_, 0, 0, 0); } \
            LDS_BAR(); \
            _Pragma("unroll") for (int s = 0; s < 4; ++s) { const bf16x8 uf_ = *(const LAS bf16x8*)(lds + UFO + (s * 64 + lane) * 16); \
                acc_ = __builtin_amdgcn_mfma_f32_32x32x16_bf16(__builtin_bit_cast(bf16x8, qk[SET][s]), uf_, acc_, 0, 0, 0); } \
            const unsigned ob_ = (unsigned)(((b * TB + chunk_s0(dir, (C)) + (dir ? 63 - ot0 : ot0)) * 512 + r) * 4); \
            _Pragma("unroll") for (int q = 0; q < 16; ++q) { *(float*)(OGu + (ob_ + (unsigned)(((q & 3) + 8 * (q >> 2)) * ostep))) = acc_[q]; } \
            LDS_BAR(); } while (0)
        LD_B(0, 0); LD_B(1, 1);
        for (int c = 0; c < NCHUNK; c += 3) { LD_B(2, c + 2); ST_B(0, c); LD_B(0, min(c + 3, NCHUNK - 1)); ST_B(1, c + 1); LD_B(1, min(c + 4, NCHUNK - 1)); ST_B(2, c + 2); }
#undef LD_B
#undef ST_B
    } else {
        const int db = wid - 4;
        u32x4 ke[3][4]; float ee[3];
        f32x16 sacc;
#pragma unroll
        for (int q = 0; q < 16; ++q) sacc[q] = 0.f;
#define LD_C(SET, C) do { const unsigned char* gf_ = gfc + (size_t)(C) * GF_ITEM; \
            _Pragma("unroll") for (int s = 0; s < 4; ++s) ke[SET][s] = *(const u32x4*)(gf_ + GF_KE + (size_t)((db * 4 + s) * 64 + lane) * 16); ee[SET] = *(const float*)(gf_ + GF_EE); } while (0)
#define ST_C(SET, C) do { LAS unsigned char* sn_ = lds + (((C) & 1) ^ 1) * SBS; \
            _Pragma("unroll") for (int q = 0; q < 16; ++q) sacc[q] *= ee[SET]; \
            LDS_BAR(); \
            _Pragma("unroll") for (int s = 0; s < 4; ++s) { const bf16x8 uf_ = *(const LAS bf16x8*)(lds + UFO + (s * 64 + lane) * 16); \
                sacc = __builtin_amdgcn_mfma_f32_32x32x16_bf16(__builtin_bit_cast(bf16x8, ke[SET][s]), uf_, sacc, 0, 0, 0); } \
            _Pragma("unroll") for (int g4 = 0; g4 < 4; ++g4) *(LAS u32x2*)(sn_ + r * 272 + 2 * (32 * db + 8 * g4 + 4 * h)) = (u32x2){cvtpk(sacc[4 * g4], sacc[4 * g4 + 1]), cvtpk(sacc[4 * g4 + 2], sacc[4 * g4 + 3])}; \
            LDS_BAR(); } while (0)
        LD_C(0, 0); LD_C(1, 1);
        for (int c = 0; c < NCHUNK; c += 3) { LD_C(2, c + 2); ST_C(0, c); LD_C(0, min(c + 3, NCHUNK - 1)); ST_C(1, c + 1); LD_C(1, min(c + 4, NCHUNK - 1)); ST_C(2, c + 2); }
#undef LD_C
#undef ST_C
    }
}

__device__ __forceinline__ void phase_scan(const PView& p, int l, LAS unsigned char* lds, int bid, int G) {
    for (int wi = bid; wi < 256; wi += G) {
        const int x = wi & 7, k = wi >> 3, item = ((k >> 4) << 7) + x * 16 + (k & 15);
        const int it = item & 127, chain = it >> 2, vq = it & 3;
        if (item < 128) { for (int rp = 0; rp < NREP(53); ++rp) { gdn_seq_item(p, lds, chain, vq); __syncthreads(); } }
        else { for (int rp = 0; rp < NREP(54); ++rp) { mlstm_chunk_item(p, lds, chain, vq); __syncthreads(); } }
        __syncthreads();
    }
}

__device__ __forceinline__ void phase_scanout(const PView& p, int l, int bid, int G) {
    const int tid = ltid(), wid = __builtin_amdgcn_readfirstlane(tid >> 6), lane = tid & 63;
    unsigned char* ws = p.ws;
    const bf16* P = (const bf16*)(ws + OFF_R1); const bf16* Y = (const bf16*)(ws + OFF_Y);
    signed char* Y8 = (signed char*)(ws + OFF_Y8); float* SY = (float*)(ws + OFF_SY);
    const float* OG = (const float*)(ws + OFF_OGD); const float* OM = (const float*)(ws + OFF_OML);
    for (int tp = bid * NWAVES + wid; tp < T / 2; tp += G * NWAVES) {
        f32x4 oa[2][2][2], ob[2][2][2]; u32x4 gw[2][2], ya[2][2];
#pragma unroll
        for (int u = 0; u < 2; ++u)
#pragma unroll
            for (int which = 0; which < 2; ++which) { const int tk = 2 * tp + u;
                const float* o0 = (which ? OM : OG) + (size_t)tk * 512 + 8 * lane; const float* o1 = o0 + (size_t)T * 512;
                oa[u][which][0] = *(const f32x4*)o0; oa[u][which][1] = *(const f32x4*)(o0 + 4); ob[u][which][0] = *(const f32x4*)o1; ob[u][which][1] = *(const f32x4*)(o1 + 4);
                gw[u][which] = *(const u32x4*)(P + (size_t)tk * LDP + (which ? PC_LO : PC_GG) + 8 * lane);
                ya[u][which] = *(const u32x4*)(Y + (size_t)tk * 2048 + which * 1024 + 8 * lane); }
#pragma unroll
        for (int u = 0; u < 2; ++u)
#pragma unroll
            for (int br = 0; br < 4; ++br) { const int tk = 2 * tp + u, which = br >> 1;
                float y[8];
                if (br & 1) {
                    float x[8]; { const f32x4 a0 = oa[u][which][0], a1 = oa[u][which][1], b0 = ob[u][which][0], b1 = ob[u][which][1];
                        x[0] = a0.x + b0.x; x[1] = a0.y + b0.y; x[2] = a0.z + b0.z; x[3] = a0.w + b0.w; x[4] = a1.x + b1.x; x[5] = a1.y + b1.y; x[6] = a1.z + b1.z; x[7] = a1.w + b1.w; }
                    float ss = 0.f;
#pragma unroll
                    for (int i = 0; i < 8; ++i) ss += x[i] * x[i];
                    ss = row16_sum(ss);
                    const float rs = __builtin_amdgcn_rsqf(ss * (1.f / 128.f) + 1e-6f);
                    const float* ng = (which ? p.in[I_MLG] : p.in[I_GNG]) + l * 128 + 8 * (lane & 15);
                    float gt[8]; unpack8(gw[u][which], gt);
#pragma unroll
                    for (int i = 0; i < 8; ++i) { const float sg = fsigmoid(gt[i]); y[i] = x[i] * rs * ng[i] * (which ? sg : gt[i] * sg); }
                } else unpack8(ya[u][which], y);
                float am = 0.f;
#pragma unroll
                for (int i = 0; i < 8; ++i) am = fmaxf(am, fabsf(y[i]));
                const float amax = wave_max(am), inv = amax > 0.f ? 127.0f / amax : 0.f;
                if (lane == 0) SY[tk * 4 + br] = amax * (1.0f / 127.0f);
                *(u32x2*)(Y8 + (size_t)tk * 2048 + br * 512 + 8 * lane) = (u32x2){q8x4((f32x4){y[0], y[1], y[2], y[3]} * inv), q8x4((f32x4){y[4], y[5], y[6], y[7]} * inv)}; }
    }
}

constexpr int NPH_L = 14, PH_L0 = 1, PH_FINAL = PH_L0 + DEPTH * NPH_L, NPHASES = PH_FINAL + 1;
__global__ void __launch_bounds__(NTHR, 2) fwd_kernel(Params kp) {
    extern __shared__ __attribute__((aligned(16))) unsigned char lds_raw[];
    LAS unsigned char* lds = (LAS unsigned char*)lds_raw;
    volatile LAS unsigned* MISC = (volatile LAS unsigned*)(lds + MISC_OFF);
    const int tid = threadIdx.x;
    for (int u = tid; u < (LDS_BYTES - MISC_OFF) / 4; u += NTHR) ((LAS unsigned*)(lds + MISC_OFF))[u] = 0u;
    __syncthreads();
    const int lo = kp.ph_lo, hi = kp.ph_hi;
    XcdBarrier bar; bar.bar = (unsigned*)(kp.ws + OFF_CTL) + CW_BAR; bar.x = 0; bar.st = MISC + 8;
    if (hi - lo > 1) bar = xcd_barrier_post((unsigned*)(kp.ws + OFF_CTL) + CW_BAR, MISC + 8);
#define IN(k) (lo <= (k) && (k) < hi)
#define SEAM(k) do { if ((k) + 1 < hi) xcd_barrier(bar); } while (0)

    if (IN(0)) { const PView p = pview(); phase_prologue(p, lds, p.bid, p.G); SEAM(0); }
    for (int l = 0; l < DEPTH; ++l) {
        const int pb = PH_L0 + l * NPH_L;
        if (IN(pb + 0)) { const PView p = pview(); if (NREP(60) == 2) { phase_norm1<0>(p, l, p.bid, p.G, true); __syncthreads(); } phase_norm1<0>(p, l, p.bid, p.G); SEAM(pb + 0); }
        if (IN(pb + 1)) {
            const PView p = pview(); unsigned char* ws = p.ws;
            ProbPlain pr{(const char*)(ws + OFF_H), (const char*)(ws + OFF_WIN) + (size_t)l * NIN * 1024, 1024u, 1024u, 8};
            pg8::Order S; S.init(T / 256, NIN / 256, p.G, p.bid);
            EpiIn8 E{(bf16*)(ws + OFF_R1), (bf16*)(ws + OFF_R2), (float*)(ws + OFF_GATES), p.in[I_BMG] + (size_t)l * NGATE, (const float*)(ws + OFF_SH), (const float*)(ws + OFF_CMIN) + (size_t)l * NIN};
            for (int rp = 0; rp < NREP(1); ++rp) pg8::gemm_phase(lds, pr, S, E); SEAM(pb + 1); }
        if (IN(pb + 2)) { const PView p = pview(); if (NREP(2) == 2) { phase_prep(p, l, lds, p.bid, p.G); __syncthreads(); } phase_prep(p, l, lds, p.bid, p.G); SEAM(pb + 2); }
        if (IN(pb + 3)) {
            const PView p = pview(); unsigned char* ws = p.ws;
            ProbPlain pr{(const char*)(ws + OFF_AQ), (const char*)(ws + OFF_WUQKV) + (size_t)l * 1792 * 384 * 2, 768u, 768u, 6};
            pg8::Order S; S.init(T / 256, 7, p.G, p.bid);
            EpiStore E{(bf16*)(ws + OFF_QKVR), 1792, nullptr, 0};
            for (int rp = 0; rp < NREP(3); ++rp) pg8::gemm_phase(lds, pr, S, E); SEAM(pb + 3); }
        if (IN(pb + 4)) { const PView p = pview(); if (NREP(62) == 2) { phase_mlapost(p, l, lds, p.bid, p.G, true); __syncthreads(); } phase_mlapost(p, l, lds, p.bid, p.G); SEAM(pb + 4); }
        if (IN(pb + 5)) { for (int rp = 0; rp < NREP(50); ++rp) { const PView p = pview(); phase_attn(p, l, lds, p.bid, p.G); __syncthreads(); }
                          for (int rp = 0; rp < NREP(52); ++rp) { const PView p = pview(); phase_gdnpre(p, l, lds, p.bid, p.G); __syncthreads(); } SEAM(pb + 5); }
        if (IN(pb + 6)) { for (int rp = 0; rp < NREP(51); ++rp) { const PView p = pview(); phase_scan(p, l, lds, p.bid, p.G); __syncthreads(); } SEAM(pb + 6); }
        if (IN(pb + 7)) { const PView p = pview(); for (int rp = 0; rp < NREP(6); ++rp) phase_scanout(p, l, p.bid, p.G); SEAM(pb + 7); }
        if (IN(pb + 8)) {
            const PView p = pview(); unsigned char* ws = p.ws;
            ProbBO pr{(const char*)(ws + OFF_Y8), (const char*)(ws + OFF_WBO) + (size_t)l * 4096 * 512, 2048u, 512u, 4};
            pg8::Order S; if (l == DEPTH - 1) S.init(NB * SEQ / 256, 4, p.G, p.bid, 4, 1); else S.init(T / 256, 4, p.G, p.bid, 4);
            EpiBO E{(bf16*)(ws + OFF_R3), (const bf16*)(ws + OFF_R2), (const float*)(ws + OFF_SY), (const float*)(ws + OFF_CMBO) + (size_t)l * 4096};
            for (int rp = 0; rp < NREP(7); ++rp) pg8::gemm_phase(lds, pr, S, E); SEAM(pb + 8); }
        if (IN(pb + 9)) {
            const PView p = pview(); unsigned char* ws = p.ws;
            ProbPlain pr{(const char*)(ws + OFF_R3), (const char*)(ws + OFF_WOUT4) + (size_t)l * 1024 * 4096 * 2, 2048u, 8192u, 16};
            pg8::Order S; if (l == DEPTH - 1) S.init(NB * SEQ / 256, 4, p.G, p.bid, 1, 1); else S.init(T / 256, 4, p.G, p.bid);
            EpiOut E{(float*)(ws + OFF_X), (const float*)(ws + OFF_MOD) + (size_t)l * 5 * 6144};
            pg8::gemm_phase(lds, pr, S, E); SEAM(pb + 9); }
        if (IN(pb + 10)) { const PView p = pview(); if (NREP(61) == 2) { phase_router(p, l, lds, p.bid, p.G, true); __syncthreads(); } phase_router(p, l, lds, p.bid, p.G); SEAM(pb + 10); }
        if (IN(pb + 11)) { const PView p = pview(); for (int rp = 0; rp < NREP(10); ++rp) { phase_gather(p, l, lds, p.bid, p.G); __syncthreads(); } SEAM(pb + 11); }
        if (IN(pb + 12)) {
            const PView p = pview(); unsigned char* ws = p.ws; const int* tst = (const int*)(ws + OFF_CTL) + CW_TST + l * 64;
            ProbMoE pr{(const char*)(ws + OFF_R1), (const char*)(ws + OFF_WGU) + (size_t)l * 32 * 2048 * 1024, 1024u, 1024u, 8, tst, (size_t)2048 * 1024};
            pg8::Order S; S.init(tst[32], 8, p.G, p.bid);
            EpiMoE18 E{(bf16*)(ws + OFF_R2), p.in[I_BGU] + (size_t)l * 32 * 2048, (const float*)(ws + OFF_SX), (const float*)(ws + OFF_CMGU) + (size_t)l * 32 * 2048};
            for (int rp = 0; rp < NREP(11); ++rp) pg8::gemm_phase(lds, pr, S, E); SEAM(pb + 12); }
        if (IN(pb + 13)) {
            const PView p = pview(); unsigned char* ws = p.ws; const int* tst = (const int*)(ws + OFF_CTL) + CW_TST + l * 64;
            ProbMoE pr{(const char*)(ws + OFF_R2), (const char*)(ws + OFF_WDN) + (size_t)l * 32 * 1024 * 1024 * 2, 2048u, 2048u, 16, tst, (size_t)1024 * 1024 * 2};
            pg8::Order S; S.init(tst[32], 4, p.G, p.bid);
            EpiStore E{(bf16*)(ws + OFF_R3), 1024, p.in[I_BDN] + (size_t)l * 32 * 1024, 1024};
            for (int rp = 0; rp < NREP(12); ++rp) pg8::gemm_phase(lds, pr, S, E); SEAM(pb + 13); }
    }
    if (IN(PH_FINAL)) { const PView p = pview(); phase_norm1<2>(p, DEPTH, p.bid, p.G); }
#undef IN
#undef SEAM
}

extern "C" void kernel_launch(void* const* d_in, const int* in_sizes, int n_in, void* d_out, int out_size, void* d_ws, size_t ws_size, hipStream_t stream) {
    static int grid = 0;
    if (!grid) {
        if (n_in != 31 || ws_size < WS_END) { fprintf(stderr, "kernel_launch: expected 31 inputs and >= %zu bytes of workspace (got %d, %zu)\n", (size_t)WS_END, n_in, ws_size); grid = -1; return; }
        int dev = 0, cus = 0, per_cu = 0;
        hipGetDevice(&dev); hipDeviceGetAttribute(&cus, hipDeviceAttributeMultiprocessorCount, dev);
        hipFuncSetAttribute((const void*)fwd_kernel, hipFuncAttributeMaxDynamicSharedMemorySize, LDS_BYTES);
        hipOccupancyMaxActiveBlocksPerMultiprocessor(&per_cu, (const void*)fwd_kernel, NTHR, LDS_BYTES);
        if (per_cu < 1) fprintf(stderr, "kernel_launch: occupancy query reports %d blocks per CU\n", per_cu);
        grid = cus;
    }
    if (grid < 0) return;
    hipMemsetAsync((char*)d_ws + OFF_CTL, 0, CTL_BYTES, stream);
    Params p{};
    for (int i = 0; i < 31; ++i) p.in[i] = (const float*)d_in[i];
    p.out = (float*)d_out; p.ws = (unsigned char*)d_ws;
#if MK_N_LAUNCHES == 1
    p.ph_lo = 0; p.ph_hi = NPHASES;
    hipLaunchKernelGGL(fwd_kernel, dim3(grid), dim3(NTHR), LDS_BYTES, stream, p);
#else
    for (int ph = 0; ph < NPHASES; ++ph) { p.ph_lo = ph; p.ph_hi = ph + 1; hipLaunchKernelGGL(fwd_kernel, dim3(grid), dim3(NTHR), LDS_BYTES, stream, p); }
#endif
}
```

```cpp
#include <hip/hip_runtime.h>
#include <cstdio>
#include <cstdint>

#ifndef MK_N_LAUNCHES
#define MK_N_LAUNCHES 1
#endif

#ifndef PROBE_DUP
#define PROBE_DUP -1
#endif
#define NREP(k) ((PROBE_DUP == (k)) ? 2 : 1)
#define GAS __attribute__((address_space(1)))
#define LAS __attribute__((address_space(3)))
typedef unsigned short bf16;
typedef short bf16x8 __attribute__((ext_vector_type(8)));
typedef short s16x4 __attribute__((ext_vector_type(4)));
typedef float f32x4 __attribute__((ext_vector_type(4)));
typedef float f32x2 __attribute__((ext_vector_type(2)));
typedef float f32x16 __attribute__((ext_vector_type(16)));
typedef unsigned u32x4 __attribute__((ext_vector_type(4)));
typedef unsigned u32x2 __attribute__((ext_vector_type(2)));
typedef int i32x4 __attribute__((ext_vector_type(4)));
typedef int i32x8 __attribute__((ext_vector_type(8)));
typedef __bf16 bf16x2_t __attribute__((ext_vector_type(2)));

constexpr int D = 1024, NB = 4, SEQ = 8192, CTX = 256, TB = SEQ + CTX, T = NB * TB, DEPTH = 4;
constexpr int DIN = 5568, LDP = 5632, NGATE = 4096, NIN = LDP + NGATE;
constexpr int NE = 32, TOPK = 4, DFF = 1024;
constexpr int NSLOT = 143360;
constexpr int NWAVES = 8, NTHR = 512;
constexpr int PC_NAQ = 0, PC_NAK = 512, PC_NAV = 1024, PC_GQKV = 1536, PC_GG = 3072, PC_MQ = 3600, PC_MKV = 3856, PC_MKPE = 3984,
              PC_LQ = 4016, PC_LK = 4272, PC_LV = 4528, PC_LO = 5040;

constexpr size_t MiB = (size_t)1 << 20;
constexpr size_t OFF_CTL = 0, CTL_BYTES = 1 * MiB;
constexpr size_t OFF_MOD = 1 * MiB;
constexpr size_t OFF_X = 2 * MiB;
constexpr size_t OFF_H = 134 * MiB;
constexpr size_t OFF_SH = OFF_H + 40 * MiB;
constexpr size_t OFF_SX = 200 * MiB + 300 * MiB;
constexpr size_t OFF_R1 = 200 * MiB;
constexpr size_t OFF_R2 = 563 * MiB;
constexpr size_t OFF_R3 = 843 * MiB;
constexpr size_t OFF_GQKV = 1123 * MiB;
constexpr size_t OFF_GATES = 1222 * MiB;
constexpr size_t OFF_GDNG = 1227 * MiB;
constexpr size_t OFF_MLG = 1230 * MiB;
constexpr size_t OFF_AQ = 1233 * MiB;
constexpr size_t OFF_QKVR = 1258 * MiB;
constexpr size_t OFF_KM = 1374 * MiB;
constexpr size_t OFF_VTM = 1424 * MiB;
constexpr size_t OFF_VTN = 1457 * MiB;
constexpr size_t OFF_OGD = 1490 * MiB;
constexpr size_t OFF_OML = 1622 * MiB;
constexpr size_t OFF_Y = 1754 * MiB;
constexpr size_t OFF_TOPW = 1886 * MiB;
constexpr size_t OFF_TOPE = OFF_TOPW + 768 * 1024;
constexpr size_t OFF_POS = OFF_TOPE + 768 * 1024;
constexpr size_t OFF_SLOT = OFF_POS + 768 * 1024;
constexpr size_t OFF_WIN = 1889 * MiB;
constexpr size_t OFF_CMIN = OFF_WIN + 40 * MiB;
constexpr size_t OFF_WUQKV = 1965 * MiB;
constexpr size_t OFF_WBO = 1971 * MiB;
constexpr size_t OFF_CMBO = OFF_WBO + 10 * MiB;
constexpr size_t OFF_WOUT4 = 1987 * MiB;
constexpr size_t OFF_WGU = 2019 * MiB;
constexpr size_t OFF_CMGU = OFF_WGU + 260 * MiB;
constexpr size_t OFF_WDN = 2531 * MiB;
constexpr size_t OFF_GC = 2787 * MiB;
constexpr size_t OFF_MC = 2791 * MiB;
constexpr size_t OFF_GF = 2794 * MiB;
constexpr size_t OFF_Y8 = 3200 * MiB;
constexpr size_t OFF_SY = 3270 * MiB;
constexpr size_t WS_END = 3272 * MiB;
constexpr int CW_BAR = 4096, CW_CNT = 8192  , CW_TST = 8448  ;

constexpr int RING_BYTES = 131072, MISC_OFF = RING_BYTES, LDS_BYTES = 147456;

__device__ __forceinline__ unsigned cvtpk(float lo, float hi) { f32x2 v = {lo, hi}; bf16x2_t b = __builtin_convertvector(v, bf16x2_t); return __builtin_bit_cast(unsigned, b); }
__device__ __forceinline__ float bflo(unsigned w) { return __uint_as_float(w << 16); }
__device__ __forceinline__ float bfhi(unsigned w) { return __uint_as_float(w & 0xffff0000u); }
__device__ __forceinline__ float bf2f(bf16 b) { return __uint_as_float(((unsigned)b) << 16); }
__device__ __forceinline__ float fexp2(float x) { return __builtin_amdgcn_exp2f(x); }
__device__ __forceinline__ float fexp(float x) { return __builtin_amdgcn_exp2f(x * 1.4426950408889634f); }
__device__ __forceinline__ float frcp(float x) { return __builtin_amdgcn_rcpf(x); }
__device__ __forceinline__ float fsigmoid(float x) { return frcp(1.0f + fexp(-x)); }
__device__ __forceinline__ float wave_sum(float v) {
#pragma unroll
    for (int o = 1; o < 64; o <<= 1) v += __shfl_xor(v, o);
    return v;
}
#define LDS_BAR() do { asm volatile("s_waitcnt lgkmcnt(0)" ::: "memory"); __builtin_amdgcn_s_barrier(); asm volatile("" ::: "memory"); } while (0)
__device__ __forceinline__ int ltid() { int t = threadIdx.x; asm volatile("" : "+v"(t)); return t; }
__device__ __forceinline__ float wave_max(float v) {
#pragma unroll
    for (int o = 1; o < 64; o <<= 1) v = fmaxf(v, __shfl_xor(v, o));
    return v;
}
__device__ __forceinline__ unsigned q8x4(const f32x4 x) {
    const int a = (int)__builtin_rintf(x.x), b = (int)__builtin_rintf(x.y), c = (int)__builtin_rintf(x.z), d = (int)__builtin_rintf(x.w);
    return ((unsigned)a & 0xffu) | (((unsigned)b & 0xffu) << 8) | (((unsigned)c & 0xffu) << 16) | (((unsigned)d & 0xffu) << 24);
}
template <int CTRL> __device__ __forceinline__ float dppf(float v) { return __int_as_float(__builtin_amdgcn_update_dpp(0, __float_as_int(v), CTRL, 0xf, 0xf, true)); }
__device__ __forceinline__ float row16_sum(float v) { v += dppf<0xB1>(v); v += dppf<0x4E>(v); v += dppf<0x141>(v); v += dppf<0x140>(v); return v; }
__device__ __forceinline__ void unpack8(const u32x4 w, float (&f)[8]) { f[0] = bflo(w.x); f[1] = bfhi(w.x); f[2] = bflo(w.y); f[3] = bfhi(w.y); f[4] = bflo(w.z); f[5] = bfhi(w.z); f[6] = bflo(w.w); f[7] = bfhi(w.w); }
__device__ __forceinline__ u32x4 pack8(const float (&f)[8]) { u32x4 w; w.x = cvtpk(f[0], f[1]); w.y = cvtpk(f[2], f[3]); w.z = cvtpk(f[4], f[5]); w.w = cvtpk(f[6], f[7]); return w; }

#define XB_TMO      128
#define XB_XCNT(j)  (256  + 64 * (j))
#define XB_XSUB(j)  (1280 + 64 * (j))
#define XB_XGEN(j)  (2304 + 64 * (j))
#define XB_TOP      3328
#define XB_TOPGEN   3392
#define XCD_BAR_WORDS 3456
#define XB_SPIN_CAP (1u << 25)
__device__ __forceinline__ unsigned xb_ld(unsigned* p)              { return __hip_atomic_load(p, __ATOMIC_RELAXED, __HIP_MEMORY_SCOPE_AGENT); }
__device__ __forceinline__ unsigned xb_add(unsigned* p, unsigned v) { return __hip_atomic_fetch_add(p, v, __ATOMIC_RELAXED, __HIP_MEMORY_SCOPE_AGENT); }
__device__ __forceinline__ unsigned xb_xcc_id() { return (unsigned)__builtin_amdgcn_s_getreg((3 << 11) | 20) & 0xFu; }
#define XB_SPIN(cond, bar) do { unsigned _sp = 0; while (cond) { __builtin_amdgcn_s_sleep(1); \
    if ((++_sp & 255u) == 0u) { if (xb_ld(&(bar)[XB_TMO])) break; if (_sp > XB_SPIN_CAP) { atomicAdd(&(bar)[XB_TMO], 1u); break; } } } } while (0)
struct XcdBarrier { unsigned* bar; unsigned x; volatile LAS unsigned* st; };
__device__ __forceinline__ XcdBarrier xcd_barrier_post(unsigned* bar, volatile LAS unsigned* st) {
    XcdBarrier b; b.bar = bar; b.x = xb_xcc_id(); b.st = st;
    if (threadIdx.x == 0) (void)xb_add(&bar[XB_XCNT(b.x)], 1u);
    return b;
}
__device__ __forceinline__ void xcd_barrier_complete(unsigned* bar, unsigned x, unsigned& nloc, unsigned& nx) {
    const unsigned G = gridDim.x * gridDim.y * gridDim.z;
    unsigned sum, cnt, mine, sp = 0u;
    for (;;) {
        sum = 0u; cnt = 0u; mine = 0u;
#pragma unroll
        for (unsigned j = 0; j < 16; ++j) { const unsigned c = xb_ld(&bar[XB_XCNT(j)]); sum += c; cnt += (c > 0u) ? 1u : 0u; mine = (j == x) ? c : mine; }
        if (sum == G) break;
        __builtin_amdgcn_s_sleep(1);
        if ((++sp & 255u) == 0u) { if (xb_ld(&bar[XB_TMO])) break; if (sp > XB_SPIN_CAP) { atomicAdd(&bar[XB_TMO], 1u); break; } }
    }
    nloc = mine > 0u ? mine : 1u; nx = cnt > 0u ? cnt : 1u;
}
__device__ __forceinline__ void xcd_barrier(const XcdBarrier& b) {
    asm volatile("s_waitcnt vmcnt(0)" ::: "memory");
    __syncthreads();
    if (threadIdx.x == 0) {
        unsigned* bar = b.bar;
        __builtin_amdgcn_s_waitcnt(0);
        unsigned nloc = b.st[0], nx = b.st[1];
        if (nloc == 0u) { xcd_barrier_complete(bar, b.x, nloc, nx); b.st[0] = nloc; b.st[1] = nx; }
        const unsigned old = xb_add(&bar[XB_XSUB(b.x)], 1u);
        const unsigned gen = old / nloc;
        if (old + 1u == (gen + 1u) * nloc) {
            __builtin_amdgcn_fence(__ATOMIC_RELEASE, "agent");
            asm volatile("s_waitcnt vmcnt(0)" ::: "memory");
            const unsigned og = xb_add(&bar[XB_TOP], 1u);
            const unsigned tg = og / nx;
            if (og + 1u == (tg + 1u) * nx) xb_add(&bar[XB_TOPGEN], 1u);
            else XB_SPIN(xb_ld(&bar[XB_TOPGEN]) == tg, bar);
            __builtin_amdgcn_fence(__ATOMIC_ACQUIRE, "agent");
            xb_add(&bar[XB_XGEN(b.x)], 1u);
            asm volatile("s_waitcnt vmcnt(0)" ::: "memory");
        } else {
            XB_SPIN(xb_ld(&bar[XB_XGEN(b.x)]) == gen, bar);
            __builtin_amdgcn_fence(__ATOMIC_ACQUIRE, "agent");
            asm volatile("s_waitcnt vmcnt(0)" ::: "memory");
        }
    }
    __syncthreads();
}

namespace pg8 {
constexpr int BM = 256, BK = 64, HALF = 128, HTB = HALF * BK * 2, STAGE_BYTES = 8 * HTB, NXCD = 8, WGM = 8;
__device__ __forceinline__ int lds_byte(int r, int c) { const int st = (r >> 4) * 2 + (c >> 5), rr = r & 15, cc = c & 31, ob = rr * 64 + cc * 2; return st * 1024 + (ob ^ (((ob >> 9) & 1) << 5)); }
__device__ __forceinline__ void stage_rc(int b, int& R, int& C) { const int st = b / 1024, sb = b % 1024, swz = sb ^ (((sb >> 9) & 1) << 5); R = (st >> 1) * 16 + swz / 64; C = (st & 1) * 32 + (swz % 64) / 2; }
__device__ __forceinline__ int perm32(int rho) { const int n = rho >> 4, i = rho & 15; return 8 * (i >> 2) + 4 * n + (i & 3); }
struct Unit { int pm, pn, aux; };
struct Order {
    int nM, nN, nwg, G, c, br, skipctx;
    __device__ void init(int nM_, int nN_, int G_, int c_, int br_ = 1, int skipctx_ = 0) { nM = nM_; nN = nN_; nwg = nM * nN; G = G_; c = c_; br = br_; skipctx = skipctx_; }
    __device__ bool next(int i, Unit& u) const {
        const int it = i / br, ia = i - it * br;
        const long L = (long)it * G + c; if (L >= nwg) return false;
        int wgid = (int)L; { const int q = nwg / NXCD, r = nwg % NXCD, xcd = wgid % NXCD, off = wgid / NXCD; wgid = (xcd < r ? xcd * (q + 1) : r * (q + 1) + (xcd - r) * q) + off; }
        const int nig = WGM * nN, gid = wgid / nig, fm = gid * WGM, gsz = (nM - fm) < WGM ? (nM - fm) : WGM;
        u.pm = fm + ((wgid % nig) % gsz); u.pn = (wgid % nig) / gsz + ia * nN; u.aux = ia;
        if (skipctx) u.pm += (u.pm >> 5) + 1;
        return true;
    }
};
template <class Prob, class Epi>
__device__ __forceinline__ void gemm_phase(LAS unsigned char* lds, const Prob& P, const Order& S, const Epi& E) {
    const int tid = ltid(), wid = __builtin_amdgcn_readfirstlane(tid >> 6), lane = tid & 63, wr = wid >> 2, wc = wid & 3, fr = lane & 15, fq = lane >> 4;
    const int nt = P.nt;
    unsigned voffA[2], voffB[2];
#pragma unroll
    for (int i = 0; i < 2; ++i) { int R, C; stage_rc(tid * 16 + i * 8192, R, C); const int Rb = Epi::PERM ? ((R & ~31) + perm32(R & 31)) : R;
        voffA[i] = (unsigned)R * P.lda + (unsigned)C * 2u; voffB[i] = (unsigned)Rb * P.ldb + (unsigned)C * 2u; }
    const size_t kstep = (size_t)(BK * 2);
    const size_t hA = (size_t)HALF * P.lda, hB = (size_t)HALF * P.ldb;
    const unsigned ldsw = (unsigned)wid * 1024u;
    const int aoff = lds_byte(wr * 64 + fr, fq * 8), boff = lds_byte(wc * 32 + fr, fq * 8);
#define PG8_SA(b, h) (((b) * 2 + (h)) * HTB)
#define PG8_SB(b, h) ((4 + (b) * 2 + (h)) * HTB)
#define PG8_STAGE(bufoff, gbase, voff) do { _Pragma("unroll") for (int _i = 0; _i < 2; ++_i) \
        __builtin_amdgcn_global_load_lds((const unsigned*)((const char*)(gbase) + (voff)[_i]), (LAS unsigned*)(lds + (bufoff) + ldsw + _i * 8192), 16, 0, 0); } while (0)
#define PG8_LDA(dst, b, h) do { _Pragma("unroll") for (int m = 0; m < 4; ++m) { \
        if constexpr (Epi::F8) { const i32x4 lo_ = *(const LAS i32x4*)(lds + PG8_SA(b, h) + aoff + m * 2048), hi_ = *(const LAS i32x4*)(lds + PG8_SA(b, h) + aoff + m * 2048 + 1024); \
            dst##8[m] = __builtin_shufflevector(lo_, hi_, 0, 1, 2, 3, 4, 5, 6, 7); } \
        else { _Pragma("unroll") for (int k = 0; k < 2; ++k) dst[m][k] = *(const LAS bf16x8*)(lds + PG8_SA(b, h) + aoff + m * 2048 + k * 1024); } } } while (0)
#define PG8_LDB(dst, b, h) do { _Pragma("unroll") for (int n = 0; n < 2; ++n) { \
        if constexpr (Epi::F8) { const i32x4 lo_ = *(const LAS i32x4*)(lds + PG8_SB(b, h) + boff + n * 2048), hi_ = *(const LAS i32x4*)(lds + PG8_SB(b, h) + boff + n * 2048 + 1024); \
            dst##8[n] = __builtin_shufflevector(lo_, hi_, 0, 1, 2, 3, 4, 5, 6, 7); } \
        else { _Pragma("unroll") for (int k = 0; k < 2; ++k) dst[n][k] = *(const LAS bf16x8*)(lds + PG8_SB(b, h) + boff + n * 2048 + k * 1024); } } } while (0)
#define PG8_MMA(ai, bj, At, Bt) do { __builtin_amdgcn_s_setprio(1); _Pragma("unroll") for (int m = 0; m < 4; ++m) _Pragma("unroll") for (int n = 0; n < 2; ++n) { \
        if constexpr (Epi::F8) asm volatile("v_mfma_scale_f32_16x16x128_f8f6f4 %0, %1, %2, %0, %3, %3 op_sel_hi:[0,0,0]" : "+v"(acc[ai][bj][m][n]) : "v"(Bt##8[n]), "v"(At##8[m]), "v"(f8scale));   \
        else { _Pragma("unroll") for (int k = 0; k < 2; ++k) { \
        if constexpr (Epi::I8) acc[ai][bj][m][n] = __builtin_bit_cast(f32x4, __builtin_amdgcn_mfma_i32_16x16x64_i8(__builtin_bit_cast(i32x4, Bt[n][k]), __builtin_bit_cast(i32x4, At[m][k]), __builtin_bit_cast(i32x4, acc[ai][bj][m][n]), 0, 0, 0)); \
        else acc[ai][bj][m][n] = __builtin_amdgcn_mfma_f32_16x16x32_bf16(Bt[n][k], At[m][k], acc[ai][bj][m][n], 0, 0, 0); } } } __builtin_amdgcn_s_setprio(0); } while (0)
#define PG8_WAIT_V(n) asm volatile("s_waitcnt vmcnt(" #n ")" ::: "memory")
#define PG8_WAIT_L(n) asm volatile("s_waitcnt lgkmcnt(" #n ")" ::: "memory")
#define PG8_BAR __builtin_amdgcn_s_barrier()
#define PG8_SCHED __builtin_amdgcn_sched_barrier(0)
    Unit cur, nxt; int ui = 0;
    if (!S.next(0, cur)) return;
    f32x4 acc[2][2][4][2];
#pragma unroll
    for (int a = 0; a < 2; ++a)
#pragma unroll
        for (int b = 0; b < 2; ++b)
#pragma unroll
            for (int m = 0; m < 4; ++m)
#pragma unroll
                for (int n = 0; n < 2; ++n) acc[a][b][m][n] = (f32x4){0.f, 0.f, 0.f, 0.f};
    bf16x8 At[4][2], B0[2][2], B1[2][2];
    const int f8scale = 0x7f7f7f7f;
    i32x8 At8[4], B08[2], B18[2];
    const char* cA; const char* cB; P.setup(cur, cA, cB);
    PG8_STAGE(PG8_SB(0, 0), cB, voffB); PG8_STAGE(PG8_SB(0, 1), cB + hB, voffB); PG8_STAGE(PG8_SA(0, 0), cA, voffA); PG8_STAGE(PG8_SA(0, 1), cA + hA, voffA);
    if (wr == 1) PG8_BAR;
    PG8_WAIT_V(2); PG8_BAR;
    PG8_STAGE(PG8_SB(1, 0), cB + kstep, voffB); PG8_STAGE(PG8_SA(1, 0), cA + kstep, voffA); PG8_STAGE(PG8_SB(1, 1), cB + hB + kstep, voffB);
    PG8_WAIT_V(6); PG8_BAR;
    for (;;) {
        const bool has_next = S.next(ui + 1, nxt);
        const char* nA = cA; const char* nB = cB;
        if (has_next) P.setup(nxt, nA, nB);
        for (int t = 0; t < nt; t += 2) {
            const bool last = (t == nt - 2);
            const char* a1 = cA + (size_t)(t + 1) * kstep;
            const char* a2 = last ? nA : cA + (size_t)(t + 2) * kstep; const char* b2 = last ? nB : cB + (size_t)(t + 2) * kstep;
            const char* a3 = a2 + kstep; const char* b3 = b2 + kstep;
            PG8_LDB(B0, 0, 0); PG8_LDB(B1, 0, 1); PG8_SCHED; PG8_LDA(At, 0, 0); PG8_STAGE(PG8_SA(1, 1), a1 + hA, voffA);
            PG8_WAIT_V(8); PG8_WAIT_L(0); PG8_BAR; PG8_MMA(0, 0, At, B0); PG8_MMA(0, 1, At, B1); PG8_BAR; PG8_SCHED;
            PG8_LDA(At, 0, 1); PG8_STAGE(PG8_SB(0, 0), b2, voffB); PG8_STAGE(PG8_SB(0, 1), b2 + hB, voffB); PG8_STAGE(PG8_SA(0, 0), a2, voffA);
            PG8_WAIT_V(8); PG8_WAIT_L(0); PG8_BAR; PG8_MMA(1, 0, At, B0); PG8_MMA(1, 1, At, B1); PG8_BAR; PG8_SCHED;
            PG8_LDB(B0, 1, 0); PG8_LDB(B1, 1, 1); PG8_SCHED; PG8_LDA(At, 1, 0); PG8_STAGE(PG8_SA(0, 1), a2 + hA, voffA);
            PG8_WAIT_V(8); PG8_WAIT_L(0); PG8_BAR; PG8_MMA(0, 0, At, B0); PG8_MMA(0, 1, At, B1); PG8_BAR; PG8_SCHED;
            PG8_LDA(At, 1, 1); PG8_STAGE(PG8_SB(1, 0), b3, voffB); PG8_STAGE(PG8_SB(1, 1), b3 + hB, voffB); PG8_STAGE(PG8_SA(1, 0), a3, voffA);
            PG8_WAIT_V(8); PG8_WAIT_L(0); PG8_BAR; PG8_MMA(1, 0, At, B0); PG8_MMA(1, 1, At, B1); PG8_BAR; PG8_SCHED;
        }
        if (wr == 0) PG8_BAR;
        if constexpr (Epi::F8) asm volatile("s_nop 15\n\ts_nop 7" ::: "memory");
        E(acc, cur, wr, wc, fr, fq);
        if (!has_next) break;
#pragma unroll
        for (int a = 0; a < 2; ++a)
#pragma unroll
            for (int b = 0; b < 2; ++b)
#pragma unroll
                for (int m = 0; m < 4; ++m)
#pragma unroll
                    for (int n = 0; n < 2; ++n) acc[a][b][m][n] = (f32x4){0.f, 0.f, 0.f, 0.f};
        cur = nxt; cA = nA; cB = nB; ++ui;
        if (wr == 1) PG8_BAR;
    }
    PG8_WAIT_V(0);
    PG8_BAR;
#undef PG8_SA
#undef PG8_SB
#undef PG8_STAGE
#undef PG8_LDA
#undef PG8_LDB
#undef PG8_MMA
#undef PG8_WAIT_V
#undef PG8_WAIT_L
#undef PG8_BAR
#undef PG8_SCHED
}
}

struct ProbPlain { const char* A; const char* B; unsigned lda, ldb; int nt;
    __device__ __forceinline__ void setup(pg8::Unit& u, const char*& a, const char*& b) const { a = A + (size_t)u.pm * 256 * lda; b = B + (size_t)u.pn * 256 * ldb; } };
struct ProbBO { const char* A; const char* B; unsigned lda, ldb; int nt;
    __device__ __forceinline__ void setup(pg8::Unit& u, const char*& a, const char*& b) const { a = A + (size_t)u.pm * 256 * lda + (size_t)(u.pn >> 2) * 512; b = B + (size_t)u.pn * 256 * ldb; } };
struct ProbMoE { const char* A; const char* B; unsigned lda, ldb; int nt; const int* tstart; size_t bstride;
    __device__ __forceinline__ void setup(pg8::Unit& u, const char*& a, const char*& b) const {
        int e = 0;
#pragma unroll 1
        for (int j = 1; j < NE; ++j) e += (u.pm >= tstart[j]) ? 1 : 0;
        u.aux = e; a = A + (size_t)u.pm * 256 * lda; b = B + (size_t)e * bstride + (size_t)u.pn * 256 * ldb; } };

__device__ __forceinline__ f32x4 i2f4(const f32x4 a) { const i32x4 i = __builtin_bit_cast(i32x4, a); return (f32x4){(float)i.x, (float)i.y, (float)i.z, (float)i.w}; }
typedef const f32x4 (&AccRef)[2][2][4][2];
struct EpiIn {
    static constexpr bool PERM = true, I8 = false, F8 = false;
    bf16* Pb; bf16* Gb; float* gates; const float* bmg;
    __device__ __forceinline__ void operator()(AccRef acc, const pg8::Unit& u, int wr, int wc, int fr, int fq) const {
        const int row0 = u.pm * 256 + wr * 64 + fr;
        if (u.pn < 22) {
            const int col0 = u.pn * 256 + wc * 32 + 8 * fq;
#pragma unroll
            for (int ai = 0; ai < 2; ++ai)
#pragma unroll
                for (int m = 0; m < 4; ++m) { const int row = row0 + ai * 128 + m * 16; bf16* rowp = Pb + (size_t)row * LDP + col0;
#pragma unroll
                    for (int bj = 0; bj < 2; ++bj) { const f32x4 v0 = acc[ai][bj][m][0], v1 = acc[ai][bj][m][1];
                        u32x4 w; w.x = cvtpk(v0[0], v0[1]); w.y = cvtpk(v0[2], v0[3]); w.z = cvtpk(v1[0], v1[1]); w.w = cvtpk(v1[2], v1[3]);
                        *(u32x4*)(rowp + bj * 128) = w;
                        if (bj == 0 && u.pn == 14 && wc == 0 && fq < 2) { float* g = gates + (size_t)row * 32 + 8 * fq; *(f32x4*)g = v0; *(f32x4*)(g + 4) = v1; }
                        if (bj == 1 && u.pn == 21 && wc == 1 && fq >= 2) { float* g = gates + (size_t)row * 32 + 16 + 8 * (fq - 2); *(f32x4*)g = v0; *(f32x4*)(g + 4) = v1; } } }
        } else {
            const int col0 = (u.pn - 22) * 256 + wc * 32 + 8 * fq;
            f32x4 bv[2][2];
#pragma unroll
            for (int bj = 0; bj < 2; ++bj)
#pragma unroll
                for (int n = 0; n < 2; ++n) bv[bj][n] = *(const f32x4*)(bmg + col0 + bj * 128 + 4 * n);
#pragma unroll
            for (int ai = 0; ai < 2; ++ai)
#pragma unroll
                for (int m = 0; m < 4; ++m) { bf16* rowp = Gb + (size_t)(row0 + ai * 128 + m * 16) * NGATE + col0;
#pragma unroll
                    for (int bj = 0; bj < 2; ++bj) { f32x4 v0 = acc[ai][bj][m][0] + bv[bj][0], v1 = acc[ai][bj][m][1] + bv[bj][1];
#pragma unroll
                        for (int j = 0; j < 4; ++j) { v0[j] = fsigmoid(v0[j]); v1[j] = fsigmoid(v1[j]); }
                        u32x4 w; w.x = cvtpk(v0[0], v0[1]); w.y = cvtpk(v0[2], v0[3]); w.z = cvtpk(v1[0], v1[1]); w.w = cvtpk(v1[2], v1[3]);
                        *(u32x4*)(rowp + bj * 128) = w; } }
        }
    }
};
struct EpiStore {
    static constexpr bool PERM = true, I8 = false, F8 = false;
    bf16* O; int ldc; const float* bias; int bias_stride;
    __device__ __forceinline__ void operator()(AccRef acc, const pg8::Unit& u, int wr, int wc, int fr, int fq) const {
        const int row0 = u.pm * 256 + wr * 64 + fr, col0 = u.pn * 256 + wc * 32 + 8 * fq;
        f32x4 bv[2][2];
#pragma unroll
        for (int bj = 0; bj < 2; ++bj)
#pragma unroll
            for (int n = 0; n < 2; ++n) bv[bj][n] = bias ? *(const f32x4*)(bias + (size_t)u.aux * bias_stride + col0 + bj * 128 + 4 * n) : (f32x4){0.f, 0.f, 0.f, 0.f};
#pragma unroll
        for (int ai = 0; ai < 2; ++ai)
#pragma unroll
            for (int m = 0; m < 4; ++m) { bf16* rowp = O + (size_t)(row0 + ai * 128 + m * 16) * ldc + col0;
#pragma unroll
                for (int bj = 0; bj < 2; ++bj) { const f32x4 v0 = acc[ai][bj][m][0] + bv[bj][0], v1 = acc[ai][bj][m][1] + bv[bj][1];
                    u32x4 w; w.x = cvtpk(v0[0], v0[1]); w.y = cvtpk(v0[2], v0[3]); w.z = cvtpk(v1[0], v1[1]); w.w = cvtpk(v1[2], v1[3]);
                    *(u32x4*)(rowp + bj * 128) = w; } }
    }
};
struct EpiStoreF8 {
    static constexpr bool PERM = true, I8 = false, F8 = true; static constexpr int SCALE_A = 0x7f7f7f7f, SCALE_B = 0x7f7f7f7f;
    bf16* O; int ldc; const float* bias; int bias_stride;
    __device__ __forceinline__ void operator()(AccRef acc, const pg8::Unit& u, int wr, int wc, int fr, int fq) const {
        const int row0 = u.pm * 256 + wr * 64 + fr, col0 = u.pn * 256 + wc * 32 + 8 * fq;
        f32x4 bv[2][2];
#pragma unroll
        for (int bj = 0; bj < 2; ++bj)
#pragma unroll
            for (int n = 0; n < 2; ++n) bv[bj][n] = *(const f32x4*)(bias + (size_t)u.aux * bias_stride + col0 + bj * 128 + 4 * n);
#pragma unroll
        for (int ai = 0; ai < 2; ++ai)
#pragma unroll
            for (int m = 0; m < 4; ++m) { bf16* rowp = O + (size_t)(row0 + ai * 128 + m * 16) * ldc + col0;
#pragma unroll
                for (int bj = 0; bj < 2; ++bj) { const f32x4 v0 = acc[ai][bj][m][0] * 0.015625f + bv[bj][0], v1 = acc[ai][bj][m][1] * 0.015625f + bv[bj][1];
                    u32x4 w; w.x = cvtpk(v0[0], v0[1]); w.y = cvtpk(v0[2], v0[3]); w.z = cvtpk(v1[0], v1[1]); w.w = cvtpk(v1[2], v1[3]);
                    *(u32x4*)(rowp + bj * 128) = w; } }
    }
};
struct EpiBO {
    static constexpr bool PERM = true, I8 = true, F8 = false;
    bf16* Z; const bf16* G; const float* sY; const float* cmB;
    __device__ __forceinline__ void operator()(AccRef acc, const pg8::Unit& u, int wr, int wc, int fr, int fq) const {
        const int row0 = u.pm * 256 + wr * 64 + fr, colg = u.pn * 256 + wc * 32 + 8 * fq, colz = (u.pn & 3) * 256 + wc * 32 + 8 * fq;
        const bool first = u.aux == 0;
        f32x4 sw[2][2];
#pragma unroll
        for (int bj = 0; bj < 2; ++bj)
#pragma unroll
            for (int n = 0; n < 2; ++n) sw[bj][n] = *(const f32x4*)(cmB + colg + bj * 128 + 4 * n) * (1.0f / 127.0f);
#pragma unroll
        for (int ai = 0; ai < 2; ++ai)
#pragma unroll
            for (int m = 0; m < 4; ++m) { const int row = row0 + ai * 128 + m * 16; const float sa = sY[row * 4 + u.aux];
#pragma unroll
                for (int bj = 0; bj < 2; ++bj) { const u32x4 gw = *(const u32x4*)(G + (size_t)row * NGATE + colg + bj * 128); float g[8]; unpack8(gw, g);
                    bf16* zp = Z + (size_t)row * D + colz + bj * 128;
                    float z[8];
                    if (first) {
#pragma unroll
                        for (int j = 0; j < 8; ++j) z[j] = 0.f;
                    } else unpack8(*(const u32x4*)zp, z);
                    const f32x4 v0 = i2f4(acc[ai][bj][m][0]) * sw[bj][0] * sa, v1 = i2f4(acc[ai][bj][m][1]) * sw[bj][1] * sa;
#pragma unroll
                    for (int j = 0; j < 4; ++j) { z[j] += v0[j] * g[j]; z[4 + j] += v1[j] * g[4 + j]; }
                    *(u32x4*)zp = pack8(z); } }
    }
};
struct EpiOut {
    static constexpr bool PERM = false, I8 = false, F8 = false;
    float* X; const float* modl;
    __device__ __forceinline__ void operator()(AccRef acc, const pg8::Unit& u, int wr, int wc, int fr, int fq) const {
        const int row0 = u.pm * 256 + wr * 64 + fr, col0 = u.pn * 256 + wc * 32 + 4 * fq;
        const int mv = (u.pm % 33 == 0) ? 4 : u.pm / 33;
        const float* g1 = modl + mv * 6144 + 2048;
        f32x4 gv[2][2];
#pragma unroll
        for (int bj = 0; bj < 2; ++bj)
#pragma unroll
            for (int n = 0; n < 2; ++n) gv[bj][n] = *(const f32x4*)(g1 + col0 + bj * 128 + n * 16);
#pragma unroll
        for (int ai = 0; ai < 2; ++ai)
#pragma unroll
            for (int m = 0; m < 4; ++m) { float* rowp = X + (size_t)(row0 + ai * 128 + m * 16) * D + col0;
#pragma unroll
                for (int bj = 0; bj < 2; ++bj)
#pragma unroll
                    for (int n = 0; n < 2; ++n) { f32x4* p = (f32x4*)(rowp + bj * 128 + n * 16); *p = *p + gv[bj][n] * acc[ai][bj][m][n]; } }
    }
};
struct EpiMoE1 {
    static constexpr bool PERM = true, I8 = false, F8 = false;
    bf16* ACT; const float* bgu;
    __device__ __forceinline__ void operator()(AccRef acc, const pg8::Unit& u, int wr, int wc, int fr, int fq) const {
        const int row0 = u.pm * 256 + wr * 64 + fr, c0 = u.pn * 128 + wc * 32 + 8 * fq;
        const float* bg = bgu + (size_t)u.aux * 2048 + c0;
        f32x4 bgt[2], bup[2];
#pragma unroll
        for (int n = 0; n < 2; ++n) { bgt[n] = *(const f32x4*)(bg + 4 * n); bup[n] = *(const f32x4*)(bg + 1024 + 4 * n); }
#pragma unroll
        for (int ai = 0; ai < 2; ++ai)
#pragma unroll
            for (int m = 0; m < 4; ++m) { float o[8];
#pragma unroll
                for (int n = 0; n < 2; ++n)
#pragma unroll
                    for (int j = 0; j < 4; ++j) { const float gate = fminf(acc[ai][0][m][n][j] + bgt[n][j], 7.0f); const float up = fminf(fmaxf(acc[ai][1][m][n][j] + bup[n][j], -7.0f), 7.0f);
                        o[4 * n + j] = (up + 1.0f) * gate * fsigmoid(1.702f * gate); }
                *(u32x4*)(ACT + (size_t)(row0 + ai * 128 + m * 16) * DFF + c0) = pack8(o); }
    }
};

struct EpiIn8 {
    static constexpr bool PERM = true, I8 = true, F8 = false;
    bf16* Pb; bf16* Gb; float* gates; const float* bmg; const float* sA; const float* cmB;
    __device__ __forceinline__ void operator()(AccRef acc, const pg8::Unit& u, int wr, int wc, int fr, int fq) const {
        const int row0 = u.pm * 256 + wr * 64 + fr, cb0 = u.pn * 256 + wc * 32 + 8 * fq;
        f32x4 sw[2][2];
#pragma unroll
        for (int bj = 0; bj < 2; ++bj)
#pragma unroll
            for (int n = 0; n < 2; ++n) sw[bj][n] = *(const f32x4*)(cmB + cb0 + bj * 128 + 4 * n) * (1.0f / 127.0f);
        if (u.pn < 22) {
#pragma unroll
            for (int ai = 0; ai < 2; ++ai)
#pragma unroll
                for (int m = 0; m < 4; ++m) { const int row = row0 + ai * 128 + m * 16; bf16* rowp = Pb + (size_t)row * LDP + cb0; const float sa = sA[row];
#pragma unroll
                    for (int bj = 0; bj < 2; ++bj) { const f32x4 v0 = i2f4(acc[ai][bj][m][0]) * sw[bj][0] * sa, v1 = i2f4(acc[ai][bj][m][1]) * sw[bj][1] * sa;
                        u32x4 w; w.x = cvtpk(v0[0], v0[1]); w.y = cvtpk(v0[2], v0[3]); w.z = cvtpk(v1[0], v1[1]); w.w = cvtpk(v1[2], v1[3]);
                        *(u32x4*)(rowp + bj * 128) = w;
                        if (bj == 0 && u.pn == 14 && wc == 0 && fq < 2) { float* g = gates + (size_t)row * 32 + 8 * fq; *(f32x4*)g = v0; *(f32x4*)(g + 4) = v1; }
                        if (bj == 1 && u.pn == 21 && wc == 1 && fq >= 2) { float* g = gates + (size_t)row * 32 + 16 + 8 * (fq - 2); *(f32x4*)g = v0; *(f32x4*)(g + 4) = v1; } } }
        } else {
            const int col0 = cb0 - LDP;
            f32x4 bv[2][2];
#pragma unroll
            for (int bj = 0; bj < 2; ++bj)
#pragma unroll
                for (int n = 0; n < 2; ++n) bv[bj][n] = *(const f32x4*)(bmg + col0 + bj * 128 + 4 * n);
#pragma unroll
            for (int ai = 0; ai < 2; ++ai)
#pragma unroll
                for (int m = 0; m < 4; ++m) { const int row = row0 + ai * 128 + m * 16; bf16* rowp = Gb + (size_t)row * NGATE + col0; const float sa = sA[row];
#pragma unroll
                    for (int bj = 0; bj < 2; ++bj) { f32x4 v0 = i2f4(acc[ai][bj][m][0]) * sw[bj][0] * sa + bv[bj][0], v1 = i2f4(acc[ai][bj][m][1]) * sw[bj][1] * sa + bv[bj][1];
#pragma unroll
                        for (int j = 0; j < 4; ++j) { v0[j] = fsigmoid(v0[j]); v1[j] = fsigmoid(v1[j]); }
                        u32x4 w; w.x = cvtpk(v0[0], v0[1]); w.y = cvtpk(v0[2], v0[3]); w.z = cvtpk(v1[0], v1[1]); w.w = cvtpk(v1[2], v1[3]);
                        *(u32x4*)(rowp + bj * 128) = w; } }
        }
    }
};
struct EpiMoE18 {
    static constexpr bool PERM = true, I8 = true, F8 = false;
    bf16* ACT; const float* bgu; const float* sA; const float* cmB;
    __device__ __forceinline__ void operator()(AccRef acc, const pg8::Unit& u, int wr, int wc, int fr, int fq) const {
        const int row0 = u.pm * 256 + wr * 64 + fr, c0 = u.pn * 128 + wc * 32 + 8 * fq;
        const float* bg = bgu + (size_t)u.aux * 2048 + c0;
        const float* cm = cmB + (size_t)u.aux * 2048 + u.pn * 256 + wc * 32 + 8 * fq;
        f32x4 bgt[2], bup[2], sg[2], su[2];
#pragma unroll
        for (int n = 0; n < 2; ++n) { bgt[n] = *(const f32x4*)(bg + 4 * n); bup[n] = *(const f32x4*)(bg + 1024 + 4 * n); sg[n] = *(const f32x4*)(cm + 4 * n) * (1.0f / 127.0f); su[n] = *(const f32x4*)(cm + 128 + 4 * n) * (1.0f / 127.0f); }
#pragma unroll
        for (int ai = 0; ai < 2; ++ai)
#pragma unroll
            for (int m = 0; m < 4; ++m) { const int row = row0 + ai * 128 + m * 16; const float sa = sA[row]; float o[8];
#pragma unroll
                for (int n = 0; n < 2; ++n) { const f32x4 ga = i2f4(acc[ai][0][m][n]) * sg[n] * sa + bgt[n], ua = i2f4(acc[ai][1][m][n]) * su[n] * sa + bup[n];
#pragma unroll
                    for (int j = 0; j < 4; ++j) { const float gate = fminf(ga[j], 7.0f); const float up = fminf(fmaxf(ua[j], -7.0f), 7.0f);
                        o[4 * n + j] = (up + 1.0f) * gate * fsigmoid(1.702f * gate); } }
                int w0 = 0, w1 = 0;
                w0 = __builtin_amdgcn_cvt_pk_fp8_f32(o[0], o[1], w0, false); w0 = __builtin_amdgcn_cvt_pk_fp8_f32(o[2], o[3], w0, true);
                w1 = __builtin_amdgcn_cvt_pk_fp8_f32(o[4], o[5], w1, false); w1 = __builtin_amdgcn_cvt_pk_fp8_f32(o[6], o[7], w1, true);
                *(u32x2*)((unsigned char*)ACT + (size_t)row * DFF + c0) = (u32x2){(unsigned)w0, (unsigned)w1}; }
    }
};

struct AttnJob {
    const bf16* Q; int qpitch;
    const bf16* K; int kpitch;
    const bf16* VT;
    bf16* O; int opitch;
    int ntiles; float c;
    int s0_first_n, s0_jump;
    int kr_lo, r_w, c_q;
    const LAS float* bias;
};
template <int DQK, bool NA>
__device__ __forceinline__ void attn_unit(LAS unsigned char* lds, const AttnJob& J) {
    constexpr int KPB = (DQK == 96) ? 208 : 144, VPB = 136, NS = DQK / 16, KCH = DQK / 8;
    constexpr int KBUF = 64 * KPB, VBUF = 64 * VPB;
    const int tid = ltid(), wid = __builtin_amdgcn_readfirstlane(tid >> 6), lane = tid & 63, r = lane & 31, h = lane >> 5;
    LAS unsigned char* kb0 = lds; LAS unsigned char* vb0 = lds + 2 * KBUF;
    bf16x8 qf[NS];
    { const bf16* qrow = J.Q + (size_t)(wid * 32 + r) * J.qpitch + 8 * h;
#pragma unroll
      for (int s = 0; s < NS; ++s) qf[s] = *(const bf16x8*)(qrow + 16 * s); }
    f32x16 o0, o1;
#pragma unroll
    for (int i = 0; i < 16; ++i) { o0[i] = 0.f; o1[i] = 0.f; }
    float mrun = -1e30f, lsum = 0.f;
    const int k0r = tid / KCH, k0c = tid % KCH, k1r = (tid + 512) / KCH, k1c = (tid + 512) % KCH;
    const bool k1 = (tid + 512) < 64 * KCH;
    const int vd = tid >> 3, vc = tid & 7;
    u32x4 kr0, kr1, vr;
    auto s0_of = [&](int j) { return j < J.s0_first_n ? 64 * j : J.s0_jump + 64 * (j - J.s0_first_n); };
    auto gload = [&](int j) { const int s0 = s0_of(j);
        kr0 = *(const u32x4*)(J.K + (size_t)(s0 + k0r) * J.kpitch + 8 * k0c);
        if (k1) kr1 = *(const u32x4*)(J.K + (size_t)(s0 + k1r) * J.kpitch + 8 * k1c);
        vr = *(const u32x4*)(J.VT + (size_t)vd * TB + s0 + 8 * vc); };
    auto lstore = [&](int buf) {
        *(LAS u32x4*)(kb0 + buf * KBUF + k0r * KPB + 16 * k0c) = kr0;
        if (k1) *(LAS u32x4*)(kb0 + buf * KBUF + k1r * KPB + 16 * k1c) = kr1;
        LAS unsigned char* vp = vb0 + buf * VBUF + vd * VPB + 16 * vc;
        *(LAS u32x2*)vp = (u32x2){vr.x, vr.y}; *(LAS u32x2*)(vp + 8) = (u32x2){vr.z, vr.w}; };
    gload(0); lstore(0);
    __syncthreads();
    const int r0w = NA ? min(max(J.r_w - 4, 0), 120) : 0;
    const int c0 = NA ? min(max(J.c_q - 8, 0), 48) : 0;
    for (int j = 0; j < J.ntiles; ++j) {
        const int buf = j & 1;
        if (j + 1 < J.ntiles) gload(j + 1);
        bool active = true; int dr = 0;
        if (NA && j >= 4) { const int kr = J.kr_lo + j - 4; active = (kr >= r0w) && (kr < r0w + 8); dr = kr - J.r_w + 7; }
        if (active) {
            f32x16 s0v, s1v;
#pragma unroll
            for (int i = 0; i < 16; ++i) { s0v[i] = 0.f; s1v[i] = 0.f; }
            const LAS unsigned char* kp = kb0 + buf * KBUF + r * KPB + 16 * h;
#pragma unroll
            for (int s = 0; s < NS; ++s) {
                const bf16x8 a0 = *(const LAS bf16x8*)(kp + 32 * s), a1 = *(const LAS bf16x8*)(kp + 32 * KPB + 32 * s);
                s0v = __builtin_amdgcn_mfma_f32_32x32x16_bf16(a0, qf[s], s0v, 0, 0, 0);
                s1v = __builtin_amdgcn_mfma_f32_32x32x16_bf16(a1, qf[s], s1v, 0, 0, 0);
            }
            float mx;
            if (NA && j >= 4) {
                const LAS float* bp = J.bias + dr * 31 + 15 - J.c_q;
#pragma unroll
                for (int i = 0; i < 16; ++i) { const int kc = (i & 3) + 8 * (i >> 2) + 4 * h;
                    { const bool ok = (unsigned)(kc - c0) < 16u; const float bz = bp[ok ? kc : c0]; s0v[i] = ok ? s0v[i] * J.c + bz : -1e30f; }
                    { const int kc1 = kc + 32; const bool ok = (unsigned)(kc1 - c0) < 16u; const float bz = bp[ok ? kc1 : c0]; s1v[i] = ok ? s1v[i] * J.c + bz : -1e30f; } }
                mx = -1e30f;
#pragma unroll
                for (int i = 0; i < 16; ++i) mx = fmaxf(mx, fmaxf(s0v[i], s1v[i]));
                mx = fmaxf(mx, __shfl_xor(mx, 32));
            } else {
                float ma = fmaxf(s0v[0], s1v[0]), mb = fmaxf(s0v[1], s1v[1]);
#pragma unroll
                for (int i = 2; i < 16; i += 2) { ma = fmaxf(fmaxf(ma, s0v[i]), s1v[i]); mb = fmaxf(fmaxf(mb, s0v[i + 1]), s1v[i + 1]); }
                mx = fmaxf(ma, mb); mx = fmaxf(mx, __shfl_xor(mx, 32)) * J.c;
            }
            if (__any(mx > mrun + 8.0f)) {
                const float mnew = fmaxf(mrun, mx), alpha = fexp2(mrun - mnew); mrun = mnew; lsum *= alpha;
#pragma unroll
                for (int i = 0; i < 16; ++i) { o0[i] *= alpha; o1[i] *= alpha; }
            }
            float ps = 0.f;
            if (NA && j >= 4) {
#pragma unroll
                for (int i = 0; i < 16; ++i) { s0v[i] = fexp2(s0v[i] - mrun); s1v[i] = fexp2(s1v[i] - mrun); ps += s0v[i] + s1v[i]; }
            } else {
                const float nm = -mrun;
#pragma unroll
                for (int i = 0; i < 16; ++i) { s0v[i] = fexp2(__builtin_fmaf(s0v[i], J.c, nm)); s1v[i] = fexp2(__builtin_fmaf(s1v[i], J.c, nm)); ps += s0v[i] + s1v[i]; }
            }
            lsum += ps;
            bf16x8 pf[4];
#pragma unroll
            for (int st = 0; st < 4; ++st) { u32x4 w;
#pragma unroll
                for (int q = 0; q < 4; ++q) { const int i = 8 * (st & 1) + 2 * q; w[q] = (st < 2) ? cvtpk(s0v[i], s0v[i + 1]) : cvtpk(s1v[i], s1v[i + 1]); }
                pf[st] = __builtin_bit_cast(bf16x8, w); }
            const LAS unsigned char* vp = vb0 + buf * VBUF + r * VPB + 8 * h;
#pragma unroll
            for (int st = 0; st < 4; ++st) {
                const u32x2 a0l = *(const LAS u32x2*)(vp + 32 * st), a0h = *(const LAS u32x2*)(vp + 32 * st + 16);
                const u32x2 a1l = *(const LAS u32x2*)(vp + 32 * VPB + 32 * st), a1h = *(const LAS u32x2*)(vp + 32 * VPB + 32 * st + 16);
                const bf16x8 va0 = __builtin_bit_cast(bf16x8, (u32x4){a0l.x, a0l.y, a0h.x, a0h.y}), va1 = __builtin_bit_cast(bf16x8, (u32x4){a1l.x, a1l.y, a1h.x, a1h.y});
                o0 = __builtin_amdgcn_mfma_f32_32x32x16_bf16(va0, pf[st], o0, 0, 0, 0);
                o1 = __builtin_amdgcn_mfma_f32_32x32x16_bf16(va1, pf[st], o1, 0, 0, 0);
            }
        }
        if (j + 1 < J.ntiles) lstore(buf ^ 1);
        __syncthreads();
    }
    lsum += __shfl_xor(lsum, 32);
    const float inv = frcp(lsum);
    bf16* orow = J.O + (size_t)(wid * 32 + r) * J.opitch + 4 * h;
#pragma unroll
    for (int g = 0; g < 4; ++g) {
        *(u32x2*)(orow + 8 * g) = (u32x2){cvtpk(o0[4 * g] * inv, o0[4 * g + 1] * inv), cvtpk(o0[4 * g + 2] * inv, o0[4 * g + 3] * inv)};
        *(u32x2*)(orow + 32 + 8 * g) = (u32x2){cvtpk(o1[4 * g] * inv, o1[4 * g + 1] * inv), cvtpk(o1[4 * g + 2] * inv, o1[4 * g + 3] * inv)};
    }
}

template <int DQK>
__device__ __forceinline__ void attn_unit_dense(LAS unsigned char* lds, const AttnJob& J) {
    constexpr int KPB = (DQK == 96) ? 208 : 144, VPB = 264, NS = DQK / 16, KCH = DQK / 8, NKC = 128 * KCH / 512;
    constexpr int KBUF = 128 * KPB, VBUF = 64 * VPB;
    const int tid = ltid(), wid = __builtin_amdgcn_readfirstlane(tid >> 6), lane = tid & 63, r = lane & 31, h = lane >> 5;
    LAS unsigned char* kb0 = lds; LAS unsigned char* vb0 = lds + 2 * KBUF;
    bf16x8 qf[NS];
    { const bf16* qrow = J.Q + (size_t)(wid * 32 + r) * J.qpitch + 8 * h;
#pragma unroll
      for (int s = 0; s < NS; ++s) qf[s] = *(const bf16x8*)(qrow + 16 * s); }
    f32x16 o0, o1;
#pragma unroll
    for (int i = 0; i < 16; ++i) { o0[i] = 0.f; o1[i] = 0.f; }
    float mrun = -1e30f, lsum = 0.f;
    u32x4 kr[NKC], vr[2];
    const int vd = tid >> 3, vc = tid & 7;
    auto gload = [&](int j) { const int s0 = 128 * j;
#pragma unroll
        for (int q = 0; q < NKC; ++q) { const int ch = tid + 512 * q; kr[q] = *(const u32x4*)(J.K + (size_t)(s0 + ch / KCH) * J.kpitch + 8 * (ch % KCH)); }
        vr[0] = *(const u32x4*)(J.VT + (size_t)vd * TB + s0 + 8 * vc); vr[1] = *(const u32x4*)(J.VT + (size_t)vd * TB + s0 + 64 + 8 * vc); };
    auto lstore = [&](int buf) {
#pragma unroll
        for (int q = 0; q < NKC; ++q) { const int ch = tid + 512 * q; *(LAS u32x4*)(kb0 + buf * KBUF + (ch / KCH) * KPB + 16 * (ch % KCH)) = kr[q]; }
        LAS unsigned char* vp = vb0 + buf * VBUF + vd * VPB + 16 * vc;
        *(LAS u32x2*)vp = (u32x2){vr[0].x, vr[0].y}; *(LAS u32x2*)(vp + 8) = (u32x2){vr[0].z, vr[0].w};
        *(LAS u32x2*)(vp + 128) = (u32x2){vr[1].x, vr[1].y}; *(LAS u32x2*)(vp + 136) = (u32x2){vr[1].z, vr[1].w}; };
    const int nst = J.ntiles >> 1;
    const int grp = wid >> 2;
    gload(0); lstore(0);
    __syncthreads();
    if (nst > 1) gload(1);
    if (grp == 1) LDS_BAR();
    for (int j = 0; j < nst; ++j) {
        const int buf = j & 1;
        f32x16 sv[4];
#pragma unroll
        for (int bk = 0; bk < 4; ++bk)
#pragma unroll
            for (int i = 0; i < 16; ++i) sv[bk][i] = 0.f;
        const LAS unsigned char* kp = kb0 + buf * KBUF + r * KPB + 16 * h;
        { bf16x8 ka[2][4];
#pragma unroll
          for (int bk = 0; bk < 4; ++bk) ka[0][bk] = *(const LAS bf16x8*)(kp + bk * 32 * KPB);
#pragma unroll
          for (int s = 0; s < NS; ++s) {
              if (s + 1 < NS) {
#pragma unroll
                  for (int bk = 0; bk < 4; ++bk) ka[(s + 1) & 1][bk] = *(const LAS bf16x8*)(kp + bk * 32 * KPB + 32 * (s + 1)); }
              __builtin_amdgcn_sched_barrier(0);
#pragma unroll
              for (int bk = 0; bk < 4; ++bk) sv[bk] = __builtin_amdgcn_mfma_f32_32x32x16_bf16(ka[s & 1][bk], qf[s], sv[bk], 0, 0, 0);
              __builtin_amdgcn_sched_barrier(0); } }
        if (grp == 1 && j + 1 < nst) lstore(buf ^ 1);
        LDS_BAR();
        if (grp == 1 && j + 2 < nst) gload(j + 2);
        float ma = fmaxf(sv[0][0], sv[1][0]), mb = fmaxf(sv[2][0], sv[3][0]);
#pragma unroll
        for (int i = 1; i < 16; ++i) { ma = fmaxf(fmaxf(ma, sv[0][i]), sv[1][i]); mb = fmaxf(fmaxf(mb, sv[2][i]), sv[3][i]); }
        float mx = fmaxf(ma, mb) * J.c;
        { auto rr = __builtin_amdgcn_permlane32_swap(__float_as_uint(mx), __float_as_uint(mx), false, false); mx = fmaxf(__uint_as_float(rr[0]), __uint_as_float(rr[1])); }
        if (__any(mx > mrun + 8.0f)) {
            const float mnew = fmaxf(mrun, mx), alpha = fexp2(mrun - mnew); mrun = mnew; lsum *= alpha;
#pragma unroll
            for (int i = 0; i < 16; ++i) { o0[i] *= alpha; o1[i] *= alpha; }
        }
        const float nm = -mrun; float ps = 0.f;
#pragma unroll
        for (int bk = 0; bk < 4; ++bk)
#pragma unroll
            for (int i = 0; i < 16; ++i) { sv[bk][i] = fexp2(__builtin_fmaf(sv[bk][i], J.c, nm)); ps += sv[bk][i]; }
        lsum += ps;
        const LAS unsigned char* vp = vb0 + buf * VBUF + r * VPB + 8 * h;
        { u32x2 vf[2][4];
#pragma unroll
          for (int q = 0; q < 4; ++q) vf[0][q] = *(const LAS u32x2*)(vp + (q >> 1) * 32 * VPB + 16 * (q & 1));
#pragma unroll
          for (int st = 0; st < 8; ++st) { u32x4 w;
#pragma unroll
              for (int q = 0; q < 4; ++q) { const int i = 8 * (st & 1) + 2 * q; w[q] = cvtpk(sv[st >> 1][i], sv[st >> 1][i + 1]); }
              const bf16x8 pf = __builtin_bit_cast(bf16x8, w);
              if (st + 1 < 8) {
#pragma unroll
                  for (int q = 0; q < 4; ++q) vf[(st + 1) & 1][q] = *(const LAS u32x2*)(vp + (q >> 1) * 32 * VPB + 32 * (st + 1) + 16 * (q & 1)); }
              __builtin_amdgcn_sched_barrier(0);
              const bf16x8 va0 = __builtin_bit_cast(bf16x8, (u32x4){vf[st & 1][0].x, vf[st & 1][0].y, vf[st & 1][1].x, vf[st & 1][1].y}), va1 = __builtin_bit_cast(bf16x8, (u32x4){vf[st & 1][2].x, vf[st & 1][2].y, vf[st & 1][3].x, vf[st & 1][3].y});
              o0 = __builtin_amdgcn_mfma_f32_32x32x16_bf16(va0, pf, o0, 0, 0, 0);
              o1 = __builtin_amdgcn_mfma_f32_32x32x16_bf16(va1, pf, o1, 0, 0, 0);
              __builtin_amdgcn_sched_barrier(0); } }
        if (grp == 0 && j + 1 < nst) lstore(buf ^ 1);
        LDS_BAR();
        if (grp == 0 && j + 2 < nst) gload(j + 2);
    }
    if (grp == 0) LDS_BAR();
    __syncthreads();
    { auto rr = __builtin_amdgcn_permlane32_swap(__float_as_uint(lsum), __float_as_uint(lsum), false, false); lsum = __uint_as_float(rr[0]) + __uint_as_float(rr[1]); }
    const float inv = frcp(lsum);
    bf16* orow = J.O + (size_t)(wid * 32 + r) * J.opitch + 4 * h;
#pragma unroll
    for (int g = 0; g < 4; ++g) {
        *(u32x2*)(orow + 8 * g) = (u32x2){cvtpk(o0[4 * g] * inv, o0[4 * g + 1] * inv), cvtpk(o0[4 * g + 2] * inv, o0[4 * g + 3] * inv)};
        *(u32x2*)(orow + 32 + 8 * g) = (u32x2){cvtpk(o1[4 * g] * inv, o1[4 * g + 1] * inv), cvtpk(o1[4 * g + 2] * inv, o1[4 * g + 3] * inv)};
    }
}

struct Params { const float* in[31]; float* out; unsigned char* ws; int ph_lo, ph_hi; };
typedef const __attribute__((address_space(4))) unsigned char* kaptr_t;
struct PView {
    kaptr_t ka; unsigned char* ws; float* out; int bid, G;
    struct InArr { kaptr_t ka; __device__ __forceinline__ const float* operator[](int i) const { return *(const float* const __attribute__((address_space(4)))*)(ka + 8 * i); } } in;
};
__device__ __forceinline__ PView pview() {
    kaptr_t k = (kaptr_t)__builtin_amdgcn_kernarg_segment_ptr(); asm volatile("" : "+s"(k));
    PView v; v.ka = k; v.in.ka = k; v.out = *(float* const __attribute__((address_space(4)))*)(k + 248); v.ws = *(unsigned char* const __attribute__((address_space(4)))*)(k + 256);
    int b = blockIdx.x, g = gridDim.x; asm volatile("" : "+s"(b), "+s"(g)); v.bid = b; v.G = g; return v;
}
enum { I_X = 0, I_C, I_CTX, I_CCTX, I_WADA, I_BADA, I_N1G, I_N2G, I_WIN, I_RPB, I_CONVW, I_ALOG, I_DTB, I_GNG, I_MQG, I_WUQ, I_MKVG, I_WUKV, I_BIF, I_MLG,
       I_WMG, I_BMG, I_WBO, I_WOUT, I_RW, I_RB, I_WGU, I_BGU, I_WDN, I_BDN, I_FG };

__device__ __forceinline__ void transpose_item(const float* W, int N, int k0, int n0, bf16* dst_row0, int ldd, LAS float* scr, int lane) {
#pragma unroll 8
    for (int i = 0; i < 32; ++i) { const int kk = 2 * i + (lane >> 5); scr[kk * 33 + (lane & 31)] = W[(size_t)(k0 + kk) * N + n0 + (lane & 31)]; }
    asm volatile("s_waitcnt lgkmcnt(0)" ::: "memory");
    const int c = lane & 7;
#pragma unroll
    for (int j = 0; j < 4; ++j) { const int n = (lane >> 3) + 8 * j; const LAS float* s = scr + (8 * c) * 33 + n;
        u32x4 o; o.x = cvtpk(s[0 * 33], s[1 * 33]); o.y = cvtpk(s[2 * 33], s[3 * 33]); o.z = cvtpk(s[4 * 33], s[5 * 33]); o.w = cvtpk(s[6 * 33], s[7 * 33]);
        *(u32x4*)(dst_row0 + (size_t)n * ldd + k0 + 8 * c) = o; }
    asm volatile("s_waitcnt lgkmcnt(0)" ::: "memory");
}
__device__ __forceinline__ void transpose_item8(const float* W, int N, int k0, int n0, signed char* dst_row0, int ldd, const float* cm_row0, LAS float* scr, int lane) {
#pragma unroll 8
    for (int i = 0; i < 32; ++i) { const int kk = 2 * i + (lane >> 5); scr[kk * 33 + (lane & 31)] = W[(size_t)(k0 + kk) * N + n0 + (lane & 31)]; }
    asm volatile("s_waitcnt lgkmcnt(0)" ::: "memory");
    const int c = lane & 7;
#pragma unroll
    for (int j = 0; j < 4; ++j) { const int n = (lane >> 3) + 8 * j; const LAS float* s = scr + (8 * c) * 33 + n;
        const float cm = cm_row0[n], inv = cm > 0.f ? 127.0f / cm : 0.f;
        unsigned w0 = 0u, w1 = 0u;
#pragma unroll
        for (int e = 0; e < 4; ++e) { const int q0 = (int)__builtin_rintf(s[e * 33] * inv), q1 = (int)__builtin_rintf(s[(4 + e) * 33] * inv); w0 |= ((unsigned)q0 & 0xffu) << (8 * e); w1 |= ((unsigned)q1 & 0xffu) << (8 * e); }
        *(u32x2*)(dst_row0 + (size_t)n * ldd + k0 + 8 * c) = (u32x2){w0, w1}; }
    asm volatile("s_waitcnt lgkmcnt(0)" ::: "memory");
}
__device__ __forceinline__ void transpose_item_f8(const float* W, int N, int k0, int n0, unsigned char* dst_row0, int ldd, LAS float* scr, int lane) {
#pragma unroll 8
    for (int i = 0; i < 32; ++i) { const int kk = 2 * i + (lane >> 5); scr[kk * 33 + (lane & 31)] = W[(size_t)(k0 + kk) * N + n0 + (lane & 31)]; }
    asm volatile("s_waitcnt lgkmcnt(0)" ::: "memory");
    const int c = lane & 7;
#pragma unroll
    for (int j = 0; j < 4; ++j) { const int n = (lane >> 3) + 8 * j; const LAS float* s = scr + (8 * c) * 33 + n;
        int w0 = 0, w1 = 0;
        w0 = __builtin_amdgcn_cvt_pk_fp8_f32(s[0 * 33] * 64.f, s[1 * 33] * 64.f, w0, false); w0 = __builtin_amdgcn_cvt_pk_fp8_f32(s[2 * 33] * 64.f, s[3 * 33] * 64.f, w0, true);
        w1 = __builtin_amdgcn_cvt_pk_fp8_f32(s[4 * 33] * 64.f, s[5 * 33] * 64.f, w1, false); w1 = __builtin_amdgcn_cvt_pk_fp8_f32(s[6 * 33] * 64.f, s[7 * 33] * 64.f, w1, true);
        *(u32x2*)(dst_row0 + (size_t)n * ldd + k0 + 8 * c) = (u32x2){(unsigned)w0, (unsigned)w1}; }
    asm volatile("s_waitcnt lgkmcnt(0)" ::: "memory");
}
struct TJob { int cnt, K, N; };
__device__ __forceinline__ void phase_prologue(const PView& p, LAS unsigned char* lds, int bid, int G) {
    const int tid = ltid(), wid = __builtin_amdgcn_readfirstlane(tid >> 6), lane = tid & 63;
    unsigned char* ws = p.ws;
    LAS float* scr = (LAS float*)(lds + wid * 16384);
    const int gw = bid * NWAVES + wid, NGW = G * NWAVES;
    constexpr int I0 = 4 * 16 * 174, I1 = 4 * 16 * 128, I2 = 16 * 8 * 32, I3 = 16 * 16 * 32, I4 = 4 * 4 * 24, I5 = 4 * 2 * 32, I6 = 128 * 16 * 64, I7 = 128 * 16 * 32;
    constexpr int NIT = I0 + I1 + I2 + I3 + I4 + I5 + I6 + I7;
    for (int it = gw; it < NIT; it += NGW) {
        int r = it;
        if (r < I0 + I1) continue; r -= I0 + I1;
        if (r < I2) continue; r -= I2;
        if (r < I3) { const int c = r / (16 * 32), q = r % (16 * 32), kb = q / 32, nb = q % 32, l = c >> 2, rep = c & 3;
            transpose_item(p.in[I_WOUT] + (size_t)l * 1024 * 1024, 1024, 64 * kb, 32 * nb, (bf16*)(ws + OFF_WOUT4) + ((size_t)l * 1024 + 32 * nb) * 4096 + rep * 1024, 4096, scr, lane); continue; } r -= I3;
        if (r < I4) { const int l = r / (4 * 24), q = r % (4 * 24), kb = q / 24, nb = q % 24;
            transpose_item(p.in[I_WUQ] + (size_t)l * 256 * 768, 768, 64 * kb, 32 * nb, (bf16*)(ws + OFF_WUQKV) + ((size_t)l * 1792 + 32 * nb) * 384, 384, scr, lane); continue; } r -= I4;
        if (r < I5) { const int l = r / (2 * 32), q = r % (2 * 32), kb = q / 32, nb = q % 32;
            transpose_item(p.in[I_WUKV] + (size_t)l * 128 * 1024, 1024, 64 * kb, 32 * nb, (bf16*)(ws + OFF_WUQKV) + ((size_t)l * 1792 + 768 + 32 * nb) * 384 + 256, 384, scr, lane); continue; } r -= I5;
        if (r < I6) { continue; } r -= I6;
        { const int c = r / (16 * 32), q = r % (16 * 32), kb = q / 32, nb = q % 32;
            transpose_item_f8(p.in[I_WDN] + (size_t)c * 1024 * 1024, 1024, 64 * kb, 32 * nb, (unsigned char*)(ws + OFF_WDN) + ((size_t)c * 1024 + 32 * nb) * 1024, 1024, scr, lane); }
    }
    { const int gt = bid * NTHR + tid, NT_ = G * NTHR;
      for (int i = gt; i < 4 * 64 * 64; i += NT_) { const int l = i / (64 * 64), q = i % (64 * 64), rr = q / 64, cc = q % 64;
          *(u32x4*)((signed char*)(ws + OFF_WIN) + ((size_t)l * NIN + DIN + rr) * 1024 + 16 * cc) = (u32x4){0u, 0u, 0u, 0u}; }
      for (int i = gt; i < 4 * 64; i += NT_) ((float*)(ws + OFF_CMIN))[(size_t)(i >> 6) * NIN + DIN + (i & 63)] = 0.f;
      for (int i = gt; i < 4 * 768 * 16; i += NT_) { const int l = i / (768 * 16), q = i % (768 * 16), rr = q / 16, cc = q % 16;
          *(u32x4*)((bf16*)(ws + OFF_WUQKV) + ((size_t)l * 1792 + rr) * 384 + 256 + 8 * cc) = (u32x4){0u, 0u, 0u, 0u}; }
      for (int i = gt; i < 4 * 1024 * 32; i += NT_) { const int l = i / (1024 * 32), q = i % (1024 * 32), rr = q / 32, cc = q % 32;
          *(u32x4*)((bf16*)(ws + OFF_WUQKV) + ((size_t)l * 1792 + 768 + rr) * 384 + 8 * cc) = (u32x4){0u, 0u, 0u, 0u}; } }
    __syncthreads();
    { LAS float* sc = (LAS float*)lds;
      for (int i = tid; i < 5 * 1024; i += NTHR) { const float v = (i < 4096) ? p.in[I_C][i] : p.in[I_CCTX][i - 4096]; sc[i] = v * fsigmoid(v); }
      LAS float* part = (LAS float*)(lds + 32768);
      __syncthreads();
      for (int item = bid; item < 4 * 96; item += G) { const int l = item / 96, cb = item % 96, col = cb * 64 + lane;
          const float* w = p.in[I_WADA] + (size_t)l * 1024 * 6144 + col;
          float a0 = 0.f, a1 = 0.f, a2 = 0.f, a3 = 0.f, a4 = 0.f;
#pragma unroll 8
          for (int k = wid * 128; k < wid * 128 + 128; ++k) { const float wv = w[(size_t)k * 6144];
              a0 += sc[k] * wv; a1 += sc[1024 + k] * wv; a2 += sc[2048 + k] * wv; a3 += sc[3072 + k] * wv; a4 += sc[4096 + k] * wv; }
          LAS float* pp = part + (wid * 64 + lane) * 5; pp[0] = a0; pp[1] = a1; pp[2] = a2; pp[3] = a3; pp[4] = a4;
          __syncthreads();
          if (tid < 320) { const int c = tid % 64, rr = tid / 64; float s = 0.f;
#pragma unroll
              for (int w8 = 0; w8 < 8; ++w8) s += part[(w8 * 64 + c) * 5 + rr];
              ((float*)(ws + OFF_MOD))[((size_t)l * 5 + rr) * 6144 + cb * 64 + c] = s + p.in[I_BADA][l * 6144 + cb * 64 + c]; }
          __syncthreads(); } }
    { LAS float* part = (LAS float*)(lds + 65536);
      LAS unsigned char* t8 = lds;
      constexpr int NI0 = 4 * 174, NI1 = 4 * 128, NI2 = 128 * 64, NI3 = 16 * 32;
      const int n = lane & 31, k2 = lane >> 5;
      for (int item = bid; item < NI3; item += G) { const int c = item >> 5, cb = item & 31, n0 = 32 * cb;
          const float* w = p.in[I_WBO] + (size_t)c * 512 * 1024; float* cmd = (float*)(ws + OFF_CMBO) + (size_t)c * 1024; signed char* dst = (signed char*)(ws + OFF_WBO) + (size_t)c * 1024 * 512;
          float x[8][4]; float m = 0.f;
#pragma unroll
          for (int i = 0; i < 8; ++i)
#pragma unroll
              for (int e = 0; e < 4; ++e) { x[i][e] = w[(size_t)(64 * i + 8 * wid + 4 * k2 + e) * 1024 + n0 + n]; m = fmaxf(m, fabsf(x[i][e])); }
          part[(wid * 2 + k2) * 32 + n] = m;
          __syncthreads();
          if (tid < 32) { float mm = part[tid];
#pragma unroll
              for (int q = 1; q < 16; ++q) mm = fmaxf(mm, part[q * 32 + tid]);
              part[512 + tid] = mm; cmd[n0 + tid] = mm; }
          __syncthreads();
          { const float cm = part[512 + n], inv = cm > 0.f ? 127.0f / cm : 0.f;
#pragma unroll
            for (int i = 0; i < 8; ++i) *(LAS unsigned*)(t8 + n * 516 + 64 * i + 8 * wid + 4 * k2) = q8x4((f32x4){x[i][0], x[i][1], x[i][2], x[i][3]} * inv); }
          __syncthreads();
#pragma unroll
          for (int q = 0; q < 2; ++q) { const int ch = tid + 512 * q, rr = ch >> 5, cc = ch & 31; const LAS unsigned* s = (const LAS unsigned*)(t8 + rr * 516 + 16 * cc);
              *(u32x4*)(dst + (size_t)(n0 + rr) * 512 + 16 * cc) = (u32x4){s[0], s[1], s[2], s[3]}; }
          __syncthreads(); }
      for (int item = bid; item < NI0 + NI1 + NI2; item += G) {
          const float* w; int N, n0; float* cmd; signed char* dst; int drow0;
          if (item < NI0) { const int l = item / 174, cb = item % 174; N = DIN; n0 = 32 * cb; w = p.in[I_WIN] + (size_t)l * 1024 * DIN; drow0 = n0; cmd = (float*)(ws + OFF_CMIN) + (size_t)l * NIN; dst = (signed char*)(ws + OFF_WIN) + (size_t)l * NIN * 1024; }
          else if (item < NI0 + NI1) { const int r = item - NI0, l = r / 128, cb = r % 128; N = NGATE; n0 = 32 * cb; w = p.in[I_WMG] + (size_t)l * 1024 * NGATE; drow0 = LDP + n0; cmd = (float*)(ws + OFF_CMIN) + (size_t)l * NIN; dst = (signed char*)(ws + OFF_WIN) + (size_t)l * NIN * 1024; }
          else { const int r = item - NI0 - NI1, c = r / 64, cb = r % 64; N = 2048; n0 = 32 * cb; w = p.in[I_WGU] + (size_t)c * 1024 * 2048; const int j = n0 & 1023; drow0 = (j >> 7) * 256 + ((n0 >= 1024) ? 128 : 0) + (j & 127);
                 cmd = (float*)(ws + OFF_CMGU) + (size_t)c * 2048; dst = (signed char*)(ws + OFF_WGU) + (size_t)c * 2048 * 1024; }
          float x[16][4]; float m = 0.f;
#pragma unroll
          for (int i = 0; i < 16; ++i)
#pragma unroll
              for (int e = 0; e < 4; ++e) { x[i][e] = w[(size_t)(64 * i + 8 * wid + 4 * k2 + e) * N + n0 + n]; }
#pragma unroll
          for (int i = 0; i < 16; ++i)
#pragma unroll
              for (int e = 0; e < 4; ++e) m = fmaxf(m, fabsf(x[i][e]));
          part[(wid * 2 + k2) * 32 + n] = m;
          __syncthreads();
          if (tid < 32) { float mm = part[tid];
#pragma unroll
              for (int q = 1; q < 16; ++q) mm = fmaxf(mm, part[q * 32 + tid]);
              part[512 + tid] = mm; cmd[drow0 + tid] = mm; }
          __syncthreads();
          { const float cm = part[512 + n], inv = cm > 0.f ? 127.0f / cm : 0.f;
#pragma unroll
            for (int i = 0; i < 16; ++i) *(LAS unsigned*)(t8 + n * 1028 + 64 * i + 8 * wid + 4 * k2) = q8x4((f32x4){x[i][0], x[i][1], x[i][2], x[i][3]} * inv); }
          __syncthreads();
#pragma unroll
          for (int q = 0; q < 4; ++q) { const int ch = tid + 512 * q, rr = ch >> 6, cc = ch & 63; const LAS unsigned* s = (const LAS unsigned*)(t8 + rr * 1028 + 16 * cc);
              *(u32x4*)(dst + (size_t)(drow0 + rr) * 1024 + 16 * cc) = (u32x4){s[0], s[1], s[2], s[3]}; }
          __syncthreads(); } }
}

__device__ __forceinline__ int tok_mv(int tk) { const int b = tk / TB, s = tk - b * TB; return s < CTX ? 4 : b; }
template <int MODE>
__device__ __forceinline__ void phase_norm1(const PView& p, int l, int bid, int G, bool dummy = false) {
    const int tid = ltid(), wid = __builtin_amdgcn_readfirstlane(tid >> 6), lane = tid & 63;
    unsigned char* ws = p.ws;
    float* X = (float*)(ws + OFF_X); signed char* H8 = (signed char*)(ws + OFF_H); float* SH = (float*)(ws + OFF_SH);
    float* Xw = dummy ? (float*)(ws + OFF_GF) : X;
    const float* MOD = (const float*)(ws + OFF_MOD);
    const bf16* YS = (const bf16*)(ws + OFF_R3);
    const float* TW = (const float*)(ws + OFF_TOPW); const int* SL = (const int*)(ws + OFF_SLOT);
    for (int tp = bid * NWAVES + wid; tp < T / 2; tp += G * NWAVES) {
        const int tk0 = 2 * tp, b = tk0 / TB, s = tk0 - b * TB, mv = s < CTX ? 4 : b;
        if (MODE == 2 && s < CTX) continue;
        f32x4 v[2][4];
        if (l == 0) { const float* src = (s < CTX) ? p.in[I_CTX] + ((size_t)b * CTX + s) * D : p.in[I_X] + ((size_t)b * SEQ + (s - CTX)) * D;
#pragma unroll
            for (int u = 0; u < 2; ++u)
#pragma unroll
                for (int j = 0; j < 4; ++j) v[u][j] = *(const f32x4*)(src + u * D + 256 * j + 4 * lane);
        } else {
            float w[2][4]; int sl[2][4];
#pragma unroll
            for (int u = 0; u < 2; ++u)
#pragma unroll
                for (int k = 0; k < 4; ++k) { w[u][k] = TW[(tk0 + u) * 4 + k]; sl[u][k] = SL[(tk0 + u) * 4 + k]; }
#pragma unroll
            for (int u = 0; u < 2; ++u)
#pragma unroll
                for (int j = 0; j < 4; ++j) v[u][j] = *(const f32x4*)(X + (size_t)(tk0 + u) * D + 256 * j + 4 * lane);
            u32x2 y[2][4][4];
#pragma unroll
            for (int u = 0; u < 2; ++u)
#pragma unroll
                for (int k = 0; k < 4; ++k)
#pragma unroll
                    for (int j = 0; j < 4; ++j) y[u][k][j] = *(const u32x2*)(YS + (size_t)sl[u][k] * D + 256 * j + 4 * lane);
            const float* g2 = MOD + ((size_t)(l - 1) * 5 + mv) * 6144 + 5120;
#pragma unroll
            for (int j = 0; j < 4; ++j) { const f32x4 g2v = *(const f32x4*)(g2 + 256 * j + 4 * lane);
#pragma unroll
                for (int u = 0; u < 2; ++u) { f32x4 f = (f32x4){0.f, 0.f, 0.f, 0.f};
#pragma unroll
                    for (int k = 0; k < 4; ++k) f += w[u][k] * (f32x4){bflo(y[u][k][j].x), bfhi(y[u][k][j].x), bflo(y[u][k][j].y), bfhi(y[u][k][j].y)};
                    v[u][j] += g2v * f; } }
        }
        if (MODE != 2) {
#pragma unroll
            for (int u = 0; u < 2; ++u)
#pragma unroll
                for (int j = 0; j < 4; ++j) *(f32x4*)(Xw + (size_t)(tk0 + u) * D + 256 * j + 4 * lane) = v[u][j];
        }
        float rstd[2];
#pragma unroll
        for (int u = 0; u < 2; ++u) { float ss = 0.f;
#pragma unroll
            for (int j = 0; j < 4; ++j) ss += v[u][j].x * v[u][j].x + v[u][j].y * v[u][j].y + v[u][j].z * v[u][j].z + v[u][j].w * v[u][j].w;
            rstd[u] = __builtin_amdgcn_rsqf(wave_sum(ss) * (1.f / D) + 1e-6f); }
        if (MODE == 2) {
            float* o = p.out + ((size_t)b * SEQ + (s - CTX)) * D;
#pragma unroll
            for (int j = 0; j < 4; ++j) { const f32x4 g = *(const f32x4*)(p.in[I_FG] + 256 * j + 4 * lane);
#pragma unroll
                for (int u = 0; u < 2; ++u) *(f32x4*)(o + u * D + 256 * j + 4 * lane) = v[u][j] * rstd[u] * g; }
        } else {
            const float* ng = p.in[I_N1G] + l * D; const float* md = MOD + ((size_t)l * 5 + mv) * 6144;
            float am[2] = {0.f, 0.f};
#pragma unroll
            for (int j = 0; j < 4; ++j) { const int c = 256 * j + 4 * lane; const f32x4 g = *(const f32x4*)(ng + c), sh = *(const f32x4*)(md + c), sc = *(const f32x4*)(md + 1024 + c);
#pragma unroll
                for (int u = 0; u < 2; ++u) { v[u][j] = v[u][j] * rstd[u] * g * (sc + 1.0f) + sh;
                    am[u] = fmaxf(am[u], fmaxf(fmaxf(fabsf(v[u][j].x), fabsf(v[u][j].y)), fmaxf(fabsf(v[u][j].z), fabsf(v[u][j].w)))); } }
#pragma unroll
            for (int u = 0; u < 2; ++u) { const float amax = wave_max(am[u]), inv = amax > 0.f ? 127.0f / amax : 0.f;
                if (lane == 0) SH[tk0 + u] = amax * (1.0f / 127.0f);
#pragma unroll
                for (int j = 0; j < 4; ++j) *(unsigned*)(H8 + (size_t)(tk0 + u) * D + 256 * j + 4 * lane) = q8x4(v[u][j] * inv); }
        }
    }
}

__device__ __forceinline__ void phase_router(const PView& p, int l, LAS unsigned char* lds, int bid, int G, bool dummy = false) {
    const int tid = ltid(), wid = __builtin_amdgcn_readfirstlane(tid >> 6), lane = tid & 63;
    unsigned char* ws = p.ws;
    const float* X = (const float*)(ws + OFF_X); signed char* H8 = (signed char*)(ws + OFF_H); float* SH = (float*)(ws + OFF_SH);
    const float* MOD = (const float*)(ws + OFF_MOD);
    float* TW = (float*)(ws + OFF_TOPW); int* TE = (int*)(ws + OFF_TOPE); int* PS = (int*)(ws + OFF_POS);
    unsigned* gcnt = (unsigned*)(ws + OFF_CTL) + CW_CNT + l * 32 + (dummy ? 1024 : 0);
    LAS float* rw = (LAS float*)lds;
    LAS int* hist = (LAS int*)(lds + MISC_OFF + 64);
    LAS int* base = hist + 32;
    LAS int* lrec = base + 32;
    { const float* rg = p.in[I_RW] + (size_t)l * 1024 * 32;
      for (int i = tid; i < 1024 * 32; i += NTHR) rw[(i & 31) * 1024 + (i >> 5)] = rg[i]; }
    constexpr int TPB = 132;
    for (int item = bid; item < T / TPB; item += G) {
        if (tid < 32) hist[tid] = 0;
        __syncthreads();
        for (int tp = wid; tp < TPB / 2; tp += NWAVES) {
            const int ti0 = 2 * tp, tk0 = item * TPB + ti0, mv = tok_mv(tk0);
            f32x4 hv[2][4];
            const float* ng = p.in[I_N2G] + l * D; const float* md = MOD + ((size_t)l * 5 + mv) * 6144;
#pragma unroll
            for (int t2 = 0; t2 < 2; ++t2) { const int tk = tk0 + t2;
                f32x4 v[4]; float ss = 0.f;
#pragma unroll
                for (int j = 0; j < 4; ++j) { v[j] = *(const f32x4*)(X + (size_t)tk * D + 256 * j + 4 * lane); ss += v[j].x * v[j].x + v[j].y * v[j].y + v[j].z * v[j].z + v[j].w * v[j].w; }
                const float rstd = __builtin_amdgcn_rsqf(wave_sum(ss) * (1.f / D) + 1e-6f);
                float am = 0.f;
#pragma unroll
                for (int j = 0; j < 4; ++j) { const int c = 256 * j + 4 * lane; const f32x4 g = *(const f32x4*)(ng + c), sh = *(const f32x4*)(md + 3072 + c), sc = *(const f32x4*)(md + 4096 + c);
                    hv[t2][j] = v[j] * rstd * g * (sc + 1.0f) + sh;
                    am = fmaxf(am, fmaxf(fmaxf(fabsf(hv[t2][j].x), fabsf(hv[t2][j].y)), fmaxf(fabsf(hv[t2][j].z), fabsf(hv[t2][j].w)))); }
                { const float amax = wave_max(am), inv = amax > 0.f ? 127.0f / amax : 0.f;
                  if (lane == 0) SH[tk] = amax * (1.0f / 127.0f);
#pragma unroll
                  for (int j = 0; j < 4; ++j) *(unsigned*)(H8 + (size_t)tk * D + 256 * j + 4 * lane) = q8x4(hv[t2][j] * inv); }
                }
            float A16[2][16];
#pragma unroll
            for (int cq = 0; cq < 4; ++cq) { float acc[2][8];
#pragma unroll
                for (int q = 0; q < 8; ++q) { acc[0][q] = 0.f; acc[1][q] = 0.f; }
#pragma unroll
                for (int j = 0; j < 4; ++j) { const int c = 256 * j + 4 * lane;
#pragma unroll
                    for (int q = 0; q < 8; ++q) { const int e = 4 * cq + (q & 3) + 16 * (q >> 2); const f32x4 w = *(const LAS f32x4*)(rw + e * 1024 + c);
                        acc[0][q] += hv[0][j].x * w.x + hv[0][j].y * w.y + hv[0][j].z * w.z + hv[0][j].w * w.w;
                        acc[1][q] += hv[1][j].x * w.x + hv[1][j].y * w.y + hv[1][j].z * w.z + hv[1][j].w * w.w; } }
#pragma unroll
                for (int t2 = 0; t2 < 2; ++t2)
#pragma unroll
                    for (int q = 0; q < 4; ++q) { auto rr = __builtin_amdgcn_permlane32_swap(__float_as_uint(acc[t2][q]), __float_as_uint(acc[t2][q + 4]), false, false); A16[t2][4 * cq + q] = __uint_as_float(rr[0]) + __uint_as_float(rr[1]); }
                asm volatile("" ::: "memory"); }
            const int myE = lane >> 1; const float rbias = p.in[I_RB][l * 32 + myE];
            const bool b3 = (lane & 8) != 0, b2 = (lane & 4) != 0, b1 = (lane & 2) != 0;
#pragma unroll
            for (int t2 = 0; t2 < 2; ++t2) {
                float B8[8], C4[4], D2[2];
#pragma unroll
                for (int e = 0; e < 8; ++e) { auto rr = __builtin_amdgcn_permlane16_swap(__float_as_uint(A16[t2][e]), __float_as_uint(A16[t2][e + 8]), false, false); B8[e] = __uint_as_float(rr[0]) + __uint_as_float(rr[1]); }
#pragma unroll
                for (int e = 0; e < 4; ++e) { const float keep = b3 ? B8[e + 4] : B8[e], send = b3 ? B8[e] : B8[e + 4]; C4[e] = keep + dppf<0x140>(send); }
#pragma unroll
                for (int e = 0; e < 2; ++e) { const float keep = b2 ? C4[e + 2] : C4[e], send = b2 ? C4[e] : C4[e + 2]; D2[e] = keep + dppf<0x141>(send); }
                float v; { const float keep = b1 ? D2[1] : D2[0], send = b1 ? D2[0] : D2[1]; v = keep + dppf<0x1B>(send); }
                v += dppf<0xB1>(v); v += rbias;
                int cnt = 0;
#pragma unroll
                for (int e = 0; e < 32; ++e) { const float s = __int_as_float(__builtin_amdgcn_readlane(__float_as_int(v), 2 * e)); cnt += ((s > v) || (s == v && e < myE)) ? 1 : 0; }
                const bool sel = (cnt < 4) && ((lane & 1) == 0);
                const unsigned long long top = __ballot(sel && cnt == 0);
                const float m0 = __int_as_float(__builtin_amdgcn_readlane(__float_as_int(v), (int)__builtin_ctzll(top)));
                const float ex = sel ? fexp(v - m0) : 0.f;
                float tot = row16_sum(ex); { auto rr = __builtin_amdgcn_permlane16_swap(__float_as_uint(tot), __float_as_uint(tot), false, false); tot = __uint_as_float(rr[0]) + __uint_as_float(rr[1]); }
                { auto rr = __builtin_amdgcn_permlane32_swap(__float_as_uint(tot), __float_as_uint(tot), false, false); tot = __uint_as_float(rr[0]) + __uint_as_float(rr[1]); }
                if (sel) { const int tk = tk0 + t2, ti = ti0 + t2;
                    TW[tk * 4 + cnt] = ex / tot; TE[tk * 4 + cnt] = myE;
                    const int rk = atomicAdd((int*)&hist[myE], 1); lrec[ti * 4 + cnt] = (myE << 16) | rk; }
            }
        }
        __syncthreads();
        if (tid < 32) base[tid] = (int)__hip_atomic_fetch_add(gcnt + tid, (unsigned)hist[tid], __ATOMIC_RELAXED, __HIP_MEMORY_SCOPE_AGENT);
        __syncthreads();
        for (int i = tid; i < TPB * 4; i += NTHR) { const int rec = lrec[i]; PS[(size_t)item * TPB * 4 + i] = base[rec >> 16] + (rec & 0xffff); }
        __syncthreads();
    }
}

__device__ __forceinline__ void phase_gather(const PView& p, int l, LAS unsigned char* lds, int bid, int G) {
    const int tid = ltid(), wid = __builtin_amdgcn_readfirstlane(tid >> 6), lane = tid & 63;
    unsigned char* ws = p.ws;
    const unsigned* gcnt = (const unsigned*)(ws + OFF_CTL) + CW_CNT + l * 32;
    int* tst = (int*)(ws + OFF_CTL) + CW_TST + l * 64;
    LAS int* off = (LAS int*)(lds + MISC_OFF + 64);
    if (tid == 0) { int acc = 0; for (int e = 0; e < 32; ++e) { off[e] = acc * 256; if (bid == 0) tst[e] = acc; acc += ((int)gcnt[e] + 255) >> 8; } if (bid == 0) tst[32] = acc; }
    __syncthreads();
    const signed char* H8 = (const signed char*)(ws + OFF_H); signed char* XG = (signed char*)(ws + OFF_R1); const float* SH = (const float*)(ws + OFF_SH); float* SX = (float*)(ws + OFF_SX);
    const int* TE = (const int*)(ws + OFF_TOPE); const int* PS = (const int*)(ws + OFF_POS); int* SL = (int*)(ws + OFF_SLOT);
    for (int tk = bid * NWAVES + wid; tk < T; tk += G * NWAVES) {
        int dst[4];
#pragma unroll
        for (int k = 0; k < 4; ++k) dst[k] = off[TE[tk * 4 + k]] + PS[tk * 4 + k];
        const u32x4 r0 = ((const u32x4*)(H8 + (size_t)tk * D))[lane]; const float sc = SH[tk];
        if (lane < 4) { const int d = dst[0] * (lane == 0) + dst[1] * (lane == 1) + dst[2] * (lane == 2) + dst[3] * (lane == 3); SL[tk * 4 + lane] = d; SX[d] = sc; }
#pragma unroll
        for (int k = 0; k < 4; ++k) ((u32x4*)(XG + (size_t)dst[k] * D))[lane] = r0;
    }
}

template <class SrcFn>
__device__ __forceinline__ void transpose64x128(LAS unsigned char* lds, int tid, SrcFn srcp, bf16* dst_hd0  ) {
    LAS bf16* tl = (LAS bf16*)lds;
#pragma unroll
    for (int q = 0; q < 2; ++q) { const int ch = tid + 512 * q, ti = ch >> 4, cc = ch & 15; *(LAS u32x4*)(tl + ti * 136 + 8 * cc) = *(const u32x4*)srcp(ti, cc); }
    __syncthreads();
#pragma unroll
    for (int q = 0; q < 2; ++q) { const int hd = tid & 127, c8 = (tid >> 7) + 4 * q; unsigned w[4];
#pragma unroll
        for (int e = 0; e < 4; ++e) { const unsigned lo = tl[(8 * c8 + 2 * e) * 136 + hd], hi = tl[(8 * c8 + 2 * e + 1) * 136 + hd]; w[e] = lo | (hi << 16); }
        *(u32x4*)(dst_hd0 + (size_t)hd * TB + 8 * c8) = (u32x4){w[0], w[1], w[2], w[3]}; }
    __syncthreads();
}
__device__ __forceinline__ void phase_prep(const PView& p, int l, LAS unsigned char* lds, int bid, int G) {
    const int tid = ltid(), wid = __builtin_amdgcn_readfirstlane(tid >> 6), lane = tid & 63;
    unsigned char* ws = p.ws;
    const bf16* P = (const bf16*)(ws + OFF_R1);
    bf16* GQ = (bf16*)(ws + OFF_GQKV); const float* GT = (const float*)(ws + OFF_GATES);
    bf16* AQ = (bf16*)(ws + OFF_AQ); bf16* VTN = (bf16*)(ws + OFF_VTN);
    const float* cw = p.in[I_CONVW] + (size_t)l * 3 * 1536;
    { const int NT_ = G * NTHR, NCH = T * 192;
      for (int ch0 = bid * NTHR + tid; ch0 < NCH; ch0 += 4 * NT_) {
          u32x4 r0[4], rm[4], rp[4];
#pragma unroll
          for (int u = 0; u < 4; ++u) { const int ch = ch0 + u * NT_;
              if (ch < NCH) { const int tk = ch / 192, cc = ch - tk * 192, b = tk / TB, s = tk - b * TB; const bool c_ = s < CTX; const int lo = c_ ? 0 : CTX, hi = c_ ? CTX : TB;
                  const bf16* pr = P + (size_t)tk * LDP + PC_GQKV + 8 * cc;
                  r0[u] = *(const u32x4*)pr;
                  rm[u] = (s - 1 >= lo) ? *(const u32x4*)(pr - LDP) : (u32x4){0u, 0u, 0u, 0u};
                  rp[u] = (s + 1 < hi) ? *(const u32x4*)(pr + LDP) : (u32x4){0u, 0u, 0u, 0u}; } }
#pragma unroll
          for (int u = 0; u < 4; ++u) { const int ch = ch0 + u * NT_;
              if (ch < NCH) { const int tk = ch / 192, cc = ch - tk * 192;
                  float xm[8], x0[8], xp[8]; unpack8(r0[u], x0); unpack8(rm[u], xm); unpack8(rp[u], xp);
                  float y[8]; float ss = 0.f;
#pragma unroll
                  for (int i = 0; i < 8; ++i) { const int c = 8 * cc + i; const float z = xm[i] * cw[c] + x0[i] * cw[1536 + c] + xp[i] * cw[3072 + c]; y[i] = z * fsigmoid(z); ss += y[i] * y[i]; }
                  ss = row16_sum(ss);
                  if (cc < 128) { const float sc = __builtin_amdgcn_rsqf(ss + 1e-6f) * ((cc < 64) ? 0.08838834764831845f : 1.0f);
#pragma unroll
                      for (int i = 0; i < 8; ++i) y[i] *= sc; }
                  *(u32x4*)(GQ + (size_t)tk * 1536 + 8 * cc) = pack8(y); } } } }
    { float* GC = (float*)(ws + OFF_GC); float* MC = (float*)(ws + OFF_MC);
      for (int it = (wid * 64 + lane) * G + bid; it < (T / 64) * 16; it += G * NTHR) {
          const int tile = it >> 4, sq = it & 15, dh = sq & 7, d = dh >> 2, hh = dh & 3, tk0 = tile * 64;
          const bool isg = sq < 8;
          const float c0_ = isg ? p.in[I_DTB][l * 8 + dh] : p.in[I_BIF][((l * 2 + d) * 2 + 1) * 4 + hh];
          const float c1_ = isg ? -__expf(p.in[I_ALOG][l * 8 + dh]) : p.in[I_BIF][((l * 2 + d) * 2 + 0) * 4 + hh];
          float run = 0.f;
#pragma unroll 8
          for (int n = 0; n < 64; ++n) { const int tk = tk0 + (d ? 63 - n : n); const float* g = GT + (size_t)tk * 32;
              if (isg) { const float a = g[dh] + c0_; const float sp = (a > 20.f) ? a : __logf(1.0f + __expf(a)); run += c1_ * sp;
                  GC[(size_t)tk * 24 + dh] = run; GC[(size_t)tk * 24 + 8 + dh] = fsigmoid(g[8 + dh]); }
              else { const float y = -(g[24 + dh] + c0_); run -= (y > 20.f) ? y : __logf(1.0f + __expf(y));
                  MC[(size_t)tk * 16 + dh] = run; MC[(size_t)tk * 16 + 8 + dh] = g[16 + dh] + c1_; } } } }
    for (int tk = bid * NWAVES + wid; tk < T; tk += G * NWAVES) {
        float x[8]; float ss = 0.f;
        if (lane < 48) { unpack8(*(const u32x4*)(P + (size_t)tk * LDP + PC_MQ + 8 * lane), x); for (int i = 0; i < 8; ++i) ss += x[i] * x[i]; }
        else { for (int i = 0; i < 8; ++i) x[i] = 0.f; }
        ss = row16_sum(ss); { auto rr = __builtin_amdgcn_permlane16_swap(__float_as_uint(ss), __float_as_uint(ss), false, false); ss = __uint_as_float(rr[0]) + __uint_as_float(rr[1]); }
        if (lane < 48) { const bool isq = lane < 32; const float rs = __builtin_amdgcn_rsqf(ss * (isq ? (1.f / 256.f) : (1.f / 128.f)) + 1e-6f);
            const float* g = isq ? p.in[I_MQG] + l * 256 + 8 * lane : p.in[I_MKVG] + l * 128 + 8 * (lane - 32);
#pragma unroll
            for (int i = 0; i < 8; ++i) x[i] *= rs * g[i];
            *(u32x4*)(AQ + (size_t)tk * 384 + 8 * lane) = pack8(x); } }
    for (int it = bid; it < (T / 64) * 4; it += G) { const int tile = it >> 2, hp = it & 3, tk0 = tile * 64, b = tk0 / TB, s0 = tk0 - b * TB;
        transpose64x128(lds, tid, [&](int ti, int cc) { return P + (size_t)(tk0 + ti) * LDP + PC_NAV + hp * 128 + 8 * cc; }, VTN + ((size_t)b * 512 + hp * 128) * TB + s0); }
}

__device__ __forceinline__ void rope16(float (&x)[16], float pos) {
#pragma unroll
    for (int i = 0; i < 8; ++i) { const float inv = fexp2(-1.6609640474436813f * (float)i);
        const float rev = pos * inv * 0.15915494309189535f; const float fr = rev - floorf(rev);
        const float sn = __builtin_amdgcn_sinf(fr), cs = __builtin_amdgcn_cosf(fr);
        const float a = x[i], bb = x[i + 8]; x[i] = a * cs - bb * sn; x[i + 8] = bb * cs + a * sn; }
}
__device__ __forceinline__ void phase_mlapost(const PView& p, int l, LAS unsigned char* lds, int bid, int G, bool dummy = false) {
    const int tid = ltid();
    unsigned char* ws = p.ws;
    const bf16* P = (const bf16*)(ws + OFF_R1); bf16* QR = (bf16*)(ws + OFF_QKVR); bf16* KM = (bf16*)(ws + OFF_KM); bf16* VTM = (bf16*)(ws + OFF_VTM);
    const int gt = bid * NTHR + tid, NT_ = G * NTHR;
    for (int it = gt; it < NB * SEQ * 16; it += NT_) { const int tl_ = it >> 4, hh = (it >> 1) & 7, g = it & 1, b = tl_ / SEQ, t = tl_ - b * SEQ; const size_t tk = (size_t)b * TB + CTX + t;
        bf16* q = QR + tk * 1792 + hh * 96 + 64 + 16 * g;
        float x[16]; { float a[8], c[8]; unpack8(*(const u32x4*)q, a); unpack8(*(const u32x4*)(q + 8), c); for (int i = 0; i < 8; ++i) { x[i] = a[i]; x[8 + i] = c[i]; } }
        rope16(x, (float)(g == 0 ? (t >> 6) : (t & 63)));
        float a[8], c[8]; for (int i = 0; i < 8; ++i) { a[i] = x[i]; c[i] = x[8 + i]; }
        bf16* qo = dummy ? (bf16*)(ws + OFF_GF) + tk * 1792 + hh * 96 + 64 + 16 * g : q;
        *(u32x4*)qo = pack8(a); *(u32x4*)(qo + 8) = pack8(c); }
    for (int it = gt; it < T * 96; it += NT_) { const int tk = it / 96, q = it - tk * 96, hh = q / 12, cc = q - hh * 12, b = tk / TB, s = tk - b * TB;
        bf16* dst = KM + (((size_t)b * 8 + hh) * TB + s) * 96 + 8 * cc;
        if (cc < 8) { *(u32x4*)dst = *(const u32x4*)(QR + (size_t)tk * 1792 + 768 + hh * 128 + 8 * cc); }
        else { const int g = (cc - 8) >> 1, hf = (cc - 8) & 1;
            const bf16* sp = P + (size_t)tk * LDP + PC_MKPE + 16 * g;
            float x[16]; { float a[8], c[8]; unpack8(*(const u32x4*)sp, a); unpack8(*(const u32x4*)(sp + 8), c); for (int i = 0; i < 8; ++i) { x[i] = a[i]; x[8 + i] = c[i]; } }
            if (s >= CTX) { const int t = s - CTX; rope16(x, (float)(g == 0 ? (t >> 6) : (t & 63))); }
            float o[8]; for (int i = 0; i < 8; ++i) o[i] = x[8 * hf + i];
            *(u32x4*)dst = pack8(o); } }
    for (int it = bid; it < (T / 64) * 4; it += G) { const int tile = it >> 2, hp = it & 3, tk0 = tile * 64, b = tk0 / TB, s0 = tk0 - b * TB;
        transpose64x128(lds, tid, [&](int ti, int cc) { return QR + (size_t)(tk0 + ti) * 1792 + 768 + (2 * hp + (cc >> 3)) * 128 + 64 + 8 * (cc & 7); }, VTM + ((size_t)b * 512 + hp * 128) * TB + s0); }
}

__device__ __forceinline__ void phase_attn(const PView& p, int l, LAS unsigned char* lds, int bid, int G) {
    const int tid = ltid(), wid = __builtin_amdgcn_readfirstlane(tid >> 6), lane = tid & 63;
    unsigned char* ws = p.ws;
    const bf16* P = (const bf16*)(ws + OFF_R1); const bf16* QR = (const bf16*)(ws + OFF_QKVR); const bf16* KM = (const bf16*)(ws + OFF_KM);
    const bf16* VTM = (const bf16*)(ws + OFF_VTM); const bf16* VTN = (const bf16*)(ws + OFF_VTN); bf16* Y = (bf16*)(ws + OFF_Y);
    LAS float* btab = (LAS float*)(lds + 90112);
    for (int i = tid; i < 8 * 465; i += NTHR) btab[i] = p.in[I_RPB][(size_t)l * 8 * 465 + i] * 1.4426950408889634f;
    __syncthreads();
    const float c_mla = 0.10206207261596577f * 1.4426950408889634f, c_na = 0.125f * 1.4426950408889634f;
    for (int u = bid; u < 2112; u += G) {
        AttnJob J; J.bias = btab; J.kr_lo = 0; J.r_w = 0; J.c_q = 0; J.s0_first_n = 1 << 30; J.s0_jump = 0;
        if (u < 1024) {
            const int b = u >> 8, hh = u & 7, qb = (u >> 3) & 31; const size_t tq = (size_t)b * TB + CTX + qb * 256;
            J.Q = QR + tq * 1792 + hh * 96; J.qpitch = 1792; J.K = KM + ((size_t)b * 8 + hh) * TB * 96; J.kpitch = 96; J.VT = VTM + ((size_t)b * 8 + hh) * 64 * TB;
            J.O = Y + tq * 2048 + 1024 + hh * 64; J.opitch = 2048; J.ntiles = TB / 64; J.c = c_mla;
            attn_unit_dense<96>(lds, J);
        } else if (u < 2048) {
            const int v = u - 1024, b = v >> 8, hh = v & 7, rq = (v >> 3) & 31; const size_t tq = (size_t)b * TB + CTX + rq * 256;
            const int kr_lo = min(max(4 * rq - 4, 0), 120), kr_hi = min(max(4 * rq + 3 - 4, 0), 120) + 7;
            J.Q = P + tq * LDP + PC_NAQ + hh * 64; J.qpitch = LDP; J.K = P + (size_t)b * TB * LDP + PC_NAK + hh * 64; J.kpitch = LDP; J.VT = VTN + ((size_t)b * 8 + hh) * 64 * TB;
            J.O = Y + tq * 2048 + hh * 64; J.opitch = 2048; J.ntiles = 4 + (kr_hi - kr_lo + 1); J.c = c_na;
            J.s0_first_n = 4; J.s0_jump = CTX + kr_lo * 64; J.kr_lo = kr_lo; J.r_w = 4 * rq + (wid >> 1); J.c_q = 32 * (wid & 1) + (lane & 31); J.bias = btab + hh * 465;
            attn_unit<64, true>(lds, J);
        } else if (u < 2080) {
            const int v = u - 2048, b = v >> 3, hh = v & 7; const size_t tq = (size_t)b * TB;
            J.Q = QR + tq * 1792 + hh * 96; J.qpitch = 1792; J.K = KM + ((size_t)b * 8 + hh) * TB * 96; J.kpitch = 96; J.VT = VTM + ((size_t)b * 8 + hh) * 64 * TB;
            J.O = Y + tq * 2048 + 1024 + hh * 64; J.opitch = 2048; J.ntiles = 4; J.c = c_mla;
            attn_unit_dense<96>(lds, J);
        } else {
            const int v = u - 2080, b = v >> 3, hh = v & 7; const size_t tq = (size_t)b * TB;
            J.Q = P + tq * LDP + PC_NAQ + hh * 64; J.qpitch = LDP; J.K = P + (size_t)b * TB * LDP + PC_NAK + hh * 64; J.kpitch = LDP; J.VT = VTN + ((size_t)b * 8 + hh) * 64 * TB;
            J.O = Y + tq * 2048 + hh * 64; J.opitch = 2048; J.ntiles = 4; J.c = c_na;
            attn_unit<64, false>(lds, J);
        }
    }
}


__device__ __forceinline__ unsigned lds_u16(const LAS unsigned char* p) { return (unsigned)*(const LAS unsigned short*)p; }
__device__ __forceinline__ void mlstm_chunk_item(const PView& p, LAS unsigned char* lds, int chain, int vq) {
    const int tid = ltid(), wid = __builtin_amdgcn_readfirstlane(tid >> 6), lane = tid & 63, r = lane & 31, h = lane >> 5;
    const int b = chain >> 3, hh = (chain >> 1) & 3, dir = chain & 1, dh = dir * 4 + hh;
    unsigned char* ws = p.ws;
    const bf16* P = (const bf16*)(ws + OFF_R1); const float* MC = (const float*)(ws + OFF_MC);
    float* OM = (float*)(ws + OFF_OML) + (size_t)dir * T * 512;
    constexpr int KT = 0, QT = 9216, VT_ = 18432, FC = 23552, AO_ = FC + 256, BO_ = AO_ + 256, CHB = 24576;
    constexpr int CBO = 2 * CHB, CBS = 4608, NSO = CBO + 2 * CBS;
    for (int i = tid; i < (2 * CBS + 512) / 4; i += NTHR) ((LAS unsigned*)(lds + CBO))[i] = 0u;
    f32x16 cacc;
#pragma unroll
    for (int i = 0; i < 16; ++i) cacc[i] = 0.f;
    const int srow = tid >> 3, sc8 = tid & 7, vrow = tid >> 2, vc = tid & 3;
    struct Stg { u32x4 k, q, v; float fc, ip, fm, vfc, vip; };
    Stg sA, sB; sA.fc = sA.ip = sA.fm = sA.vfc = sA.vip = 0.f; sB = sA;
    auto s0_of = [&](int c) { return (dir == 0) ? 64 * c : (c < 4 ? 192 - 64 * c : TB - 64 - 64 * (c - 4)); };
    auto gload = [&](Stg& g, int c) { const size_t tk0 = (size_t)b * TB + s0_of(c);
        const size_t tkr = tk0 + (dir ? 63 - srow : srow);
        g.k = *(const u32x4*)(P + tkr * LDP + PC_LK + hh * 64 + 8 * sc8); g.q = *(const u32x4*)(P + tkr * LDP + PC_LQ + hh * 64 + 8 * sc8);
        g.fm = MC[(tk0 + (dir ? 32 : 31)) * 16 + dh];
        if (tid < 256) { const size_t tkv = tk0 + (dir ? 63 - vrow : vrow); g.v = *(const u32x4*)(P + tkv * LDP + PC_LV + hh * 128 + vq * 32 + 8 * vc); g.vfc = MC[tkv * 16 + dh]; g.vip = MC[tkv * 16 + 8 + dh]; }
        if (tid < 64) { const size_t tkg = tk0 + (dir ? 63 - tid : tid); g.fc = MC[tkg * 16 + dh]; g.ip = MC[tkg * 16 + 8 + dh]; } };
    auto lstore = [&](const Stg& g, int nb) { LAS unsigned char* cb = lds + nb * CHB;
        *(LAS u32x4*)(cb + KT + srow * 144 + 16 * sc8) = g.k;
        { float q8[8]; unpack8(g.q, q8);
#pragma unroll
          for (int e = 0; e < 8; ++e) q8[e] *= 0.125f;
          *(LAS u32x4*)(cb + QT + srow * 144 + 16 * sc8) = pack8(q8); }
        if (tid < 256) { float v8[8]; unpack8(g.v, v8); const float bj = __expf(g.vip - g.vfc + g.fm);
#pragma unroll
            for (int e = 0; e < 8; ++e) v8[e] *= bj;
            *(LAS u32x4*)(cb + VT_ + vrow * 80 + 16 * vc) = pack8(v8); }
        if (tid < 64) { ((LAS float*)(cb + FC))[tid] = g.fc; ((LAS float*)(cb + AO_))[tid] = __expf(g.fc - g.fm); ((LAS float*)(cb + BO_))[tid] = __expf(g.ip - g.fc + g.fm); }
        if (tid == 64) ((LAS float*)(cb + FC + 768))[0] = g.fm; };
    gload(sA, 0); lstore(sA, 0); gload(sB, 1);
    __syncthreads();
    auto compute = [&](const int c, const int cur) {
        const int nxt = cur ^ 1;
        const LAS unsigned char* cb = lds + cur * CHB;
        const LAS float* fcS = (const LAS float*)(cb + FC); const LAS float* aS = (const LAS float*)(cb + AO_); const LAS float* bS = (const LAS float*)(cb + BO_);
        const float fend = fcS[63], dec = __expf(fend), cw = __expf(fend - fcS[192]);
        if (wid < 2) {
            const int ib = wid, i = 32 * ib + r;
            bf16x8 qf[4];
#pragma unroll
            for (int s = 0; s < 4; ++s) qf[s] = *(const LAS bf16x8*)(cb + QT + i * 144 + 32 * s + 16 * h);
            f32x16 s0v, s1v, nacc, iacc;
#pragma unroll
            for (int q = 0; q < 16; ++q) { s0v[q] = 0.f; s1v[q] = 0.f; nacc[q] = 0.f; iacc[q] = 0.f; }
#pragma unroll
            for (int s = 0; s < 4; ++s) { const bf16x8 a0 = *(const LAS bf16x8*)(cb + KT + r * 144 + 32 * s + 16 * h); s0v = __builtin_amdgcn_mfma_f32_32x32x16_bf16(a0, qf[s], s0v, 0, 0, 0); }
            float den = 0.f;
            if (ib == 0) {
#pragma unroll
                for (int g4 = 0; g4 < 4; ++g4) { const f32x4 B0 = *(const LAS f32x4*)(bS + 8 * g4 + 4 * h);
#pragma unroll
                    for (int q = 0; q < 4; ++q) { const int reg = 4 * g4 + q, j0 = 8 * g4 + 4 * h + q; const float p0 = (j0 <= r) ? s0v[reg] : 0.f; s0v[reg] = p0; den += p0 * B0[q]; } }
            } else {
#pragma unroll
                for (int s = 0; s < 4; ++s) { const bf16x8 a1 = *(const LAS bf16x8*)(cb + KT + (32 + r) * 144 + 32 * s + 16 * h); s1v = __builtin_amdgcn_mfma_f32_32x32x16_bf16(a1, qf[s], s1v, 0, 0, 0); }
#pragma unroll
                for (int g4 = 0; g4 < 4; ++g4) { const f32x4 B0 = *(const LAS f32x4*)(bS + 8 * g4 + 4 * h), B1 = *(const LAS f32x4*)(bS + 32 + 8 * g4 + 4 * h);
#pragma unroll
                    for (int q = 0; q < 4; ++q) { const int reg = 4 * g4 + q, j0 = 8 * g4 + 4 * h + q; den += s0v[reg] * B0[q];
                        const float p1 = (j0 <= r) ? s1v[reg] : 0.f; s1v[reg] = p1; den += p1 * B1[q]; } }
            }
#pragma unroll
            for (int st = 0; st < 4; ++st) { if (st < 2 || ib == 1) {
                u32x4 pw;
#pragma unroll
                for (int q = 0; q < 4; ++q) { const int reg = 8 * (st & 1) + 2 * q; pw[q] = (st < 2) ? cvtpk(s0v[reg], s0v[reg + 1]) : cvtpk(s1v[reg], s1v[reg + 1]); }
                u32x4 vw;
#pragma unroll
                for (int q = 0; q < 4; ++q) { const int t0 = 16 * st + 8 * (q >> 1) + 4 * h + 2 * (q & 1);
                    vw[q] = lds_u16(cb + VT_ + t0 * 80 + 2 * r) | (lds_u16(cb + VT_ + (t0 + 1) * 80 + 2 * r) << 16); }
                nacc = __builtin_amdgcn_mfma_f32_32x32x16_bf16(__builtin_bit_cast(bf16x8, vw), __builtin_bit_cast(bf16x8, pw), nacc, 0, 0, 0); } }
            const LAS unsigned char* cbt = lds + CBO + cur * CBS; const LAS float* nS = (const LAS float*)(lds + NSO + cur * 256);
            float dint = 0.f;
#pragma unroll
            for (int s = 0; s < 4; ++s) { const bf16x8 ca = *(const LAS bf16x8*)(cbt + r * 144 + 32 * s + 16 * h); iacc = __builtin_amdgcn_mfma_f32_32x32x16_bf16(ca, qf[s], iacc, 0, 0, 0);
                float q8[8]; unpack8(__builtin_bit_cast(u32x4, qf[s]), q8); const f32x4 n0 = *(const LAS f32x4*)(nS + 16 * s + 8 * h), n1 = *(const LAS f32x4*)(nS + 16 * s + 8 * h + 4);
                dint += q8[0] * n0.x + q8[1] * n0.y + q8[2] * n0.z + q8[3] * n0.w + q8[4] * n1.x + q8[5] * n1.y + q8[6] * n1.z + q8[7] * n1.w; }
            { auto rr = __builtin_amdgcn_permlane32_swap(__float_as_uint(den), __float_as_uint(den), false, false); den = __uint_as_float(rr[0]) + __uint_as_float(rr[1]); }
            { auto rr = __builtin_amdgcn_permlane32_swap(__float_as_uint(dint), __float_as_uint(dint), false, false); dint = __uint_as_float(rr[0]) + __uint_as_float(rr[1]); }
            const float ai = aS[i], egi = __expf(fcS[i]), dtot = ai * den + egi * dint, inv = 1.0f / fmaxf(fabsf(dtot), 1.0f), ka = ai * inv, ke_ = egi * inv;
            const size_t tko = (size_t)b * TB + s0_of(c) + (dir ? 63 - i : i);
            float* op = OM + tko * 512 + hh * 128 + vq * 32 + 4 * h;
#pragma unroll
            for (int g4 = 0; g4 < 4; ++g4) { f32x4 o;
#pragma unroll
                for (int q = 0; q < 4; ++q) o[q] = nacc[4 * g4 + q] * ka + iacc[4 * g4 + q] * ke_;
                *(f32x4*)(op + 8 * g4) = o; }
        } else if (wid < 4) {
            const int cbk = wid - 2;
            f32x16 tacc;
#pragma unroll
            for (int q = 0; q < 16; ++q) tacc[q] = 0.f;
#pragma unroll
            for (int s = 0; s < 4; ++s) { const int t0 = 16 * s + 8 * h;
                u32x4 vw, kw;
#pragma unroll
                for (int q = 0; q < 4; ++q) { const int ta = t0 + 2 * q;
                    vw[q] = lds_u16(cb + VT_ + ta * 80 + 2 * r) | (lds_u16(cb + VT_ + (ta + 1) * 80 + 2 * r) << 16);
                    kw[q] = lds_u16(cb + KT + ta * 144 + 2 * (r + 32 * cbk)) | (lds_u16(cb + KT + (ta + 1) * 144 + 2 * (r + 32 * cbk)) << 16); }
                tacc = __builtin_amdgcn_mfma_f32_32x32x16_bf16(__builtin_bit_cast(bf16x8, vw), __builtin_bit_cast(bf16x8, kw), tacc, 0, 0, 0); }
            LAS unsigned char* cbn = lds + CBO + nxt * CBS;
#pragma unroll
            for (int q = 0; q < 16; ++q) { cacc[q] = dec * cacc[q] + cw * tacc[q]; const int v = (q & 3) + 8 * (q >> 2) + 4 * h; *(LAS unsigned short*)(cbn + v * 144 + 2 * (r + 32 * cbk)) = (unsigned short)(cvtpk(cacc[q], 0.f) & 0xffffu); }
        } else if (wid == 4) {
            float s0 = 0.f, s1 = 0.f;
#pragma unroll 8
            for (int j = 0; j < 64; j += 2) { s0 += bS[j] * bf2f((bf16)lds_u16(cb + KT + j * 144 + 2 * lane)); s1 += bS[j + 1] * bf2f((bf16)lds_u16(cb + KT + (j + 1) * 144 + 2 * lane)); }
            const LAS float* nc = (const LAS float*)(lds + NSO + cur * 256); LAS float* nn = (LAS float*)(lds + NSO + nxt * 256);
            nn[lane] = dec * nc[lane] + cw * (s0 + s1);
        }
    };
    for (int c = 0; c < TB / 64; c += 2) {
        gload(sA, min(c + 2, TB / 64 - 1)); compute(c, 0); lstore(sB, 1); LDS_BAR();
        gload(sB, min(c + 3, TB / 64 - 1)); compute(c + 1, 1); lstore(sA, 0); LDS_BAR();
    }
}

constexpr int GF_WM = 0, GF_QD = 16384, GF_QK = 32768, GF_KE = 40960, GF_U0 = 57344, GF_EE = 90112, GF_ITEM = 90368, NCHUNK = TB / 64;
__device__ __forceinline__ int chunk_s0(int dir, int c) { return (dir == 0) ? 64 * c : (c < 4 ? 192 - 64 * c : TB - 64 - 64 * (c - 4)); }
__device__ __forceinline__ void phase_gdnpre(const PView& p, int l, LAS unsigned char* lds, int bid, int G) {
    const int tid = ltid(), wid = __builtin_amdgcn_readfirstlane(tid >> 6), lane = tid & 63, r = lane & 31, h = lane >> 5;
    unsigned char* ws = p.ws;
    const bf16* GQ = (const bf16*)(ws + OFF_GQKV); const float* GC = (const float*)(ws + OFF_GC);
    constexpr int KO = 0, QO = 17408, VO = 34816, AO = 52224, GSO = 69632, BSO = GSO + 256, XO = 70400, UO = 87808;
    const LAS float* gS = (const LAS float*)(lds + GSO); const LAS float* bS = (const LAS float*)(lds + BSO);
    for (int it = bid; it < 32 * NCHUNK; it += G) {
        const int chain = it / NCHUNK, c = it % NCHUNK, b = chain >> 3, hh = (chain >> 1) & 3, dir = chain & 1, dh = dir * 4 + hh;
        const size_t tk0 = (size_t)b * TB + chunk_s0(dir, c);
        unsigned char* gf = ws + OFF_GF + (size_t)it * GF_ITEM;
#pragma unroll
        for (int rep = 0; rep < 6; ++rep) { const int ch = tid + 512 * rep, tile = ch >> 10, row = (ch & 1023) >> 4, c8 = ch & 15;
            const size_t tk = tk0 + (dir ? 63 - row : row);
            const int col = (tile == 0 ? 512 : (tile == 1 ? 0 : 1024)) + hh * 128 + 8 * c8;
            *(LAS u32x4*)(lds + tile * 17408 + row * 272 + 16 * c8) = *(const u32x4*)(GQ + tk * 1536 + col); }
        if (tid < 64) { const size_t tk = tk0 + (dir ? 63 - tid : tid); const float gg = GC[tk * 24 + dh], bb = GC[tk * 24 + 8 + dh];
            ((LAS float*)(lds + GSO))[tid] = gg; ((LAS float*)(lds + BSO))[tid] = bb; ((LAS float*)(lds + BSO + 256))[tid] = bb * __expf(gg); }
        __syncthreads();
        { const int w4 = wid & 3, jb = w4 >> 1, ib = w4 & 1, i = 32 * ib + r;
          f32x16 acc;
#pragma unroll
          for (int q = 0; q < 16; ++q) acc[q] = 0.f;
          const LAS unsigned char* bsrc = lds + ((wid < 4) ? KO : QO) + i * 272 + 16 * h;
#pragma unroll
          for (int s = 0; s < 8; ++s) { const bf16x8 a = *(const LAS bf16x8*)(lds + KO + (32 * jb + r) * 272 + 32 * s + 16 * h), bq = *(const LAS bf16x8*)(bsrc + 32 * s);
              acc = __builtin_amdgcn_mfma_f32_32x32x16_bf16(a, bq, acc, 0, 0, 0); }
          const float gi = gS[i], bi = bS[i];
          if (wid < 4) {
#pragma unroll
              for (int g4 = 0; g4 < 4; ++g4) { const int j0 = 32 * jb + 8 * g4 + 4 * h; const f32x4 gj = *(const LAS f32x4*)(gS + j0); f32x4 o;
#pragma unroll
                  for (int q = 0; q < 4; ++q) o[q] = (i > j0 + q) ? bi * __expf(gi - gj[q]) * acc[4 * g4 + q] : 0.f;
                  *(LAS f32x4*)(lds + AO + i * 272 + 4 * j0) = o; }
          } else {
#pragma unroll
              for (int g4 = 0; g4 < 4; ++g4) { const int j0 = 32 * jb + 8 * g4 + 4 * h; const f32x4 gj = *(const LAS f32x4*)(gS + j0);
#pragma unroll
                  for (int q = 0; q < 4; ++q) acc[4 * g4 + q] = (i >= j0 + q) ? __expf(gi - gj[q]) * acc[4 * g4 + q] : 0.f; }
#pragma unroll
              for (int s2 = 0; s2 < 2; ++s2) { u32x4 w;
#pragma unroll
                  for (int q = 0; q < 4; ++q) w[q] = cvtpk(acc[8 * s2 + 2 * q], acc[8 * s2 + 2 * q + 1]);
                  *(u32x4*)(gf + GF_QK + (size_t)((ib * 4 + 2 * jb + s2) * 64 + lane) * 16) = w; }
          } }
        __syncthreads();
        constexpr int TO = UO;
        if (wid == 0) {
            float t[32];
#pragma unroll
            for (int i = 0; i < 32; ++i) {
                float acc0 = (i == r) ? 1.0f : 0.0f, acc1 = 0.f;
#pragma unroll
                for (int j4 = 0; j4 < (i + 3) / 4; ++j4) { const f32x4 a4 = *(const LAS f32x4*)(lds + AO + (32 * h + i) * 272 + (32 * h + 4 * j4) * 4);
#pragma unroll
                    for (int q = 0; q < 4; ++q) if (4 * j4 + q < i) { if (q & 1) acc1 -= a4[q] * t[4 * j4 + q]; else acc0 -= a4[q] * t[4 * j4 + q]; } }
                t[i] = acc0 + acc1;
                *(LAS unsigned short*)(lds + TO + h * 2048 + i * 64 + 2 * r) = (unsigned short)(cvtpk(t[i], 0.f) & 0xffffu);
                if ((i & 3) == 3) asm volatile("" ::: "memory");
            }
        } else if (wid >= 4) {
            const int w4 = wid - 4; const float gend = gS[63];
#pragma unroll
            for (int k = 0; k < 4; ++k) { const int f = w4 * 4 + k, ib = f >> 3, s = f & 7, i = 32 * ib + r;
                float q8[8]; unpack8(*(const LAS u32x4*)(lds + QO + i * 272 + 32 * s + 16 * h), q8); const float e = __expf(gS[i]);
#pragma unroll
                for (int q = 0; q < 8; ++q) q8[q] *= e;
                *(u32x4*)(gf + GF_QD + (size_t)(f * 64 + lane) * 16) = pack8(q8); }
#pragma unroll
            for (int k = 0; k < 4; ++k) { const int f = w4 * 4 + k, db = f >> 2, st = f & 3, dk = 32 * db + r;
                u32x4 w;
#pragma unroll
                for (int q = 0; q < 4; ++q) { const int t0 = 16 * st + 8 * (q >> 1) + 4 * h + 2 * (q & 1);
                    const float ka = bf2f((bf16)lds_u16(lds + KO + t0 * 272 + 2 * dk)) * __expf(gend - gS[t0]), kb = bf2f((bf16)lds_u16(lds + KO + (t0 + 1) * 272 + 2 * dk)) * __expf(gend - gS[t0 + 1]);
                    w[q] = cvtpk(ka, kb); }
                *(u32x4*)(gf + GF_KE + (size_t)(f * 64 + lane) * 16) = w; }
            if (tid == 256) *(float*)(gf + GF_EE) = __expf(gend);
        }
        __syncthreads();
        { const bool isv = wid < 4; const int c = 32 * (wid & 3) + r;
          const LAS unsigned char* srcp = lds + (isv ? VO : KO) + 2 * c; const LAS float* fS = (const LAS float*)(lds + (isv ? BSO : BSO + 256));
          f32x16 x0, x1;
#pragma unroll
          for (int q = 0; q < 16; ++q) { x0[q] = 0.f; const int tok = 32 + (q & 3) + 8 * (q >> 2) + 4 * h; x1[q] = fS[tok] * bf2f((bf16)lds_u16(srcp + tok * 272)); }
#pragma unroll
          for (int s = 0; s < 2; ++s) { u32x4 rw_;
#pragma unroll
              for (int q = 0; q < 4; ++q) { const int t0 = 16 * s + 8 * h + 2 * q; rw_[q] = cvtpk(fS[t0] * bf2f((bf16)lds_u16(srcp + t0 * 272)), fS[t0 + 1] * bf2f((bf16)lds_u16(srcp + (t0 + 1) * 272))); }
              const bf16x8 ta = *(const LAS bf16x8*)(lds + TO + r * 64 + 32 * s + 16 * h);
              x0 = __builtin_amdgcn_mfma_f32_32x32x16_bf16(ta, __builtin_bit_cast(bf16x8, rw_), x0, 0, 0, 0); }
#pragma unroll
          for (int s2 = 0; s2 < 2; ++s2) { u32x4 xb, aw;
#pragma unroll
              for (int q = 0; q < 4; ++q) xb[q] = cvtpk(x0[8 * s2 + 2 * q], x0[8 * s2 + 2 * q + 1]);
              const f32x4 a0 = *(const LAS f32x4*)(lds + AO + (32 + r) * 272 + (16 * s2 + 4 * h) * 4), a1 = *(const LAS f32x4*)(lds + AO + (32 + r) * 272 + (16 * s2 + 8 + 4 * h) * 4);
              aw[0] = cvtpk(-a0.x, -a0.y); aw[1] = cvtpk(-a0.z, -a0.w); aw[2] = cvtpk(-a1.x, -a1.y); aw[3] = cvtpk(-a1.z, -a1.w);
              x1 = __builtin_amdgcn_mfma_f32_32x32x16_bf16(__builtin_bit_cast(bf16x8, aw), __builtin_bit_cast(bf16x8, xb), x1, 0, 0, 0); }
          f32x16 y1;
#pragma unroll
          for (int q = 0; q < 16; ++q) y1[q] = 0.f;
#pragma unroll
          for (int s2 = 0; s2 < 2; ++s2) { u32x4 rb;
#pragma unroll
              for (int q = 0; q < 4; ++q) rb[q] = cvtpk(x1[8 * s2 + 2 * q], x1[8 * s2 + 2 * q + 1]);
              const u32x2 t0 = *(const LAS u32x2*)(lds + TO + 2048 + r * 64 + (16 * s2 + 4 * h) * 2), t1 = *(const LAS u32x2*)(lds + TO + 2048 + r * 64 + (16 * s2 + 8 + 4 * h) * 2);
              y1 = __builtin_amdgcn_mfma_f32_32x32x16_bf16(__builtin_bit_cast(bf16x8, (u32x4){t0.x, t0.y, t1.x, t1.y}), __builtin_bit_cast(bf16x8, rb), y1, 0, 0, 0); }
          if (isv) {
              f32x4* d0 = (f32x4*)(gf + GF_U0 + (size_t)((wid * 2 + 0) * 64 + lane) * 64); f32x4* d1 = (f32x4*)(gf + GF_U0 + (size_t)((wid * 2 + 1) * 64 + lane) * 64);
#pragma unroll
              for (int q = 0; q < 4; ++q) { d0[q] = (f32x4){x0[4 * q], x0[4 * q + 1], x0[4 * q + 2], x0[4 * q + 3]}; d1[q] = (f32x4){y1[4 * q], y1[4 * q + 1], y1[4 * q + 2], y1[4 * q + 3]}; }
          } else {
              const int dk = 32 * (wid - 4) + r;
#pragma unroll
              for (int q = 0; q < 16; ++q) { const int tok = (q & 3) + 8 * (q >> 2) + 4 * h;
                  *(LAS unsigned short*)(lds + XO + tok * 272 + 2 * dk) = (unsigned short)(cvtpk(-x0[q], 0.f) & 0xffffu);
                  *(LAS unsigned short*)(lds + XO + (32 + tok) * 272 + 2 * dk) = (unsigned short)(cvtpk(-y1[q], 0.f) & 0xffffu); }
          } }
        __syncthreads();
#pragma unroll
        for (int k = 0; k < 2; ++k) { const int f = wid * 2 + k, tb = f >> 3, s = f & 7;
            *(u32x4*)(gf + GF_WM + (size_t)(f * 64 + lane) * 16) = *(const LAS u32x4*)(lds + XO + (32 * tb + r) * 272 + 32 * s + 16 * h); }
        __syncthreads();
    }
}

__device__ __forceinline__ void gdn_seq_item(const PView& p, LAS unsigned char* lds, int chain, int vq) {
    const int tid = ltid(), wid = __builtin_amdgcn_readfirstlane(tid >> 6), lane = tid & 63, r = lane & 31, h = lane >> 5;
    const int b = chain >> 3, hh = (chain >> 1) & 3, dir = chain & 1;
    unsigned char* ws = p.ws;
    const unsigned char* gfc = ws + OFF_GF + (size_t)chain * NCHUNK * GF_ITEM;
    constexpr int SBS = 8704, UFO = 17408;
    for (int i = tid; i < SBS / 4; i += NTHR) ((LAS unsigned*)lds)[i] = 0u;
    __syncthreads();
    if (wid < 2) {
        u32x4 wm[3][8]; f32x4 uu[3][4];
#define LD_A(SET, C) do { const unsigned char* gf_ = gfc + (size_t)(C) * GF_ITEM; \
            _Pragma("unroll") for (int s = 0; s < 8; ++s) wm[SET][s] = *(const u32x4*)(gf_ + GF_WM + (size_t)((wid * 8 + s) * 64 + lane) * 16); \
            const f32x4* up_ = (const f32x4*)(gf_ + GF_U0 + (size_t)((vq * 2 + wid) * 64 + lane) * 64); \
            _Pragma("unroll") for (int q = 0; q < 4; ++q) uu[SET][q] = up_[q]; } while (0)
#define ST_A(SET, C) do { const LAS unsigned char* sb_ = lds + ((C) & 1) * SBS; f32x16 acc_; \
            _Pragma("unroll") for (int q = 0; q < 4; ++q) { acc_[4 * q] = uu[SET][q].x; acc_[4 * q + 1] = uu[SET][q].y; acc_[4 * q + 2] = uu[SET][q].z; acc_[4 * q + 3] = uu[SET][q].w; } \
            _Pragma("unroll") for (int s = 0; s < 8; ++s) { const bf16x8 sf_ = *(const LAS bf16x8*)(sb_ + r * 272 + 32 * s + 16 * h); \
                acc_ = __builtin_amdgcn_mfma_f32_32x32x16_bf16(__builtin_bit_cast(bf16x8, wm[SET][s]), sf_, acc_, 0, 0, 0); } \
            _Pragma("unroll") for (int s2 = 0; s2 < 2; ++s2) { u32x4 w_; _Pragma("unroll") for (int q = 0; q < 4; ++q) w_[q] = cvtpk(acc_[8 * s2 + 2 * q], acc_[8 * s2 + 2 * q + 1]); \
                *(LAS u32x4*)(lds + UFO + ((2 * wid + s2) * 64 + lane) * 16) = w_; } \
            LDS_BAR(); LDS_BAR(); } while (0)
        LD_A(0, 0); LD_A(1, 1);
        for (int c = 0; c < NCHUNK; c += 3) { LD_A(2, c + 2); ST_A(0, c); LD_A(0, min(c + 3, NCHUNK - 1)); ST_A(1, c + 1); LD_A(1, min(c + 4, NCHUNK - 1)); ST_A(2, c + 2); }
#undef LD_A
#undef ST_A
    } else if (wid < 4) {
        const int ib = wid - 2;
        char* OGu = (char*)((float*)(ws + OFF_OGD) + (size_t)dir * T * 512 + hh * 128 + vq * 32);
        const int ostep = dir ? -2048 : 2048, ot0 = 32 * ib + 4 * h;
        u32x4 qd[3][8], qk[3][4];
#define LD_B(SET, C) do { const unsigned char* gf_ = gfc + (size_t)(C) * GF_ITEM; \
            _Pragma("unroll") for (int s = 0; s < 8; ++s) qd[SET][s] = *(const u32x4*)(gf_ + GF_QD + (size_t)((ib * 8 + s) * 64 + lane) * 16); \
            _Pragma("unroll") for (int s = 0; s < 4; ++s) qk[SET][s] = *(const u32x4*)(gf_ + GF_QK + (size_t)((ib * 4 + s) * 64 + lane) * 16); } while (0)
#define ST_B(SET, C) do { const LAS unsigned char* sb_ = lds + ((C) & 1) * SBS; f32x16 acc_; \
            _Pragma("unroll") for (int q = 0; q < 16; ++q) acc_[q] = 0.f; \
            _Pragma("unroll") for (int s = 0; s < 8; ++s) { const bf16x8 sf_ = *(const LAS bf16x8*)(sb_ + r * 272 + 32 * s + 16 * h); \
                acc_ = __builtin_amdgcn_mfma_f32_32x32x16_bf16(__builtin_bit_cast(bf16x8, qd[SET][s]), sf_, acc_, 0, 0, 0); } \
            LDS_BAR(); \
            _Pragma("unroll") for (int s = 0; s < 4; ++s) { const bf16x8 uf_ = *(const LAS bf16x8*)(lds + UFO + (s * 64 + lane) * 16); \
                acc_ = __builtin_amdgcn_mfma_f32_32x32x16_bf16(__builtin_bit_cast(bf16x8, qk[SET][s]), uf_, acc_, 0, 0, 0); } \
            const unsigned ob_ = (unsigned)(((b * TB + chunk_s0(dir, (C)) + (dir ? 63 - ot0 : ot0)) * 512 + r) * 4); \
            _Pragma("unroll") for (int q = 0; q < 16; ++q) { *(float*)(OGu + (ob_ + (unsigned)(((q & 3) + 8 * (q >> 2)) * ostep))) = acc_[q]; } \
            LDS_BAR(); } while (0)
        LD_B(0, 0); LD_B(1, 1);
        for (int c = 0; c < NCHUNK; c += 3) { LD_B(2, c + 2); ST_B(0, c); LD_B(0, min(c + 3, NCHUNK - 1)); ST_B(1, c + 1); LD_B(1, min(c + 4, NCHUNK - 1)); ST_B(2, c + 2); }
#undef LD_B
#undef ST_B
    } else {
        const int db = wid - 4;
        u32x4 ke[3][4]; float ee[3];
        f32x16 sacc;
#pragma unroll
        for (int q = 0; q < 16; ++q) sacc[q] = 0.f;
#define LD_C(SET, C) do { const unsigned char* gf_ = gfc + (size_t)(C) * GF_ITEM; \
            _Pragma("unroll") for (int s = 0; s < 4; ++s) ke[SET][s] = *(const u32x4*)(gf_ + GF_KE + (size_t)((db * 4 + s) * 64 + lane) * 16); ee[SET] = *(const float*)(gf_ + GF_EE); } while (0)
#define ST_C(SET, C) do { LAS unsigned char* sn_ = lds + (((C) & 1) ^ 1) * SBS; \
            _Pragma("unroll") for (int q = 0; q < 16; ++q) sacc[q] *= ee[SET]; \
            LDS_BAR(); \
            _Pragma("unroll") for (int s = 0; s < 4; ++s) { const bf16x8 uf_ = *(const LAS bf16x8*)(lds + UFO + (s * 64 + lane) * 16); \
                sacc = __builtin_amdgcn_mfma_f32_32x32x16_bf16(__builtin_bit_cast(bf16x8, ke[SET][s]), uf_, sacc, 0, 0, 0); } \
            _Pragma("unroll") for (int g4 = 0; g4 < 4; ++g4) *(LAS u32x2*)(sn_ + r * 272 + 2 * (32 * db + 8 * g4 + 4 * h)) = (u32x2){cvtpk(sacc[4 * g4], sacc[4 * g4 + 1]), cvtpk(sacc[4 * g4 + 2], sacc[4 * g4 + 3])}; \
            LDS_BAR(); } while (0)
        LD_C(0, 0); LD_C(1, 1);
        for (int c = 0; c < NCHUNK; c += 3) { LD_C(2, c + 2); ST_C(0, c); LD_C(0, min(c + 3, NCHUNK - 1)); ST_C(1, c + 1); LD_C(1, min(c + 4, NCHUNK - 1)); ST_C(2, c + 2); }
#undef LD_C
#undef ST_C
    }
}

__device__ __forceinline__ void phase_scan(const PView& p, int l, LAS unsigned char* lds, int bid, int G) {
    for (int wi = bid; wi < 256; wi += G) {
        const int x = wi & 7, k = wi >> 3, item = ((k >> 4) << 7) + x * 16 + (k & 15);
        const int it = item & 127, chain = it >> 2, vq = it & 3;
        if (item < 128) { for (int rp = 0; rp < NREP(53); ++rp) { gdn_seq_item(p, lds, chain, vq); __syncthreads(); } }
        else { for (int rp = 0; rp < NREP(54); ++rp) { mlstm_chunk_item(p, lds, chain, vq); __syncthreads(); } }
        __syncthreads();
    }
}

__device__ __forceinline__ void phase_scanout(const PView& p, int l, int bid, int G) {
    const int tid = ltid(), wid = __builtin_amdgcn_readfirstlane(tid >> 6), lane = tid & 63;
    unsigned char* ws = p.ws;
    const bf16* P = (const bf16*)(ws + OFF_R1); const bf16* Y = (const bf16*)(ws + OFF_Y);
    signed char* Y8 = (signed char*)(ws + OFF_Y8); float* SY = (float*)(ws + OFF_SY);
    const float* OG = (const float*)(ws + OFF_OGD); const float* OM = (const float*)(ws + OFF_OML);
    for (int tp = bid * NWAVES + wid; tp < T / 2; tp += G * NWAVES) {
        f32x4 oa[2][2][2], ob[2][2][2]; u32x4 gw[2][2], ya[2][2];
#pragma unroll
        for (int u = 0; u < 2; ++u)
#pragma unroll
            for (int which = 0; which < 2; ++which) { const int tk = 2 * tp + u;
                const float* o0 = (which ? OM : OG) + (size_t)tk * 512 + 8 * lane; const float* o1 = o0 + (size_t)T * 512;
                oa[u][which][0] = *(const f32x4*)o0; oa[u][which][1] = *(const f32x4*)(o0 + 4); ob[u][which][0] = *(const f32x4*)o1; ob[u][which][1] = *(const f32x4*)(o1 + 4);
                gw[u][which] = *(const u32x4*)(P + (size_t)tk * LDP + (which ? PC_LO : PC_GG) + 8 * lane);
                ya[u][which] = *(const u32x4*)(Y + (size_t)tk * 2048 + which * 1024 + 8 * lane); }
#pragma unroll
        for (int u = 0; u < 2; ++u)
#pragma unroll
            for (int br = 0; br < 4; ++br) { const int tk = 2 * tp + u, which = br >> 1;
                float y[8];
                if (br & 1) {
                    float x[8]; { const f32x4 a0 = oa[u][which][0], a1 = oa[u][which][1], b0 = ob[u][which][0], b1 = ob[u][which][1];
                        x[0] = a0.x + b0.x; x[1] = a0.y + b0.y; x[2] = a0.z + b0.z; x[3] = a0.w + b0.w; x[4] = a1.x + b1.x; x[5] = a1.y + b1.y; x[6] = a1.z + b1.z; x[7] = a1.w + b1.w; }
                    float ss = 0.f;
#pragma unroll
                    for (int i = 0; i < 8; ++i) ss += x[i] * x[i];
                    ss = row16_sum(ss);
                    const float rs = __builtin_amdgcn_rsqf(ss * (1.f / 128.f) + 1e-6f);
                    const float* ng = (which ? p.in[I_MLG] : p.in[I_GNG]) + l * 128 + 8 * (lane & 15);
                    float gt[8]; unpack8(gw[u][which], gt);
#pragma unroll
                    for (int i = 0; i < 8; ++i) { const float sg = fsigmoid(gt[i]); y[i] = x[i] * rs * ng[i] * (which ? sg : gt[i] * sg); }
                } else unpack8(ya[u][which], y);
                float am = 0.f;
#pragma unroll
                for (int i = 0; i < 8; ++i) am = fmaxf(am, fabsf(y[i]));
                const float amax = wave_max(am), inv = amax > 0.f ? 127.0f / amax : 0.f;
                if (lane == 0) SY[tk * 4 + br] = amax * (1.0f / 127.0f);
                *(u32x2*)(Y8 + (size_t)tk * 2048 + br * 512 + 8 * lane) = (u32x2){q8x4((f32x4){y[0], y[1], y[2], y[3]} * inv), q8x4((f32x4){y[4], y[5], y[6], y[7]} * inv)}; }
    }
}

constexpr int NPH_L = 14, PH_L0 = 1, PH_FINAL = PH_L0 + DEPTH * NPH_L, NPHASES = PH_FINAL + 1;
__global__ void __launch_bounds__(NTHR, 2) fwd_kernel(Params kp) {
    extern __shared__ __attribute__((aligned(16))) unsigned char lds_raw[];
    LAS unsigned char* lds = (LAS unsigned char*)lds_raw;
    volatile LAS unsigned* MISC = (volatile LAS unsigned*)(lds + MISC_OFF);
    const int tid = threadIdx.x;
    for (int u = tid; u < (LDS_BYTES - MISC_OFF) / 4; u += NTHR) ((LAS unsigned*)(lds + MISC_OFF))[u] = 0u;
    __syncthreads();
    const int lo = kp.ph_lo, hi = kp.ph_hi;
    XcdBarrier bar; bar.bar = (unsigned*)(kp.ws + OFF_CTL) + CW_BAR; bar.x = 0; bar.st = MISC + 8;
    if (hi - lo > 1) bar = xcd_barrier_post((unsigned*)(kp.ws + OFF_CTL) + CW_BAR, MISC + 8);
#define IN(k) (lo <= (k) && (k) < hi)
#define SEAM(k) do { if ((k) + 1 < hi) xcd_barrier(bar); } while (0)

    if (IN(0)) { const PView p = pview(); phase_prologue(p, lds, p.bid, p.G); SEAM(0); }
    for (int l = 0; l < DEPTH; ++l) {
        const int pb = PH_L0 + l * NPH_L;
        if (IN(pb + 0)) { const PView p = pview(); if (NREP(60) == 2) { phase_norm1<0>(p, l, p.bid, p.G, true); __syncthreads(); } phase_norm1<0>(p, l, p.bid, p.G); SEAM(pb + 0); }
        if (IN(pb + 1)) {
            const PView p = pview(); unsigned char* ws = p.ws;
            ProbPlain pr{(const char*)(ws + OFF_H), (const char*)(ws + OFF_WIN) + (size_t)l * NIN * 1024, 1024u, 1024u, 8};
            pg8::Order S; S.init(T / 256, NIN / 256, p.G, p.bid);
            EpiIn8 E{(bf16*)(ws + OFF_R1), (bf16*)(ws + OFF_R2), (float*)(ws + OFF_GATES), p.in[I_BMG] + (size_t)l * NGATE, (const float*)(ws + OFF_SH), (const float*)(ws + OFF_CMIN) + (size_t)l * NIN};
            for (int rp = 0; rp < NREP(1); ++rp) pg8::gemm_phase(lds, pr, S, E); SEAM(pb + 1); }
        if (IN(pb + 2)) { const PView p = pview(); if (NREP(2) == 2) { phase_prep(p, l, lds, p.bid, p.G); __syncthreads(); } phase_prep(p, l, lds, p.bid, p.G); SEAM(pb + 2); }
        if (IN(pb + 3)) {
            const PView p = pview(); unsigned char* ws = p.ws;
            ProbPlain pr{(const char*)(ws + OFF_AQ), (const char*)(ws + OFF_WUQKV) + (size_t)l * 1792 * 384 * 2, 768u, 768u, 6};
            pg8::Order S; S.init(T / 256, 7, p.G, p.bid);
            EpiStore E{(bf16*)(ws + OFF_QKVR), 1792, nullptr, 0};
            for (int rp = 0; rp < NREP(3); ++rp) pg8::gemm_phase(lds, pr, S, E); SEAM(pb + 3); }
        if (IN(pb + 4)) { const PView p = pview(); if (NREP(62) == 2) { phase_mlapost(p, l, lds, p.bid, p.G, true); __syncthreads(); } phase_mlapost(p, l, lds, p.bid, p.G); SEAM(pb + 4); }
        if (IN(pb + 5)) { for (int rp = 0; rp < NREP(50); ++rp) { const PView p = pview(); phase_attn(p, l, lds, p.bid, p.G); __syncthreads(); }
                          for (int rp = 0; rp < NREP(52); ++rp) { const PView p = pview(); phase_gdnpre(p, l, lds, p.bid, p.G); __syncthreads(); } SEAM(pb + 5); }
        if (IN(pb + 6)) { for (int rp = 0; rp < NREP(51); ++rp) { const PView p = pview(); phase_scan(p, l, lds, p.bid, p.G); __syncthreads(); } SEAM(pb + 6); }
        if (IN(pb + 7)) { const PView p = pview(); for (int rp = 0; rp < NREP(6); ++rp) phase_scanout(p, l, p.bid, p.G); SEAM(pb + 7); }
        if (IN(pb + 8)) {
            const PView p = pview(); unsigned char* ws = p.ws;
            ProbBO pr{(const char*)(ws + OFF_Y8), (const char*)(ws + OFF_WBO) + (size_t)l * 4096 * 512, 2048u, 512u, 4};
            pg8::Order S; if (l == DEPTH - 1) S.init(NB * SEQ / 256, 4, p.G, p.bid, 4, 1); else S.init(T / 256, 4, p.G, p.bid, 4);
            EpiBO E{(bf16*)(ws + OFF_R3), (const bf16*)(ws + OFF_R2), (const float*)(ws + OFF_SY), (const float*)(ws + OFF_CMBO) + (size_t)l * 4096};
            for (int rp = 0; rp < NREP(7); ++rp) pg8::gemm_phase(lds, pr, S, E); SEAM(pb + 8); }
        if (IN(pb + 9)) {
            const PView p = pview(); unsigned char* ws = p.ws;
            ProbPlain pr{(const char*)(ws + OFF_R3), (const char*)(ws + OFF_WOUT4) + (size_t)l * 1024 * 4096 * 2, 2048u, 8192u, 16};
            pg8::Order S; if (l == DEPTH - 1) S.init(NB * SEQ / 256, 4, p.G, p.bid, 1, 1); else S.init(T / 256, 4, p.G, p.bid);
            EpiOut E{(float*)(ws + OFF_X), (const float*)(ws + OFF_MOD) + (size_t)l * 5 * 6144};
            pg8::gemm_phase(lds, pr, S, E); SEAM(pb + 9); }
        if (IN(pb + 10)) { const PView p = pview(); if (NREP(61) == 2) { phase_router(p, l, lds, p.bid, p.G, true); __syncthreads(); } phase_router(p, l, lds, p.bid, p.G); SEAM(pb + 10); }
        if (IN(pb + 11)) { const PView p = pview(); for (int rp = 0; rp < NREP(10); ++rp) { phase_gather(p, l, lds, p.bid, p.G); __syncthreads(); } SEAM(pb + 11); }
        if (IN(pb + 12)) {
            const PView p = pview(); unsigned char* ws = p.ws; const int* tst = (const int*)(ws + OFF_CTL) + CW_TST + l * 64;
            ProbMoE pr{(const char*)(ws + OFF_R1), (const char*)(ws + OFF_WGU) + (size_t)l * 32 * 2048 * 1024, 1024u, 1024u, 8, tst, (size_t)2048 * 1024};
            pg8::Order S; S.init(tst[32], 8, p.G, p.bid);
            EpiMoE18 E{(bf16*)(ws + OFF_R2), p.in[I_BGU] + (size_t)l * 32 * 2048, (const float*)(ws + OFF_SX), (const float*)(ws + OFF_CMGU) + (size_t)l * 32 * 2048};
            for (int rp = 0; rp < NREP(11); ++rp) pg8::gemm_phase(lds, pr, S, E); SEAM(pb + 12); }
        if (IN(pb + 13)) {
            const PView p = pview(); unsigned char* ws = p.ws; const int* tst = (const int*)(ws + OFF_CTL) + CW_TST + l * 64;
            ProbMoE pr{(const char*)(ws + OFF_R2), (const char*)(ws + OFF_WDN) + (size_t)l * 32 * 1024 * 1024, 1024u, 1024u, 8, tst, (size_t)1024 * 1024};
            pg8::Order S; S.init(tst[32], 4, p.G, p.bid);
            EpiStoreF8 E{(bf16*)(ws + OFF_R3), 1024, p.in[I_BDN] + (size_t)l * 32 * 1024, 1024};
            for (int rp = 0; rp < NREP(12); ++rp) pg8::gemm_phase(lds, pr, S, E); SEAM(pb + 13); }
    }
    if (IN(PH_FINAL)) { const PView p = pview(); phase_norm1<2>(p, DEPTH, p.bid, p.G); }
#undef IN
#undef SEAM
}

extern "C" void kernel_launch(void* const* d_in, const int* in_sizes, int n_in, void* d_out, int out_size, void* d_ws, size_t ws_size, hipStream_t stream) {
    static int grid = 0;
    if (!grid) {
        if (n_in != 31 || ws_size < WS_END) { fprintf(stderr, "kernel_launch: expected 31 inputs and >= %zu bytes of workspace (got %d, %zu)\n", (size_t)WS_END, n_in, ws_size); grid = -1; return; }
        int dev = 0, cus = 0, per_cu = 0;
        hipGetDevice(&dev); hipDeviceGetAttribute(&cus, hipDeviceAttributeMultiprocessorCount, dev);
        hipFuncSetAttribute((const void*)fwd_kernel, hipFuncAttributeMaxDynamicSharedMemorySize, LDS_BYTES);
        hipOccupancyMaxActiveBlocksPerMultiprocessor(&per_cu, (const void*)fwd_kernel, NTHR, LDS_BYTES);
        if (per_cu < 1) fprintf(stderr, "kernel_launch: occupancy query reports %d blocks per CU\n", per_cu);
        grid = cus;
    }
    if (grid < 0) return;
    hipMemsetAsync((char*)d_ws + OFF_CTL, 0, CTL_BYTES, stream);
    Params p{};
    for (int i = 0; i < 31; ++i) p.in[i] = (const float*)d_in[i];
    p.out = (float*)d_out; p.ws = (unsigned char*)d_ws;
#if MK_N_LAUNCHES == 1
    p.ph_lo = 0; p.ph_hi = NPHASES;
    hipLaunchKernelGGL(fwd_kernel, dim3(grid), dim3(NTHR), LDS_BYTES, stream, p);
#else
    for (int ph = 0; ph < NPHASES; ++ph) { p.ph_lo = ph; p.ph_hi = ph + 1; hipLaunchKernelGGL(fwd_kernel, dim3(grid), dim3(NTHR), LDS_BYTES, stream, p); }
#endif
}
```

```cpp
#include <hip/hip_runtime.h>
#include <cstdio>
#include <cstdint>

#ifndef MK_N_LAUNCHES
#define MK_N_LAUNCHES 1
#endif

#ifndef PROBE_DUP
#define PROBE_DUP -1
#endif
#define NREP(k) ((PROBE_DUP == (k)) ? 2 : 1)
#define GAS __attribute__((address_space(1)))
#define LAS __attribute__((address_space(3)))
typedef unsigned short bf16;
typedef short bf16x8 __attribute__((ext_vector_type(8)));
typedef short s16x4 __attribute__((ext_vector_type(4)));
typedef float f32x4 __attribute__((ext_vector_type(4)));
typedef float f32x2 __attribute__((ext_vector_type(2)));
typedef float f32x16 __attribute__((ext_vector_type(16)));
typedef unsigned u32x4 __attribute__((ext_vector_type(4)));
typedef unsigned u32x2 __attribute__((ext_vector_type(2)));
typedef int i32x4 __attribute__((ext_vector_type(4)));
typedef int i32x8 __attribute__((ext_vector_type(8)));
typedef __bf16 bf16x2_t __attribute__((ext_vector_type(2)));

constexpr int D = 1024, NB = 4, SEQ = 8192, CTX = 256, TB = SEQ + CTX, T = NB * TB, DEPTH = 4;
constexpr int DIN = 5568, LDP = 5632, NGATE = 4096, NIN = LDP + NGATE;
constexpr int NE = 32, TOPK = 4, DFF = 1024;
constexpr int NSLOT = 143360;
constexpr int NWAVES = 8, NTHR = 512;
constexpr int PC_NAQ = 0, PC_NAK = 512, PC_NAV = 1024, PC_GQKV = 1536, PC_GG = 3072, PC_MQ = 3600, PC_MKV = 3856, PC_MKPE = 3984,
              PC_LQ = 4016, PC_LK = 4272, PC_LV = 4528, PC_LO = 5040;

constexpr size_t MiB = (size_t)1 << 20;
constexpr size_t OFF_CTL = 0, CTL_BYTES = 1 * MiB;
constexpr size_t OFF_MOD = 1 * MiB;
constexpr size_t OFF_X = 2 * MiB;
constexpr size_t OFF_H = 134 * MiB;
constexpr size_t OFF_SH = OFF_H + 40 * MiB;
constexpr size_t OFF_SX = 200 * MiB + 300 * MiB;
constexpr size_t OFF_R1 = 200 * MiB;
constexpr size_t OFF_R2 = 563 * MiB;
constexpr size_t OFF_R3 = 843 * MiB;
constexpr size_t OFF_GQKV = 1123 * MiB;
constexpr size_t OFF_GATES = 1222 * MiB;
constexpr size_t OFF_GDNG = 1227 * MiB;
constexpr size_t OFF_MLG = 1230 * MiB;
constexpr size_t OFF_AQ = 1233 * MiB;
constexpr size_t OFF_QKVR = 1258 * MiB;
constexpr size_t OFF_KM = 1374 * MiB;
constexpr size_t OFF_VTM = 1424 * MiB;
constexpr size_t OFF_VTN = 1457 * MiB;
constexpr size_t OFF_OGD = 1490 * MiB;
constexpr size_t OFF_OML = 1622 * MiB;
constexpr size_t OFF_Y = 1754 * MiB;
constexpr size_t OFF_TOPW = 1886 * MiB;
constexpr size_t OFF_TOPE = OFF_TOPW + 768 * 1024;
constexpr size_t OFF_POS = OFF_TOPE + 768 * 1024;
constexpr size_t OFF_SLOT = OFF_POS + 768 * 1024;
constexpr size_t OFF_WIN = 1889 * MiB;
constexpr size_t OFF_CMIN = OFF_WIN + 40 * MiB;
constexpr size_t OFF_WUQKV = 1965 * MiB;
constexpr size_t OFF_WBO = 1971 * MiB;
constexpr size_t OFF_CMBO = OFF_WBO + 10 * MiB;
constexpr size_t OFF_WOUT4 = 1987 * MiB;
constexpr size_t OFF_WGU = 2019 * MiB;
constexpr size_t OFF_CMGU = OFF_WGU + 260 * MiB;
constexpr size_t OFF_WDN = 2531 * MiB;
constexpr size_t OFF_GC = 2787 * MiB;
constexpr size_t OFF_MC = 2791 * MiB;
constexpr size_t OFF_GF = 2794 * MiB;
constexpr size_t OFF_Y8 = 3200 * MiB;
constexpr size_t OFF_SY = 3270 * MiB;
constexpr size_t OFF_QM8 = 3272 * MiB;
constexpr size_t WS_END = 3306 * MiB;
constexpr int CW_BAR = 4096, CW_CNT = 8192  , CW_TST = 8448  ;

constexpr int RING_BYTES = 131072, MISC_OFF = RING_BYTES, LDS_BYTES = 147456;

__device__ __forceinline__ unsigned cvtpk(float lo, float hi) { f32x2 v = {lo, hi}; bf16x2_t b = __builtin_convertvector(v, bf16x2_t); return __builtin_bit_cast(unsigned, b); }
__device__ __forceinline__ float bflo(unsigned w) { return __uint_as_float(w << 16); }
__device__ __forceinline__ float bfhi(unsigned w) { return __uint_as_float(w & 0xffff0000u); }
__device__ __forceinline__ float bf2f(bf16 b) { return __uint_as_float(((unsigned)b) << 16); }
__device__ __forceinline__ float fexp2(float x) { return __builtin_amdgcn_exp2f(x); }
__device__ __forceinline__ float fexp(float x) { return __builtin_amdgcn_exp2f(x * 1.4426950408889634f); }
__device__ __forceinline__ float frcp(float x) { return __builtin_amdgcn_rcpf(x); }
__device__ __forceinline__ float fsigmoid(float x) { return frcp(1.0f + fexp(-x)); }
__device__ __forceinline__ float wave_sum(float v) {
#pragma unroll
    for (int o = 1; o < 64; o <<= 1) v += __shfl_xor(v, o);
    return v;
}
#define LDS_BAR() do { asm volatile("s_waitcnt lgkmcnt(0)" ::: "memory"); __builtin_amdgcn_s_barrier(); asm volatile("" ::: "memory"); } while (0)
__device__ __forceinline__ int ltid() { int t = threadIdx.x; asm volatile("" : "+v"(t)); return t; }
__device__ __forceinline__ float wave_max(float v) {
#pragma unroll
    for (int o = 1; o < 64; o <<= 1) v = fmaxf(v, __shfl_xor(v, o));
    return v;
}
__device__ __forceinline__ unsigned q8x4(const f32x4 x) {
    const int a = (int)__builtin_rintf(x.x), b = (int)__builtin_rintf(x.y), c = (int)__builtin_rintf(x.z), d = (int)__builtin_rintf(x.w);
    return ((unsigned)a & 0xffu) | (((unsigned)b & 0xffu) << 8) | (((unsigned)c & 0xffu) << 16) | (((unsigned)d & 0xffu) << 24);
}
template <int CTRL> __device__ __forceinline__ float dppf(float v) { return __int_as_float(__builtin_amdgcn_update_dpp(0, __float_as_int(v), CTRL, 0xf, 0xf, true)); }
__device__ __forceinline__ float row16_sum(float v) { v += dppf<0xB1>(v); v += dppf<0x4E>(v); v += dppf<0x141>(v); v += dppf<0x140>(v); return v; }
__device__ __forceinline__ void unpack8(const u32x4 w, float (&f)[8]) { f[0] = bflo(w.x); f[1] = bfhi(w.x); f[2] = bflo(w.y); f[3] = bfhi(w.y); f[4] = bflo(w.z); f[5] = bfhi(w.z); f[6] = bflo(w.w); f[7] = bfhi(w.w); }
__device__ __forceinline__ u32x4 pack8(const float (&f)[8]) { u32x4 w; w.x = cvtpk(f[0], f[1]); w.y = cvtpk(f[2], f[3]); w.z = cvtpk(f[4], f[5]); w.w = cvtpk(f[6], f[7]); return w; }

#define XB_TMO      128
#define XB_XCNT(j)  (256  + 64 * (j))
#define XB_XSUB(j)  (1280 + 64 * (j))
#define XB_XGEN(j)  (2304 + 64 * (j))
#define XB_TOP      3328
#define XB_TOPGEN   3392
#define XCD_BAR_WORDS 3456
#define XB_SPIN_CAP (1u << 25)
__device__ __forceinline__ unsigned xb_ld(unsigned* p)              { return __hip_atomic_load(p, __ATOMIC_RELAXED, __HIP_MEMORY_SCOPE_AGENT); }
__device__ __forceinline__ unsigned xb_add(unsigned* p, unsigned v) { return __hip_atomic_fetch_add(p, v, __ATOMIC_RELAXED, __HIP_MEMORY_SCOPE_AGENT); }
__device__ __forceinline__ unsigned xb_xcc_id() { return (unsigned)__builtin_amdgcn_s_getreg((3 << 11) | 20) & 0xFu; }
#define XB_SPIN(cond, bar) do { unsigned _sp = 0; while (cond) { __builtin_amdgcn_s_sleep(1); \
    if ((++_sp & 255u) == 0u) { if (xb_ld(&(bar)[XB_TMO])) break; if (_sp > XB_SPIN_CAP) { atomicAdd(&(bar)[XB_TMO], 1u); break; } } } } while (0)
struct XcdBarrier { unsigned* bar; unsigned x; volatile LAS unsigned* st; };
__device__ __forceinline__ XcdBarrier xcd_barrier_post(unsigned* bar, volatile LAS unsigned* st) {
    XcdBarrier b; b.bar = bar; b.x = xb_xcc_id(); b.st = st;
    if (threadIdx.x == 0) (void)xb_add(&bar[XB_XCNT(b.x)], 1u);
    return b;
}
__device__ __forceinline__ void xcd_barrier_complete(unsigned* bar, unsigned x, unsigned& nloc, unsigned& nx) {
    const unsigned G = gridDim.x * gridDim.y * gridDim.z;
    unsigned sum, cnt, mine, sp = 0u;
    for (;;) {
        sum = 0u; cnt = 0u; mine = 0u;
#pragma unroll
        for (unsigned j = 0; j < 16; ++j) { const unsigned c = xb_ld(&bar[XB_XCNT(j)]); sum += c; cnt += (c > 0u) ? 1u : 0u; mine = (j == x) ? c : mine; }
        if (sum == G) break;
        __builtin_amdgcn_s_sleep(1);
        if ((++sp & 255u) == 0u) { if (xb_ld(&bar[XB_TMO])) break; if (sp > XB_SPIN_CAP) { atomicAdd(&bar[XB_TMO], 1u); break; } }
    }
    nloc = mine > 0u ? mine : 1u; nx = cnt > 0u ? cnt : 1u;
}
__device__ __forceinline__ void xcd_barrier(const XcdBarrier& b) {
    asm volatile("s_waitcnt vmcnt(0)" ::: "memory");
    __syncthreads();
    if (threadIdx.x == 0) {
        unsigned* bar = b.bar;
        __builtin_amdgcn_s_waitcnt(0);
        unsigned nloc = b.st[0], nx = b.st[1];
        if (nloc == 0u) { xcd_barrier_complete(bar, b.x, nloc, nx); b.st[0] = nloc; b.st[1] = nx; }
        const unsigned old = xb_add(&bar[XB_XSUB(b.x)], 1u);
        const unsigned gen = old / nloc;
        if (old + 1u == (gen + 1u) * nloc) {
            __builtin_amdgcn_fence(__ATOMIC_RELEASE, "agent");
            asm volatile("s_waitcnt vmcnt(0)" ::: "memory");
            const unsigned og = xb_add(&bar[XB_TOP], 1u);
            const unsigned tg = og / nx;
            if (og + 1u == (tg + 1u) * nx) xb_add(&bar[XB_TOPGEN], 1u);
            else XB_SPIN(xb_ld(&bar[XB_TOPGEN]) == tg, bar);
            __builtin_amdgcn_fence(__ATOMIC_ACQUIRE, "agent");
            xb_add(&bar[XB_XGEN(b.x)], 1u);
            asm volatile("s_waitcnt vmcnt(0)" ::: "memory");
        } else {
            XB_SPIN(xb_ld(&bar[XB_XGEN(b.x)]) == gen, bar);
            __builtin_amdgcn_fence(__ATOMIC_ACQUIRE, "agent");
            asm volatile("s_waitcnt vmcnt(0)" ::: "memory");
        }
    }
    __syncthreads();
}

namespace pg8 {
constexpr int BM = 256, BK = 64, HALF = 128, HTB = HALF * BK * 2, STAGE_BYTES = 8 * HTB, NXCD = 8, WGM = 8;
__device__ __forceinline__ int lds_byte(int r, int c) { const int st = (r >> 4) * 2 + (c >> 5), rr = r & 15, cc = c & 31, ob = rr * 64 + cc * 2; return st * 1024 + (ob ^ (((ob >> 9) & 1) << 5)); }
__device__ __forceinline__ void stage_rc(int b, int& R, int& C) { const int st = b / 1024, sb = b % 1024, swz = sb ^ (((sb >> 9) & 1) << 5); R = (st >> 1) * 16 + swz / 64; C = (st & 1) * 32 + (swz % 64) / 2; }
__device__ __forceinline__ int perm32(int rho) { const int n = rho >> 4, i = rho & 15; return 8 * (i >> 2) + 4 * n + (i & 3); }
struct Unit { int pm, pn, aux; };
struct Order {
    int nM, nN, nwg, G, c, br, skipctx;
    __device__ void init(int nM_, int nN_, int G_, int c_, int br_ = 1, int skipctx_ = 0) { nM = nM_; nN = nN_; nwg = nM * nN; G = G_; c = c_; br = br_; skipctx = skipctx_; }
    __device__ bool next(int i, Unit& u) const {
        const int it = i / br, ia = i - it * br;
        const long L = (long)it * G + c; if (L >= nwg) return false;
        int wgid = (int)L; { const int q = nwg / NXCD, r = nwg % NXCD, xcd = wgid % NXCD, off = wgid / NXCD; wgid = (xcd < r ? xcd * (q + 1) : r * (q + 1) + (xcd - r) * q) + off; }
        const int nig = WGM * nN, gid = wgid / nig, fm = gid * WGM, gsz = (nM - fm) < WGM ? (nM - fm) : WGM;
        u.pm = fm + ((wgid % nig) % gsz); u.pn = (wgid % nig) / gsz + ia * nN; u.aux = ia;
        if (skipctx) u.pm += (u.pm >> 5) + 1;
        return true;
    }
};
template <class Prob, class Epi>
__device__ __forceinline__ void gemm_phase(LAS unsigned char* lds, const Prob& P, const Order& S, const Epi& E) {
    const int tid = ltid(), wid = __builtin_amdgcn_readfirstlane(tid >> 6), lane = tid & 63, wr = wid >> 2, wc = wid & 3, fr = lane & 15, fq = lane >> 4;
    const int nt = P.nt;
    unsigned voffA[2], voffB[2];
#pragma unroll
    for (int i = 0; i < 2; ++i) { int R, C; stage_rc(tid * 16 + i * 8192, R, C); const int Rb = Epi::PERM ? ((R & ~31) + perm32(R & 31)) : R;
        voffA[i] = (unsigned)R * P.lda + (unsigned)C * 2u; voffB[i] = (unsigned)Rb * P.ldb + (unsigned)C * 2u; }
    const size_t kstep = (size_t)(BK * 2);
    const size_t hA = (size_t)HALF * P.lda, hB = (size_t)HALF * P.ldb;
    const unsigned ldsw = (unsigned)wid * 1024u;
    const int aoff = lds_byte(wr * 64 + fr, fq * 8), boff = lds_byte(wc * 32 + fr, fq * 8);
#define PG8_SA(b, h) (((b) * 2 + (h)) * HTB)
#define PG8_SB(b, h) ((4 + (b) * 2 + (h)) * HTB)
#define PG8_STAGE(bufoff, gbase, voff) do { _Pragma("unroll") for (int _i = 0; _i < 2; ++_i) \
        __builtin_amdgcn_global_load_lds((const unsigned*)((const char*)(gbase) + (voff)[_i]), (LAS unsigned*)(lds + (bufoff) + ldsw + _i * 8192), 16, 0, 0); } while (0)
#define PG8_LDA(dst, b, h) do { _Pragma("unroll") for (int m = 0; m < 4; ++m) { \
        if constexpr (Epi::F8) { const i32x4 lo_ = *(const LAS i32x4*)(lds + PG8_SA(b, h) + aoff + m * 2048), hi_ = *(const LAS i32x4*)(lds + PG8_SA(b, h) + aoff + m * 2048 + 1024); \
            dst##8[m] = __builtin_shufflevector(lo_, hi_, 0, 1, 2, 3, 4, 5, 6, 7); } \
        else { _Pragma("unroll") for (int k = 0; k < 2; ++k) dst[m][k] = *(const LAS bf16x8*)(lds + PG8_SA(b, h) + aoff + m * 2048 + k * 1024); } } } while (0)
#define PG8_LDB(dst, b, h) do { _Pragma("unroll") for (int n = 0; n < 2; ++n) { \
        if constexpr (Epi::F8) { const i32x4 lo_ = *(const LAS i32x4*)(lds + PG8_SB(b, h) + boff + n * 2048), hi_ = *(const LAS i32x4*)(lds + PG8_SB(b, h) + boff + n * 2048 + 1024); \
            dst##8[n] = __builtin_shufflevector(lo_, hi_, 0, 1, 2, 3, 4, 5, 6, 7); } \
        else { _Pragma("unroll") for (int k = 0; k < 2; ++k) dst[n][k] = *(const LAS bf16x8*)(lds + PG8_SB(b, h) + boff + n * 2048 + k * 1024); } } } while (0)
#define PG8_MMA(ai, bj, At, Bt) do { __builtin_amdgcn_s_setprio(1); _Pragma("unroll") for (int m = 0; m < 4; ++m) _Pragma("unroll") for (int n = 0; n < 2; ++n) { \
        if constexpr (Epi::F8) asm volatile("v_mfma_scale_f32_16x16x128_f8f6f4 %0, %1, %2, %0, %3, %3 op_sel_hi:[0,0,0]" : "+v"(acc[ai][bj][m][n]) : "v"(Bt##8[n]), "v"(At##8[m]), "v"(f8scale));   \
        else { _Pragma("unroll") for (int k = 0; k < 2; ++k) { \
        if constexpr (Epi::I8) acc[ai][bj][m][n] = __builtin_bit_cast(f32x4, __builtin_amdgcn_mfma_i32_16x16x64_i8(__builtin_bit_cast(i32x4, Bt[n][k]), __builtin_bit_cast(i32x4, At[m][k]), __builtin_bit_cast(i32x4, acc[ai][bj][m][n]), 0, 0, 0)); \
        else acc[ai][bj][m][n] = __builtin_amdgcn_mfma_f32_16x16x32_bf16(Bt[n][k], At[m][k], acc[ai][bj][m][n], 0, 0, 0); } } } __builtin_amdgcn_s_setprio(0); } while (0)
#define PG8_WAIT_V(n) asm volatile("s_waitcnt vmcnt(" #n ")" ::: "memory")
#define PG8_WAIT_L(n) asm volatile("s_waitcnt lgkmcnt(" #n ")" ::: "memory")
#define PG8_BAR __builtin_amdgcn_s_barrier()
#define PG8_SCHED __builtin_amdgcn_sched_barrier(0)
    Unit cur, nxt; int ui = 0;
    if (!S.next(0, cur)) return;
    f32x4 acc[2][2][4][2];
#pragma unroll
    for (int a = 0; a < 2; ++a)
#pragma unroll
        for (int b = 0; b < 2; ++b)
#pragma unroll
            for (int m = 0; m < 4; ++m)
#pragma unroll
                for (int n = 0; n < 2; ++n) acc[a][b][m][n] = (f32x4){0.f, 0.f, 0.f, 0.f};
    bf16x8 At[4][2], B0[2][2], B1[2][2];
    const int f8scale = 0x7f7f7f7f;
    i32x8 At8[4], B08[2], B18[2];
    const char* cA; const char* cB; P.setup(cur, cA, cB);
    PG8_STAGE(PG8_SB(0, 0), cB, voffB); PG8_STAGE(PG8_SB(0, 1), cB + hB, voffB); PG8_STAGE(PG8_SA(0, 0), cA, voffA); PG8_STAGE(PG8_SA(0, 1), cA + hA, voffA);
    if (wr == 1) PG8_BAR;
    PG8_WAIT_V(2); PG8_BAR;
    PG8_STAGE(PG8_SB(1, 0), cB + kstep, voffB); PG8_STAGE(PG8_SA(1, 0), cA + kstep, voffA); PG8_STAGE(PG8_SB(1, 1), cB + hB + kstep, voffB);
    PG8_WAIT_V(6); PG8_BAR;
    for (;;) {
        const bool has_next = S.next(ui + 1, nxt);
        const char* nA = cA; const char* nB = cB;
        if (has_next) P.setup(nxt, nA, nB);
        for (int t = 0; t < nt; t += 2) {
            const bool last = (t == nt - 2);
            const char* a1 = cA + (size_t)(t + 1) * kstep;
            const char* a2 = last ? nA : cA + (size_t)(t + 2) * kstep; const char* b2 = last ? nB : cB + (size_t)(t + 2) * kstep;
            const char* a3 = a2 + kstep; const char* b3 = b2 + kstep;
            PG8_LDB(B0, 0, 0); PG8_LDB(B1, 0, 1); PG8_SCHED; PG8_LDA(At, 0, 0); PG8_STAGE(PG8_SA(1, 1), a1 + hA, voffA);
            PG8_WAIT_V(8); PG8_WAIT_L(0); PG8_BAR; PG8_MMA(0, 0, At, B0); PG8_MMA(0, 1, At, B1); PG8_BAR; PG8_SCHED;
            PG8_LDA(At, 0, 1); PG8_STAGE(PG8_SB(0, 0), b2, voffB); PG8_STAGE(PG8_SB(0, 1), b2 + hB, voffB); PG8_STAGE(PG8_SA(0, 0), a2, voffA);
            PG8_WAIT_V(8); PG8_WAIT_L(0); PG8_BAR; PG8_MMA(1, 0, At, B0); PG8_MMA(1, 1, At, B1); PG8_BAR; PG8_SCHED;
            PG8_LDB(B0, 1, 0); PG8_LDB(B1, 1, 1); PG8_SCHED; PG8_LDA(At, 1, 0); PG8_STAGE(PG8_SA(0, 1), a2 + hA, voffA);
            PG8_WAIT_V(8); PG8_WAIT_L(0); PG8_BAR; PG8_MMA(0, 0, At, B0); PG8_MMA(0, 1, At, B1); PG8_BAR; PG8_SCHED;
            PG8_LDA(At, 1, 1); PG8_STAGE(PG8_SB(1, 0), b3, voffB); PG8_STAGE(PG8_SB(1, 1), b3 + hB, voffB); PG8_STAGE(PG8_SA(1, 0), a3, voffA);
            PG8_WAIT_V(8); PG8_WAIT_L(0); PG8_BAR; PG8_MMA(1, 0, At, B0); PG8_MMA(1, 1, At, B1); PG8_BAR; PG8_SCHED;
        }
        if (wr == 0) PG8_BAR;
        if constexpr (Epi::F8) asm volatile("s_nop 15\n\ts_nop 7" ::: "memory");
        E(acc, cur, wr, wc, fr, fq);
        if (!has_next) break;
#pragma unroll
        for (int a = 0; a < 2; ++a)
#pragma unroll
            for (int b = 0; b < 2; ++b)
#pragma unroll
                for (int m = 0; m < 4; ++m)
#pragma unroll
                    for (int n = 0; n < 2; ++n) acc[a][b][m][n] = (f32x4){0.f, 0.f, 0.f, 0.f};
        cur = nxt; cA = nA; cB = nB; ++ui;
        if (wr == 1) PG8_BAR;
    }
    PG8_WAIT_V(0);
    PG8_BAR;
#undef PG8_SA
#undef PG8_SB
#undef PG8_STAGE
#undef PG8_LDA
#undef PG8_LDB
#undef PG8_MMA
#undef PG8_WAIT_V
#undef PG8_WAIT_L
#undef PG8_BAR
#undef PG8_SCHED
}
}

struct ProbPlain { const char* A; const char* B; unsigned lda, ldb; int nt;
    __device__ __forceinline__ void setup(pg8::Unit& u, const char*& a, const char*& b) const { a = A + (size_t)u.pm * 256 * lda; b = B + (size_t)u.pn * 256 * ldb; } };
struct ProbBO { const char* A; const char* B; unsigned lda, ldb; int nt;
    __device__ __forceinline__ void setup(pg8::Unit& u, const char*& a, const char*& b) const { a = A + (size_t)u.pm * 256 * lda + (size_t)(u.pn >> 2) * 512; b = B + (size_t)u.pn * 256 * ldb; } };
struct ProbMoE { const char* A; const char* B; unsigned lda, ldb; int nt; const int* tstart; size_t bstride;
    __device__ __forceinline__ void setup(pg8::Unit& u, const char*& a, const char*& b) const {
        int e = 0;
#pragma unroll 1
        for (int j = 1; j < NE; ++j) e += (u.pm >= tstart[j]) ? 1 : 0;
        u.aux = e; a = A + (size_t)u.pm * 256 * lda; b = B + (size_t)e * bstride + (size_t)u.pn * 256 * ldb; } };

__device__ __forceinline__ f32x4 i2f4(const f32x4 a) { const i32x4 i = __builtin_bit_cast(i32x4, a); return (f32x4){(float)i.x, (float)i.y, (float)i.z, (float)i.w}; }
typedef const f32x4 (&AccRef)[2][2][4][2];
struct EpiIn {
    static constexpr bool PERM = true, I8 = false, F8 = false;
    bf16* Pb; bf16* Gb; float* gates; const float* bmg;
    __device__ __forceinline__ void operator()(AccRef acc, const pg8::Unit& u, int wr, int wc, int fr, int fq) const {
        const int row0 = u.pm * 256 + wr * 64 + fr;
        if (u.pn < 22) {
            const int col0 = u.pn * 256 + wc * 32 + 8 * fq;
#pragma unroll
            for (int ai = 0; ai < 2; ++ai)
#pragma unroll
                for (int m = 0; m < 4; ++m) { const int row = row0 + ai * 128 + m * 16; bf16* rowp = Pb + (size_t)row * LDP + col0;
#pragma unroll
                    for (int bj = 0; bj < 2; ++bj) { const f32x4 v0 = acc[ai][bj][m][0], v1 = acc[ai][bj][m][1];
                        u32x4 w; w.x = cvtpk(v0[0], v0[1]); w.y = cvtpk(v0[2], v0[3]); w.z = cvtpk(v1[0], v1[1]); w.w = cvtpk(v1[2], v1[3]);
                        *(u32x4*)(rowp + bj * 128) = w;
                        if (bj == 0 && u.pn == 14 && wc == 0 && fq < 2) { float* g = gates + (size_t)row * 32 + 8 * fq; *(f32x4*)g = v0; *(f32x4*)(g + 4) = v1; }
                        if (bj == 1 && u.pn == 21 && wc == 1 && fq >= 2) { float* g = gates + (size_t)row * 32 + 16 + 8 * (fq - 2); *(f32x4*)g = v0; *(f32x4*)(g + 4) = v1; } } }
        } else {
            const int col0 = (u.pn - 22) * 256 + wc * 32 + 8 * fq;
            f32x4 bv[2][2];
#pragma unroll
            for (int bj = 0; bj < 2; ++bj)
#pragma unroll
                for (int n = 0; n < 2; ++n) bv[bj][n] = *(const f32x4*)(bmg + col0 + bj * 128 + 4 * n);
#pragma unroll
            for (int ai = 0; ai < 2; ++ai)
#pragma unroll
                for (int m = 0; m < 4; ++m) { bf16* rowp = Gb + (size_t)(row0 + ai * 128 + m * 16) * NGATE + col0;
#pragma unroll
                    for (int bj = 0; bj < 2; ++bj) { f32x4 v0 = acc[ai][bj][m][0] + bv[bj][0], v1 = acc[ai][bj][m][1] + bv[bj][1];
#pragma unroll
                        for (int j = 0; j < 4; ++j) { v0[j] = fsigmoid(v0[j]); v1[j] = fsigmoid(v1[j]); }
                        u32x4 w; w.x = cvtpk(v0[0], v0[1]); w.y = cvtpk(v0[2], v0[3]); w.z = cvtpk(v1[0], v1[1]); w.w = cvtpk(v1[2], v1[3]);
                        *(u32x4*)(rowp + bj * 128) = w; } }
        }
    }
};
struct EpiStore {
    static constexpr bool PERM = true, I8 = false, F8 = false;
    bf16* O; int ldc; const float* bias; int bias_stride;
    __device__ __forceinline__ void operator()(AccRef acc, const pg8::Unit& u, int wr, int wc, int fr, int fq) const {
        const int row0 = u.pm * 256 + wr * 64 + fr, col0 = u.pn * 256 + wc * 32 + 8 * fq;
        f32x4 bv[2][2];
#pragma unroll
        for (int bj = 0; bj < 2; ++bj)
#pragma unroll
            for (int n = 0; n < 2; ++n) bv[bj][n] = bias ? *(const f32x4*)(bias + (size_t)u.aux * bias_stride + col0 + bj * 128 + 4 * n) : (f32x4){0.f, 0.f, 0.f, 0.f};
#pragma unroll
        for (int ai = 0; ai < 2; ++ai)
#pragma unroll
            for (int m = 0; m < 4; ++m) { bf16* rowp = O + (size_t)(row0 + ai * 128 + m * 16) * ldc + col0;
#pragma unroll
                for (int bj = 0; bj < 2; ++bj) { const f32x4 v0 = acc[ai][bj][m][0] + bv[bj][0], v1 = acc[ai][bj][m][1] + bv[bj][1];
                    u32x4 w; w.x = cvtpk(v0[0], v0[1]); w.y = cvtpk(v0[2], v0[3]); w.z = cvtpk(v1[0], v1[1]); w.w = cvtpk(v1[2], v1[3]);
                    *(u32x4*)(rowp + bj * 128) = w; } }
    }
};
struct EpiStoreF8 {
    static constexpr bool PERM = true, I8 = false, F8 = true; static constexpr int SCALE_A = 0x7f7f7f7f, SCALE_B = 0x7f7f7f7f;
    bf16* O; int ldc; const float* bias; int bias_stride;
    __device__ __forceinline__ void operator()(AccRef acc, const pg8::Unit& u, int wr, int wc, int fr, int fq) const {
        const int row0 = u.pm * 256 + wr * 64 + fr, col0 = u.pn * 256 + wc * 32 + 8 * fq;
        f32x4 bv[2][2];
#pragma unroll
        for (int bj = 0; bj < 2; ++bj)
#pragma unroll
            for (int n = 0; n < 2; ++n) bv[bj][n] = *(const f32x4*)(bias + (size_t)u.aux * bias_stride + col0 + bj * 128 + 4 * n);
#pragma unroll
        for (int ai = 0; ai < 2; ++ai)
#pragma unroll
            for (int m = 0; m < 4; ++m) { bf16* rowp = O + (size_t)(row0 + ai * 128 + m * 16) * ldc + col0;
#pragma unroll
                for (int bj = 0; bj < 2; ++bj) { const f32x4 v0 = acc[ai][bj][m][0] * 0.015625f + bv[bj][0], v1 = acc[ai][bj][m][1] * 0.015625f + bv[bj][1];
                    u32x4 w; w.x = cvtpk(v0[0], v0[1]); w.y = cvtpk(v0[2], v0[3]); w.z = cvtpk(v1[0], v1[1]); w.w = cvtpk(v1[2], v1[3]);
                    *(u32x4*)(rowp + bj * 128) = w; } }
    }
};
struct EpiBO {
    static constexpr bool PERM = true, I8 = true, F8 = false;
    bf16* Z; const bf16* G; const float* sY; const float* cmB;
    __device__ __forceinline__ void operator()(AccRef acc, const pg8::Unit& u, int wr, int wc, int fr, int fq) const {
        const int row0 = u.pm * 256 + wr * 64 + fr, colg = u.pn * 256 + wc * 32 + 8 * fq, colz = (u.pn & 3) * 256 + wc * 32 + 8 * fq;
        const bool first = u.aux == 0;
        f32x4 sw[2][2];
#pragma unroll
        for (int bj = 0; bj < 2; ++bj)
#pragma unroll
            for (int n = 0; n < 2; ++n) sw[bj][n] = *(const f32x4*)(cmB + colg + bj * 128 + 4 * n) * (1.0f / 127.0f);
#pragma unroll
        for (int ai = 0; ai < 2; ++ai)
#pragma unroll
            for (int m = 0; m < 4; ++m) { const int row = row0 + ai * 128 + m * 16; const float sa = sY[row * 4 + u.aux];
#pragma unroll
                for (int bj = 0; bj < 2; ++bj) { const u32x4 gw = *(const u32x4*)(G + (size_t)row * NGATE + colg + bj * 128); float g[8]; unpack8(gw, g);
                    bf16* zp = Z + (size_t)row * D + colz + bj * 128;
                    float z[8];
                    if (first) {
#pragma unroll
                        for (int j = 0; j < 8; ++j) z[j] = 0.f;
                    } else unpack8(*(const u32x4*)zp, z);
                    const f32x4 v0 = i2f4(acc[ai][bj][m][0]) * sw[bj][0] * sa, v1 = i2f4(acc[ai][bj][m][1]) * sw[bj][1] * sa;
#pragma unroll
                    for (int j = 0; j < 4; ++j) { z[j] += v0[j] * g[j]; z[4 + j] += v1[j] * g[4 + j]; }
                    *(u32x4*)zp = pack8(z); } }
    }
};
struct EpiOut {
    static constexpr bool PERM = false, I8 = false, F8 = false;
    float* X; const float* modl;
    __device__ __forceinline__ void operator()(AccRef acc, const pg8::Unit& u, int wr, int wc, int fr, int fq) const {
        const int row0 = u.pm * 256 + wr * 64 + fr, col0 = u.pn * 256 + wc * 32 + 4 * fq;
        const int mv = (u.pm % 33 == 0) ? 4 : u.pm / 33;
        const float* g1 = modl + mv * 6144 + 2048;
        f32x4 gv[2][2];
#pragma unroll
        for (int bj = 0; bj < 2; ++bj)
#pragma unroll
            for (int n = 0; n < 2; ++n) gv[bj][n] = *(const f32x4*)(g1 + col0 + bj * 128 + n * 16);
#pragma unroll
        for (int ai = 0; ai < 2; ++ai)
#pragma unroll
            for (int m = 0; m < 4; ++m) { float* rowp = X + (size_t)(row0 + ai * 128 + m * 16) * D + col0;
#pragma unroll
                for (int bj = 0; bj < 2; ++bj)
#pragma unroll
                    for (int n = 0; n < 2; ++n) { f32x4* p = (f32x4*)(rowp + bj * 128 + n * 16); *p = *p + gv[bj][n] * acc[ai][bj][m][n]; } }
    }
};
struct EpiMoE1 {
    static constexpr bool PERM = true, I8 = false, F8 = false;
    bf16* ACT; const float* bgu;
    __device__ __forceinline__ void operator()(AccRef acc, const pg8::Unit& u, int wr, int wc, int fr, int fq) const {
        const int row0 = u.pm * 256 + wr * 64 + fr, c0 = u.pn * 128 + wc * 32 + 8 * fq;
        const float* bg = bgu + (size_t)u.aux * 2048 + c0;
        f32x4 bgt[2], bup[2];
#pragma unroll
        for (int n = 0; n < 2; ++n) { bgt[n] = *(const f32x4*)(bg + 4 * n); bup[n] = *(const f32x4*)(bg + 1024 + 4 * n); }
#pragma unroll
        for (int ai = 0; ai < 2; ++ai)
#pragma unroll
            for (int m = 0; m < 4; ++m) { float o[8];
#pragma unroll
                for (int n = 0; n < 2; ++n)
#pragma unroll
                    for (int j = 0; j < 4; ++j) { const float gate = fminf(acc[ai][0][m][n][j] + bgt[n][j], 7.0f); const float up = fminf(fmaxf(acc[ai][1][m][n][j] + bup[n][j], -7.0f), 7.0f);
                        o[4 * n + j] = (up + 1.0f) * gate * fsigmoid(1.702f * gate); }
                *(u32x4*)(ACT + (size_t)(row0 + ai * 128 + m * 16) * DFF + c0) = pack8(o); }
    }
};

struct EpiIn8 {
    static constexpr bool PERM = true, I8 = true, F8 = false;
    bf16* Pb; bf16* Gb; float* gates; const float* bmg; const float* sA; const float* cmB;
    __device__ __forceinline__ void operator()(AccRef acc, const pg8::Unit& u, int wr, int wc, int fr, int fq) const {
        const int row0 = u.pm * 256 + wr * 64 + fr, cb0 = u.pn * 256 + wc * 32 + 8 * fq;
        f32x4 sw[2][2];
#pragma unroll
        for (int bj = 0; bj < 2; ++bj)
#pragma unroll
            for (int n = 0; n < 2; ++n) sw[bj][n] = *(const f32x4*)(cmB + cb0 + bj * 128 + 4 * n) * (1.0f / 127.0f);
        if (u.pn < 22) {
#pragma unroll
            for (int ai = 0; ai < 2; ++ai)
#pragma unroll
                for (int m = 0; m < 4; ++m) { const int row = row0 + ai * 128 + m * 16; bf16* rowp = Pb + (size_t)row * LDP + cb0; const float sa = sA[row];
#pragma unroll
                    for (int bj = 0; bj < 2; ++bj) { const f32x4 v0 = i2f4(acc[ai][bj][m][0]) * sw[bj][0] * sa, v1 = i2f4(acc[ai][bj][m][1]) * sw[bj][1] * sa;
                        u32x4 w; w.x = cvtpk(v0[0], v0[1]); w.y = cvtpk(v0[2], v0[3]); w.z = cvtpk(v1[0], v1[1]); w.w = cvtpk(v1[2], v1[3]);
                        *(u32x4*)(rowp + bj * 128) = w;
                        if (bj == 0 && u.pn == 14 && wc == 0 && fq < 2) { float* g = gates + (size_t)row * 32 + 8 * fq; *(f32x4*)g = v0; *(f32x4*)(g + 4) = v1; }
                        if (bj == 1 && u.pn == 21 && wc == 1 && fq >= 2) { float* g = gates + (size_t)row * 32 + 16 + 8 * (fq - 2); *(f32x4*)g = v0; *(f32x4*)(g + 4) = v1; } } }
        } else {
            const int col0 = cb0 - LDP;
            f32x4 bv[2][2];
#pragma unroll
            for (int bj = 0; bj < 2; ++bj)
#pragma unroll
                for (int n = 0; n < 2; ++n) bv[bj][n] = *(const f32x4*)(bmg + col0 + bj * 128 + 4 * n);
#pragma unroll
            for (int ai = 0; ai < 2; ++ai)
#pragma unroll
                for (int m = 0; m < 4; ++m) { const int row = row0 + ai * 128 + m * 16; bf16* rowp = Gb + (size_t)row * NGATE + col0; const float sa = sA[row];
#pragma unroll
                    for (int bj = 0; bj < 2; ++bj) { f32x4 v0 = i2f4(acc[ai][bj][m][0]) * sw[bj][0] * sa + bv[bj][0], v1 = i2f4(acc[ai][bj][m][1]) * sw[bj][1] * sa + bv[bj][1];
#pragma unroll
                        for (int j = 0; j < 4; ++j) { v0[j] = fsigmoid(v0[j]); v1[j] = fsigmoid(v1[j]); }
                        u32x4 w; w.x = cvtpk(v0[0], v0[1]); w.y = cvtpk(v0[2], v0[3]); w.z = cvtpk(v1[0], v1[1]); w.w = cvtpk(v1[2], v1[3]);
                        *(u32x4*)(rowp + bj * 128) = w; } }
        }
    }
};
struct EpiMoE18 {
    static constexpr bool PERM = true, I8 = true, F8 = false;
    bf16* ACT; const float* bgu; const float* sA; const float* cmB;
    __device__ __forceinline__ void operator()(AccRef acc, const pg8::Unit& u, int wr, int wc, int fr, int fq) const {
        const int row0 = u.pm * 256 + wr * 64 + fr, c0 = u.pn * 128 + wc * 32 + 8 * fq;
        const float* bg = bgu + (size_t)u.aux * 2048 + c0;
        const float* cm = cmB + (size_t)u.aux * 2048 + u.pn * 256 + wc * 32 + 8 * fq;
        f32x4 bgt[2], bup[2], sg[2], su[2];
#pragma unroll
        for (int n = 0; n < 2; ++n) { bgt[n] = *(const f32x4*)(bg + 4 * n); bup[n] = *(const f32x4*)(bg + 1024 + 4 * n); sg[n] = *(const f32x4*)(cm + 4 * n) * (1.0f / 127.0f); su[n] = *(const f32x4*)(cm + 128 + 4 * n) * (1.0f / 127.0f); }
#pragma unroll
        for (int ai = 0; ai < 2; ++ai)
#pragma unroll
            for (int m = 0; m < 4; ++m) { const int row = row0 + ai * 128 + m * 16; const float sa = sA[row]; float o[8];
#pragma unroll
                for (int n = 0; n < 2; ++n) { const f32x4 ga = i2f4(acc[ai][0][m][n]) * sg[n] * sa + bgt[n], ua = i2f4(acc[ai][1][m][n]) * su[n] * sa + bup[n];
#pragma unroll
                    for (int j = 0; j < 4; ++j) { const float gate = fminf(ga[j], 7.0f); const float up = fminf(fmaxf(ua[j], -7.0f), 7.0f);
                        o[4 * n + j] = (up + 1.0f) * gate * fsigmoid(1.702f * gate); } }
                int w0 = 0, w1 = 0;
                w0 = __builtin_amdgcn_cvt_pk_fp8_f32(o[0], o[1], w0, false); w0 = __builtin_amdgcn_cvt_pk_fp8_f32(o[2], o[3], w0, true);
                w1 = __builtin_amdgcn_cvt_pk_fp8_f32(o[4], o[5], w1, false); w1 = __builtin_amdgcn_cvt_pk_fp8_f32(o[6], o[7], w1, true);
                *(u32x2*)((unsigned char*)ACT + (size_t)row * DFF + c0) = (u32x2){(unsigned)w0, (unsigned)w1}; }
    }
};

struct AttnJob {
    const bf16* Q; int qpitch;
    const bf16* K; int kpitch;
    const bf16* VT;
    bf16* O; int opitch;
    int ntiles; float c;
    int s0_first_n, s0_jump;
    int kr_lo, r_w, c_q;
    const LAS float* bias;
};
template <int DQK, bool NA>
__device__ __forceinline__ void attn_unit(LAS unsigned char* lds, const AttnJob& J) {
    constexpr int KPB = (DQK == 96) ? 208 : 144, VPB = 136, NS = DQK / 16, KCH = DQK / 8;
    constexpr int KBUF = 64 * KPB, VBUF = 64 * VPB;
    const int tid = ltid(), wid = __builtin_amdgcn_readfirstlane(tid >> 6), lane = tid & 63, r = lane & 31, h = lane >> 5;
    LAS unsigned char* kb0 = lds; LAS unsigned char* vb0 = lds + 2 * KBUF;
    bf16x8 qf[NS];
    { const bf16* qrow = J.Q + (size_t)(wid * 32 + r) * J.qpitch + 8 * h;
#pragma unroll
      for (int s = 0; s < NS; ++s) qf[s] = *(const bf16x8*)(qrow + 16 * s); }
    f32x16 o0, o1;
#pragma unroll
    for (int i = 0; i < 16; ++i) { o0[i] = 0.f; o1[i] = 0.f; }
    float mrun = -1e30f, lsum = 0.f;
    const int k0r = tid / KCH, k0c = tid % KCH, k1r = (tid + 512) / KCH, k1c = (tid + 512) % KCH;
    const bool k1 = (tid + 512) < 64 * KCH;
    const int vd = tid >> 3, vc = tid & 7;
    u32x4 kr0, kr1, vr;
    auto s0_of = [&](int j) { return j < J.s0_first_n ? 64 * j : J.s0_jump + 64 * (j - J.s0_first_n); };
    auto gload = [&](int j) { const int s0 = s0_of(j);
        kr0 = *(const u32x4*)(J.K + (size_t)(s0 + k0r) * J.kpitch + 8 * k0c);
        if (k1) kr1 = *(const u32x4*)(J.K + (size_t)(s0 + k1r) * J.kpitch + 8 * k1c);
        vr = *(const u32x4*)(J.VT + (size_t)vd * TB + s0 + 8 * vc); };
    auto lstore = [&](int buf) {
        *(LAS u32x4*)(kb0 + buf * KBUF + k0r * KPB + 16 * k0c) = kr0;
        if (k1) *(LAS u32x4*)(kb0 + buf * KBUF + k1r * KPB + 16 * k1c) = kr1;
        LAS unsigned char* vp = vb0 + buf * VBUF + vd * VPB + 16 * vc;
        *(LAS u32x2*)vp = (u32x2){vr.x, vr.y}; *(LAS u32x2*)(vp + 8) = (u32x2){vr.z, vr.w}; };
    gload(0); lstore(0);
    __syncthreads();
    const int r0w = NA ? min(max(J.r_w - 4, 0), 120) : 0;
    const int c0 = NA ? min(max(J.c_q - 8, 0), 48) : 0;
    for (int j = 0; j < J.ntiles; ++j) {
        const int buf = j & 1;
        if (j + 1 < J.ntiles) gload(j + 1);
        bool active = true; int dr = 0;
        if (NA && j >= 4) { const int kr = J.kr_lo + j - 4; active = (kr >= r0w) && (kr < r0w + 8); dr = kr - J.r_w + 7; }
        if (active) {
            f32x16 s0v, s1v;
#pragma unroll
            for (int i = 0; i < 16; ++i) { s0v[i] = 0.f; s1v[i] = 0.f; }
            const LAS unsigned char* kp = kb0 + buf * KBUF + r * KPB + 16 * h;
#pragma unroll
            for (int s = 0; s < NS; ++s) {
                const bf16x8 a0 = *(const LAS bf16x8*)(kp + 32 * s), a1 = *(const LAS bf16x8*)(kp + 32 * KPB + 32 * s);
                s0v = __builtin_amdgcn_mfma_f32_32x32x16_bf16(a0, qf[s], s0v, 0, 0, 0);
                s1v = __builtin_amdgcn_mfma_f32_32x32x16_bf16(a1, qf[s], s1v, 0, 0, 0);
            }
            float mx;
            if (NA && j >= 4) {
                const LAS float* bp = J.bias + dr * 31 + 15 - J.c_q;
#pragma unroll
                for (int i = 0; i < 16; ++i) { const int kc = (i & 3) + 8 * (i >> 2) + 4 * h;
                    { const bool ok = (unsigned)(kc - c0) < 16u; const float bz = bp[ok ? kc : c0]; s0v[i] = ok ? s0v[i] * J.c + bz : -1e30f; }
                    { const int kc1 = kc + 32; const bool ok = (unsigned)(kc1 - c0) < 16u; const float bz = bp[ok ? kc1 : c0]; s1v[i] = ok ? s1v[i] * J.c + bz : -1e30f; } }
                mx = -1e30f;
#pragma unroll
                for (int i = 0; i < 16; ++i) mx = fmaxf(mx, fmaxf(s0v[i], s1v[i]));
                mx = fmaxf(mx, __shfl_xor(mx, 32));
            } else {
                float ma = fmaxf(s0v[0], s1v[0]), mb = fmaxf(s0v[1], s1v[1]);
#pragma unroll
                for (int i = 2; i < 16; i += 2) { ma = fmaxf(fmaxf(ma, s0v[i]), s1v[i]); mb = fmaxf(fmaxf(mb, s0v[i + 1]), s1v[i + 1]); }
                mx = fmaxf(ma, mb); mx = fmaxf(mx, __shfl_xor(mx, 32)) * J.c;
            }
            if (__any(mx > mrun + 8.0f)) {
                const float mnew = fmaxf(mrun, mx), alpha = fexp2(mrun - mnew); mrun = mnew; lsum *= alpha;
#pragma unroll
                for (int i = 0; i < 16; ++i) { o0[i] *= alpha; o1[i] *= alpha; }
            }
            float ps = 0.f;
            if (NA && j >= 4) {
#pragma unroll
                for (int i = 0; i < 16; ++i) { s0v[i] = fexp2(s0v[i] - mrun); s1v[i] = fexp2(s1v[i] - mrun); ps += s0v[i] + s1v[i]; }
            } else {
                const float nm = -mrun;
#pragma unroll
                for (int i = 0; i < 16; ++i) { s0v[i] = fexp2(__builtin_fmaf(s0v[i], J.c, nm)); s1v[i] = fexp2(__builtin_fmaf(s1v[i], J.c, nm)); ps += s0v[i] + s1v[i]; }
            }
            lsum += ps;
            bf16x8 pf[4];
#pragma unroll
            for (int st = 0; st < 4; ++st) { u32x4 w;
#pragma unroll
                for (int q = 0; q < 4; ++q) { const int i = 8 * (st & 1) + 2 * q; w[q] = (st < 2) ? cvtpk(s0v[i], s0v[i + 1]) : cvtpk(s1v[i], s1v[i + 1]); }
                pf[st] = __builtin_bit_cast(bf16x8, w); }
            const LAS unsigned char* vp = vb0 + buf * VBUF + r * VPB + 8 * h;
#pragma unroll
            for (int st = 0; st < 4; ++st) {
                const u32x2 a0l = *(const LAS u32x2*)(vp + 32 * st), a0h = *(const LAS u32x2*)(vp + 32 * st + 16);
                const u32x2 a1l = *(const LAS u32x2*)(vp + 32 * VPB + 32 * st), a1h = *(const LAS u32x2*)(vp + 32 * VPB + 32 * st + 16);
                const bf16x8 va0 = __builtin_bit_cast(bf16x8, (u32x4){a0l.x, a0l.y, a0h.x, a0h.y}), va1 = __builtin_bit_cast(bf16x8, (u32x4){a1l.x, a1l.y, a1h.x, a1h.y});
                o0 = __builtin_amdgcn_mfma_f32_32x32x16_bf16(va0, pf[st], o0, 0, 0, 0);
                o1 = __builtin_amdgcn_mfma_f32_32x32x16_bf16(va1, pf[st], o1, 0, 0, 0);
            }
        }
        if (j + 1 < J.ntiles) lstore(buf ^ 1);
        __syncthreads();
    }
    lsum += __shfl_xor(lsum, 32);
    const float inv = frcp(lsum);
    bf16* orow = J.O + (size_t)(wid * 32 + r) * J.opitch + 4 * h;
#pragma unroll
    for (int g = 0; g < 4; ++g) {
        *(u32x2*)(orow + 8 * g) = (u32x2){cvtpk(o0[4 * g] * inv, o0[4 * g + 1] * inv), cvtpk(o0[4 * g + 2] * inv, o0[4 * g + 3] * inv)};
        *(u32x2*)(orow + 32 + 8 * g) = (u32x2){cvtpk(o1[4 * g] * inv, o1[4 * g + 1] * inv), cvtpk(o1[4 * g + 2] * inv, o1[4 * g + 3] * inv)};
    }
}

template <int DQK>
__device__ __forceinline__ void attn_unit_dense(LAS unsigned char* lds, const AttnJob& J) {
    static_assert(DQK == 96, "fp8 score path: rows are 128 bytes (64 nope | 32 rotary | 32 zero)");
    constexpr int KPB = 144, VPB = 144, KCH = 8, NKC = 2;
    constexpr int KBUF = 128 * KPB, VBUF = 64 * VPB;
    const int tid = ltid(), wid = __builtin_amdgcn_readfirstlane(tid >> 6), lane = tid & 63, r = lane & 31, h = lane >> 5;
    LAS unsigned char* kb0 = lds; LAS unsigned char* vb0 = lds + 2 * KBUF;
    i32x8 qf[2];
    { const unsigned char* qrow = (const unsigned char*)J.Q + (size_t)(wid * 32 + r) * J.qpitch + 32 * h;
#pragma unroll
      for (int i = 0; i < 2; ++i) { const i32x4 lo_ = *(const i32x4*)(qrow + 64 * i), hi_ = *(const i32x4*)(qrow + 64 * i + 16); qf[i] = __builtin_shufflevector(lo_, hi_, 0, 1, 2, 3, 4, 5, 6, 7); } }
    f32x16 o0, o1;
#pragma unroll
    for (int i = 0; i < 16; ++i) { o0[i] = 0.f; o1[i] = 0.f; }
    float mrun = -1e30f, lsum = 0.f;
    u32x4 kr[NKC], vr;
    const int vd = tid >> 3, vc = tid & 7;
    auto gload = [&](int j) { const int s0 = 128 * j;
#pragma unroll
        for (int q = 0; q < NKC; ++q) { const int ch = tid + 512 * q; kr[q] = *(const u32x4*)((const unsigned char*)J.K + (size_t)(s0 + ch / KCH) * J.kpitch + 16 * (ch % KCH)); }
        vr = *(const u32x4*)((const unsigned char*)J.VT + (size_t)vd * TB + s0 + 16 * vc); };
    auto lstore = [&](int buf) {
#pragma unroll
        for (int q = 0; q < NKC; ++q) { const int ch = tid + 512 * q; *(LAS u32x4*)(kb0 + buf * KBUF + (ch / KCH) * KPB + 16 * (ch % KCH)) = kr[q]; }
        LAS unsigned char* vp = vb0 + buf * VBUF + vd * VPB + 64 * (vc >> 2) + 8 * (vc & 3);
        *(LAS u32x2*)vp = (u32x2){vr.x, vr.z}; *(LAS u32x2*)(vp + 32) = (u32x2){vr.y, vr.w}; };
    const int nst = J.ntiles >> 1;
    const int grp = wid >> 2;
    gload(0); lstore(0);
    __syncthreads();
    if (nst > 1) gload(1);
    if (grp == 1) LDS_BAR();
    for (int j = 0; j < nst; ++j) {
        const int buf = j & 1;
        f32x16 sv[4];
#pragma unroll
        for (int bk = 0; bk < 4; ++bk)
#pragma unroll
            for (int i = 0; i < 16; ++i) sv[bk][i] = 0.f;
        { const LAS unsigned char* kq = kb0 + buf * KBUF + r * KPB + 32 * h;
          i32x8 ka[2][4];
#pragma unroll
          for (int bk = 0; bk < 4; ++bk) { const i32x4 lo_ = *(const LAS i32x4*)(kq + bk * 32 * KPB), hi_ = *(const LAS i32x4*)(kq + bk * 32 * KPB + 16); ka[0][bk] = __builtin_shufflevector(lo_, hi_, 0, 1, 2, 3, 4, 5, 6, 7); }
#pragma unroll
          for (int bk = 0; bk < 4; ++bk) { const i32x4 lo_ = *(const LAS i32x4*)(kq + bk * 32 * KPB + 64), hi_ = *(const LAS i32x4*)(kq + bk * 32 * KPB + 80); ka[1][bk] = __builtin_shufflevector(lo_, hi_, 0, 1, 2, 3, 4, 5, 6, 7); }
          __builtin_amdgcn_sched_barrier(0);
#pragma unroll
          for (int i = 0; i < 2; ++i)
#pragma unroll
              for (int bk = 0; bk < 4; ++bk) sv[bk] = __builtin_amdgcn_mfma_scale_f32_32x32x64_f8f6f4(ka[i][bk], qf[i], sv[bk], 0, 0, 0, 0x7f7f7f7f, 0, 0x7f7f7f7f);
          __builtin_amdgcn_sched_barrier(0); }
        if (grp == 1 && j + 1 < nst) lstore(buf ^ 1);
        LDS_BAR();
        if (grp == 1 && j + 2 < nst) gload(j + 2);
        float ma = fmaxf(sv[0][0], sv[1][0]), mb = fmaxf(sv[2][0], sv[3][0]);
#pragma unroll
        for (int i = 1; i < 16; ++i) { ma = fmaxf(fmaxf(ma, sv[0][i]), sv[1][i]); mb = fmaxf(fmaxf(mb, sv[2][i]), sv[3][i]); }
        float mx = fmaxf(ma, mb) * J.c;
        { auto rr = __builtin_amdgcn_permlane32_swap(__float_as_uint(mx), __float_as_uint(mx), false, false); mx = fmaxf(__uint_as_float(rr[0]), __uint_as_float(rr[1])); }
        if (__any(mx > mrun + 8.0f)) {
            const float mnew = fmaxf(mrun, mx), alpha = fexp2(mrun - mnew); mrun = mnew; lsum *= alpha;
#pragma unroll
            for (int i = 0; i < 16; ++i) { o0[i] *= alpha; o1[i] *= alpha; }
        }
        const float nm = -mrun; float ps = 0.f;
#pragma unroll
        for (int bk = 0; bk < 4; ++bk)
#pragma unroll
            for (int i = 0; i < 16; ++i) { sv[bk][i] = fexp2(__builtin_fmaf(sv[bk][i], J.c, nm)); ps += sv[bk][i]; }
        lsum += ps;
        { const LAS unsigned char* vp = vb0 + buf * VBUF + r * VPB + 32 * h;
          i32x8 va[2][2];
#pragma unroll
          for (int t = 0; t < 2; ++t)
#pragma unroll
              for (int db = 0; db < 2; ++db) { const i32x4 lo_ = *(const LAS i32x4*)(vp + db * 32 * VPB + 64 * t), hi_ = *(const LAS i32x4*)(vp + db * 32 * VPB + 64 * t + 16); va[t][db] = __builtin_shufflevector(lo_, hi_, 0, 1, 2, 3, 4, 5, 6, 7); }
#pragma unroll
          for (int t = 0; t < 2; ++t) { i32x8 pf;
#pragma unroll
              for (int q = 0; q < 8; ++q) { const int bk = 2 * t + (q >> 2), i = 4 * (q & 3); int w = 0;
                  w = __builtin_amdgcn_cvt_pk_fp8_f32(sv[bk][i], sv[bk][i + 1], w, false); w = __builtin_amdgcn_cvt_pk_fp8_f32(sv[bk][i + 2], sv[bk][i + 3], w, true); pf[q] = w; }
              o0 = __builtin_amdgcn_mfma_scale_f32_32x32x64_f8f6f4(va[t][0], pf, o0, 0, 0, 0, 0x7f7f7f7f, 0, 0x7f7f7f7f);
              o1 = __builtin_amdgcn_mfma_scale_f32_32x32x64_f8f6f4(va[t][1], pf, o1, 0, 0, 0, 0x7f7f7f7f, 0, 0x7f7f7f7f); } }
        if (grp == 0 && j + 1 < nst) lstore(buf ^ 1);
        LDS_BAR();
        if (grp == 0 && j + 2 < nst) gload(j + 2);
    }
    if (grp == 0) LDS_BAR();
    __syncthreads();
    { auto rr = __builtin_amdgcn_permlane32_swap(__float_as_uint(lsum), __float_as_uint(lsum), false, false); lsum = __uint_as_float(rr[0]) + __uint_as_float(rr[1]); }
    const float inv = frcp(lsum);
    bf16* orow = J.O + (size_t)(wid * 32 + r) * J.opitch + 4 * h;
#pragma unroll
    for (int g = 0; g < 4; ++g) {
        *(u32x2*)(orow + 8 * g) = (u32x2){cvtpk(o0[4 * g] * inv, o0[4 * g + 1] * inv), cvtpk(o0[4 * g + 2] * inv, o0[4 * g + 3] * inv)};
        *(u32x2*)(orow + 32 + 8 * g) = (u32x2){cvtpk(o1[4 * g] * inv, o1[4 * g + 1] * inv), cvtpk(o1[4 * g + 2] * inv, o1[4 * g + 3] * inv)};
    }
}

struct Params { const float* in[31]; float* out; unsigned char* ws; int ph_lo, ph_hi; };
typedef const __attribute__((address_space(4))) unsigned char* kaptr_t;
struct PView {
    kaptr_t ka; unsigned char* ws; float* out; int bid, G;
    struct InArr { kaptr_t ka; __device__ __forceinline__ const float* operator[](int i) const { return *(const float* const __attribute__((address_space(4)))*)(ka + 8 * i); } } in;
};
__device__ __forceinline__ PView pview() {
    kaptr_t k = (kaptr_t)__builtin_amdgcn_kernarg_segment_ptr(); asm volatile("" : "+s"(k));
    PView v; v.ka = k; v.in.ka = k; v.out = *(float* const __attribute__((address_space(4)))*)(k + 248); v.ws = *(unsigned char* const __attribute__((address_space(4)))*)(k + 256);
    int b = blockIdx.x, g = gridDim.x; asm volatile("" : "+s"(b), "+s"(g)); v.bid = b; v.G = g; return v;
}
enum { I_X = 0, I_C, I_CTX, I_CCTX, I_WADA, I_BADA, I_N1G, I_N2G, I_WIN, I_RPB, I_CONVW, I_ALOG, I_DTB, I_GNG, I_MQG, I_WUQ, I_MKVG, I_WUKV, I_BIF, I_MLG,
       I_WMG, I_BMG, I_WBO, I_WOUT, I_RW, I_RB, I_WGU, I_BGU, I_WDN, I_BDN, I_FG };

__device__ __forceinline__ void transpose_item(const float* W, int N, int k0, int n0, bf16* dst_row0, int ldd, LAS float* scr, int lane) {
#pragma unroll 8
    for (int i = 0; i < 32; ++i) { const int kk = 2 * i + (lane >> 5); scr[kk * 33 + (lane & 31)] = W[(size_t)(k0 + kk) * N + n0 + (lane & 31)]; }
    asm volatile("s_waitcnt lgkmcnt(0)" ::: "memory");
    const int c = lane & 7;
#pragma unroll
    for (int j = 0; j < 4; ++j) { const int n = (lane >> 3) + 8 * j; const LAS float* s = scr + (8 * c) * 33 + n;
        u32x4 o; o.x = cvtpk(s[0 * 33], s[1 * 33]); o.y = cvtpk(s[2 * 33], s[3 * 33]); o.z = cvtpk(s[4 * 33], s[5 * 33]); o.w = cvtpk(s[6 * 33], s[7 * 33]);
        *(u32x4*)(dst_row0 + (size_t)n * ldd + k0 + 8 * c) = o; }
    asm volatile("s_waitcnt lgkmcnt(0)" ::: "memory");
}
__device__ __forceinline__ void transpose_item8(const float* W, int N, int k0, int n0, signed char* dst_row0, int ldd, const float* cm_row0, LAS float* scr, int lane) {
#pragma unroll 8
    for (int i = 0; i < 32; ++i) { const int kk = 2 * i + (lane >> 5); scr[kk * 33 + (lane & 31)] = W[(size_t)(k0 + kk) * N + n0 + (lane & 31)]; }
    asm volatile("s_waitcnt lgkmcnt(0)" ::: "memory");
    const int c = lane & 7;
#pragma unroll
    for (int j = 0; j < 4; ++j) { const int n = (lane >> 3) + 8 * j; const LAS float* s = scr + (8 * c) * 33 + n;
        const float cm = cm_row0[n], inv = cm > 0.f ? 127.0f / cm : 0.f;
        unsigned w0 = 0u, w1 = 0u;
#pragma unroll
        for (int e = 0; e < 4; ++e) { const int q0 = (int)__builtin_rintf(s[e * 33] * inv), q1 = (int)__builtin_rintf(s[(4 + e) * 33] * inv); w0 |= ((unsigned)q0 & 0xffu) << (8 * e); w1 |= ((unsigned)q1 & 0xffu) << (8 * e); }
        *(u32x2*)(dst_row0 + (size_t)n * ldd + k0 + 8 * c) = (u32x2){w0, w1}; }
    asm volatile("s_waitcnt lgkmcnt(0)" ::: "memory");
}
__device__ __forceinline__ void transpose_item_f8(const float* W, int N, int k0, int n0, unsigned char* dst_row0, int ldd, LAS float* scr, int lane) {
#pragma unroll 8
    for (int i = 0; i < 32; ++i) { const int kk = 2 * i + (lane >> 5); scr[kk * 33 + (lane & 31)] = W[(size_t)(k0 + kk) * N + n0 + (lane & 31)]; }
    asm volatile("s_waitcnt lgkmcnt(0)" ::: "memory");
    const int c = lane & 7;
#pragma unroll
    for (int j = 0; j < 4; ++j) { const int n = (lane >> 3) + 8 * j; const LAS float* s = scr + (8 * c) * 33 + n;
        int w0 = 0, w1 = 0;
        w0 = __builtin_amdgcn_cvt_pk_fp8_f32(s[0 * 33] * 64.f, s[1 * 33] * 64.f, w0, false); w0 = __builtin_amdgcn_cvt_pk_fp8_f32(s[2 * 33] * 64.f, s[3 * 33] * 64.f, w0, true);
        w1 = __builtin_amdgcn_cvt_pk_fp8_f32(s[4 * 33] * 64.f, s[5 * 33] * 64.f, w1, false); w1 = __builtin_amdgcn_cvt_pk_fp8_f32(s[6 * 33] * 64.f, s[7 * 33] * 64.f, w1, true);
        *(u32x2*)(dst_row0 + (size_t)n * ldd + k0 + 8 * c) = (u32x2){(unsigned)w0, (unsigned)w1}; }
    asm volatile("s_waitcnt lgkmcnt(0)" ::: "memory");
}
struct TJob { int cnt, K, N; };
__device__ __forceinline__ void phase_prologue(const PView& p, LAS unsigned char* lds, int bid, int G) {
    const int tid = ltid(), wid = __builtin_amdgcn_readfirstlane(tid >> 6), lane = tid & 63;
    unsigned char* ws = p.ws;
    LAS float* scr = (LAS float*)(lds + wid * 16384);
    const int gw = bid * NWAVES + wid, NGW = G * NWAVES;
    constexpr int I0 = 4 * 16 * 174, I1 = 4 * 16 * 128, I2 = 16 * 8 * 32, I3 = 16 * 16 * 32, I4 = 4 * 4 * 24, I5 = 4 * 2 * 32, I6 = 128 * 16 * 64, I7 = 128 * 16 * 32;
    constexpr int NIT = I0 + I1 + I2 + I3 + I4 + I5 + I6 + I7;
    for (int it = gw; it < NIT; it += NGW) {
        int r = it;
        if (r < I0 + I1) continue; r -= I0 + I1;
        if (r < I2) continue; r -= I2;
        if (r < I3) { const int c = r / (16 * 32), q = r % (16 * 32), kb = q / 32, nb = q % 32, l = c >> 2, rep = c & 3;
            transpose_item(p.in[I_WOUT] + (size_t)l * 1024 * 1024, 1024, 64 * kb, 32 * nb, (bf16*)(ws + OFF_WOUT4) + ((size_t)l * 1024 + 32 * nb) * 4096 + rep * 1024, 4096, scr, lane); continue; } r -= I3;
        if (r < I4) { const int l = r / (4 * 24), q = r % (4 * 24), kb = q / 24, nb = q % 24;
            transpose_item(p.in[I_WUQ] + (size_t)l * 256 * 768, 768, 64 * kb, 32 * nb, (bf16*)(ws + OFF_WUQKV) + ((size_t)l * 1792 + 32 * nb) * 384, 384, scr, lane); continue; } r -= I4;
        if (r < I5) { const int l = r / (2 * 32), q = r % (2 * 32), kb = q / 32, nb = q % 32;
            transpose_item(p.in[I_WUKV] + (size_t)l * 128 * 1024, 1024, 64 * kb, 32 * nb, (bf16*)(ws + OFF_WUQKV) + ((size_t)l * 1792 + 768 + 32 * nb) * 384 + 256, 384, scr, lane); continue; } r -= I5;
        if (r < I6) { continue; } r -= I6;
        { const int c = r / (16 * 32), q = r % (16 * 32), kb = q / 32, nb = q % 32;
            transpose_item_f8(p.in[I_WDN] + (size_t)c * 1024 * 1024, 1024, 64 * kb, 32 * nb, (unsigned char*)(ws + OFF_WDN) + ((size_t)c * 1024 + 32 * nb) * 1024, 1024, scr, lane); }
    }
    { const int gt = bid * NTHR + tid, NT_ = G * NTHR;
      for (int i = gt; i < 4 * 64 * 64; i += NT_) { const int l = i / (64 * 64), q = i % (64 * 64), rr = q / 64, cc = q % 64;
          *(u32x4*)((signed char*)(ws + OFF_WIN) + ((size_t)l * NIN + DIN + rr) * 1024 + 16 * cc) = (u32x4){0u, 0u, 0u, 0u}; }
      for (int i = gt; i < 4 * 64; i += NT_) ((float*)(ws + OFF_CMIN))[(size_t)(i >> 6) * NIN + DIN + (i & 63)] = 0.f;
      for (int i = gt; i < 4 * 768 * 16; i += NT_) { const int l = i / (768 * 16), q = i % (768 * 16), rr = q / 16, cc = q % 16;
          *(u32x4*)((bf16*)(ws + OFF_WUQKV) + ((size_t)l * 1792 + rr) * 384 + 256 + 8 * cc) = (u32x4){0u, 0u, 0u, 0u}; }
      for (int i = gt; i < 4 * 1024 * 32; i += NT_) { const int l = i / (1024 * 32), q = i % (1024 * 32), rr = q / 32, cc = q % 32;
          *(u32x4*)((bf16*)(ws + OFF_WUQKV) + ((size_t)l * 1792 + 768 + rr) * 384 + 8 * cc) = (u32x4){0u, 0u, 0u, 0u}; } }
    __syncthreads();
    { LAS float* sc = (LAS float*)lds;
      for (int i = tid; i < 5 * 1024; i += NTHR) { const float v = (i < 4096) ? p.in[I_C][i] : p.in[I_CCTX][i - 4096]; sc[i] = v * fsigmoid(v); }
      LAS float* part = (LAS float*)(lds + 32768);
      __syncthreads();
      for (int item = bid; item < 4 * 96; item += G) { const int l = item / 96, cb = item % 96, col = cb * 64 + lane;
          const float* w = p.in[I_WADA] + (size_t)l * 1024 * 6144 + col;
          float a0 = 0.f, a1 = 0.f, a2 = 0.f, a3 = 0.f, a4 = 0.f;
#pragma unroll 8
          for (int k = wid * 128; k < wid * 128 + 128; ++k) { const float wv = w[(size_t)k * 6144];
              a0 += sc[k] * wv; a1 += sc[1024 + k] * wv; a2 += sc[2048 + k] * wv; a3 += sc[3072 + k] * wv; a4 += sc[4096 + k] * wv; }
          LAS float* pp = part + (wid * 64 + lane) * 5; pp[0] = a0; pp[1] = a1; pp[2] = a2; pp[3] = a3; pp[4] = a4;
          __syncthreads();
          if (tid < 320) { const int c = tid % 64, rr = tid / 64; float s = 0.f;
#pragma unroll
              for (int w8 = 0; w8 < 8; ++w8) s += part[(w8 * 64 + c) * 5 + rr];
              ((float*)(ws + OFF_MOD))[((size_t)l * 5 + rr) * 6144 + cb * 64 + c] = s + p.in[I_BADA][l * 6144 + cb * 64 + c]; }
          __syncthreads(); } }
    { LAS float* part = (LAS float*)(lds + 65536);
      LAS unsigned char* t8 = lds;
      constexpr int NI0 = 4 * 174, NI1 = 4 * 128, NI2 = 128 * 64, NI3 = 16 * 32;
      const int n = lane & 31, k2 = lane >> 5;
      for (int item = bid; item < NI3; item += G) { const int c = item >> 5, cb = item & 31, n0 = 32 * cb;
          const float* w = p.in[I_WBO] + (size_t)c * 512 * 1024; float* cmd = (float*)(ws + OFF_CMBO) + (size_t)c * 1024; signed char* dst = (signed char*)(ws + OFF_WBO) + (size_t)c * 1024 * 512;
          float x[8][4]; float m = 0.f;
#pragma unroll
          for (int i = 0; i < 8; ++i)
#pragma unroll
              for (int e = 0; e < 4; ++e) { x[i][e] = w[(size_t)(64 * i + 8 * wid + 4 * k2 + e) * 1024 + n0 + n]; m = fmaxf(m, fabsf(x[i][e])); }
          part[(wid * 2 + k2) * 32 + n] = m;
          __syncthreads();
          if (tid < 32) { float mm = part[tid];
#pragma unroll
              for (int q = 1; q < 16; ++q) mm = fmaxf(mm, part[q * 32 + tid]);
              part[512 + tid] = mm; cmd[n0 + tid] = mm; }
          __syncthreads();
          { const float cm = part[512 + n], inv = cm > 0.f ? 127.0f / cm : 0.f;
#pragma unroll
            for (int i = 0; i < 8; ++i) *(LAS unsigned*)(t8 + n * 516 + 64 * i + 8 * wid + 4 * k2) = q8x4((f32x4){x[i][0], x[i][1], x[i][2], x[i][3]} * inv); }
          __syncthreads();
#pragma unroll
          for (int q = 0; q < 2; ++q) { const int ch = tid + 512 * q, rr = ch >> 5, cc = ch & 31; const LAS unsigned* s = (const LAS unsigned*)(t8 + rr * 516 + 16 * cc);
              *(u32x4*)(dst + (size_t)(n0 + rr) * 512 + 16 * cc) = (u32x4){s[0], s[1], s[2], s[3]}; }
          __syncthreads(); }
      for (int item = bid; item < NI0 + NI1 + NI2; item += G) {
          const float* w; int N, n0; float* cmd; signed char* dst; int drow0;
          if (item < NI0) { const int l = item / 174, cb = item % 174; N = DIN; n0 = 32 * cb; w = p.in[I_WIN] + (size_t)l * 1024 * DIN; drow0 = n0; cmd = (float*)(ws + OFF_CMIN) + (size_t)l * NIN; dst = (signed char*)(ws + OFF_WIN) + (size_t)l * NIN * 1024; }
          else if (item < NI0 + NI1) { const int r = item - NI0, l = r / 128, cb = r % 128; N = NGATE; n0 = 32 * cb; w = p.in[I_WMG] + (size_t)l * 1024 * NGATE; drow0 = LDP + n0; cmd = (float*)(ws + OFF_CMIN) + (size_t)l * NIN; dst = (signed char*)(ws + OFF_WIN) + (size_t)l * NIN * 1024; }
          else { const int r = item - NI0 - NI1, c = r / 64, cb = r % 64; N = 2048; n0 = 32 * cb; w = p.in[I_WGU] + (size_t)c * 1024 * 2048; const int j = n0 & 1023; drow0 = (j >> 7) * 256 + ((n0 >= 1024) ? 128 : 0) + (j & 127);
                 cmd = (float*)(ws + OFF_CMGU) + (size_t)c * 2048; dst = (signed char*)(ws + OFF_WGU) + (size_t)c * 2048 * 1024; }
          float x[16][4]; float m = 0.f;
#pragma unroll
          for (int i = 0; i < 16; ++i)
#pragma unroll
              for (int e = 0; e < 4; ++e) { x[i][e] = w[(size_t)(64 * i + 8 * wid + 4 * k2 + e) * N + n0 + n]; }
#pragma unroll
          for (int i = 0; i < 16; ++i)
#pragma unroll
              for (int e = 0; e < 4; ++e) m = fmaxf(m, fabsf(x[i][e]));
          part[(wid * 2 + k2) * 32 + n] = m;
          __syncthreads();
          if (tid < 32) { float mm = part[tid];
#pragma unroll
              for (int q = 1; q < 16; ++q) mm = fmaxf(mm, part[q * 32 + tid]);
              part[512 + tid] = mm; cmd[drow0 + tid] = mm; }
          __syncthreads();
          { const float cm = part[512 + n], inv = cm > 0.f ? 127.0f / cm : 0.f;
#pragma unroll
            for (int i = 0; i < 16; ++i) *(LAS unsigned*)(t8 + n * 1028 + 64 * i + 8 * wid + 4 * k2) = q8x4((f32x4){x[i][0], x[i][1], x[i][2], x[i][3]} * inv); }
          __syncthreads();
#pragma unroll
          for (int q = 0; q < 4; ++q) { const int ch = tid + 512 * q, rr = ch >> 6, cc = ch & 63; const LAS unsigned* s = (const LAS unsigned*)(t8 + rr * 1028 + 16 * cc);
              *(u32x4*)(dst + (size_t)(drow0 + rr) * 1024 + 16 * cc) = (u32x4){s[0], s[1], s[2], s[3]}; }
          __syncthreads(); } }
}

__device__ __forceinline__ int tok_mv(int tk) { const int b = tk / TB, s = tk - b * TB; return s < CTX ? 4 : b; }
template <int MODE>
__device__ __forceinline__ void phase_norm1(const PView& p, int l, int bid, int G, bool dummy = false) {
    const int tid = ltid(), wid = __builtin_amdgcn_readfirstlane(tid >> 6), lane = tid & 63;
    unsigned char* ws = p.ws;
    float* X = (float*)(ws + OFF_X); signed char* H8 = (signed char*)(ws + OFF_H); float* SH = (float*)(ws + OFF_SH);
    float* Xw = dummy ? (float*)(ws + OFF_GF) : X;
    const float* MOD = (const float*)(ws + OFF_MOD);
    const bf16* YS = (const bf16*)(ws + OFF_R3);
    const float* TW = (const float*)(ws + OFF_TOPW); const int* SL = (const int*)(ws + OFF_SLOT);
    for (int tp = bid * NWAVES + wid; tp < T / 2; tp += G * NWAVES) {
        const int tk0 = 2 * tp, b = tk0 / TB, s = tk0 - b * TB, mv = s < CTX ? 4 : b;
        if (MODE == 2 && s < CTX) continue;
        f32x4 v[2][4];
        if (l == 0) { const float* src = (s < CTX) ? p.in[I_CTX] + ((size_t)b * CTX + s) * D : p.in[I_X] + ((size_t)b * SEQ + (s - CTX)) * D;
#pragma unroll
            for (int u = 0; u < 2; ++u)
#pragma unroll
                for (int j = 0; j < 4; ++j) v[u][j] = *(const f32x4*)(src + u * D + 256 * j + 4 * lane);
        } else {
            float w[2][4]; int sl[2][4];
#pragma unroll
            for (int u = 0; u < 2; ++u)
#pragma unroll
                for (int k = 0; k < 4; ++k) { w[u][k] = TW[(tk0 + u) * 4 + k]; sl[u][k] = SL[(tk0 + u) * 4 + k]; }
#pragma unroll
            for (int u = 0; u < 2; ++u)
#pragma unroll
                for (int j = 0; j < 4; ++j) v[u][j] = *(const f32x4*)(X + (size_t)(tk0 + u) * D + 256 * j + 4 * lane);
            u32x2 y[2][4][4];
#pragma unroll
            for (int u = 0; u < 2; ++u)
#pragma unroll
                for (int k = 0; k < 4; ++k)
#pragma unroll
                    for (int j = 0; j < 4; ++j) y[u][k][j] = *(const u32x2*)(YS + (size_t)sl[u][k] * D + 256 * j + 4 * lane);
            const float* g2 = MOD + ((size_t)(l - 1) * 5 + mv) * 6144 + 5120;
#pragma unroll
            for (int j = 0; j < 4; ++j) { const f32x4 g2v = *(const f32x4*)(g2 + 256 * j + 4 * lane);
#pragma unroll
                for (int u = 0; u < 2; ++u) { f32x4 f = (f32x4){0.f, 0.f, 0.f, 0.f};
#pragma unroll
                    for (int k = 0; k < 4; ++k) f += w[u][k] * (f32x4){bflo(y[u][k][j].x), bfhi(y[u][k][j].x), bflo(y[u][k][j].y), bfhi(y[u][k][j].y)};
                    v[u][j] += g2v * f; } }
        }
        if (MODE != 2) {
#pragma unroll
            for (int u = 0; u < 2; ++u)
#pragma unroll
                for (int j = 0; j < 4; ++j) *(f32x4*)(Xw + (size_t)(tk0 + u) * D + 256 * j + 4 * lane) = v[u][j];
        }
        float rstd[2];
#pragma unroll
        for (int u = 0; u < 2; ++u) { float ss = 0.f;
#pragma unroll
            for (int j = 0; j < 4; ++j) ss += v[u][j].x * v[u][j].x + v[u][j].y * v[u][j].y + v[u][j].z * v[u][j].z + v[u][j].w * v[u][j].w;
            rstd[u] = __builtin_amdgcn_rsqf(wave_sum(ss) * (1.f / D) + 1e-6f); }
        if (MODE == 2) {
            float* o = p.out + ((size_t)b * SEQ + (s - CTX)) * D;
#pragma unroll
            for (int j = 0; j < 4; ++j) { const f32x4 g = *(const f32x4*)(p.in[I_FG] + 256 * j + 4 * lane);
#pragma unroll
                for (int u = 0; u < 2; ++u) *(f32x4*)(o + u * D + 256 * j + 4 * lane) = v[u][j] * rstd[u] * g; }
        } else {
            const float* ng = p.in[I_N1G] + l * D; const float* md = MOD + ((size_t)l * 5 + mv) * 6144;
            float am[2] = {0.f, 0.f};
#pragma unroll
            for (int j = 0; j < 4; ++j) { const int c = 256 * j + 4 * lane; const f32x4 g = *(const f32x4*)(ng + c), sh = *(const f32x4*)(md + c), sc = *(const f32x4*)(md + 1024 + c);
#pragma unroll
                for (int u = 0; u < 2; ++u) { v[u][j] = v[u][j] * rstd[u] * g * (sc + 1.0f) + sh;
                    am[u] = fmaxf(am[u], fmaxf(fmaxf(fabsf(v[u][j].x), fabsf(v[u][j].y)), fmaxf(fabsf(v[u][j].z), fabsf(v[u][j].w)))); } }
#pragma unroll
            for (int u = 0; u < 2; ++u) { const float amax = wave_max(am[u]), inv = amax > 0.f ? 127.0f / amax : 0.f;
                if (lane == 0) SH[tk0 + u] = amax * (1.0f / 127.0f);
#pragma unroll
                for (int j = 0; j < 4; ++j) *(unsigned*)(H8 + (size_t)(tk0 + u) * D + 256 * j + 4 * lane) = q8x4(v[u][j] * inv); }
        }
    }
}

__device__ __forceinline__ void phase_router(const PView& p, int l, LAS unsigned char* lds, int bid, int G, bool dummy = false) {
    const int tid = ltid(), wid = __builtin_amdgcn_readfirstlane(tid >> 6), lane = tid & 63;
    unsigned char* ws = p.ws;
    const float* X = (const float*)(ws + OFF_X); signed char* H8 = (signed char*)(ws + OFF_H); float* SH = (float*)(ws + OFF_SH);
    const float* MOD = (const float*)(ws + OFF_MOD);
    float* TW = (float*)(ws + OFF_TOPW); int* TE = (int*)(ws + OFF_TOPE); int* PS = (int*)(ws + OFF_POS);
    unsigned* gcnt = (unsigned*)(ws + OFF_CTL) + CW_CNT + l * 32 + (dummy ? 1024 : 0);
    LAS float* rw = (LAS float*)lds;
    LAS int* hist = (LAS int*)(lds + MISC_OFF + 64);
    LAS int* base = hist + 32;
    LAS int* lrec = base + 32;
    { const float* rg = p.in[I_RW] + (size_t)l * 1024 * 32;
      for (int i = tid; i < 1024 * 32; i += NTHR) rw[(i & 31) * 1024 + (i >> 5)] = rg[i]; }
    constexpr int TPB = 132;
    for (int item = bid; item < T / TPB; item += G) {
        if (tid < 32) hist[tid] = 0;
        __syncthreads();
        for (int tp = wid; tp < TPB / 2; tp += NWAVES) {
            const int ti0 = 2 * tp, tk0 = item * TPB + ti0, mv = tok_mv(tk0);
            f32x4 hv[2][4];
            const float* ng = p.in[I_N2G] + l * D; const float* md = MOD + ((size_t)l * 5 + mv) * 6144;
#pragma unroll
            for (int t2 = 0; t2 < 2; ++t2) { const int tk = tk0 + t2;
                f32x4 v[4]; float ss = 0.f;
#pragma unroll
                for (int j = 0; j < 4; ++j) { v[j] = *(const f32x4*)(X + (size_t)tk * D + 256 * j + 4 * lane); ss += v[j].x * v[j].x + v[j].y * v[j].y + v[j].z * v[j].z + v[j].w * v[j].w; }
                const float rstd = __builtin_amdgcn_rsqf(wave_sum(ss) * (1.f / D) + 1e-6f);
                float am = 0.f;
#pragma unroll
                for (int j = 0; j < 4; ++j) { const int c = 256 * j + 4 * lane; const f32x4 g = *(const f32x4*)(ng + c), sh = *(const f32x4*)(md + 3072 + c), sc = *(const f32x4*)(md + 4096 + c);
                    hv[t2][j] = v[j] * rstd * g * (sc + 1.0f) + sh;
                    am = fmaxf(am, fmaxf(fmaxf(fabsf(hv[t2][j].x), fabsf(hv[t2][j].y)), fmaxf(fabsf(hv[t2][j].z), fabsf(hv[t2][j].w)))); }
                { const float amax = wave_max(am), inv = amax > 0.f ? 127.0f / amax : 0.f;
                  if (lane == 0) SH[tk] = amax * (1.0f / 127.0f);
#pragma unroll
                  for (int j = 0; j < 4; ++j) *(unsigned*)(H8 + (size_t)tk * D + 256 * j + 4 * lane) = q8x4(hv[t2][j] * inv); }
                }
            float A16[2][16];
#pragma unroll
            for (int cq = 0; cq < 4; ++cq) { float acc[2][8];
#pragma unroll
                for (int q = 0; q < 8; ++q) { acc[0][q] = 0.f; acc[1][q] = 0.f; }
#pragma unroll
                for (int j = 0; j < 4; ++j) { const int c = 256 * j + 4 * lane;
#pragma unroll
                    for (int q = 0; q < 8; ++q) { const int e = 4 * cq + (q & 3) + 16 * (q >> 2); const f32x4 w = *(const LAS f32x4*)(rw + e * 1024 + c);
                        acc[0][q] += hv[0][j].x * w.x + hv[0][j].y * w.y + hv[0][j].z * w.z + hv[0][j].w * w.w;
                        acc[1][q] += hv[1][j].x * w.x + hv[1][j].y * w.y + hv[1][j].z * w.z + hv[1][j].w * w.w; } }
#pragma unroll
                for (int t2 = 0; t2 < 2; ++t2)
#pragma unroll
                    for (int q = 0; q < 4; ++q) { auto rr = __builtin_amdgcn_permlane32_swap(__float_as_uint(acc[t2][q]), __float_as_uint(acc[t2][q + 4]), false, false); A16[t2][4 * cq + q] = __uint_as_float(rr[0]) + __uint_as_float(rr[1]); }
                asm volatile("" ::: "memory"); }
            const int myE = lane >> 1; const float rbias = p.in[I_RB][l * 32 + myE];
            const bool b3 = (lane & 8) != 0, b2 = (lane & 4) != 0, b1 = (lane & 2) != 0;
#pragma unroll
            for (int t2 = 0; t2 < 2; ++t2) {
                float B8[8], C4[4], D2[2];
#pragma unroll
                for (int e = 0; e < 8; ++e) { auto rr = __builtin_amdgcn_permlane16_swap(__float_as_uint(A16[t2][e]), __float_as_uint(A16[t2][e + 8]), false, false); B8[e] = __uint_as_float(rr[0]) + __uint_as_float(rr[1]); }
#pragma unroll
                for (int e = 0; e < 4; ++e) { const float keep = b3 ? B8[e + 4] : B8[e], send = b3 ? B8[e] : B8[e + 4]; C4[e] = keep + dppf<0x140>(send); }
#pragma unroll
                for (int e = 0; e < 2; ++e) { const float keep = b2 ? C4[e + 2] : C4[e], send = b2 ? C4[e] : C4[e + 2]; D2[e] = keep + dppf<0x141>(send); }
                float v; { const float keep = b1 ? D2[1] : D2[0], send = b1 ? D2[0] : D2[1]; v = keep + dppf<0x1B>(send); }
                v += dppf<0xB1>(v); v += rbias;
                int cnt = 0;
#pragma unroll
                for (int e = 0; e < 32; ++e) { const float s = __int_as_float(__builtin_amdgcn_readlane(__float_as_int(v), 2 * e)); cnt += ((s > v) || (s == v && e < myE)) ? 1 : 0; }
                const bool sel = (cnt < 4) && ((lane & 1) == 0);
                const unsigned long long top = __ballot(sel && cnt == 0);
                const float m0 = __int_as_float(__builtin_amdgcn_readlane(__float_as_int(v), (int)__builtin_ctzll(top)));
                const float ex = sel ? fexp(v - m0) : 0.f;
                float tot = row16_sum(ex); { auto rr = __builtin_amdgcn_permlane16_swap(__float_as_uint(tot), __float_as_uint(tot), false, false); tot = __uint_as_float(rr[0]) + __uint_as_float(rr[1]); }
                { auto rr = __builtin_amdgcn_permlane32_swap(__float_as_uint(tot), __float_as_uint(tot), false, false); tot = __uint_as_float(rr[0]) + __uint_as_float(rr[1]); }
                if (sel) { const int tk = tk0 + t2, ti = ti0 + t2;
                    TW[tk * 4 + cnt] = ex / tot; TE[tk * 4 + cnt] = myE;
                    const int rk = atomicAdd((int*)&hist[myE], 1); lrec[ti * 4 + cnt] = (myE << 16) | rk; }
            }
        }
        __syncthreads();
        if (tid < 32) base[tid] = (int)__hip_atomic_fetch_add(gcnt + tid, (unsigned)hist[tid], __ATOMIC_RELAXED, __HIP_MEMORY_SCOPE_AGENT);
        __syncthreads();
        for (int i = tid; i < TPB * 4; i += NTHR) { const int rec = lrec[i]; PS[(size_t)item * TPB * 4 + i] = base[rec >> 16] + (rec & 0xffff); }
        __syncthreads();
    }
}

__device__ __forceinline__ void phase_gather(const PView& p, int l, LAS unsigned char* lds, int bid, int G) {
    const int tid = ltid(), wid = __builtin_amdgcn_readfirstlane(tid >> 6), lane = tid & 63;
    unsigned char* ws = p.ws;
    const unsigned* gcnt = (const unsigned*)(ws + OFF_CTL) + CW_CNT + l * 32;
    int* tst = (int*)(ws + OFF_CTL) + CW_TST + l * 64;
    LAS int* off = (LAS int*)(lds + MISC_OFF + 64);
    if (tid == 0) { int acc = 0; for (int e = 0; e < 32; ++e) { off[e] = acc * 256; if (bid == 0) tst[e] = acc; acc += ((int)gcnt[e] + 255) >> 8; } if (bid == 0) tst[32] = acc; }
    __syncthreads();
    const signed char* H8 = (const signed char*)(ws + OFF_H); signed char* XG = (signed char*)(ws + OFF_R1); const float* SH = (const float*)(ws + OFF_SH); float* SX = (float*)(ws + OFF_SX);
    const int* TE = (const int*)(ws + OFF_TOPE); const int* PS = (const int*)(ws + OFF_POS); int* SL = (int*)(ws + OFF_SLOT);
    for (int tk = bid * NWAVES + wid; tk < T; tk += G * NWAVES) {
        int dst[4];
#pragma unroll
        for (int k = 0; k < 4; ++k) dst[k] = off[TE[tk * 4 + k]] + PS[tk * 4 + k];
        const u32x4 r0 = ((const u32x4*)(H8 + (size_t)tk * D))[lane]; const float sc = SH[tk];
        if (lane < 4) { const int d = dst[0] * (lane == 0) + dst[1] * (lane == 1) + dst[2] * (lane == 2) + dst[3] * (lane == 3); SL[tk * 4 + lane] = d; SX[d] = sc; }
#pragma unroll
        for (int k = 0; k < 4; ++k) ((u32x4*)(XG + (size_t)dst[k] * D))[lane] = r0;
    }
}

template <class SrcFn>
__device__ __forceinline__ void transpose64x128(LAS unsigned char* lds, int tid, SrcFn srcp, bf16* dst_hd0  ) {
    LAS bf16* tl = (LAS bf16*)lds;
#pragma unroll
    for (int q = 0; q < 2; ++q) { const int ch = tid + 512 * q, ti = ch >> 4, cc = ch & 15; *(LAS u32x4*)(tl + ti * 136 + 8 * cc) = *(const u32x4*)srcp(ti, cc); }
    __syncthreads();
#pragma unroll
    for (int q = 0; q < 2; ++q) { const int hd = tid & 127, c8 = (tid >> 7) + 4 * q; unsigned w[4];
#pragma unroll
        for (int e = 0; e < 4; ++e) { const unsigned lo = tl[(8 * c8 + 2 * e) * 136 + hd], hi = tl[(8 * c8 + 2 * e + 1) * 136 + hd]; w[e] = lo | (hi << 16); }
        *(u32x4*)(dst_hd0 + (size_t)hd * TB + 8 * c8) = (u32x4){w[0], w[1], w[2], w[3]}; }
    __syncthreads();
}
template <class SrcFn>
__device__ __forceinline__ void transpose64x128_f8(LAS unsigned char* lds, int tid, SrcFn srcp, unsigned char* dst_hd0) {
    LAS bf16* tl = (LAS bf16*)lds;
#pragma unroll
    for (int q = 0; q < 2; ++q) { const int ch = tid + 512 * q, ti = ch >> 4, cc = ch & 15; *(LAS u32x4*)(tl + ti * 136 + 8 * cc) = *(const u32x4*)srcp(ti, cc); }
    __syncthreads();
    { const int hd = tid & 127, c4 = tid >> 7; int w[4] = {0, 0, 0, 0};
#pragma unroll
      for (int q = 0; q < 4; ++q) { const float x0 = bf2f(tl[(16 * c4 + 4 * q) * 136 + hd]), x1 = bf2f(tl[(16 * c4 + 4 * q + 1) * 136 + hd]), x2 = bf2f(tl[(16 * c4 + 4 * q + 2) * 136 + hd]), x3 = bf2f(tl[(16 * c4 + 4 * q + 3) * 136 + hd]);
          w[q] = __builtin_amdgcn_cvt_pk_fp8_f32(x0, x1, w[q], false); w[q] = __builtin_amdgcn_cvt_pk_fp8_f32(x2, x3, w[q], true); }
      *(u32x4*)(dst_hd0 + (size_t)hd * TB + 16 * c4) = (u32x4){(unsigned)w[0], (unsigned)w[1], (unsigned)w[2], (unsigned)w[3]}; }
    __syncthreads();
}
__device__ __forceinline__ void phase_prep(const PView& p, int l, LAS unsigned char* lds, int bid, int G) {
    const int tid = ltid(), wid = __builtin_amdgcn_readfirstlane(tid >> 6), lane = tid & 63;
    unsigned char* ws = p.ws;
    const bf16* P = (const bf16*)(ws + OFF_R1);
    bf16* GQ = (bf16*)(ws + OFF_GQKV); const float* GT = (const float*)(ws + OFF_GATES);
    bf16* AQ = (bf16*)(ws + OFF_AQ); bf16* VTN = (bf16*)(ws + OFF_VTN);
    const float* cw = p.in[I_CONVW] + (size_t)l * 3 * 1536;
    { const int NT_ = G * NTHR, NCH = T * 192;
      for (int ch0 = bid * NTHR + tid; ch0 < NCH; ch0 += 4 * NT_) {
          u32x4 r0[4], rm[4], rp[4];
#pragma unroll
          for (int u = 0; u < 4; ++u) { const int ch = ch0 + u * NT_;
              if (ch < NCH) { const int tk = ch / 192, cc = ch - tk * 192, b = tk / TB, s = tk - b * TB; const bool c_ = s < CTX; const int lo = c_ ? 0 : CTX, hi = c_ ? CTX : TB;
                  const bf16* pr = P + (size_t)tk * LDP + PC_GQKV + 8 * cc;
                  r0[u] = *(const u32x4*)pr;
                  rm[u] = (s - 1 >= lo) ? *(const u32x4*)(pr - LDP) : (u32x4){0u, 0u, 0u, 0u};
                  rp[u] = (s + 1 < hi) ? *(const u32x4*)(pr + LDP) : (u32x4){0u, 0u, 0u, 0u}; } }
#pragma unroll
          for (int u = 0; u < 4; ++u) { const int ch = ch0 + u * NT_;
              if (ch < NCH) { const int tk = ch / 192, cc = ch - tk * 192;
                  float xm[8], x0[8], xp[8]; unpack8(r0[u], x0); unpack8(rm[u], xm); unpack8(rp[u], xp);
                  float y[8]; float ss = 0.f;
#pragma unroll
                  for (int i = 0; i < 8; ++i) { const int c = 8 * cc + i; const float z = xm[i] * cw[c] + x0[i] * cw[1536 + c] + xp[i] * cw[3072 + c]; y[i] = z * fsigmoid(z); ss += y[i] * y[i]; }
                  ss = row16_sum(ss);
                  if (cc < 128) { const float sc = __builtin_amdgcn_rsqf(ss + 1e-6f) * ((cc < 64) ? 0.08838834764831845f : 1.0f);
#pragma unroll
                      for (int i = 0; i < 8; ++i) y[i] *= sc; }
                  *(u32x4*)(GQ + (size_t)tk * 1536 + 8 * cc) = pack8(y); } } } }
    { float* GC = (float*)(ws + OFF_GC); float* MC = (float*)(ws + OFF_MC);
      for (int it = (wid * 64 + lane) * G + bid; it < (T / 64) * 16; it += G * NTHR) {
          const int tile = it >> 4, sq = it & 15, dh = sq & 7, d = dh >> 2, hh = dh & 3, tk0 = tile * 64;
          const bool isg = sq < 8;
          const float c0_ = isg ? p.in[I_DTB][l * 8 + dh] : p.in[I_BIF][((l * 2 + d) * 2 + 1) * 4 + hh];
          const float c1_ = isg ? -__expf(p.in[I_ALOG][l * 8 + dh]) : p.in[I_BIF][((l * 2 + d) * 2 + 0) * 4 + hh];
          float run = 0.f;
#pragma unroll 8
          for (int n = 0; n < 64; ++n) { const int tk = tk0 + (d ? 63 - n : n); const float* g = GT + (size_t)tk * 32;
              if (isg) { const float a = g[dh] + c0_; const float sp = (a > 20.f) ? a : __logf(1.0f + __expf(a)); run += c1_ * sp;
                  GC[(size_t)tk * 24 + dh] = run; GC[(size_t)tk * 24 + 8 + dh] = fsigmoid(g[8 + dh]); }
              else { const float y = -(g[24 + dh] + c0_); run -= (y > 20.f) ? y : __logf(1.0f + __expf(y));
                  MC[(size_t)tk * 16 + dh] = run; MC[(size_t)tk * 16 + 8 + dh] = g[16 + dh] + c1_; } } } }
    for (int tk = bid * NWAVES + wid; tk < T; tk += G * NWAVES) {
        float x[8]; float ss = 0.f;
        if (lane < 48) { unpack8(*(const u32x4*)(P + (size_t)tk * LDP + PC_MQ + 8 * lane), x); for (int i = 0; i < 8; ++i) ss += x[i] * x[i]; }
        else { for (int i = 0; i < 8; ++i) x[i] = 0.f; }
        ss = row16_sum(ss); { auto rr = __builtin_amdgcn_permlane16_swap(__float_as_uint(ss), __float_as_uint(ss), false, false); ss = __uint_as_float(rr[0]) + __uint_as_float(rr[1]); }
        if (lane < 48) { const bool isq = lane < 32; const float rs = __builtin_amdgcn_rsqf(ss * (isq ? (1.f / 256.f) : (1.f / 128.f)) + 1e-6f);
            const float* g = isq ? p.in[I_MQG] + l * 256 + 8 * lane : p.in[I_MKVG] + l * 128 + 8 * (lane - 32);
#pragma unroll
            for (int i = 0; i < 8; ++i) x[i] *= rs * g[i];
            *(u32x4*)(AQ + (size_t)tk * 384 + 8 * lane) = pack8(x); } }
    for (int it = bid; it < (T / 64) * 4; it += G) { const int tile = it >> 2, hp = it & 3, tk0 = tile * 64, b = tk0 / TB, s0 = tk0 - b * TB;
        transpose64x128(lds, tid, [&](int ti, int cc) { return P + (size_t)(tk0 + ti) * LDP + PC_NAV + hp * 128 + 8 * cc; }, VTN + ((size_t)b * 512 + hp * 128) * TB + s0); }
}

__device__ __forceinline__ void rope16(float (&x)[16], float pos) {
#pragma unroll
    for (int i = 0; i < 8; ++i) { const float inv = fexp2(-1.6609640474436813f * (float)i);
        const float rev = pos * inv * 0.15915494309189535f; const float fr = rev - floorf(rev);
        const float sn = __builtin_amdgcn_sinf(fr), cs = __builtin_amdgcn_cosf(fr);
        const float a = x[i], bb = x[i + 8]; x[i] = a * cs - bb * sn; x[i + 8] = bb * cs + a * sn; }
}
__device__ __forceinline__ void phase_mlapost(const PView& p, int l, LAS unsigned char* lds, int bid, int G, bool dummy = false) {
    const int tid = ltid();
    unsigned char* ws = p.ws;
    const bf16* P = (const bf16*)(ws + OFF_R1); const bf16* QR = (const bf16*)(ws + OFF_QKVR); bf16* VTM = (bf16*)(ws + OFF_VTM);
    const int gt = bid * NTHR + tid, NT_ = G * NTHR;
    unsigned char* QM8 = ws + OFF_QM8; unsigned char* KM8 = ws + OFF_KM; (void)dummy;
    for (int it = gt; it < T * 8 * 16; it += NT_) { const int c = it & 7, isk = (it >> 3) & 1, hh = (it >> 4) & 7, tk = it >> 7, b = tk / TB, s = tk - b * TB;
        unsigned char* dst = isk ? KM8 + ((((size_t)b * 8 + hh) * TB + s) * 128 + 16 * c) : QM8 + (((size_t)tk * 8 + hh) * 128 + 16 * c);
        if (c >= 6) { *(u32x4*)dst = (u32x4){0u, 0u, 0u, 0u}; continue; }
        const bf16* sp;
        if (c < 4) sp = isk ? QR + (size_t)tk * 1792 + 768 + hh * 128 + 16 * c : QR + (size_t)tk * 1792 + hh * 96 + 16 * c;
        else sp = isk ? P + (size_t)tk * LDP + PC_MKPE + 16 * (c - 4) : QR + (size_t)tk * 1792 + hh * 96 + 64 + 16 * (c - 4);
        float x[16]; { float a8[8], c8[8]; unpack8(*(const u32x4*)sp, a8); unpack8(*(const u32x4*)(sp + 8), c8); for (int i = 0; i < 8; ++i) { x[i] = a8[i]; x[8 + i] = c8[i]; } }
        if (c >= 4 && s >= CTX) { const int t = s - CTX; rope16(x, (float)(c == 4 ? (t >> 6) : (t & 63))); }
        int w[4] = {0, 0, 0, 0};
#pragma unroll
        for (int q = 0; q < 4; ++q) { w[q] = __builtin_amdgcn_cvt_pk_fp8_f32(x[4 * q], x[4 * q + 1], w[q], false); w[q] = __builtin_amdgcn_cvt_pk_fp8_f32(x[4 * q + 2], x[4 * q + 3], w[q], true); }
        *(u32x4*)dst = (u32x4){(unsigned)w[0], (unsigned)w[1], (unsigned)w[2], (unsigned)w[3]}; }
    for (int it = bid; it < (T / 64) * 4; it += G) { const int tile = it >> 2, hp = it & 3, tk0 = tile * 64, b = tk0 / TB, s0 = tk0 - b * TB;
        transpose64x128_f8(lds, tid, [&](int ti, int cc) { return QR + (size_t)(tk0 + ti) * 1792 + 768 + (2 * hp + (cc >> 3)) * 128 + 64 + 8 * (cc & 7); }, (unsigned char*)VTM + ((size_t)b * 512 + hp * 128) * TB + s0); }
}

__device__ __forceinline__ void phase_attn(const PView& p, int l, LAS unsigned char* lds, int bid, int G) {
    const int tid = ltid(), wid = __builtin_amdgcn_readfirstlane(tid >> 6), lane = tid & 63;
    unsigned char* ws = p.ws;
    const bf16* P = (const bf16*)(ws + OFF_R1); const unsigned char* QM8 = ws + OFF_QM8; const unsigned char* KM8 = ws + OFF_KM;
    const bf16* VTM = (const bf16*)(ws + OFF_VTM); const bf16* VTN = (const bf16*)(ws + OFF_VTN); bf16* Y = (bf16*)(ws + OFF_Y);
    LAS float* btab = (LAS float*)(lds + 90112);
    for (int i = tid; i < 8 * 465; i += NTHR) btab[i] = p.in[I_RPB][(size_t)l * 8 * 465 + i] * 1.4426950408889634f;
    __syncthreads();
    const float c_mla = 0.10206207261596577f * 1.4426950408889634f, c_na = 0.125f * 1.4426950408889634f;
    for (int u = bid; u < 2112; u += G) {
        AttnJob J; J.bias = btab; J.kr_lo = 0; J.r_w = 0; J.c_q = 0; J.s0_first_n = 1 << 30; J.s0_jump = 0;
        if (u < 1024) {
            const int b = u >> 8, hh = u & 7, qb = (u >> 3) & 31; const size_t tq = (size_t)b * TB + CTX + qb * 256;
            J.Q = (const bf16*)(QM8 + (tq * 8 + hh) * 128); J.qpitch = 1024; J.K = (const bf16*)(KM8 + ((size_t)b * 8 + hh) * TB * 128); J.kpitch = 128; J.VT = (const bf16*)((const unsigned char*)VTM + ((size_t)b * 8 + hh) * 64 * TB);
            J.O = Y + tq * 2048 + 1024 + hh * 64; J.opitch = 2048; J.ntiles = TB / 64; J.c = c_mla;
            attn_unit_dense<96>(lds, J);
        } else if (u < 2048) {
            const int v = u - 1024, b = v >> 8, hh = v & 7, rq = (v >> 3) & 31; const size_t tq = (size_t)b * TB + CTX + rq * 256;
            const int kr_lo = min(max(4 * rq - 4, 0), 120), kr_hi = min(max(4 * rq + 3 - 4, 0), 120) + 7;
            J.Q = P + tq * LDP + PC_NAQ + hh * 64; J.qpitch = LDP; J.K = P + (size_t)b * TB * LDP + PC_NAK + hh * 64; J.kpitch = LDP; J.VT = VTN + ((size_t)b * 8 + hh) * 64 * TB;
            J.O = Y + tq * 2048 + hh * 64; J.opitch = 2048; J.ntiles = 4 + (kr_hi - kr_lo + 1); J.c = c_na;
            J.s0_first_n = 4; J.s0_jump = CTX + kr_lo * 64; J.kr_lo = kr_lo; J.r_w = 4 * rq + (wid >> 1); J.c_q = 32 * (wid & 1) + (lane & 31); J.bias = btab + hh * 465;
            attn_unit<64, true>(lds, J);
        } else if (u < 2080) {
            const int v = u - 2048, b = v >> 3, hh = v & 7; const size_t tq = (size_t)b * TB;
            J.Q = (const bf16*)(QM8 + (tq * 8 + hh) * 128); J.qpitch = 1024; J.K = (const bf16*)(KM8 + ((size_t)b * 8 + hh) * TB * 128); J.kpitch = 128; J.VT = (const bf16*)((const unsigned char*)VTM + ((size_t)b * 8 + hh) * 64 * TB);
            J.O = Y + tq * 2048 + 1024 + hh * 64; J.opitch = 2048; J.ntiles = 4; J.c = c_mla;
            attn_unit_dense<96>(lds, J);
        } else {
            const int v = u - 2080, b = v >> 3, hh = v & 7; const size_t tq = (size_t)b * TB;
            J.Q = P + tq * LDP + PC_NAQ + hh * 64; J.qpitch = LDP; J.K = P + (size_t)b * TB * LDP + PC_NAK + hh * 64; J.kpitch = LDP; J.VT = VTN + ((size_t)b * 8 + hh) * 64 * TB;
            J.O = Y + tq * 2048 + hh * 64; J.opitch = 2048; J.ntiles = 4; J.c = c_na;
            attn_unit<64, false>(lds, J);
        }
    }
}


__device__ __forceinline__ unsigned lds_u16(const LAS unsigned char* p) { return (unsigned)*(const LAS unsigned short*)p; }
__device__ __forceinline__ void mlstm_chunk_item(const PView& p, LAS unsigned char* lds, int chain, int vq) {
    const int tid = ltid(), wid = __builtin_amdgcn_readfirstlane(tid >> 6), lane = tid & 63, r = lane & 31, h = lane >> 5;
    const int b = chain >> 3, hh = (chain >> 1) & 3, dir = chain & 1, dh = dir * 4 + hh;
    unsigned char* ws = p.ws;
    const bf16* P = (const bf16*)(ws + OFF_R1); const float* MC = (const float*)(ws + OFF_MC);
    float* OM = (float*)(ws + OFF_OML) + (size_t)dir * T * 512;
    constexpr int KT = 0, QT = 9216, VT_ = 18432, FC = 23552, AO_ = FC + 256, BO_ = AO_ + 256, CHB = 24576;
    constexpr int CBO = 2 * CHB, CBS = 4608, NSO = CBO + 2 * CBS;
    for (int i = tid; i < (2 * CBS + 512) / 4; i += NTHR) ((LAS unsigned*)(lds + CBO))[i] = 0u;
    f32x16 cacc;
#pragma unroll
    for (int i = 0; i < 16; ++i) cacc[i] = 0.f;
    const int srow = tid >> 3, sc8 = tid & 7, vrow = tid >> 2, vc = tid & 3;
    struct Stg { u32x4 k, q, v; float fc, ip, fm, vfc, vip; };
    Stg sA, sB; sA.fc = sA.ip = sA.fm = sA.vfc = sA.vip = 0.f; sB = sA;
    auto s0_of = [&](int c) { return (dir == 0) ? 64 * c : (c < 4 ? 192 - 64 * c : TB - 64 - 64 * (c - 4)); };
    auto gload = [&](Stg& g, int c) { const size_t tk0 = (size_t)b * TB + s0_of(c);
        const size_t tkr = tk0 + (dir ? 63 - srow : srow);
        g.k = *(const u32x4*)(P + tkr * LDP + PC_LK + hh * 64 + 8 * sc8); g.q = *(const u32x4*)(P + tkr * LDP + PC_LQ + hh * 64 + 8 * sc8);
        g.fm = MC[(tk0 + (dir ? 32 : 31)) * 16 + dh];
        if (tid < 256) { const size_t tkv = tk0 + (dir ? 63 - vrow : vrow); g.v = *(const u32x4*)(P + tkv * LDP + PC_LV + hh * 128 + vq * 32 + 8 * vc); g.vfc = MC[tkv * 16 + dh]; g.vip = MC[tkv * 16 + 8 + dh]; }
        if (tid < 64) { const size_t tkg = tk0 + (dir ? 63 - tid : tid); g.fc = MC[tkg * 16 + dh]; g.ip = MC[tkg * 16 + 8 + dh]; } };
    auto lstore = [&](const Stg& g, int nb) { LAS unsigned char* cb = lds + nb * CHB;
        *(LAS u32x4*)(cb + KT + srow * 144 + 16 * sc8) = g.k;
        { float q8[8]; unpack8(g.q, q8);
#pragma unroll
          for (int e = 0; e < 8; ++e) q8[e] *= 0.125f;
          *(LAS u32x4*)(cb + QT + srow * 144 + 16 * sc8) = pack8(q8); }
        if (tid < 256) { float v8[8]; unpack8(g.v, v8); const float bj = __expf(g.vip - g.vfc + g.fm);
#pragma unroll
            for (int e = 0; e < 8; ++e) v8[e] *= bj;
            *(LAS u32x4*)(cb + VT_ + vrow * 80 + 16 * vc) = pack8(v8); }
        if (tid < 64) { ((LAS float*)(cb + FC))[tid] = g.fc; ((LAS float*)(cb + AO_))[tid] = __expf(g.fc - g.fm); ((LAS float*)(cb + BO_))[tid] = __expf(g.ip - g.fc + g.fm); }
        if (tid == 64) ((LAS float*)(cb + FC + 768))[0] = g.fm; };
    gload(sA, 0); lstore(sA, 0); gload(sB, 1);
    __syncthreads();
    auto compute = [&](const int c, const int cur) {
        const int nxt = cur ^ 1;
        const LAS unsigned char* cb = lds + cur * CHB;
        const LAS float* fcS = (const LAS float*)(cb + FC); const LAS float* aS = (const LAS float*)(cb + AO_); const LAS float* bS = (const LAS float*)(cb + BO_);
        const float fend = fcS[63], dec = __expf(fend), cw = __expf(fend - fcS[192]);
        if (wid < 2) {
            const int ib = wid, i = 32 * ib + r;
            bf16x8 qf[4];
#pragma unroll
            for (int s = 0; s < 4; ++s) qf[s] = *(const LAS bf16x8*)(cb + QT + i * 144 + 32 * s + 16 * h);
            f32x16 s0v, s1v, nacc, iacc;
#pragma unroll
            for (int q = 0; q < 16; ++q) { s0v[q] = 0.f; s1v[q] = 0.f; nacc[q] = 0.f; iacc[q] = 0.f; }
#pragma unroll
            for (int s = 0; s < 4; ++s) { const bf16x8 a0 = *(const LAS bf16x8*)(cb + KT + r * 144 + 32 * s + 16 * h); s0v = __builtin_amdgcn_mfma_f32_32x32x16_bf16(a0, qf[s], s0v, 0, 0, 0); }
            float den = 0.f;
            if (ib == 0) {
#pragma unroll
                for (int g4 = 0; g4 < 4; ++g4) { const f32x4 B0 = *(const LAS f32x4*)(bS + 8 * g4 + 4 * h);
#pragma unroll
                    for (int q = 0; q < 4; ++q) { const int reg = 4 * g4 + q, j0 = 8 * g4 + 4 * h + q; const float p0 = (j0 <= r) ? s0v[reg] : 0.f; s0v[reg] = p0; den += p0 * B0[q]; } }
            } else {
#pragma unroll
                for (int s = 0; s < 4; ++s) { const bf16x8 a1 = *(const LAS bf16x8*)(cb + KT + (32 + r) * 144 + 32 * s + 16 * h); s1v = __builtin_amdgcn_mfma_f32_32x32x16_bf16(a1, qf[s], s1v, 0, 0, 0); }
#pragma unroll
                for (int g4 = 0; g4 < 4; ++g4) { const f32x4 B0 = *(const LAS f32x4*)(bS + 8 * g4 + 4 * h), B1 = *(const LAS f32x4*)(bS + 32 + 8 * g4 + 4 * h);
#pragma unroll
                    for (int q = 0; q < 4; ++q) { const int reg = 4 * g4 + q, j0 = 8 * g4 + 4 * h + q; den += s0v[reg] * B0[q];
                        const float p1 = (j0 <= r) ? s1v[reg] : 0.f; s1v[reg] = p1; den += p1 * B1[q]; } }
            }
#pragma unroll
            for (int st = 0; st < 4; ++st) { if (st < 2 || ib == 1) {
                u32x4 pw;
#pragma unroll
                for (int q = 0; q < 4; ++q) { const int reg = 8 * (st & 1) + 2 * q; pw[q] = (st < 2) ? cvtpk(s0v[reg], s0v[reg + 1]) : cvtpk(s1v[reg], s1v[reg + 1]); }
                u32x4 vw;
#pragma unroll
                for (int q = 0; q < 4; ++q) { const int t0 = 16 * st + 8 * (q >> 1) + 4 * h + 2 * (q & 1);
                    vw[q] = lds_u16(cb + VT_ + t0 * 80 + 2 * r) | (lds_u16(cb + VT_ + (t0 + 1) * 80 + 2 * r) << 16); }
                nacc = __builtin_amdgcn_mfma_f32_32x32x16_bf16(__builtin_bit_cast(bf16x8, vw), __builtin_bit_cast(bf16x8, pw), nacc, 0, 0, 0); } }
            const LAS unsigned char* cbt = lds + CBO + cur * CBS; const LAS float* nS = (const LAS float*)(lds + NSO + cur * 256);
            float dint = 0.f;
#pragma unroll
            for (int s = 0; s < 4; ++s) { const bf16x8 ca = *(const LAS bf16x8*)(cbt + r * 144 + 32 * s + 16 * h); iacc = __builtin_amdgcn_mfma_f32_32x32x16_bf16(ca, qf[s], iacc, 0, 0, 0);
                float q8[8]; unpack8(__builtin_bit_cast(u32x4, qf[s]), q8); const f32x4 n0 = *(const LAS f32x4*)(nS + 16 * s + 8 * h), n1 = *(const LAS f32x4*)(nS + 16 * s + 8 * h + 4);
                dint += q8[0] * n0.x + q8[1] * n0.y + q8[2] * n0.z + q8[3] * n0.w + q8[4] * n1.x + q8[5] * n1.y + q8[6] * n1.z + q8[7] * n1.w; }
            { auto rr = __builtin_amdgcn_permlane32_swap(__float_as_uint(den), __float_as_uint(den), false, false); den = __uint_as_float(rr[0]) + __uint_as_float(rr[1]); }
            { auto rr = __builtin_amdgcn_permlane32_swap(__float_as_uint(dint), __float_as_uint(dint), false, false); dint = __uint_as_float(rr[0]) + __uint_as_float(rr[1]); }
            const float ai = aS[i], egi = __expf(fcS[i]), dtot = ai * den + egi * dint, inv = 1.0f / fmaxf(fabsf(dtot), 1.0f), ka = ai * inv, ke_ = egi * inv;
            const size_t tko = (size_t)b * TB + s0_of(c) + (dir ? 63 - i : i);
            float* op = OM + tko * 512 + hh * 128 + vq * 32 + 4 * h;
#pragma unroll
            for (int g4 = 0; g4 < 4; ++g4) { f32x4 o;
#pragma unroll
                for (int q = 0; q < 4; ++q) o[q] = nacc[4 * g4 + q] * ka + iacc[4 * g4 + q] * ke_;
                *(f32x4*)(op + 8 * g4) = o; }
        } else if (wid < 4) {
            const int cbk = wid - 2;
            f32x16 tacc;
#pragma unroll
            for (int q = 0; q < 16; ++q) tacc[q] = 0.f;
#pragma unroll
            for (int s = 0; s < 4; ++s) { const int t0 = 16 * s + 8 * h;
                u32x4 vw, kw;
#pragma unroll
                for (int q = 0; q < 4; ++q) { const int ta = t0 + 2 * q;
                    vw[q] = lds_u16(cb + VT_ + ta * 80 + 2 * r) | (lds_u16(cb + VT_ + (ta + 1) * 80 + 2 * r) << 16);
                    kw[q] = lds_u16(cb + KT + ta * 144 + 2 * (r + 32 * cbk)) | (lds_u16(cb + KT + (ta + 1) * 144 + 2 * (r + 32 * cbk)) << 16); }
                tacc = __builtin_amdgcn_mfma_f32_32x32x16_bf16(__builtin_bit_cast(bf16x8, vw), __builtin_bit_cast(bf16x8, kw), tacc, 0, 0, 0); }
            LAS unsigned char* cbn = lds + CBO + nxt * CBS;
#pragma unroll
            for (int q = 0; q < 16; ++q) { cacc[q] = dec * cacc[q] + cw * tacc[q]; const int v = (q & 3) + 8 * (q >> 2) + 4 * h; *(LAS unsigned short*)(cbn + v * 144 + 2 * (r + 32 * cbk)) = (unsigned short)(cvtpk(cacc[q], 0.f) & 0xffffu); }
        } else if (wid == 4) {
            float s0 = 0.f, s1 = 0.f;
#pragma unroll 8
            for (int j = 0; j < 64; j += 2) { s0 += bS[j] * bf2f((bf16)lds_u16(cb + KT + j * 144 + 2 * lane)); s1 += bS[j + 1] * bf2f((bf16)lds_u16(cb + KT + (j + 1) * 144 + 2 * lane)); }
            const LAS float* nc = (const LAS float*)(lds + NSO + cur * 256); LAS float* nn = (LAS float*)(lds + NSO + nxt * 256);
            nn[lane] = dec * nc[lane] + cw * (s0 + s1);
        }
    };
    for (int c = 0; c < TB / 64; c += 2) {
        gload(sA, min(c + 2, TB / 64 - 1)); compute(c, 0); lstore(sB, 1); LDS_BAR();
        gload(sB, min(c + 3, TB / 64 - 1)); compute(c + 1, 1); lstore(sA, 0); LDS_BAR();
    }
}

constexpr int GF_WM = 0, GF_QD = 16384, GF_QK = 32768, GF_KE = 40960, GF_U0 = 57344, GF_EE = 90112, GF_ITEM = 90368, NCHUNK = TB / 64;
__device__ __forceinline__ int chunk_s0(int dir, int c) { return (dir == 0) ? 64 * c : (c < 4 ? 192 - 64 * c : TB - 64 - 64 * (c - 4)); }
__device__ __forceinline__ void phase_gdnpre(const PView& p, int l, LAS unsigned char* lds, int bid, int G) {
    const int tid = ltid(), wid = __builtin_amdgcn_readfirstlane(tid >> 6), lane = tid & 63, r = lane & 31, h = lane >> 5;
    unsigned char* ws = p.ws;
    const bf16* GQ = (const bf16*)(ws + OFF_GQKV); const float* GC = (const float*)(ws + OFF_GC);
    constexpr int KO = 0, QO = 17408, VO = 34816, AO = 52224, GSO = 69632, BSO = GSO + 256, XO = 70400, UO = 87808;
    const LAS float* gS = (const LAS float*)(lds + GSO); const LAS float* bS = (const LAS float*)(lds + BSO);
    for (int it = bid; it < 32 * NCHUNK; it += G) {
        const int chain = it / NCHUNK, c = it % NCHUNK, b = chain >> 3, hh = (chain >> 1) & 3, dir = chain & 1, dh = dir * 4 + hh;
        const size_t tk0 = (size_t)b * TB + chunk_s0(dir, c);
        unsigned char* gf = ws + OFF_GF + (size_t)it * GF_ITEM;
#pragma unroll
        for (int rep = 0; rep < 6; ++rep) { const int ch = tid + 512 * rep, tile = ch >> 10, row = (ch & 1023) >> 4, c8 = ch & 15;
            const size_t tk = tk0 + (dir ? 63 - row : row);
            const int col = (tile == 0 ? 512 : (tile == 1 ? 0 : 1024)) + hh * 128 + 8 * c8;
            *(LAS u32x4*)(lds + tile * 17408 + row * 272 + 16 * c8) = *(const u32x4*)(GQ + tk * 1536 + col); }
        if (tid < 64) { const size_t tk = tk0 + (dir ? 63 - tid : tid); const float gg = GC[tk * 24 + dh], bb = GC[tk * 24 + 8 + dh];
            ((LAS float*)(lds + GSO))[tid] = gg; ((LAS float*)(lds + BSO))[tid] = bb; ((LAS float*)(lds + BSO + 256))[tid] = bb * __expf(gg); }
        __syncthreads();
        { const int w4 = wid & 3, jb = w4 >> 1, ib = w4 & 1, i = 32 * ib + r;
          f32x16 acc;
#pragma unroll
          for (int q = 0; q < 16; ++q) acc[q] = 0.f;
          const LAS unsigned char* bsrc = lds + ((wid < 4) ? KO : QO) + i * 272 + 16 * h;
#pragma unroll
          for (int s = 0; s < 8; ++s) { const bf16x8 a = *(const LAS bf16x8*)(lds + KO + (32 * jb + r) * 272 + 32 * s + 16 * h), bq = *(const LAS bf16x8*)(bsrc + 32 * s);
              acc = __builtin_amdgcn_mfma_f32_32x32x16_bf16(a, bq, acc, 0, 0, 0); }
          const float gi = gS[i], bi = bS[i];
          if (wid < 4) {
#pragma unroll
              for (int g4 = 0; g4 < 4; ++g4) { const int j0 = 32 * jb + 8 * g4 + 4 * h; const f32x4 gj = *(const LAS f32x4*)(gS + j0); f32x4 o;
#pragma unroll
                  for (int q = 0; q < 4; ++q) o[q] = (i > j0 + q) ? bi * __expf(gi - gj[q]) * acc[4 * g4 + q] : 0.f;
                  *(LAS f32x4*)(lds + AO + i * 272 + 4 * j0) = o; }
          } else {
#pragma unroll
              for (int g4 = 0; g4 < 4; ++g4) { const int j0 = 32 * jb + 8 * g4 + 4 * h; const f32x4 gj = *(const LAS f32x4*)(gS + j0);
#pragma unroll
                  for (int q = 0; q < 4; ++q) acc[4 * g4 + q] = (i >= j0 + q) ? __expf(gi - gj[q]) * acc[4 * g4 + q] : 0.f; }
#pragma unroll
              for (int s2 = 0; s2 < 2; ++s2) { u32x4 w;
#pragma unroll
                  for (int q = 0; q < 4; ++q) w[q] = cvtpk(acc[8 * s2 + 2 * q], acc[8 * s2 + 2 * q + 1]);
                  *(u32x4*)(gf + GF_QK + (size_t)((ib * 4 + 2 * jb + s2) * 64 + lane) * 16) = w; }
          } }
        __syncthreads();
        constexpr int TO = UO;
        if (wid == 0) {
            float t[32];
#pragma unroll
            for (int i = 0; i < 32; ++i) {
                float acc0 = (i == r) ? 1.0f : 0.0f, acc1 = 0.f;
#pragma unroll
                for (int j4 = 0; j4 < (i + 3) / 4; ++j4) { const f32x4 a4 = *(const LAS f32x4*)(lds + AO + (32 * h + i) * 272 + (32 * h + 4 * j4) * 4);
#pragma unroll
                    for (int q = 0; q < 4; ++q) if (4 * j4 + q < i) { if (q & 1) acc1 -= a4[q] * t[4 * j4 + q]; else acc0 -= a4[q] * t[4 * j4 + q]; } }
                t[i] = acc0 + acc1;
                *(LAS unsigned short*)(lds + TO + h * 2048 + i * 64 + 2 * r) = (unsigned short)(cvtpk(t[i], 0.f) & 0xffffu);
                if ((i & 3) == 3) asm volatile("" ::: "memory");
            }
        } else if (wid >= 4) {
            const int w4 = wid - 4; const float gend = gS[63];
#pragma unroll
            for (int k = 0; k < 4; ++k) { const int f = w4 * 4 + k, ib = f >> 3, s = f & 7, i = 32 * ib + r;
                float q8[8]; unpack8(*(const LAS u32x4*)(lds + QO + i * 272 + 32 * s + 16 * h), q8); const float e = __expf(gS[i]);
#pragma unroll
                for (int q = 0; q < 8; ++q) q8[q] *= e;
                *(u32x4*)(gf + GF_QD + (size_t)(f * 64 + lane) * 16) = pack8(q8); }
#pragma unroll
            for (int k = 0; k < 4; ++k) { const int f = w4 * 4 + k, db = f >> 2, st = f & 3, dk = 32 * db + r;
                u32x4 w;
#pragma unroll
                for (int q = 0; q < 4; ++q) { const int t0 = 16 * st + 8 * (q >> 1) + 4 * h + 2 * (q & 1);
                    const float ka = bf2f((bf16)lds_u16(lds + KO + t0 * 272 + 2 * dk)) * __expf(gend - gS[t0]), kb = bf2f((bf16)lds_u16(lds + KO + (t0 + 1) * 272 + 2 * dk)) * __expf(gend - gS[t0 + 1]);
                    w[q] = cvtpk(ka, kb); }
                *(u32x4*)(gf + GF_KE + (size_t)(f * 64 + lane) * 16) = w; }
            if (tid == 256) *(float*)(gf + GF_EE) = __expf(gend);
        }
        __syncthreads();
        { const bool isv = wid < 4; const int c = 32 * (wid & 3) + r;
          const LAS unsigned char* srcp = lds + (isv ? VO : KO) + 2 * c; const LAS float* fS = (const LAS float*)(lds + (isv ? BSO : BSO + 256));
          f32x16 x0, x1;
#pragma unroll
          for (int q = 0; q < 16; ++q) { x0[q] = 0.f; const int tok = 32 + (q & 3) + 8 * (q >> 2) + 4 * h; x1[q] = fS[tok] * bf2f((bf16)lds_u16(srcp + tok * 272)); }
#pragma unroll
          for (int s = 0; s < 2; ++s) { u32x4 rw_;
#pragma unroll
              for (int q = 0; q < 4; ++q) { const int t0 = 16 * s + 8 * h + 2 * q; rw_[q] = cvtpk(fS[t0] * bf2f((bf16)lds_u16(srcp + t0 * 272)), fS[t0 + 1] * bf2f((bf16)lds_u16(srcp + (t0 + 1) * 272))); }
              const bf16x8 ta = *(const LAS bf16x8*)(lds + TO + r * 64 + 32 * s + 16 * h);
              x0 = __builtin_amdgcn_mfma_f32_32x32x16_bf16(ta, __builtin_bit_cast(bf16x8, rw_), x0, 0, 0, 0); }
#pragma unroll
          for (int s2 = 0; s2 < 2; ++s2) { u32x4 xb, aw;
#pragma unroll
              for (int q = 0; q < 4; ++q) xb[q] = cvtpk(x0[8 * s2 + 2 * q], x0[8 * s2 + 2 * q + 1]);
              const f32x4 a0 = *(const LAS f32x4*)(lds + AO + (32 + r) * 272 + (16 * s2 + 4 * h) * 4), a1 = *(const LAS f32x4*)(lds + AO + (32 + r) * 272 + (16 * s2 + 8 + 4 * h) * 4);
              aw[0] = cvtpk(-a0.x, -a0.y); aw[1] = cvtpk(-a0.z, -a0.w); aw[2] = cvtpk(-a1.x, -a1.y); aw[3] = cvtpk(-a1.z, -a1.w);
              x1 = __builtin_amdgcn_mfma_f32_32x32x16_bf16(__builtin_bit_cast(bf16x8, aw), __builtin_bit_cast(bf16x8, xb), x1, 0, 0, 0); }
          f32x16 y1;
#pragma unroll
          for (int q = 0; q < 16; ++q) y1[q] = 0.f;
#pragma unroll
          for (int s2 = 0; s2 < 2; ++s2) { u32x4 rb;
#pragma unroll
              for (int q = 0; q < 4; ++q) rb[q] = cvtpk(x1[8 * s2 + 2 * q], x1[8 * s2 + 2 * q + 1]);
              const u32x2 t0 = *(const LAS u32x2*)(lds + TO + 2048 + r * 64 + (16 * s2 + 4 * h) * 2), t1 = *(const LAS u32x2*)(lds + TO + 2048 + r * 64 + (16 * s2 + 8 + 4 * h) * 2);
              y1 = __builtin_amdgcn_mfma_f32_32x32x16_bf16(__builtin_bit_cast(bf16x8, (u32x4){t0.x, t0.y, t1.x, t1.y}), __builtin_bit_cast(bf16x8, rb), y1, 0, 0, 0); }
          if (isv) {
              f32x4* d0 = (f32x4*)(gf + GF_U0 + (size_t)((wid * 2 + 0) * 64 + lane) * 64); f32x4* d1 = (f32x4*)(gf + GF_U0 + (size_t)((wid * 2 + 1) * 64 + lane) * 64);
#pragma unroll
              for (int q = 0; q < 4; ++q) { d0[q] = (f32x4){x0[4 * q], x0[4 * q + 1], x0[4 * q + 2], x0[4 * q + 3]}; d1[q] = (f32x4){y1[4 * q], y1[4 * q + 1], y1[4 * q + 2], y1[4 * q + 3]}; }
          } else {
              const int dk = 32 * (wid - 4) + r;
#pragma unroll
              for (int q = 0; q < 16; ++q) { const int tok = (q & 3) + 8 * (q >> 2) + 4 * h;
                  *(LAS unsigned short*)(lds + XO + tok * 272 + 2 * dk) = (unsigned short)(cvtpk(-x0[q], 0.f) & 0xffffu);
                  *(LAS unsigned short*)(lds + XO + (32 + tok) * 272 + 2 * dk) = (unsigned short)(cvtpk(-y1[q], 0.f) & 0xffffu); }
          } }
        __syncthreads();
#pragma unroll
        for (int k = 0; k < 2; ++k) { const int f = wid * 2 + k, tb = f >> 3, s = f & 7;
            *(u32x4*)(gf + GF_WM + (size_t)(f * 64 + lane) * 16) = *(const LAS u32x4*)(lds + XO + (32 * tb + r) * 272 + 32 * s + 16 * h); }
        __syncthreads();
    }
}

__device__ __forceinline__ void gdn_seq_item(const PView& p, LAS unsigned char* lds, int chain, int vq) {
    const int tid = ltid(), wid = __builtin_amdgcn_readfirstlane(tid >> 6), lane = tid & 63, r = lane & 31, h = lane >> 5;
    const int b = chain >> 3, hh = (chain >> 1) & 3, dir = chain & 1;
    unsigned char* ws = p.ws;
    const unsigned char* gfc = ws + OFF_GF + (size_t)chain * NCHUNK * GF_ITEM;
    constexpr int SBS = 8704, UFO = 17408;
    for (int i = tid; i < SBS / 4; i += NTHR) ((LAS unsigned*)lds)[i] = 0u;
    __syncthreads();
    if (wid < 2) {
        u32x4 wm[3][8]; f32x4 uu[3][4];
#define LD_A(SET, C) do { const unsigned char* gf_ = gfc + (size_t)(C) * GF_ITEM; \
            _Pragma("unroll") for (int s = 0; s < 8; ++s) wm[SET][s] = *(const u32x4*)(gf_ + GF_WM + (size_t)((wid * 8 + s) * 64 + lane) * 16); \
            const f32x4* up_ = (const f32x4*)(gf_ + GF_U0 + (size_t)((vq * 2 + wid) * 64 + lane) * 64); \
            _Pragma("unroll") for (int q = 0; q < 4; ++q) uu[SET][q] = up_[q]; } while (0)
#define ST_A(SET, C) do { const LAS unsigned char* sb_ = lds + ((C) & 1) * SBS; f32x16 acc_; \
            _Pragma("unroll") for (int q = 0; q < 4; ++q) { acc_[4 * q] = uu[SET][q].x; acc_[4 * q + 1] = uu[SET][q].y; acc_[4 * q + 2] = uu[SET][q].z; acc_[4 * q + 3] = uu[SET][q].w; } \
            _Pragma("unroll") for (int s = 0; s < 8; ++s) { const bf16x8 sf_ = *(const LAS bf16x8*)(sb_ + r * 272 + 32 * s + 16 * h); \
                acc_ = __builtin_amdgcn_mfma_f32_32x32x16_bf16(__builtin_bit_cast(bf16x8, wm[SET][s]), sf_, acc_, 0, 0, 0); } \
            _Pragma("unroll") for (int s2 = 0; s2 < 2; ++s2) { u32x4 w_; _Pragma("unroll") for (int q = 0; q < 4; ++q) w_[q] = cvtpk(acc_[8 * s2 + 2 * q], acc_[8 * s2 + 2 * q + 1]); \
                *(LAS u32x4*)(lds + UFO + ((2 * wid + s2) * 64 + lane) * 16) = w_; } \
            LDS_BAR(); LDS_BAR(); } while (0)
        LD_A(0, 0); LD_A(1, 1);
        for (int c = 0; c < NCHUNK; c += 3) { LD_A(2, c + 2); ST_A(0, c); LD_A(0, min(c + 3, NCHUNK - 1)); ST_A(1, c + 1); LD_A(1, min(c + 4, NCHUNK - 1)); ST_A(2, c + 2); }
#undef LD_A
#undef ST_A
    } else if (wid < 4) {
        const int ib = wid - 2;
        char* OGu = (char*)((float*)(ws + OFF_OGD) + (size_t)dir * T * 512 + hh * 128 + vq * 32);
        const int ostep = dir ? -2048 : 2048, ot0 = 32 * ib + 4 * h;
        u32x4 qd[3][8], qk[3][4];
#define LD_B(SET, C) do { const unsigned char* gf_ = gfc + (size_t)(C) * GF_ITEM; \
            _Pragma("unroll") for (int s = 0; s < 8; ++s) qd[SET][s] = *(const u32x4*)(gf_ + GF_QD + (size_t)((ib * 8 + s) * 64 + lane) * 16); \
            _Pragma("unroll") for (int s = 0; s < 4; ++s) qk[SET][s] = *(const u32x4*)(gf_ + GF_QK + (size_t)((ib * 4 + s) * 64 + lane) * 16); } while (0)
#define ST_B(SET, C) do { const LAS unsigned char* sb_ = lds + ((C) & 1) * SBS; f32x16 acc_; \
            _Pragma("unroll") for (int q = 0; q < 16; ++q) acc_[q] = 0.f; \
            _Pragma("unroll") for (int s = 0; s < 8; ++s) { const bf16x8 sf_ = *(const LAS bf16x8*)(sb_ + r * 272 + 32 * s + 16 * h); \
                acc_ = __builtin_amdgcn_mfma_f32_32x32x16_bf16(__builtin_bit_cast(bf16x8, qd[SET][s]), sf_, acc_, 0, 0, 0); } \
            LDS_BAR(); \
            _Pragma("unroll") for (int s = 0; s < 4; ++s) { const bf16x8 uf_ = *(const LAS bf16x8*)(lds + UFO + (s * 64 + lane) * 16); \
                acc_ = __builtin_amdgcn_mfma_f32_32x32x16_bf16(__builtin_bit_cast(bf16x8, qk[SET][s]), uf_, acc_, 0, 0, 0); } \
            const unsigned ob_ = (unsigned)(((b * TB + chunk_s0(dir, (C)) + (dir ? 63 - ot0 : ot0)) * 512 + r) * 4); \
            _Pragma("unroll") for (int q = 0; q < 16; ++q) { *(float*)(OGu + (ob_ + (unsigned)(((q & 3) + 8 * (q >> 2)) * ostep))) = acc_[q]; } \
            LDS_BAR(); } while (0)
        LD_B(0, 0); LD_B(1, 1);
        for (int c = 0; c < NCHUNK; c += 3) { LD_B(2, c + 2); ST_B(0, c); LD_B(0, min(c + 3, NCHUNK - 1)); ST_B(1, c + 1); LD_B(1, min(c + 4, NCHUNK - 1)); ST_B(2, c + 2); }
#undef LD_B
#undef ST_B
    } else {
        const int db = wid - 4;
        u32x4 ke[3][4]; float ee[3];
        f32x16 sacc;
#pragma unroll
        for (int q = 0; q < 16; ++q) sacc[q] = 0.f;
#define LD_C(SET, C) do { const unsigned char* gf_ = gfc + (size_t)(C) * GF_ITEM; \
            _Pragma("unroll") for (int s = 0; s < 4; ++s) ke[SET][s] = *(const u32x4*)(gf_ + GF_KE + (size_t)((db * 4 + s) * 64 + lane) * 16); ee[SET] = *(const float*)(gf_ + GF_EE); } while (0)
#define ST_C(SET, C) do { LAS unsigned char* sn_ = lds + (((C) & 1) ^ 1) * SBS; \
            _Pragma("unroll") for (int q = 0; q < 16; ++q) sacc[q] *= ee[SET]; \
            LDS_BAR(); \
            _Pragma("unroll") for (int s = 0; s < 4; ++s) { const bf16x8 uf_ = *(const LAS bf16x8*)(lds + UFO + (s * 64 + lane) * 16); \
                sacc = __builtin_amdgcn_mfma_f32_32x32x16_bf16(__builtin_bit_cast(bf16x8, ke[SET][s]), uf_, sacc, 0, 0, 0); } \
            _Pragma("unroll") for (int g4 = 0; g4 < 4; ++g4) *(LAS u32x2*)(sn_ + r * 272 + 2 * (32 * db + 8 * g4 + 4 * h)) = (u32x2){cvtpk(sacc[4 * g4], sacc[4 * g4 + 1]), cvtpk(sacc[4 * g4 + 2], sacc[4 * g4 + 3])}; \
            LDS_BAR(); } while (0)
        LD_C(0, 0); LD_C(1, 1);
        for (int c = 0; c < NCHUNK; c += 3) { LD_C(2, c + 2); ST_C(0, c); LD_C(0, min(c + 3, NCHUNK - 1)); ST_C(1, c + 1); LD_C(1, min(c + 4, NCHUNK - 1)); ST_C(2, c + 2); }
#undef LD_C
#undef ST_C
    }
}

__device__ __forceinline__ void phase_scan(const PView& p, int l, LAS unsigned char* lds, int bid, int G) {
    for (int wi = bid; wi < 256; wi += G) {
        const int x = wi & 7, k = wi >> 3, item = ((k >> 4) << 7) + x * 16 + (k & 15);
        const int it = item & 127, chain = it >> 2, vq = it & 3;
        if (item < 128) { for (int rp = 0; rp < NREP(53); ++rp) { gdn_seq_item(p, lds, chain, vq); __syncthreads(); } }
        else { for (int rp = 0; rp < NREP(54); ++rp) { mlstm_chunk_item(p, lds, chain, vq); __syncthreads(); } }
        __syncthreads();
    }
}

__device__ __forceinline__ void phase_scanout(const PView& p, int l, int bid, int G) {
    const int tid = ltid(), wid = __builtin_amdgcn_readfirstlane(tid >> 6), lane = tid & 63;
    unsigned char* ws = p.ws;
    const bf16* P = (const bf16*)(ws + OFF_R1); const bf16* Y = (const bf16*)(ws + OFF_Y);
    signed char* Y8 = (signed char*)(ws + OFF_Y8); float* SY = (float*)(ws + OFF_SY);
    const float* OG = (const float*)(ws + OFF_OGD); const float* OM = (const float*)(ws + OFF_OML);
    for (int tp = bid * NWAVES + wid; tp < T / 2; tp += G * NWAVES) {
        f32x4 oa[2][2][2], ob[2][2][2]; u32x4 gw[2][2], ya[2][2];
#pragma unroll
        for (int u = 0; u < 2; ++u)
#pragma unroll
            for (int which = 0; which < 2; ++which) { const int tk = 2 * tp + u;
                const float* o0 = (which ? OM : OG) + (size_t)tk * 512 + 8 * lane; const float* o1 = o0 + (size_t)T * 512;
                oa[u][which][0] = *(const f32x4*)o0; oa[u][which][1] = *(const f32x4*)(o0 + 4); ob[u][which][0] = *(const f32x4*)o1; ob[u][which][1] = *(const f32x4*)(o1 + 4);
                gw[u][which] = *(const u32x4*)(P + (size_t)tk * LDP + (which ? PC_LO : PC_GG) + 8 * lane);
                ya[u][which] = *(const u32x4*)(Y + (size_t)tk * 2048 + which * 1024 + 8 * lane); }
#pragma unroll
        for (int u = 0; u < 2; ++u)
#pragma unroll
            for (int br = 0; br < 4; ++br) { const int tk = 2 * tp + u, which = br >> 1;
                float y[8];
                if (br & 1) {
                    float x[8]; { const f32x4 a0 = oa[u][which][0], a1 = oa[u][which][1], b0 = ob[u][which][0], b1 = ob[u][which][1];
                        x[0] = a0.x + b0.x; x[1] = a0.y + b0.y; x[2] = a0.z + b0.z; x[3] = a0.w + b0.w; x[4] = a1.x + b1.x; x[5] = a1.y + b1.y; x[6] = a1.z + b1.z; x[7] = a1.w + b1.w; }
                    float ss = 0.f;
#pragma unroll
                    for (int i = 0; i < 8; ++i) ss += x[i] * x[i];
                    ss = row16_sum(ss);
                    const float rs = __builtin_amdgcn_rsqf(ss * (1.f / 128.f) + 1e-6f);
                    const float* ng = (which ? p.in[I_MLG] : p.in[I_GNG]) + l * 128 + 8 * (lane & 15);
                    float gt[8]; unpack8(gw[u][which], gt);
#pragma unroll
                    for (int i = 0; i < 8; ++i) { const float sg = fsigmoid(gt[i]); y[i] = x[i] * rs * ng[i] * (which ? sg : gt[i] * sg); }
                } else unpack8(ya[u][which], y);
                float am = 0.f;
#pragma unroll
                for (int i = 0; i < 8; ++i) am = fmaxf(am, fabsf(y[i]));
                const float amax = wave_max(am), inv = amax > 0.f ? 127.0f / amax : 0.f;
                if (lane == 0) SY[tk * 4 + br] = amax * (1.0f / 127.0f);
                *(u32x2*)(Y8 + (size_t)tk * 2048 + br * 512 + 8 * lane) = (u32x2){q8x4((f32x4){y[0], y[1], y[2], y[3]} * inv), q8x4((f32x4){y[4], y[5], y[6], y[7]} * inv)}; }
    }
}

constexpr int NPH_L = 14, PH_L0 = 1, PH_FINAL = PH_L0 + DEPTH * NPH_L, NPHASES = PH_FINAL + 1;
__global__ void __launch_bounds__(NTHR, 2) fwd_kernel(Params kp) {
    extern __shared__ __attribute__((aligned(16))) unsigned char lds_raw[];
    LAS unsigned char* lds = (LAS unsigned char*)lds_raw;
    volatile LAS unsigned* MISC = (volatile LAS unsigned*)(lds + MISC_OFF);
    const int tid = threadIdx.x;
    for (int u = tid; u < (LDS_BYTES - MISC_OFF) / 4; u += NTHR) ((LAS unsigned*)(lds + MISC_OFF))[u] = 0u;
    __syncthreads();
    const int lo = kp.ph_lo, hi = kp.ph_hi;
    XcdBarrier bar; bar.bar = (unsigned*)(kp.ws + OFF_CTL) + CW_BAR; bar.x = 0; bar.st = MISC + 8;
    if (hi - lo > 1) bar = xcd_barrier_post((unsigned*)(kp.ws + OFF_CTL) + CW_BAR, MISC + 8);
#define IN(k) (lo <= (k) && (k) < hi)
#define SEAM(k) do { if ((k) + 1 < hi) xcd_barrier(bar); } while (0)

    if (IN(0)) { const PView p = pview(); phase_prologue(p, lds, p.bid, p.G); SEAM(0); }
    for (int l = 0; l < DEPTH; ++l) {
        const int pb = PH_L0 + l * NPH_L;
        if (IN(pb + 0)) { const PView p = pview(); if (NREP(60) == 2) { phase_norm1<0>(p, l, p.bid, p.G, true); __syncthreads(); } phase_norm1<0>(p, l, p.bid, p.G); SEAM(pb + 0); }
        if (IN(pb + 1)) {
            const PView p = pview(); unsigned char* ws = p.ws;
            ProbPlain pr{(const char*)(ws + OFF_H), (const char*)(ws + OFF_WIN) + (size_t)l * NIN * 1024, 1024u, 1024u, 8};
            pg8::Order S; S.init(T / 256, NIN / 256, p.G, p.bid);
            EpiIn8 E{(bf16*)(ws + OFF_R1), (bf16*)(ws + OFF_R2), (float*)(ws + OFF_GATES), p.in[I_BMG] + (size_t)l * NGATE, (const float*)(ws + OFF_SH), (const float*)(ws + OFF_CMIN) + (size_t)l * NIN};
            for (int rp = 0; rp < NREP(1); ++rp) pg8::gemm_phase(lds, pr, S, E); SEAM(pb + 1); }
        if (IN(pb + 2)) { const PView p = pview(); if (NREP(2) == 2) { phase_prep(p, l, lds, p.bid, p.G); __syncthreads(); } phase_prep(p, l, lds, p.bid, p.G); SEAM(pb + 2); }
        if (IN(pb + 3)) {
            const PView p = pview(); unsigned char* ws = p.ws;
            ProbPlain pr{(const char*)(ws + OFF_AQ), (const char*)(ws + OFF_WUQKV) + (size_t)l * 1792 * 384 * 2, 768u, 768u, 6};
            pg8::Order S; S.init(T / 256, 7, p.G, p.bid);
            EpiStore E{(bf16*)(ws + OFF_QKVR), 1792, nullptr, 0};
            for (int rp = 0; rp < NREP(3); ++rp) pg8::gemm_phase(lds, pr, S, E); SEAM(pb + 3); }
        if (IN(pb + 4)) { const PView p = pview(); if (NREP(62) == 2) { phase_mlapost(p, l, lds, p.bid, p.G, true); __syncthreads(); } phase_mlapost(p, l, lds, p.bid, p.G); SEAM(pb + 4); }
        if (IN(pb + 5)) { for (int rp = 0; rp < NREP(50); ++rp) { const PView p = pview(); phase_attn(p, l, lds, p.bid, p.G); __syncthreads(); }
                          for (int rp = 0; rp < NREP(52); ++rp) { const PView p = pview(); phase_gdnpre(p, l, lds, p.bid, p.G); __syncthreads(); } SEAM(pb + 5); }
        if (IN(pb + 6)) { for (int rp = 0; rp < NREP(51); ++rp) { const PView p = pview(); phase_scan(p, l, lds, p.bid, p.G); __syncthreads(); } SEAM(pb + 6); }
        if (IN(pb + 7)) { const PView p = pview(); for (int rp = 0; rp < NREP(6); ++rp) phase_scanout(p, l, p.bid, p.G); SEAM(pb + 7); }
        if (IN(pb + 8)) {
            const PView p = pview(); unsigned char* ws = p.ws;
            ProbBO pr{(const char*)(ws + OFF_Y8), (const char*)(ws + OFF_WBO) + (size_t)l * 4096 * 512, 2048u, 512u, 4};
            pg8::Order S; if (l == DEPTH - 1) S.init(NB * SEQ / 256, 4, p.G, p.bid, 4, 1); else S.init(T / 256, 4, p.G, p.bid, 4);
            EpiBO E{(bf16*)(ws + OFF_R3), (const bf16*)(ws + OFF_R2), (const float*)(ws + OFF_SY), (const float*)(ws + OFF_CMBO) + (size_t)l * 4096};
            for (int rp = 0; rp < NREP(7); ++rp) pg8::gemm_phase(lds, pr, S, E); SEAM(pb + 8); }
        if (IN(pb + 9)) {
            const PView p = pview(); unsigned char* ws = p.ws;
            ProbPlain pr{(const char*)(ws + OFF_R3), (const char*)(ws + OFF_WOUT4) + (size_t)l * 1024 * 4096 * 2, 2048u, 8192u, 16};
            pg8::Order S; if (l == DEPTH - 1) S.init(NB * SEQ / 256, 4, p.G, p.bid, 1, 1); else S.init(T / 256, 4, p.G, p.bid);
            EpiOut E{(float*)(ws + OFF_X), (const float*)(ws + OFF_MOD) + (size_t)l * 5 * 6144};
            pg8::gemm_phase(lds, pr, S, E); SEAM(pb + 9); }
        if (IN(pb + 10)) { const PView p = pview(); if (NREP(61) == 2) { phase_router(p, l, lds, p.bid, p.G, true); __syncthreads(); } phase_router(p, l, lds, p.bid, p.G); SEAM(pb + 10); }
        if (IN(pb + 11)) { const PView p = pview(); for (int rp = 0; rp < NREP(10); ++rp) { phase_gather(p, l, lds, p.bid, p.G); __syncthreads(); } SEAM(pb + 11); }
        if (IN(pb + 12)) {
            const PView p = pview(); unsigned char* ws = p.ws; const int* tst = (const int*)(ws + OFF_CTL) + CW_TST + l * 64;
            ProbMoE pr{(const char*)(ws + OFF_R1), (const char*)(ws + OFF_WGU) + (size_t)l * 32 * 2048 * 1024, 1024u, 1024u, 8, tst, (size_t)2048 * 1024};
            pg8::Order S; S.init(tst[32], 8, p.G, p.bid);
            EpiMoE18 E{(bf16*)(ws + OFF_R2), p.in[I_BGU] + (size_t)l * 32 * 2048, (const float*)(ws + OFF_SX), (const float*)(ws + OFF_CMGU) + (size_t)l * 32 * 2048};
            for (int rp = 0; rp < NREP(11); ++rp) pg8::gemm_phase(lds, pr, S, E); SEAM(pb + 12); }
        if (IN(pb + 13)) {
            const PView p = pview(); unsigned char* ws = p.ws; const int* tst = (const int*)(ws + OFF_CTL) + CW_TST + l * 64;
            ProbMoE pr{(const char*)(ws + OFF_R2), (const char*)(ws + OFF_WDN) + (size_t)l * 32 * 1024 * 1024, 1024u, 1024u, 8, tst, (size_t)1024 * 1024};
            pg8::Order S; S.init(tst[32], 4, p.G, p.bid);
            EpiStoreF8 E{(bf16*)(ws + OFF_R3), 1024, p.in[I_BDN] + (size_t)l * 32 * 1024, 1024};
            for (int rp = 0; rp < NREP(12); ++rp) pg8::gemm_phase(lds, pr, S, E); SEAM(pb + 13); }
    }
    if (IN(PH_FINAL)) { const PView p = pview(); phase_norm1<2>(p, DEPTH, p.bid, p.G); }
#undef IN
#undef SEAM
}

extern "C" void kernel_launch(void* const* d_in, const int* in_sizes, int n_in, void* d_out, int out_size, void* d_ws, size_t ws_size, hipStream_t stream) {
    static int grid = 0;
    if (!grid) {
        if (n_in != 31 || ws_size < WS_END) { fprintf(stderr, "kernel_launch: expected 31 inputs and >= %zu bytes of workspace (got %d, %zu)\n", (size_t)WS_END, n_in, ws_size); grid = -1; return; }
        int dev = 0, cus = 0, per_cu = 0;
        hipGetDevice(&dev); hipDeviceGetAttribute(&cus, hipDeviceAttributeMultiprocessorCount, dev);
        hipFuncSetAttribute((const void*)fwd_kernel, hipFuncAttributeMaxDynamicSharedMemorySize, LDS_BYTES);
        hipOccupancyMaxActiveBlocksPerMultiprocessor(&per_cu, (const void*)fwd_kernel, NTHR, LDS_BYTES);
        if (per_cu < 1) fprintf(stderr, "kernel_launch: occupancy query reports %d blocks per CU\n", per_cu);
        grid = cus;
    }
    if (grid < 0) return;
    hipMemsetAsync((char*)d_ws + OFF_CTL, 0, CTL_BYTES, stream);
    Params p{};
    for (int i = 0; i < 31; ++i) p.in[i] = (const float*)d_in[i];
    p.out = (float*)d_out; p.ws = (unsigned char*)d_ws;
#if MK_N_LAUNCHES == 1
    p.ph_lo = 0; p.ph_hi = NPHASES;
    hipLaunchKernelGGL(fwd_kernel, dim3(grid), dim3(NTHR), LDS_BYTES, stream, p);
#else
    for (int ph = 0; ph < NPHASES; ++ph) { p.ph_lo = ph; p.ph_hi = ph + 1; hipLaunchKernelGGL(fwd_kernel, dim3(grid), dim3(NTHR), LDS_BYTES, stream, p); }
#endif
}
```

```cpp
#include <hip/hip_runtime.h>
#include <cstdio>
#include <cstdint>

#ifndef MK_N_LAUNCHES
#define MK_N_LAUNCHES 1
#endif

#ifndef PROBE_DUP
#define PROBE_DUP -1
#endif
#define NREP(k) ((PROBE_DUP == (k)) ? 2 : 1)
#define GAS __attribute__((address_space(1)))
#define LAS __attribute__((address_space(3)))
typedef unsigned short bf16;
typedef short bf16x8 __attribute__((ext_vector_type(8)));
typedef short s16x4 __attribute__((ext_vector_type(4)));
typedef float f32x4 __attribute__((ext_vector_type(4)));
typedef float f32x2 __attribute__((ext_vector_type(2)));
typedef float f32x16 __attribute__((ext_vector_type(16)));
typedef unsigned u32x4 __attribute__((ext_vector_type(4)));
typedef unsigned u32x2 __attribute__((ext_vector_type(2)));
typedef int i32x4 __attribute__((ext_vector_type(4)));
typedef int i32x8 __attribute__((ext_vector_type(8)));
typedef __bf16 bf16x2_t __attribute__((ext_vector_type(2)));

constexpr int D = 1024, NB = 4, SEQ = 8192, CTX = 256, TB = SEQ + CTX, T = NB * TB, DEPTH = 4;
constexpr int DIN = 5568, LDP = 5632, NGATE = 4096, NIN = LDP + NGATE;
constexpr int NE = 32, TOPK = 4, DFF = 1024;
constexpr int NSLOT = 143360;
constexpr int NWAVES = 8, NTHR = 512;
constexpr int PC_NAQ = 0, PC_NAK = 512, PC_NAV = 1024, PC_GQKV = 1536, PC_GG = 3072, PC_MQ = 3600, PC_MKV = 3856, PC_MKPE = 3984,
              PC_LQ = 4016, PC_LK = 4272, PC_LV = 4528, PC_LO = 5040;

constexpr size_t MiB = (size_t)1 << 20;
constexpr size_t OFF_CTL = 0, CTL_BYTES = 1 * MiB;
constexpr size_t OFF_MOD = 1 * MiB;
constexpr size_t OFF_X = 2 * MiB;
constexpr size_t OFF_H = 134 * MiB;
constexpr size_t OFF_SH = OFF_H + 40 * MiB;
constexpr size_t OFF_SX = 200 * MiB + 300 * MiB;
constexpr size_t OFF_R1 = 200 * MiB;
constexpr size_t OFF_R2 = 563 * MiB;
constexpr size_t OFF_R3 = 843 * MiB;
constexpr size_t OFF_GQKV = 1123 * MiB;
constexpr size_t OFF_GATES = 1222 * MiB;
constexpr size_t OFF_GDNG = 1227 * MiB;
constexpr size_t OFF_MLG = 1230 * MiB;
constexpr size_t OFF_AQ = 1233 * MiB;
constexpr size_t OFF_QKVR = 1258 * MiB;
constexpr size_t OFF_KM = 1374 * MiB;
constexpr size_t OFF_VTM = 1424 * MiB;
constexpr size_t OFF_VTN = 1457 * MiB;
constexpr size_t OFF_OGD = 1490 * MiB;
constexpr size_t OFF_OML = 1622 * MiB;
constexpr size_t OFF_Y = 1754 * MiB;
constexpr size_t OFF_TOPW = 1886 * MiB;
constexpr size_t OFF_TOPE = OFF_TOPW + 768 * 1024;
constexpr size_t OFF_POS = OFF_TOPE + 768 * 1024;
constexpr size_t OFF_SLOT = OFF_POS + 768 * 1024;
constexpr size_t OFF_WIN = 1889 * MiB;
constexpr size_t OFF_CMIN = OFF_WIN + 40 * MiB;
constexpr size_t OFF_WUQKV = 1965 * MiB;
constexpr size_t OFF_WBO = 1971 * MiB;
constexpr size_t OFF_CMBO = OFF_WBO + 10 * MiB;
constexpr size_t OFF_WOUT4 = 1987 * MiB;
constexpr size_t OFF_WGU = 2019 * MiB;
constexpr size_t OFF_CMGU = OFF_WGU + 260 * MiB;
constexpr size_t OFF_WDN = 2531 * MiB;
constexpr size_t OFF_GC = 2787 * MiB;
constexpr size_t OFF_MC = 2791 * MiB;
constexpr size_t OFF_GF = 2794 * MiB;
constexpr size_t OFF_Y8 = 3200 * MiB;
constexpr size_t OFF_SY = 3270 * MiB;
constexpr size_t OFF_QM8 = 3272 * MiB;
constexpr size_t WS_END = 3306 * MiB;
constexpr int CW_BAR = 4096, CW_CNT = 8192  , CW_TST = 8448  ;

constexpr int RING_BYTES = 131072, MISC_OFF = RING_BYTES, LDS_BYTES = 147456;

__device__ __forceinline__ unsigned cvtpk(float lo, float hi) { f32x2 v = {lo, hi}; bf16x2_t b = __builtin_convertvector(v, bf16x2_t); return __builtin_bit_cast(unsigned, b); }
__device__ __forceinline__ float bflo(unsigned w) { return __uint_as_float(w << 16); }
__device__ __forceinline__ float bfhi(unsigned w) { return __uint_as_float(w & 0xffff0000u); }
__device__ __forceinline__ float bf2f(bf16 b) { return __uint_as_float(((unsigned)b) << 16); }
__device__ __forceinline__ float fexp2(float x) { return __builtin_amdgcn_exp2f(x); }
__device__ __forceinline__ float fexp(float x) { return __builtin_amdgcn_exp2f(x * 1.4426950408889634f); }
__device__ __forceinline__ float frcp(float x) { return __builtin_amdgcn_rcpf(x); }
__device__ __forceinline__ float fsigmoid(float x) { return frcp(1.0f + fexp(-x)); }
__device__ __forceinline__ float wave_sum(float v) {
#pragma unroll
    for (int o = 1; o < 64; o <<= 1) v += __shfl_xor(v, o);
    return v;
}
#define LDS_BAR() do { asm volatile("s_waitcnt lgkmcnt(0)" ::: "memory"); __builtin_amdgcn_s_barrier(); asm volatile("" ::: "memory"); } while (0)
__device__ __forceinline__ int ltid() { int t = threadIdx.x; asm volatile("" : "+v"(t)); return t; }
__device__ __forceinline__ float wave_max(float v) {
#pragma unroll
    for (int o = 1; o < 64; o <<= 1) v = fmaxf(v, __shfl_xor(v, o));
    return v;
}
__device__ __forceinline__ unsigned q8x4(const f32x4 x) {
    const int a = (int)__builtin_rintf(x.x), b = (int)__builtin_rintf(x.y), c = (int)__builtin_rintf(x.z), d = (int)__builtin_rintf(x.w);
    return ((unsigned)a & 0xffu) | (((unsigned)b & 0xffu) << 8) | (((unsigned)c & 0xffu) << 16) | (((unsigned)d & 0xffu) << 24);
}
template <int CTRL> __device__ __forceinline__ float dppf(float v) { return __int_as_float(__builtin_amdgcn_update_dpp(0, __float_as_int(v), CTRL, 0xf, 0xf, true)); }
__device__ __forceinline__ float row16_sum(float v) { v += dppf<0xB1>(v); v += dppf<0x4E>(v); v += dppf<0x141>(v); v += dppf<0x140>(v); return v; }
__device__ __forceinline__ void unpack8(const u32x4 w, float (&f)[8]) { f[0] = bflo(w.x); f[1] = bfhi(w.x); f[2] = bflo(w.y); f[3] = bfhi(w.y); f[4] = bflo(w.z); f[5] = bfhi(w.z); f[6] = bflo(w.w); f[7] = bfhi(w.w); }
__device__ __forceinline__ u32x4 pack8(const float (&f)[8]) { u32x4 w; w.x = cvtpk(f[0], f[1]); w.y = cvtpk(f[2], f[3]); w.z = cvtpk(f[4], f[5]); w.w = cvtpk(f[6], f[7]); return w; }

#define XB_TMO      128
#define XB_XCNT(j)  (256  + 64 * (j))
#define XB_XSUB(j)  (1280 + 64 * (j))
#define XB_XGEN(j)  (2304 + 64 * (j))
#define XB_TOP      3328
#define XB_TOPGEN   3392
#define XCD_BAR_WORDS 3456
#define XB_SPIN_CAP (1u << 25)
__device__ __forceinline__ unsigned xb_ld(unsigned* p)              { return __hip_atomic_load(p, __ATOMIC_RELAXED, __HIP_MEMORY_SCOPE_AGENT); }
__device__ __forceinline__ unsigned xb_add(unsigned* p, unsigned v) { return __hip_atomic_fetch_add(p, v, __ATOMIC_RELAXED, __HIP_MEMORY_SCOPE_AGENT); }
__device__ __forceinline__ unsigned xb_xcc_id() { return (unsigned)__builtin_amdgcn_s_getreg((3 << 11) | 20) & 0xFu; }
#define XB_SPIN(cond, bar) do { unsigned _sp = 0; while (cond) { __builtin_amdgcn_s_sleep(1); \
    if ((++_sp & 255u) == 0u) { if (xb_ld(&(bar)[XB_TMO])) break; if (_sp > XB_SPIN_CAP) { atomicAdd(&(bar)[XB_TMO], 1u); break; } } } } while (0)
struct XcdBarrier { unsigned* bar; unsigned x; volatile LAS unsigned* st; };
__device__ __forceinline__ XcdBarrier xcd_barrier_post(unsigned* bar, volatile LAS unsigned* st) {
    XcdBarrier b; b.bar = bar; b.x = xb_xcc_id(); b.st = st;
    if (threadIdx.x == 0) (void)xb_add(&bar[XB_XCNT(b.x)], 1u);
    return b;
}
__device__ __forceinline__ void xcd_barrier_complete(unsigned* bar, unsigned x, unsigned& nloc, unsigned& nx) {
    const unsigned G = gridDim.x * gridDim.y * gridDim.z;
    unsigned sum, cnt, mine, sp = 0u;
    for (;;) {
        sum = 0u; cnt = 0u; mine = 0u;
#pragma unroll
        for (unsigned j = 0; j < 16; ++j) { const unsigned c = xb_ld(&bar[XB_XCNT(j)]); sum += c; cnt += (c > 0u) ? 1u : 0u; mine = (j == x) ? c : mine; }
        if (sum == G) break;
        __builtin_amdgcn_s_sleep(1);
        if ((++sp & 255u) == 0u) { if (xb_ld(&bar[XB_TMO])) break; if (sp > XB_SPIN_CAP) { atomicAdd(&bar[XB_TMO], 1u); break; } }
    }
    nloc = mine > 0u ? mine : 1u; nx = cnt > 0u ? cnt : 1u;
}
__device__ __forceinline__ void xcd_barrier(const XcdBarrier& b) {
    asm volatile("s_waitcnt vmcnt(0)" ::: "memory");
    __syncthreads();
    if (threadIdx.x == 0) {
        unsigned* bar = b.bar;
        __builtin_amdgcn_s_waitcnt(0);
        unsigned nloc = b.st[0], nx = b.st[1];
        if (nloc == 0u) { xcd_barrier_complete(bar, b.x, nloc, nx); b.st[0] = nloc; b.st[1] = nx; }
        const unsigned old = xb_add(&bar[XB_XSUB(b.x)], 1u);
        const unsigned gen = old / nloc;
        if (old + 1u == (gen + 1u) * nloc) {
            __builtin_amdgcn_fence(__ATOMIC_RELEASE, "agent");
            asm volatile("s_waitcnt vmcnt(0)" ::: "memory");
            const unsigned og = xb_add(&bar[XB_TOP], 1u);
            const unsigned tg = og / nx;
            if (og + 1u == (tg + 1u) * nx) xb_add(&bar[XB_TOPGEN], 1u);
            else XB_SPIN(xb_ld(&bar[XB_TOPGEN]) == tg, bar);
            __builtin_amdgcn_fence(__ATOMIC_ACQUIRE, "agent");
            xb_add(&bar[XB_XGEN(b.x)], 1u);
            asm volatile("s_waitcnt vmcnt(0)" ::: "memory");
        } else {
            XB_SPIN(xb_ld(&bar[XB_XGEN(b.x)]) == gen, bar);
            __builtin_amdgcn_fence(__ATOMIC_ACQUIRE, "agent");
            asm volatile("s_waitcnt vmcnt(0)" ::: "memory");
        }
    }
    __syncthreads();
}

namespace pg8 {
constexpr int BM = 256, BK = 64, HALF = 128, HTB = HALF * BK * 2, STAGE_BYTES = 8 * HTB, NXCD = 8, WGM = 8;
__device__ __forceinline__ int lds_byte(int r, int c) { const int st = (r >> 4) * 2 + (c >> 5), rr = r & 15, cc = c & 31, ob = rr * 64 + cc * 2; return st * 1024 + (ob ^ (((ob >> 9) & 1) << 5)); }
__device__ __forceinline__ void stage_rc(int b, int& R, int& C) { const int st = b / 1024, sb = b % 1024, swz = sb ^ (((sb >> 9) & 1) << 5); R = (st >> 1) * 16 + swz / 64; C = (st & 1) * 32 + (swz % 64) / 2; }
__device__ __forceinline__ int perm32(int rho) { const int n = rho >> 4, i = rho & 15; return 8 * (i >> 2) + 4 * n + (i & 3); }
struct Unit { int pm, pn, aux; };
struct Order {
    int nM, nN, nwg, G, c, br, skipctx;
    __device__ void init(int nM_, int nN_, int G_, int c_, int br_ = 1, int skipctx_ = 0) { nM = nM_; nN = nN_; nwg = nM * nN; G = G_; c = c_; br = br_; skipctx = skipctx_; }
    __device__ bool next(int i, Unit& u) const {
        const int it = i / br, ia = i - it * br;
        const long L = (long)it * G + c; if (L >= nwg) return false;
        int wgid = (int)L; { const int q = nwg / NXCD, r = nwg % NXCD, xcd = wgid % NXCD, off = wgid / NXCD; wgid = (xcd < r ? xcd * (q + 1) : r * (q + 1) + (xcd - r) * q) + off; }
        const int nig = WGM * nN, gid = wgid / nig, fm = gid * WGM, gsz = (nM - fm) < WGM ? (nM - fm) : WGM;
        u.pm = fm + ((wgid % nig) % gsz); u.pn = (wgid % nig) / gsz + ia * nN; u.aux = ia;
        if (skipctx) u.pm += (u.pm >> 5) + 1;
        return true;
    }
};
template <class Prob, class Epi>
__device__ __forceinline__ void gemm_phase(LAS unsigned char* lds, const Prob& P, const Order& S, const Epi& E) {
    const int tid = ltid(), wid = __builtin_amdgcn_readfirstlane(tid >> 6), lane = tid & 63, wr = wid >> 2, wc = wid & 3, fr = lane & 15, fq = lane >> 4;
    const int nt = P.nt;
    unsigned voffA[2], voffB[2];
#pragma unroll
    for (int i = 0; i < 2; ++i) { int R, C; stage_rc(tid * 16 + i * 8192, R, C); const int Rb = Epi::PERM ? ((R & ~31) + perm32(R & 31)) : R;
        voffA[i] = (unsigned)R * P.lda + (unsigned)C * 2u; voffB[i] = (unsigned)Rb * P.ldb + (unsigned)C * 2u; }
    const size_t kstep = (size_t)(BK * 2);
    const size_t hA = (size_t)HALF * P.lda, hB = (size_t)HALF * P.ldb;
    const unsigned ldsw = (unsigned)wid * 1024u;
    const int aoff = lds_byte(wr * 64 + fr, fq * 8), boff = lds_byte(wc * 32 + fr, fq * 8);
#define PG8_SA(b, h) (((b) * 2 + (h)) * HTB)
#define PG8_SB(b, h) ((4 + (b) * 2 + (h)) * HTB)
#define PG8_STAGE(bufoff, gbase, voff) do { _Pragma("unroll") for (int _i = 0; _i < 2; ++_i) \
        __builtin_amdgcn_global_load_lds((const unsigned*)((const char*)(gbase) + (voff)[_i]), (LAS unsigned*)(lds + (bufoff) + ldsw + _i * 8192), 16, 0, 0); } while (0)
#define PG8_LDA(dst, b, h) do { _Pragma("unroll") for (int m = 0; m < 4; ++m) { \
        if constexpr (Epi::F8) { const i32x4 lo_ = *(const LAS i32x4*)(lds + PG8_SA(b, h) + aoff + m * 2048), hi_ = *(const LAS i32x4*)(lds + PG8_SA(b, h) + aoff + m * 2048 + 1024); \
            dst##8[m] = __builtin_shufflevector(lo_, hi_, 0, 1, 2, 3, 4, 5, 6, 7); } \
        else { _Pragma("unroll") for (int k = 0; k < 2; ++k) dst[m][k] = *(const LAS bf16x8*)(lds + PG8_SA(b, h) + aoff + m * 2048 + k * 1024); } } } while (0)
#define PG8_LDB(dst, b, h) do { _Pragma("unroll") for (int n = 0; n < 2; ++n) { \
        if constexpr (Epi::F8) { const i32x4 lo_ = *(const LAS i32x4*)(lds + PG8_SB(b, h) + boff + n * 2048), hi_ = *(const LAS i32x4*)(lds + PG8_SB(b, h) + boff + n * 2048 + 1024); \
            dst##8[n] = __builtin_shufflevector(lo_, hi_, 0, 1, 2, 3, 4, 5, 6, 7); } \
        else { _Pragma("unroll") for (int k = 0; k < 2; ++k) dst[n][k] = *(const LAS bf16x8*)(lds + PG8_SB(b, h) + boff + n * 2048 + k * 1024); } } } while (0)
#define PG8_MMA(ai, bj, At, Bt) do { __builtin_amdgcn_s_setprio(1); _Pragma("unroll") for (int m = 0; m < 4; ++m) _Pragma("unroll") for (int n = 0; n < 2; ++n) { \
        if constexpr (Epi::F8) asm volatile("v_mfma_scale_f32_16x16x128_f8f6f4 %0, %1, %2, %0, %3, %3 op_sel_hi:[0,0,0]" : "+v"(acc[ai][bj][m][n]) : "v"(Bt##8[n]), "v"(At##8[m]), "v"(f8scale));   \
        else { _Pragma("unroll") for (int k = 0; k < 2; ++k) { \
        if constexpr (Epi::I8) acc[ai][bj][m][n] = __builtin_bit_cast(f32x4, __builtin_amdgcn_mfma_i32_16x16x64_i8(__builtin_bit_cast(i32x4, Bt[n][k]), __builtin_bit_cast(i32x4, At[m][k]), __builtin_bit_cast(i32x4, acc[ai][bj][m][n]), 0, 0, 0)); \
        else acc[ai][bj][m][n] = __builtin_amdgcn_mfma_f32_16x16x32_bf16(Bt[n][k], At[m][k], acc[ai][bj][m][n], 0, 0, 0); } } } __builtin_amdgcn_s_setprio(0); } while (0)
#define PG8_WAIT_V(n) asm volatile("s_waitcnt vmcnt(" #n ")" ::: "memory")
#define PG8_WAIT_L(n) asm volatile("s_waitcnt lgkmcnt(" #n ")" ::: "memory")
#define PG8_BAR __builtin_amdgcn_s_barrier()
#define PG8_SCHED __builtin_amdgcn_sched_barrier(0)
    Unit cur, nxt; int ui = 0;
    if (!S.next(0, cur)) return;
    f32x4 acc[2][2][4][2];
#pragma unroll
    for (int a = 0; a < 2; ++a)
#pragma unroll
        for (int b = 0; b < 2; ++b)
#pragma unroll
            for (int m = 0; m < 4; ++m)
#pragma unroll
                for (int n = 0; n < 2; ++n) acc[a][b][m][n] = (f32x4){0.f, 0.f, 0.f, 0.f};
    bf16x8 At[4][2], B0[2][2], B1[2][2];
    const int f8scale = 0x7f7f7f7f;
    i32x8 At8[4], B08[2], B18[2];
    const char* cA; const char* cB; P.setup(cur, cA, cB);
    PG8_STAGE(PG8_SB(0, 0), cB, voffB); PG8_STAGE(PG8_SB(0, 1), cB + hB, voffB); PG8_STAGE(PG8_SA(0, 0), cA, voffA); PG8_STAGE(PG8_SA(0, 1), cA + hA, voffA);
    if (wr == 1) PG8_BAR;
    PG8_WAIT_V(2); PG8_BAR;
    PG8_STAGE(PG8_SB(1, 0), cB + kstep, voffB); PG8_STAGE(PG8_SA(1, 0), cA + kstep, voffA); PG8_STAGE(PG8_SB(1, 1), cB + hB + kstep, voffB);
    PG8_WAIT_V(6); PG8_BAR;
    for (;;) {
        const bool has_next = S.next(ui + 1, nxt);
        const char* nA = cA; const char* nB = cB;
        if (has_next) P.setup(nxt, nA, nB);
        for (int t = 0; t < nt; t += 2) {
            const bool last = (t == nt - 2);
            const char* a1 = cA + (size_t)(t + 1) * kstep;
            const char* a2 = last ? nA : cA + (size_t)(t + 2) * kstep; const char* b2 = last ? nB : cB + (size_t)(t + 2) * kstep;
            const char* a3 = a2 + kstep; const char* b3 = b2 + kstep;
            PG8_LDB(B0, 0, 0); PG8_LDB(B1, 0, 1); PG8_SCHED; PG8_LDA(At, 0, 0); PG8_STAGE(PG8_SA(1, 1), a1 + hA, voffA);
            PG8_WAIT_V(8); PG8_WAIT_L(0); PG8_BAR; PG8_MMA(0, 0, At, B0); PG8_MMA(0, 1, At, B1); PG8_BAR; PG8_SCHED;
            PG8_LDA(At, 0, 1); PG8_STAGE(PG8_SB(0, 0), b2, voffB); PG8_STAGE(PG8_SB(0, 1), b2 + hB, voffB); PG8_STAGE(PG8_SA(0, 0), a2, voffA);
            PG8_WAIT_V(8); PG8_WAIT_L(0); PG8_BAR; PG8_MMA(1, 0, At, B0); PG8_MMA(1, 1, At, B1); PG8_BAR; PG8_SCHED;
            PG8_LDB(B0, 1, 0); PG8_LDB(B1, 1, 1); PG8_SCHED; PG8_LDA(At, 1, 0); PG8_STAGE(PG8_SA(0, 1), a2 + hA, voffA);
            PG8_WAIT_V(8); PG8_WAIT_L(0); PG8_BAR; PG8_MMA(0, 0, At, B0); PG8_MMA(0, 1, At, B1); PG8_BAR; PG8_SCHED;
            PG8_LDA(At, 1, 1); PG8_STAGE(PG8_SB(1, 0), b3, voffB); PG8_STAGE(PG8_SB(1, 1), b3 + hB, voffB); PG8_STAGE(PG8_SA(1, 0), a3, voffA);
            PG8_WAIT_V(8); PG8_WAIT_L(0); PG8_BAR; PG8_MMA(1, 0, At, B0); PG8_MMA(1, 1, At, B1); PG8_BAR; PG8_SCHED;
        }
        if (wr == 0) PG8_BAR;
        if constexpr (Epi::F8) asm volatile("s_nop 15\n\ts_nop 7" ::: "memory");
        E(acc, cur, wr, wc, fr, fq);
        if (!has_next) break;
#pragma unroll
        for (int a = 0; a < 2; ++a)
#pragma unroll
            for (int b = 0; b < 2; ++b)
#pragma unroll
                for (int m = 0; m < 4; ++m)
#pragma unroll
                    for (int n = 0; n < 2; ++n) acc[a][b][m][n] = (f32x4){0.f, 0.f, 0.f, 0.f};
        cur = nxt; cA = nA; cB = nB; ++ui;
        if (wr == 1) PG8_BAR;
    }
    PG8_WAIT_V(0);
    PG8_BAR;
#undef PG8_SA
#undef PG8_SB
#undef PG8_STAGE
#undef PG8_LDA
#undef PG8_LDB
#undef PG8_MMA
#undef PG8_WAIT_V
#undef PG8_WAIT_L
#undef PG8_BAR
#undef PG8_SCHED
}
}

struct ProbPlain { const char* A; const char* B; unsigned lda, ldb; int nt;
    __device__ __forceinline__ void setup(pg8::Unit& u, const char*& a, const char*& b) const { a = A + (size_t)u.pm * 256 * lda; b = B + (size_t)u.pn * 256 * ldb; } };
struct ProbBO { const char* A; const char* B; unsigned lda, ldb; int nt;
    __device__ __forceinline__ void setup(pg8::Unit& u, const char*& a, const char*& b) const { a = A + (size_t)u.pm * 256 * lda + (size_t)(u.pn >> 2) * 512; b = B + (size_t)u.pn * 256 * ldb; } };
struct ProbMoE { const char* A; const char* B; unsigned lda, ldb; int nt; const int* tstart; size_t bstride;
    __device__ __forceinline__ void setup(pg8::Unit& u, const char*& a, const char*& b) const {
        int e = 0;
#pragma unroll 1
        for (int j = 1; j < NE; ++j) e += (u.pm >= tstart[j]) ? 1 : 0;
        u.aux = e; a = A + (size_t)u.pm * 256 * lda; b = B + (size_t)e * bstride + (size_t)u.pn * 256 * ldb; } };

__device__ __forceinline__ f32x4 i2f4(const f32x4 a) { const i32x4 i = __builtin_bit_cast(i32x4, a); return (f32x4){(float)i.x, (float)i.y, (float)i.z, (float)i.w}; }
typedef const f32x4 (&AccRef)[2][2][4][2];
struct EpiIn {
    static constexpr bool PERM = true, I8 = false, F8 = false;
    bf16* Pb; bf16* Gb; float* gates; const float* bmg;
    __device__ __forceinline__ void operator()(AccRef acc, const pg8::Unit& u, int wr, int wc, int fr, int fq) const {
        const int row0 = u.pm * 256 + wr * 64 + fr;
        if (u.pn < 22) {
            const int col0 = u.pn * 256 + wc * 32 + 8 * fq;
#pragma unroll
            for (int ai = 0; ai < 2; ++ai)
#pragma unroll
                for (int m = 0; m < 4; ++m) { const int row = row0 + ai * 128 + m * 16; bf16* rowp = Pb + (size_t)row * LDP + col0;
#pragma unroll
                    for (int bj = 0; bj < 2; ++bj) { const f32x4 v0 = acc[ai][bj][m][0], v1 = acc[ai][bj][m][1];
                        u32x4 w; w.x = cvtpk(v0[0], v0[1]); w.y = cvtpk(v0[2], v0[3]); w.z = cvtpk(v1[0], v1[1]); w.w = cvtpk(v1[2], v1[3]);
                        *(u32x4*)(rowp + bj * 128) = w;
                        if (bj == 0 && u.pn == 14 && wc == 0 && fq < 2) { float* g = gates + (size_t)row * 32 + 8 * fq; *(f32x4*)g = v0; *(f32x4*)(g + 4) = v1; }
                        if (bj == 1 && u.pn == 21 && wc == 1 && fq >= 2) { float* g = gates + (size_t)row * 32 + 16 + 8 * (fq - 2); *(f32x4*)g = v0; *(f32x4*)(g + 4) = v1; } } }
        } else {
            const int col0 = (u.pn - 22) * 256 + wc * 32 + 8 * fq;
            f32x4 bv[2][2];
#pragma unroll
            for (int bj = 0; bj < 2; ++bj)
#pragma unroll
                for (int n = 0; n < 2; ++n) bv[bj][n] = *(const f32x4*)(bmg + col0 + bj * 128 + 4 * n);
#pragma unroll
            for (int ai = 0; ai < 2; ++ai)
#pragma unroll
                for (int m = 0; m < 4; ++m) { bf16* rowp = Gb + (size_t)(row0 + ai * 128 + m * 16) * NGATE + col0;
#pragma unroll
                    for (int bj = 0; bj < 2; ++bj) { f32x4 v0 = acc[ai][bj][m][0] + bv[bj][0], v1 = acc[ai][bj][m][1] + bv[bj][1];
#pragma unroll
                        for (int j = 0; j < 4; ++j) { v0[j] = fsigmoid(v0[j]); v1[j] = fsigmoid(v1[j]); }
                        u32x4 w; w.x = cvtpk(v0[0], v0[1]); w.y = cvtpk(v0[2], v0[3]); w.z = cvtpk(v1[0], v1[1]); w.w = cvtpk(v1[2], v1[3]);
                        *(u32x4*)(rowp + bj * 128) = w; } }
        }
    }
};
struct EpiStore {
    static constexpr bool PERM = true, I8 = false, F8 = false;
    bf16* O; int ldc; const float* bias; int bias_stride;
    __device__ __forceinline__ void operator()(AccRef acc, const pg8::Unit& u, int wr, int wc, int fr, int fq) const {
        const int row0 = u.pm * 256 + wr * 64 + fr, col0 = u.pn * 256 + wc * 32 + 8 * fq;
        f32x4 bv[2][2];
#pragma unroll
        for (int bj = 0; bj < 2; ++bj)
#pragma unroll
            for (int n = 0; n < 2; ++n) bv[bj][n] = bias ? *(const f32x4*)(bias + (size_t)u.aux * bias_stride + col0 + bj * 128 + 4 * n) : (f32x4){0.f, 0.f, 0.f, 0.f};
#pragma unroll
        for (int ai = 0; ai < 2; ++ai)
#pragma unroll
            for (int m = 0; m < 4; ++m) { bf16* rowp = O + (size_t)(row0 + ai * 128 + m * 16) * ldc + col0;
#pragma unroll
                for (int bj = 0; bj < 2; ++bj) { const f32x4 v0 = acc[ai][bj][m][0] + bv[bj][0], v1 = acc[ai][bj][m][1] + bv[bj][1];
                    u32x4 w; w.x = cvtpk(v0[0], v0[1]); w.y = cvtpk(v0[2], v0[3]); w.z = cvtpk(v1[0], v1[1]); w.w = cvtpk(v1[2], v1[3]);
                    *(u32x4*)(rowp + bj * 128) = w; } }
    }
};
struct EpiStoreF8 {
    static constexpr bool PERM = true, I8 = false, F8 = true; static constexpr int SCALE_A = 0x7f7f7f7f, SCALE_B = 0x7f7f7f7f;
    bf16* O; int ldc; const float* bias; int bias_stride;
    __device__ __forceinline__ void operator()(AccRef acc, const pg8::Unit& u, int wr, int wc, int fr, int fq) const {
        const int row0 = u.pm * 256 + wr * 64 + fr, col0 = u.pn * 256 + wc * 32 + 8 * fq;
        f32x4 bv[2][2];
#pragma unroll
        for (int bj = 0; bj < 2; ++bj)
#pragma unroll
            for (int n = 0; n < 2; ++n) bv[bj][n] = *(const f32x4*)(bias + (size_t)u.aux * bias_stride + col0 + bj * 128 + 4 * n);
#pragma unroll
        for (int ai = 0; ai < 2; ++ai)
#pragma unroll
            for (int m = 0; m < 4; ++m) { bf16* rowp = O + (size_t)(row0 + ai * 128 + m * 16) * ldc + col0;
#pragma unroll
                for (int bj = 0; bj < 2; ++bj) { const f32x4 v0 = acc[ai][bj][m][0] * 0.015625f + bv[bj][0], v1 = acc[ai][bj][m][1] * 0.015625f + bv[bj][1];
                    u32x4 w; w.x = cvtpk(v0[0], v0[1]); w.y = cvtpk(v0[2], v0[3]); w.z = cvtpk(v1[0], v1[1]); w.w = cvtpk(v1[2], v1[3]);
                    *(u32x4*)(rowp + bj * 128) = w; } }
    }
};
struct EpiBO {
    static constexpr bool PERM = true, I8 = true, F8 = false;
    bf16* Z; const bf16* G; const float* sY; const float* cmB;
    __device__ __forceinline__ void operator()(AccRef acc, const pg8::Unit& u, int wr, int wc, int fr, int fq) const {
        const int row0 = u.pm * 256 + wr * 64 + fr, colg = u.pn * 256 + wc * 32 + 8 * fq, colz = (u.pn & 3) * 256 + wc * 32 + 8 * fq;
        const bool first = u.aux == 0;
        f32x4 sw[2][2];
#pragma unroll
        for (int bj = 0; bj < 2; ++bj)
#pragma unroll
            for (int n = 0; n < 2; ++n) sw[bj][n] = *(const f32x4*)(cmB + colg + bj * 128 + 4 * n) * (1.0f / 127.0f);
#pragma unroll
        for (int ai = 0; ai < 2; ++ai)
#pragma unroll
            for (int m = 0; m < 4; ++m) { const int row = row0 + ai * 128 + m * 16; const float sa = sY[row * 4 + u.aux];
#pragma unroll
                for (int bj = 0; bj < 2; ++bj) { const u32x4 gw = *(const u32x4*)(G + (size_t)row * NGATE + colg + bj * 128); float g[8]; unpack8(gw, g);
                    bf16* zp = Z + (size_t)row * D + colz + bj * 128;
                    float z[8];
                    if (first) {
#pragma unroll
                        for (int j = 0; j < 8; ++j) z[j] = 0.f;
                    } else unpack8(*(const u32x4*)zp, z);
                    const f32x4 v0 = i2f4(acc[ai][bj][m][0]) * sw[bj][0] * sa, v1 = i2f4(acc[ai][bj][m][1]) * sw[bj][1] * sa;
#pragma unroll
                    for (int j = 0; j < 4; ++j) { z[j] += v0[j] * g[j]; z[4 + j] += v1[j] * g[4 + j]; }
                    *(u32x4*)zp = pack8(z); } }
    }
};
struct EpiOut {
    static constexpr bool PERM = false, I8 = false, F8 = false;
    float* X; const float* modl;
    __device__ __forceinline__ void operator()(AccRef acc, const pg8::Unit& u, int wr, int wc, int fr, int fq) const {
        const int row0 = u.pm * 256 + wr * 64 + fr, col0 = u.pn * 256 + wc * 32 + 4 * fq;
        const int mv = (u.pm % 33 == 0) ? 4 : u.pm / 33;
        const float* g1 = modl + mv * 6144 + 2048;
        f32x4 gv[2][2];
#pragma unroll
        for (int bj = 0; bj < 2; ++bj)
#pragma unroll
            for (int n = 0; n < 2; ++n) gv[bj][n] = *(const f32x4*)(g1 + col0 + bj * 128 + n * 16);
#pragma unroll
        for (int ai = 0; ai < 2; ++ai)
#pragma unroll
            for (int m = 0; m < 4; ++m) { float* rowp = X + (size_t)(row0 + ai * 128 + m * 16) * D + col0;
#pragma unroll
                for (int bj = 0; bj < 2; ++bj)
#pragma unroll
                    for (int n = 0; n < 2; ++n) { f32x4* p = (f32x4*)(rowp + bj * 128 + n * 16); *p = *p + gv[bj][n] * acc[ai][bj][m][n]; } }
    }
};
struct EpiMoE1 {
    static constexpr bool PERM = true, I8 = false, F8 = false;
    bf16* ACT; const float* bgu;
    __device__ __forceinline__ void operator()(AccRef acc, const pg8::Unit& u, int wr, int wc, int fr, int fq) const {
        const int row0 = u.pm * 256 + wr * 64 + fr, c0 = u.pn * 128 + wc * 32 + 8 * fq;
        const float* bg = bgu + (size_t)u.aux * 2048 + c0;
        f32x4 bgt[2], bup[2];
#pragma unroll
        for (int n = 0; n < 2; ++n) { bgt[n] = *(const f32x4*)(bg + 4 * n); bup[n] = *(const f32x4*)(bg + 1024 + 4 * n); }
#pragma unroll
        for (int ai = 0; ai < 2; ++ai)
#pragma unroll
            for (int m = 0; m < 4; ++m) { float o[8];
#pragma unroll
                for (int n = 0; n < 2; ++n)
#pragma unroll
                    for (int j = 0; j < 4; ++j) { const float gate = fminf(acc[ai][0][m][n][j] + bgt[n][j], 7.0f); const float up = fminf(fmaxf(acc[ai][1][m][n][j] + bup[n][j], -7.0f), 7.0f);
                        o[4 * n + j] = (up + 1.0f) * gate * fsigmoid(1.702f * gate); }
                *(u32x4*)(ACT + (size_t)(row0 + ai * 128 + m * 16) * DFF + c0) = pack8(o); }
    }
};

struct EpiIn8 {
    static constexpr bool PERM = true, I8 = true, F8 = false;
    bf16* Pb; bf16* Gb; float* gates; const float* bmg; const float* sA; const float* cmB;
    __device__ __forceinline__ void operator()(AccRef acc, const pg8::Unit& u, int wr, int wc, int fr, int fq) const {
        const int row0 = u.pm * 256 + wr * 64 + fr, cb0 = u.pn * 256 + wc * 32 + 8 * fq;
        f32x4 sw[2][2];
#pragma unroll
        for (int bj = 0; bj < 2; ++bj)
#pragma unroll
            for (int n = 0; n < 2; ++n) sw[bj][n] = *(const f32x4*)(cmB + cb0 + bj * 128 + 4 * n) * (1.0f / 127.0f);
        if (u.pn < 22) {
#pragma unroll
            for (int ai = 0; ai < 2; ++ai)
#pragma unroll
                for (int m = 0; m < 4; ++m) { const int row = row0 + ai * 128 + m * 16; bf16* rowp = Pb + (size_t)row * LDP + cb0; const float sa = sA[row];
#pragma unroll
                    for (int bj = 0; bj < 2; ++bj) { const f32x4 v0 = i2f4(acc[ai][bj][m][0]) * sw[bj][0] * sa, v1 = i2f4(acc[ai][bj][m][1]) * sw[bj][1] * sa;
                        u32x4 w; w.x = cvtpk(v0[0], v0[1]); w.y = cvtpk(v0[2], v0[3]); w.z = cvtpk(v1[0], v1[1]); w.w = cvtpk(v1[2], v1[3]);
                        *(u32x4*)(rowp + bj * 128) = w;
                        if (bj == 0 && u.pn == 14 && wc == 0 && fq < 2) { float* g = gates + (size_t)row * 32 + 8 * fq; *(f32x4*)g = v0; *(f32x4*)(g + 4) = v1; }
                        if (bj == 1 && u.pn == 21 && wc == 1 && fq >= 2) { float* g = gates + (size_t)row * 32 + 16 + 8 * (fq - 2); *(f32x4*)g = v0; *(f32x4*)(g + 4) = v1; } } }
        } else {
            const int col0 = cb0 - LDP;
            f32x4 bv[2][2];
#pragma unroll
            for (int bj = 0; bj < 2; ++bj)
#pragma unroll
                for (int n = 0; n < 2; ++n) bv[bj][n] = *(const f32x4*)(bmg + col0 + bj * 128 + 4 * n);
#pragma unroll
            for (int ai = 0; ai < 2; ++ai)
#pragma unroll
                for (int m = 0; m < 4; ++m) { const int row = row0 + ai * 128 + m * 16; bf16* rowp = Gb + (size_t)row * NGATE + col0; const float sa = sA[row];
#pragma unroll
                    for (int bj = 0; bj < 2; ++bj) { f32x4 v0 = i2f4(acc[ai][bj][m][0]) * sw[bj][0] * sa + bv[bj][0], v1 = i2f4(acc[ai][bj][m][1]) * sw[bj][1] * sa + bv[bj][1];
#pragma unroll
                        for (int j = 0; j < 4; ++j) { v0[j] = fsigmoid(v0[j]); v1[j] = fsigmoid(v1[j]); }
                        u32x4 w; w.x = cvtpk(v0[0], v0[1]); w.y = cvtpk(v0[2], v0[3]); w.z = cvtpk(v1[0], v1[1]); w.w = cvtpk(v1[2], v1[3]);
                        *(u32x4*)(rowp + bj * 128) = w; } }
        }
    }
};
struct EpiMoE18 {
    static constexpr bool PERM = true, I8 = true, F8 = false;
    bf16* ACT; const float* bgu; const float* sA; const float* cmB;
    __device__ __forceinline__ void operator()(AccRef acc, const pg8::Unit& u, int wr, int wc, int fr, int fq) const {
        const int row0 = u.pm * 256 + wr * 64 + fr, c0 = u.pn * 128 + wc * 32 + 8 * fq;
        const float* bg = bgu + (size_t)u.aux * 2048 + c0;
        const float* cm = cmB + (size_t)u.aux * 2048 + u.pn * 256 + wc * 32 + 8 * fq;
        f32x4 bgt[2], bup[2], sg[2], su[2];
#pragma unroll
        for (int n = 0; n < 2; ++n) { bgt[n] = *(const f32x4*)(bg + 4 * n); bup[n] = *(const f32x4*)(bg + 1024 + 4 * n); sg[n] = *(const f32x4*)(cm + 4 * n) * (1.0f / 127.0f); su[n] = *(const f32x4*)(cm + 128 + 4 * n) * (1.0f / 127.0f); }
#pragma unroll
        for (int ai = 0; ai < 2; ++ai)
#pragma unroll
            for (int m = 0; m < 4; ++m) { const int row = row0 + ai * 128 + m * 16; const float sa = sA[row]; float o[8];
#pragma unroll
                for (int n = 0; n < 2; ++n) { const f32x4 ga = i2f4(acc[ai][0][m][n]) * sg[n] * sa + bgt[n], ua = i2f4(acc[ai][1][m][n]) * su[n] * sa + bup[n];
#pragma unroll
                    for (int j = 0; j < 4; ++j) { const float gate = fminf(ga[j], 7.0f); const float up = fminf(fmaxf(ua[j], -7.0f), 7.0f);
                        o[4 * n + j] = (up + 1.0f) * gate * fsigmoid(1.702f * gate); } }
                int w0 = 0, w1 = 0;
                w0 = __builtin_amdgcn_cvt_pk_fp8_f32(o[0], o[1], w0, false); w0 = __builtin_amdgcn_cvt_pk_fp8_f32(o[2], o[3], w0, true);
                w1 = __builtin_amdgcn_cvt_pk_fp8_f32(o[4], o[5], w1, false); w1 = __builtin_amdgcn_cvt_pk_fp8_f32(o[6], o[7], w1, true);
                *(u32x2*)((unsigned char*)ACT + (size_t)row * DFF + c0) = (u32x2){(unsigned)w0, (unsigned)w1}; }
    }
};

struct AttnJob {
    const bf16* Q; int qpitch;
    const bf16* K; int kpitch;
    const bf16* VT;
    bf16* O; int opitch;
    int ntiles; float c;
    int s0_first_n, s0_jump;
    int kr_lo, r_w, c_q;
    const LAS float* bias;
};
template <int DQK, bool NA>
__device__ __forceinline__ void attn_unit(LAS unsigned char* lds, const AttnJob& J) {
    constexpr int KPB = (DQK == 96) ? 208 : 144, VPB = 136, NS = DQK / 16, KCH = DQK / 8;
    constexpr int KBUF = 64 * KPB, VBUF = 64 * VPB;
    const int tid = ltid(), wid = __builtin_amdgcn_readfirstlane(tid >> 6), lane = tid & 63, r = lane & 31, h = lane >> 5;
    LAS unsigned char* kb0 = lds; LAS unsigned char* vb0 = lds + 2 * KBUF;
    bf16x8 qf[NS];
    { const bf16* qrow = J.Q + (size_t)(wid * 32 + r) * J.qpitch + 8 * h;
#pragma unroll
      for (int s = 0; s < NS; ++s) qf[s] = *(const bf16x8*)(qrow + 16 * s); }
    f32x16 o0, o1;
#pragma unroll
    for (int i = 0; i < 16; ++i) { o0[i] = 0.f; o1[i] = 0.f; }
    float mrun = -1e30f, lsum = 0.f;
    const int k0r = tid / KCH, k0c = tid % KCH, k1r = (tid + 512) / KCH, k1c = (tid + 512) % KCH;
    const bool k1 = (tid + 512) < 64 * KCH;
    const int vd = tid >> 3, vc = tid & 7;
    u32x4 kr0, kr1, vr;
    auto s0_of = [&](int j) { return j < J.s0_first_n ? 64 * j : J.s0_jump + 64 * (j - J.s0_first_n); };
    auto gload = [&](int j) { const int s0 = s0_of(j);
        kr0 = *(const u32x4*)(J.K + (size_t)(s0 + k0r) * J.kpitch + 8 * k0c);
        if (k1) kr1 = *(const u32x4*)(J.K + (size_t)(s0 + k1r) * J.kpitch + 8 * k1c);
        vr = *(const u32x4*)(J.VT + (size_t)vd * TB + s0 + 8 * vc); };
    auto lstore = [&](int buf) {
        *(LAS u32x4*)(kb0 + buf * KBUF + k0r * KPB + 16 * k0c) = kr0;
        if (k1) *(LAS u32x4*)(kb0 + buf * KBUF + k1r * KPB + 16 * k1c) = kr1;
        LAS unsigned char* vp = vb0 + buf * VBUF + vd * VPB + 16 * vc;
        *(LAS u32x2*)vp = (u32x2){vr.x, vr.y}; *(LAS u32x2*)(vp + 8) = (u32x2){vr.z, vr.w}; };
    gload(0); lstore(0);
    __syncthreads();
    const int r0w = NA ? min(max(J.r_w - 4, 0), 120) : 0;
    const int c0 = NA ? min(max(J.c_q - 8, 0), 48) : 0;
    for (int j = 0; j < J.ntiles; ++j) {
        const int buf = j & 1;
        if (j + 1 < J.ntiles) gload(j + 1);
        bool active = true; int dr = 0;
        if (NA && j >= 4) { const int kr = J.kr_lo + j - 4; active = (kr >= r0w) && (kr < r0w + 8); dr = kr - J.r_w + 7; }
        if (active) {
            f32x16 s0v, s1v;
#pragma unroll
            for (int i = 0; i < 16; ++i) { s0v[i] = 0.f; s1v[i] = 0.f; }
            const LAS unsigned char* kp = kb0 + buf * KBUF + r * KPB + 16 * h;
#pragma unroll
            for (int s = 0; s < NS; ++s) {
                const bf16x8 a0 = *(const LAS bf16x8*)(kp + 32 * s), a1 = *(const LAS bf16x8*)(kp + 32 * KPB + 32 * s);
                s0v = __builtin_amdgcn_mfma_f32_32x32x16_bf16(a0, qf[s], s0v, 0, 0, 0);
                s1v = __builtin_amdgcn_mfma_f32_32x32x16_bf16(a1, qf[s], s1v, 0, 0, 0);
            }
            float mx;
            if (NA && j >= 4) {
                const LAS float* bp = J.bias + dr * 31 + 15 - J.c_q;
#pragma unroll
                for (int i = 0; i < 16; ++i) { const int kc = (i & 3) + 8 * (i >> 2) + 4 * h;
                    { const bool ok = (unsigned)(kc - c0) < 16u; const float bz = bp[ok ? kc : c0]; s0v[i] = ok ? s0v[i] * J.c + bz : -1e30f; }
                    { const int kc1 = kc + 32; const bool ok = (unsigned)(kc1 - c0) < 16u; const float bz = bp[ok ? kc1 : c0]; s1v[i] = ok ? s1v[i] * J.c + bz : -1e30f; } }
                mx = -1e30f;
#pragma unroll
                for (int i = 0; i < 16; ++i) mx = fmaxf(mx, fmaxf(s0v[i], s1v[i]));
                mx = fmaxf(mx, __shfl_xor(mx, 32));
            } else {
                float ma = fmaxf(s0v[0], s1v[0]), mb = fmaxf(s0v[1], s1v[1]);
#pragma unroll
                for (int i = 2; i < 16; i += 2) { ma = fmaxf(fmaxf(ma, s0v[i]), s1v[i]); mb = fmaxf(fmaxf(mb, s0v[i + 1]), s1v[i + 1]); }
                mx = fmaxf(ma, mb); mx = fmaxf(mx, __shfl_xor(mx, 32)) * J.c;
            }
            if (__any(mx > mrun + 8.0f)) {
                const float mnew = fmaxf(mrun, mx), alpha = fexp2(mrun - mnew); mrun = mnew; lsum *= alpha;
#pragma unroll
                for (int i = 0; i < 16; ++i) { o0[i] *= alpha; o1[i] *= alpha; }
            }
            float ps = 0.f;
            if (NA && j >= 4) {
#pragma unroll
                for (int i = 0; i < 16; ++i) { s0v[i] = fexp2(s0v[i] - mrun); s1v[i] = fexp2(s1v[i] - mrun); ps += s0v[i] + s1v[i]; }
            } else {
                const float nm = -mrun;
#pragma unroll
                for (int i = 0; i < 16; ++i) { s0v[i] = fexp2(__builtin_fmaf(s0v[i], J.c, nm)); s1v[i] = fexp2(__builtin_fmaf(s1v[i], J.c, nm)); ps += s0v[i] + s1v[i]; }
            }
            lsum += ps;
            bf16x8 pf[4];
#pragma unroll
            for (int st = 0; st < 4; ++st) { u32x4 w;
#pragma unroll
                for (int q = 0; q < 4; ++q) { const int i = 8 * (st & 1) + 2 * q; w[q] = (st < 2) ? cvtpk(s0v[i], s0v[i + 1]) : cvtpk(s1v[i], s1v[i + 1]); }
                pf[st] = __builtin_bit_cast(bf16x8, w); }
            const LAS unsigned char* vp = vb0 + buf * VBUF + r * VPB + 8 * h;
#pragma unroll
            for (int st = 0; st < 4; ++st) {
                const u32x2 a0l = *(const LAS u32x2*)(vp + 32 * st), a0h = *(const LAS u32x2*)(vp + 32 * st + 16);
                const u32x2 a1l = *(const LAS u32x2*)(vp + 32 * VPB + 32 * st), a1h = *(const LAS u32x2*)(vp + 32 * VPB + 32 * st + 16);
                const bf16x8 va0 = __builtin_bit_cast(bf16x8, (u32x4){a0l.x, a0l.y, a0h.x, a0h.y}), va1 = __builtin_bit_cast(bf16x8, (u32x4){a1l.x, a1l.y, a1h.x, a1h.y});
                o0 = __builtin_amdgcn_mfma_f32_32x32x16_bf16(va0, pf[st], o0, 0, 0, 0);
                o1 = __builtin_amdgcn_mfma_f32_32x32x16_bf16(va1, pf[st], o1, 0, 0, 0);
            }
        }
        if (j + 1 < J.ntiles) lstore(buf ^ 1);
        __syncthreads();
    }
    lsum += __shfl_xor(lsum, 32);
    const float inv = frcp(lsum);
    bf16* orow = J.O + (size_t)(wid * 32 + r) * J.opitch + 4 * h;
#pragma unroll
    for (int g = 0; g < 4; ++g) {
        *(u32x2*)(orow + 8 * g) = (u32x2){cvtpk(o0[4 * g] * inv, o0[4 * g + 1] * inv), cvtpk(o0[4 * g + 2] * inv, o0[4 * g + 3] * inv)};
        *(u32x2*)(orow + 32 + 8 * g) = (u32x2){cvtpk(o1[4 * g] * inv, o1[4 * g + 1] * inv), cvtpk(o1[4 * g + 2] * inv, o1[4 * g + 3] * inv)};
    }
}

template <int DQK>
__device__ __forceinline__ void attn_unit_dense(LAS unsigned char* lds, const AttnJob& J) {
    static_assert(DQK == 96, "fp8 score path: rows are 128 bytes (64 nope | 32 rotary | 32 zero)");
    constexpr int KPB = 144, VPB = 144, KCH = 8, NKC = 2;
    constexpr int KBUF = 128 * KPB, VBUF = 64 * VPB;
    const int tid = ltid(), wid = __builtin_amdgcn_readfirstlane(tid >> 6), lane = tid & 63, r = lane & 31, h = lane >> 5;
    LAS unsigned char* kb0 = lds; LAS unsigned char* vb0 = lds + 2 * KBUF;
    i32x8 qf[2];
    { const unsigned char* qrow = (const unsigned char*)J.Q + (size_t)(wid * 32 + r) * J.qpitch + 32 * h;
#pragma unroll
      for (int i = 0; i < 2; ++i) { const i32x4 lo_ = *(const i32x4*)(qrow + 64 * i), hi_ = *(const i32x4*)(qrow + 64 * i + 16); qf[i] = __builtin_shufflevector(lo_, hi_, 0, 1, 2, 3, 4, 5, 6, 7); } }
    f32x16 o0, o1, o2;
#pragma unroll
    for (int i = 0; i < 16; ++i) { o0[i] = 0.f; o1[i] = 0.f; o2[i] = 0.f; }
    const int onev = (r == 0) ? 0x38383838 : 0;
    const i32x8 ones = {onev, onev, onev, onev, onev, onev, onev, onev};
    float mrun = -1e30f;
    u32x4 kr[NKC], vr;
    const int vd = tid >> 3, vc = tid & 7;
    auto gload = [&](int j) { const int s0 = 128 * j;
#pragma unroll
        for (int q = 0; q < NKC; ++q) { const int ch = tid + 512 * q; kr[q] = *(const u32x4*)((const unsigned char*)J.K + (size_t)(s0 + ch / KCH) * J.kpitch + 16 * (ch % KCH)); }
        vr = *(const u32x4*)((const unsigned char*)J.VT + (size_t)vd * TB + s0 + 16 * vc); };
    auto lstore = [&](int buf) {
#pragma unroll
        for (int q = 0; q < NKC; ++q) { const int ch = tid + 512 * q; *(LAS u32x4*)(kb0 + buf * KBUF + (ch / KCH) * KPB + 16 * (ch % KCH)) = kr[q]; }
        LAS unsigned char* vp = vb0 + buf * VBUF + vd * VPB + 64 * (vc >> 2) + 8 * (vc & 3);
        *(LAS u32x2*)vp = (u32x2){vr.x, vr.z}; *(LAS u32x2*)(vp + 32) = (u32x2){vr.y, vr.w}; };
    const int nst = J.ntiles >> 1;
    const int grp = wid >> 2;
    gload(0); lstore(0);
    __syncthreads();
    if (nst > 1) gload(1);
    if (grp == 1) LDS_BAR();
    for (int j = 0; j < nst; ++j) {
        const int buf = j & 1;
        f32x16 sv[4];
#pragma unroll
        for (int bk = 0; bk < 4; ++bk)
#pragma unroll
            for (int i = 0; i < 16; ++i) sv[bk][i] = 0.f;
        { const LAS unsigned char* kq = kb0 + buf * KBUF + r * KPB + 32 * h;
          i32x8 ka[2][4];
#pragma unroll
          for (int bk = 0; bk < 4; ++bk) { const i32x4 lo_ = *(const LAS i32x4*)(kq + bk * 32 * KPB), hi_ = *(const LAS i32x4*)(kq + bk * 32 * KPB + 16); ka[0][bk] = __builtin_shufflevector(lo_, hi_, 0, 1, 2, 3, 4, 5, 6, 7); }
#pragma unroll
          for (int bk = 0; bk < 4; ++bk) { const i32x4 lo_ = *(const LAS i32x4*)(kq + bk * 32 * KPB + 64), hi_ = *(const LAS i32x4*)(kq + bk * 32 * KPB + 80); ka[1][bk] = __builtin_shufflevector(lo_, hi_, 0, 1, 2, 3, 4, 5, 6, 7); }
          __builtin_amdgcn_sched_barrier(0);
#pragma unroll
          for (int i = 0; i < 2; ++i)
#pragma unroll
              for (int bk = 0; bk < 4; ++bk) sv[bk] = __builtin_amdgcn_mfma_scale_f32_32x32x64_f8f6f4(ka[i][bk], qf[i], sv[bk], 0, 0, 0, 0x7f7f7f7f, 0, 0x7f7f7f7f);
          __builtin_amdgcn_sched_barrier(0); }
        if (grp == 1 && j + 1 < nst) lstore(buf ^ 1);
        LDS_BAR();
        if (grp == 1 && j + 2 < nst) gload(j + 2);
        float ma = fmaxf(sv[0][0], sv[1][0]), mb = fmaxf(sv[2][0], sv[3][0]);
#pragma unroll
        for (int i = 1; i < 16; ++i) { ma = fmaxf(fmaxf(ma, sv[0][i]), sv[1][i]); mb = fmaxf(fmaxf(mb, sv[2][i]), sv[3][i]); }
        float mx = fmaxf(ma, mb) * J.c;
        { auto rr = __builtin_amdgcn_permlane32_swap(__float_as_uint(mx), __float_as_uint(mx), false, false); mx = fmaxf(__uint_as_float(rr[0]), __uint_as_float(rr[1])); }
        if (__any(mx > mrun + 8.0f)) {
            const float mnew = fmaxf(mrun, mx), alpha = fexp2(mrun - mnew); mrun = mnew; o2[0] *= alpha;
#pragma unroll
            for (int i = 0; i < 16; ++i) { o0[i] *= alpha; o1[i] *= alpha; }
        }
        const float nm = -mrun;
#pragma unroll
        for (int bk = 0; bk < 4; ++bk)
#pragma unroll
            for (int i = 0; i < 16; ++i) sv[bk][i] = fexp2(__builtin_fmaf(sv[bk][i], J.c, nm));
        { const LAS unsigned char* vp = vb0 + buf * VBUF + r * VPB + 32 * h;
          i32x8 va[2][2];
#pragma unroll
          for (int t = 0; t < 2; ++t)
#pragma unroll
              for (int db = 0; db < 2; ++db) { const i32x4 lo_ = *(const LAS i32x4*)(vp + db * 32 * VPB + 64 * t), hi_ = *(const LAS i32x4*)(vp + db * 32 * VPB + 64 * t + 16); va[t][db] = __builtin_shufflevector(lo_, hi_, 0, 1, 2, 3, 4, 5, 6, 7); }
#pragma unroll
          for (int t = 0; t < 2; ++t) { i32x8 pf;
#pragma unroll
              for (int q = 0; q < 8; ++q) { const int bk = 2 * t + (q >> 2), i = 4 * (q & 3); int w = 0;
                  w = __builtin_amdgcn_cvt_pk_fp8_f32(sv[bk][i], sv[bk][i + 1], w, false); w = __builtin_amdgcn_cvt_pk_fp8_f32(sv[bk][i + 2], sv[bk][i + 3], w, true); pf[q] = w; }
              o0 = __builtin_amdgcn_mfma_scale_f32_32x32x64_f8f6f4(va[t][0], pf, o0, 0, 0, 0, 0x7f7f7f7f, 0, 0x7f7f7f7f);
              o1 = __builtin_amdgcn_mfma_scale_f32_32x32x64_f8f6f4(va[t][1], pf, o1, 0, 0, 0, 0x7f7f7f7f, 0, 0x7f7f7f7f);
              o2 = __builtin_amdgcn_mfma_scale_f32_32x32x64_f8f6f4(ones, pf, o2, 0, 0, 0, 0x7f7f7f7f, 0, 0x7f7f7f7f); } }
        if (grp == 0 && j + 1 < nst) lstore(buf ^ 1);
        LDS_BAR();
        if (grp == 0 && j + 2 < nst) gload(j + 2);
    }
    if (grp == 0) LDS_BAR();
    __syncthreads();
    float lsum = h ? 0.f : o2[0];
    { auto rr = __builtin_amdgcn_permlane32_swap(__float_as_uint(lsum), __float_as_uint(lsum), false, false); lsum = __uint_as_float(rr[0]) + __uint_as_float(rr[1]); }
    const float inv = frcp(lsum);
    bf16* orow = J.O + (size_t)(wid * 32 + r) * J.opitch + 4 * h;
#pragma unroll
    for (int g = 0; g < 4; ++g) {
        *(u32x2*)(orow + 8 * g) = (u32x2){cvtpk(o0[4 * g] * inv, o0[4 * g + 1] * inv), cvtpk(o0[4 * g + 2] * inv, o0[4 * g + 3] * inv)};
        *(u32x2*)(orow + 32 + 8 * g) = (u32x2){cvtpk(o1[4 * g] * inv, o1[4 * g + 1] * inv), cvtpk(o1[4 * g + 2] * inv, o1[4 * g + 3] * inv)};
    }
}

struct Params { const float* in[31]; float* out; unsigned char* ws; int ph_lo, ph_hi; };
typedef const __attribute__((address_space(4))) unsigned char* kaptr_t;
struct PView {
    kaptr_t ka; unsigned char* ws; float* out; int bid, G;
    struct InArr { kaptr_t ka; __device__ __forceinline__ const float* operator[](int i) const { return *(const float* const __attribute__((address_space(4)))*)(ka + 8 * i); } } in;
};
__device__ __forceinline__ PView pview() {
    kaptr_t k = (kaptr_t)__builtin_amdgcn_kernarg_segment_ptr(); asm volatile("" : "+s"(k));
    PView v; v.ka = k; v.in.ka = k; v.out = *(float* const __attribute__((address_space(4)))*)(k + 248); v.ws = *(unsigned char* const __attribute__((address_space(4)))*)(k + 256);
    int b = blockIdx.x, g = gridDim.x; asm volatile("" : "+s"(b), "+s"(g)); v.bid = b; v.G = g; return v;
}
enum { I_X = 0, I_C, I_CTX, I_CCTX, I_WADA, I_BADA, I_N1G, I_N2G, I_WIN, I_RPB, I_CONVW, I_ALOG, I_DTB, I_GNG, I_MQG, I_WUQ, I_MKVG, I_WUKV, I_BIF, I_MLG,
       I_WMG, I_BMG, I_WBO, I_WOUT, I_RW, I_RB, I_WGU, I_BGU, I_WDN, I_BDN, I_FG };

__device__ __forceinline__ void transpose_item(const float* W, int N, int k0, int n0, bf16* dst_row0, int ldd, LAS float* scr, int lane) {
#pragma unroll 8
    for (int i = 0; i < 32; ++i) { const int kk = 2 * i + (lane >> 5); scr[kk * 33 + (lane & 31)] = W[(size_t)(k0 + kk) * N + n0 + (lane & 31)]; }
    asm volatile("s_waitcnt lgkmcnt(0)" ::: "memory");
    const int c = lane & 7;
#pragma unroll
    for (int j = 0; j < 4; ++j) { const int n = (lane >> 3) + 8 * j; const LAS float* s = scr + (8 * c) * 33 + n;
        u32x4 o; o.x = cvtpk(s[0 * 33], s[1 * 33]); o.y = cvtpk(s[2 * 33], s[3 * 33]); o.z = cvtpk(s[4 * 33], s[5 * 33]); o.w = cvtpk(s[6 * 33], s[7 * 33]);
        *(u32x4*)(dst_row0 + (size_t)n * ldd + k0 + 8 * c) = o; }
    asm volatile("s_waitcnt lgkmcnt(0)" ::: "memory");
}
__device__ __forceinline__ void transpose_item8(const float* W, int N, int k0, int n0, signed char* dst_row0, int ldd, const float* cm_row0, LAS float* scr, int lane) {
#pragma unroll 8
    for (int i = 0; i < 32; ++i) { const int kk = 2 * i + (lane >> 5); scr[kk * 33 + (lane & 31)] = W[(size_t)(k0 + kk) * N + n0 + (lane & 31)]; }
    asm volatile("s_waitcnt lgkmcnt(0)" ::: "memory");
    const int c = lane & 7;
#pragma unroll
    for (int j = 0; j < 4; ++j) { const int n = (lane >> 3) + 8 * j; const LAS float* s = scr + (8 * c) * 33 + n;
        const float cm = cm_row0[n], inv = cm > 0.f ? 127.0f / cm : 0.f;
        unsigned w0 = 0u, w1 = 0u;
#pragma unroll
        for (int e = 0; e < 4; ++e) { const int q0 = (int)__builtin_rintf(s[e * 33] * inv), q1 = (int)__builtin_rintf(s[(4 + e) * 33] * inv); w0 |= ((unsigned)q0 & 0xffu) << (8 * e); w1 |= ((unsigned)q1 & 0xffu) << (8 * e); }
        *(u32x2*)(dst_row0 + (size_t)n * ldd + k0 + 8 * c) = (u32x2){w0, w1}; }
    asm volatile("s_waitcnt lgkmcnt(0)" ::: "memory");
}
__device__ __forceinline__ void transpose_item_f8(const float* W, int N, int k0, int n0, unsigned char* dst_row0, int ldd, LAS float* scr, int lane) {
#pragma unroll 8
    for (int i = 0; i < 32; ++i) { const int kk = 2 * i + (lane >> 5); scr[kk * 33 + (lane & 31)] = W[(size_t)(k0 + kk) * N + n0 + (lane & 31)]; }
    asm volatile("s_waitcnt lgkmcnt(0)" ::: "memory");
    const int c = lane & 7;
#pragma unroll
    for (int j = 0; j < 4; ++j) { const int n = (lane >> 3) + 8 * j; const LAS float* s = scr + (8 * c) * 33 + n;
        int w0 = 0, w1 = 0;
        w0 = __builtin_amdgcn_cvt_pk_fp8_f32(s[0 * 33] * 64.f, s[1 * 33] * 64.f, w0, false); w0 = __builtin_amdgcn_cvt_pk_fp8_f32(s[2 * 33] * 64.f, s[3 * 33] * 64.f, w0, true);
        w1 = __builtin_amdgcn_cvt_pk_fp8_f32(s[4 * 33] * 64.f, s[5 * 33] * 64.f, w1, false); w1 = __builtin_amdgcn_cvt_pk_fp8_f32(s[6 * 33] * 64.f, s[7 * 33] * 64.f, w1, true);
        *(u32x2*)(dst_row0 + (size_t)n * ldd + k0 + 8 * c) = (u32x2){(unsigned)w0, (unsigned)w1}; }
    asm volatile("s_waitcnt lgkmcnt(0)" ::: "memory");
}
struct TJob { int cnt, K, N; };
__device__ __forceinline__ void phase_prologue(const PView& p, LAS unsigned char* lds, int bid, int G) {
    const int tid = ltid(), wid = __builtin_amdgcn_readfirstlane(tid >> 6), lane = tid & 63;
    unsigned char* ws = p.ws;
    LAS float* scr = (LAS float*)(lds + wid * 16384);
    const int gw = bid * NWAVES + wid, NGW = G * NWAVES;
    constexpr int I0 = 4 * 16 * 174, I1 = 4 * 16 * 128, I2 = 16 * 8 * 32, I3 = 16 * 16 * 32, I4 = 4 * 4 * 24, I5 = 4 * 2 * 32, I6 = 128 * 16 * 64, I7 = 128 * 16 * 32;
    constexpr int NIT = I0 + I1 + I2 + I3 + I4 + I5 + I6 + I7;
    for (int it = gw; it < NIT; it += NGW) {
        int r = it;
        if (r < I0 + I1) continue; r -= I0 + I1;
        if (r < I2) continue; r -= I2;
        if (r < I3) { const int c = r / (16 * 32), q = r % (16 * 32), kb = q / 32, nb = q % 32, l = c >> 2, rep = c & 3;
            transpose_item(p.in[I_WOUT] + (size_t)l * 1024 * 1024, 1024, 64 * kb, 32 * nb, (bf16*)(ws + OFF_WOUT4) + ((size_t)l * 1024 + 32 * nb) * 4096 + rep * 1024, 4096, scr, lane); continue; } r -= I3;
        if (r < I4) { const int l = r / (4 * 24), q = r % (4 * 24), kb = q / 24, nb = q % 24;
            transpose_item(p.in[I_WUQ] + (size_t)l * 256 * 768, 768, 64 * kb, 32 * nb, (bf16*)(ws + OFF_WUQKV) + ((size_t)l * 1792 + 32 * nb) * 384, 384, scr, lane); continue; } r -= I4;
        if (r < I5) { const int l = r / (2 * 32), q = r % (2 * 32), kb = q / 32, nb = q % 32;
            transpose_item(p.in[I_WUKV] + (size_t)l * 128 * 1024, 1024, 64 * kb, 32 * nb, (bf16*)(ws + OFF_WUQKV) + ((size_t)l * 1792 + 768 + 32 * nb) * 384 + 256, 384, scr, lane); continue; } r -= I5;
        if (r < I6) { continue; } r -= I6;
        { const int c = r / (16 * 32), q = r % (16 * 32), kb = q / 32, nb = q % 32;
            transpose_item_f8(p.in[I_WDN] + (size_t)c * 1024 * 1024, 1024, 64 * kb, 32 * nb, (unsigned char*)(ws + OFF_WDN) + ((size_t)c * 1024 + 32 * nb) * 1024, 1024, scr, lane); }
    }
    { const int gt = bid * NTHR + tid, NT_ = G * NTHR;
      for (int i = gt; i < 4 * 64 * 64; i += NT_) { const int l = i / (64 * 64), q = i % (64 * 64), rr = q / 64, cc = q % 64;
          *(u32x4*)((signed char*)(ws + OFF_WIN) + ((size_t)l * NIN + DIN + rr) * 1024 + 16 * cc) = (u32x4){0u, 0u, 0u, 0u}; }
      for (int i = gt; i < 4 * 64; i += NT_) ((float*)(ws + OFF_CMIN))[(size_t)(i >> 6) * NIN + DIN + (i & 63)] = 0.f;
      for (int i = gt; i < 4 * 768 * 16; i += NT_) { const int l = i / (768 * 16), q = i % (768 * 16), rr = q / 16, cc = q % 16;
          *(u32x4*)((bf16*)(ws + OFF_WUQKV) + ((size_t)l * 1792 + rr) * 384 + 256 + 8 * cc) = (u32x4){0u, 0u, 0u, 0u}; }
      for (int i = gt; i < 4 * 1024 * 32; i += NT_) { const int l = i / (1024 * 32), q = i % (1024 * 32), rr = q / 32, cc = q % 32;
          *(u32x4*)((bf16*)(ws + OFF_WUQKV) + ((size_t)l * 1792 + 768 + rr) * 384 + 8 * cc) = (u32x4){0u, 0u, 0u, 0u}; } }
    __syncthreads();
    { LAS float* sc = (LAS float*)lds;
      for (int i = tid; i < 5 * 1024; i += NTHR) { const float v = (i < 4096) ? p.in[I_C][i] : p.in[I_CCTX][i - 4096]; sc[i] = v * fsigmoid(v); }
      LAS float* part = (LAS float*)(lds + 32768);
      __syncthreads();
      for (int item = bid; item < 4 * 96; item += G) { const int l = item / 96, cb = item % 96, col = cb * 64 + lane;
          const float* w = p.in[I_WADA] + (size_t)l * 1024 * 6144 + col;
          float a0 = 0.f, a1 = 0.f, a2 = 0.f, a3 = 0.f, a4 = 0.f;
#pragma unroll 8
          for (int k = wid * 128; k < wid * 128 + 128; ++k) { const float wv = w[(size_t)k * 6144];
              a0 += sc[k] * wv; a1 += sc[1024 + k] * wv; a2 += sc[2048 + k] * wv; a3 += sc[3072 + k] * wv; a4 += sc[4096 + k] * wv; }
          LAS float* pp = part + (wid * 64 + lane) * 5; pp[0] = a0; pp[1] = a1; pp[2] = a2; pp[3] = a3; pp[4] = a4;
          __syncthreads();
          if (tid < 320) { const int c = tid % 64, rr = tid / 64; float s = 0.f;
#pragma unroll
              for (int w8 = 0; w8 < 8; ++w8) s += part[(w8 * 64 + c) * 5 + rr];
              ((float*)(ws + OFF_MOD))[((size_t)l * 5 + rr) * 6144 + cb * 64 + c] = s + p.in[I_BADA][l * 6144 + cb * 64 + c]; }
          __syncthreads(); } }
    { LAS float* part = (LAS float*)(lds + 65536);
      LAS unsigned char* t8 = lds;
      constexpr int NI0 = 4 * 174, NI1 = 4 * 128, NI2 = 128 * 64, NI3 = 16 * 32;
      const int n = lane & 31, k2 = lane >> 5;
      for (int item = bid; item < NI3; item += G) { const int c = item >> 5, cb = item & 31, n0 = 32 * cb;
          const float* w = p.in[I_WBO] + (size_t)c * 512 * 1024; float* cmd = (float*)(ws + OFF_CMBO) + (size_t)c * 1024; signed char* dst = (signed char*)(ws + OFF_WBO) + (size_t)c * 1024 * 512;
          float x[8][4]; float m = 0.f;
#pragma unroll
          for (int i = 0; i < 8; ++i)
#pragma unroll
              for (int e = 0; e < 4; ++e) { x[i][e] = w[(size_t)(64 * i + 8 * wid + 4 * k2 + e) * 1024 + n0 + n]; m = fmaxf(m, fabsf(x[i][e])); }
          part[(wid * 2 + k2) * 32 + n] = m;
          __syncthreads();
          if (tid < 32) { float mm = part[tid];
#pragma unroll
              for (int q = 1; q < 16; ++q) mm = fmaxf(mm, part[q * 32 + tid]);
              part[512 + tid] = mm; cmd[n0 + tid] = mm; }
          __syncthreads();
          { const float cm = part[512 + n], inv = cm > 0.f ? 127.0f / cm : 0.f;
#pragma unroll
            for (int i = 0; i < 8; ++i) *(LAS unsigned*)(t8 + n * 516 + 64 * i + 8 * wid + 4 * k2) = q8x4((f32x4){x[i][0], x[i][1], x[i][2], x[i][3]} * inv); }
          __syncthreads();
#pragma unroll
          for (int q = 0; q < 2; ++q) { const int ch = tid + 512 * q, rr = ch >> 5, cc = ch & 31; const LAS unsigned* s = (const LAS unsigned*)(t8 + rr * 516 + 16 * cc);
              *(u32x4*)(dst + (size_t)(n0 + rr) * 512 + 16 * cc) = (u32x4){s[0], s[1], s[2], s[3]}; }
          __syncthreads(); }
      for (int item = bid; item < NI0 + NI1 + NI2; item += G) {
          const float* w; int N, n0; float* cmd; signed char* dst; int drow0;
          if (item < NI0) { const int l = item / 174, cb = item % 174; N = DIN; n0 = 32 * cb; w = p.in[I_WIN] + (size_t)l * 1024 * DIN; drow0 = n0; cmd = (float*)(ws + OFF_CMIN) + (size_t)l * NIN; dst = (signed char*)(ws + OFF_WIN) + (size_t)l * NIN * 1024; }
          else if (item < NI0 + NI1) { const int r = item - NI0, l = r / 128, cb = r % 128; N = NGATE; n0 = 32 * cb; w = p.in[I_WMG] + (size_t)l * 1024 * NGATE; drow0 = LDP + n0; cmd = (float*)(ws + OFF_CMIN) + (size_t)l * NIN; dst = (signed char*)(ws + OFF_WIN) + (size_t)l * NIN * 1024; }
          else { const int r = item - NI0 - NI1, c = r / 64, cb = r % 64; N = 2048; n0 = 32 * cb; w = p.in[I_WGU] + (size_t)c * 1024 * 2048; const int j = n0 & 1023; drow0 = (j >> 7) * 256 + ((n0 >= 1024) ? 128 : 0) + (j & 127);
                 cmd = (float*)(ws + OFF_CMGU) + (size_t)c * 2048; dst = (signed char*)(ws + OFF_WGU) + (size_t)c * 2048 * 1024; }
          float x[16][4]; float m = 0.f;
#pragma unroll
          for (int i = 0; i < 16; ++i)
#pragma unroll
              for (int e = 0; e < 4; ++e) { x[i][e] = w[(size_t)(64 * i + 8 * wid + 4 * k2 + e) * N + n0 + n]; }
#pragma unroll
          for (int i = 0; i < 16; ++i)
#pragma unroll
              for (int e = 0; e < 4; ++e) m = fmaxf(m, fabsf(x[i][e]));
          part[(wid * 2 + k2) * 32 + n] = m;
          __syncthreads();
          if (tid < 32) { float mm = part[tid];
#pragma unroll
              for (int q = 1; q < 16; ++q) mm = fmaxf(mm, part[q * 32 + tid]);
              part[512 + tid] = mm; cmd[drow0 + tid] = mm; }
          __syncthreads();
          { const float cm = part[512 + n], inv = cm > 0.f ? 127.0f / cm : 0.f;
#pragma unroll
            for (int i = 0; i < 16; ++i) *(LAS unsigned*)(t8 + n * 1028 + 64 * i + 8 * wid + 4 * k2) = q8x4((f32x4){x[i][0], x[i][1], x[i][2], x[i][3]} * inv); }
          __syncthreads();
#pragma unroll
          for (int q = 0; q < 4; ++q) { const int ch = tid + 512 * q, rr = ch >> 6, cc = ch & 63; const LAS unsigned* s = (const LAS unsigned*)(t8 + rr * 1028 + 16 * cc);
              *(u32x4*)(dst + (size_t)(drow0 + rr) * 1024 + 16 * cc) = (u32x4){s[0], s[1], s[2], s[3]}; }
          __syncthreads(); } }
}

__device__ __forceinline__ int tok_mv(int tk) { const int b = tk / TB, s = tk - b * TB; return s < CTX ? 4 : b; }
template <int MODE>
__device__ __forceinline__ void phase_norm1(const PView& p, int l, int bid, int G, bool dummy = false) {
    const int tid = ltid(), wid = __builtin_amdgcn_readfirstlane(tid >> 6), lane = tid & 63;
    unsigned char* ws = p.ws;
    float* X = (float*)(ws + OFF_X); signed char* H8 = (signed char*)(ws + OFF_H); float* SH = (float*)(ws + OFF_SH);
    float* Xw = dummy ? (float*)(ws + OFF_GF) : X;
    const float* MOD = (const float*)(ws + OFF_MOD);
    const bf16* YS = (const bf16*)(ws + OFF_R3);
    const float* TW = (const float*)(ws + OFF_TOPW); const int* SL = (const int*)(ws + OFF_SLOT);
    for (int tp = bid * NWAVES + wid; tp < T / 2; tp += G * NWAVES) {
        const int tk0 = 2 * tp, b = tk0 / TB, s = tk0 - b * TB, mv = s < CTX ? 4 : b;
        if (MODE == 2 && s < CTX) continue;
        f32x4 v[2][4];
        if (l == 0) { const float* src = (s < CTX) ? p.in[I_CTX] + ((size_t)b * CTX + s) * D : p.in[I_X] + ((size_t)b * SEQ + (s - CTX)) * D;
#pragma unroll
            for (int u = 0; u < 2; ++u)
#pragma unroll
                for (int j = 0; j < 4; ++j) v[u][j] = *(const f32x4*)(src + u * D + 256 * j + 4 * lane);
        } else {
            float w[2][4]; int sl[2][4];
#pragma unroll
            for (int u = 0; u < 2; ++u)
#pragma unroll
                for (int k = 0; k < 4; ++k) { w[u][k] = TW[(tk0 + u) * 4 + k]; sl[u][k] = SL[(tk0 + u) * 4 + k]; }
#pragma unroll
            for (int u = 0; u < 2; ++u)
#pragma unroll
                for (int j = 0; j < 4; ++j) v[u][j] = *(const f32x4*)(X + (size_t)(tk0 + u) * D + 256 * j + 4 * lane);
            u32x2 y[2][4][4];
#pragma unroll
            for (int u = 0; u < 2; ++u)
#pragma unroll
                for (int k = 0; k < 4; ++k)
#pragma unroll
                    for (int j = 0; j < 4; ++j) y[u][k][j] = *(const u32x2*)(YS + (size_t)sl[u][k] * D + 256 * j + 4 * lane);
            const float* g2 = MOD + ((size_t)(l - 1) * 5 + mv) * 6144 + 5120;
#pragma unroll
            for (int j = 0; j < 4; ++j) { const f32x4 g2v = *(const f32x4*)(g2 + 256 * j + 4 * lane);
#pragma unroll
                for (int u = 0; u < 2; ++u) { f32x4 f = (f32x4){0.f, 0.f, 0.f, 0.f};
#pragma unroll
                    for (int k = 0; k < 4; ++k) f += w[u][k] * (f32x4){bflo(y[u][k][j].x), bfhi(y[u][k][j].x), bflo(y[u][k][j].y), bfhi(y[u][k][j].y)};
                    v[u][j] += g2v * f; } }
        }
        if (MODE != 2) {
#pragma unroll
            for (int u = 0; u < 2; ++u)
#pragma unroll
                for (int j = 0; j < 4; ++j) *(f32x4*)(Xw + (size_t)(tk0 + u) * D + 256 * j + 4 * lane) = v[u][j];
        }
        float rstd[2];
#pragma unroll
        for (int u = 0; u < 2; ++u) { float ss = 0.f;
#pragma unroll
            for (int j = 0; j < 4; ++j) ss += v[u][j].x * v[u][j].x + v[u][j].y * v[u][j].y + v[u][j].z * v[u][j].z + v[u][j].w * v[u][j].w;
            rstd[u] = __builtin_amdgcn_rsqf(wave_sum(ss) * (1.f / D) + 1e-6f); }
        if (MODE == 2) {
            float* o = p.out + ((size_t)b * SEQ + (s - CTX)) * D;
#pragma unroll
            for (int j = 0; j < 4; ++j) { const f32x4 g = *(const f32x4*)(p.in[I_FG] + 256 * j + 4 * lane);
#pragma unroll
                for (int u = 0; u < 2; ++u) *(f32x4*)(o + u * D + 256 * j + 4 * lane) = v[u][j] * rstd[u] * g; }
        } else {
            const float* ng = p.in[I_N1G] + l * D; const float* md = MOD + ((size_t)l * 5 + mv) * 6144;
            float am[2] = {0.f, 0.f};
#pragma unroll
            for (int j = 0; j < 4; ++j) { const int c = 256 * j + 4 * lane; const f32x4 g = *(const f32x4*)(ng + c), sh = *(const f32x4*)(md + c), sc = *(const f32x4*)(md + 1024 + c);
#pragma unroll
                for (int u = 0; u < 2; ++u) { v[u][j] = v[u][j] * rstd[u] * g * (sc + 1.0f) + sh;
                    am[u] = fmaxf(am[u], fmaxf(fmaxf(fabsf(v[u][j].x), fabsf(v[u][j].y)), fmaxf(fabsf(v[u][j].z), fabsf(v[u][j].w)))); } }
#pragma unroll
            for (int u = 0; u < 2; ++u) { const float amax = wave_max(am[u]), inv = amax > 0.f ? 127.0f / amax : 0.f;
                if (lane == 0) SH[tk0 + u] = amax * (1.0f / 127.0f);
#pragma unroll
                for (int j = 0; j < 4; ++j) *(unsigned*)(H8 + (size_t)(tk0 + u) * D + 256 * j + 4 * lane) = q8x4(v[u][j] * inv); }
        }
    }
}

__device__ __forceinline__ void phase_router(const PView& p, int l, LAS unsigned char* lds, int bid, int G, bool dummy = false) {
    const int tid = ltid(), wid = __builtin_amdgcn_readfirstlane(tid >> 6), lane = tid & 63;
    unsigned char* ws = p.ws;
    const float* X = (const float*)(ws + OFF_X); signed char* H8 = (signed char*)(ws + OFF_H); float* SH = (float*)(ws + OFF_SH);
    const float* MOD = (const float*)(ws + OFF_MOD);
    float* TW = (float*)(ws + OFF_TOPW); int* TE = (int*)(ws + OFF_TOPE); int* PS = (int*)(ws + OFF_POS);
    unsigned* gcnt = (unsigned*)(ws + OFF_CTL) + CW_CNT + l * 32 + (dummy ? 1024 : 0);
    LAS float* rw = (LAS float*)lds;
    LAS int* hist = (LAS int*)(lds + MISC_OFF + 64);
    LAS int* base = hist + 32;
    LAS int* lrec = base + 32;
    { const float* rg = p.in[I_RW] + (size_t)l * 1024 * 32;
      for (int i = tid; i < 1024 * 32; i += NTHR) rw[(i & 31) * 1024 + (i >> 5)] = rg[i]; }
    constexpr int TPB = 132;
    for (int item = bid; item < T / TPB; item += G) {
        if (tid < 32) hist[tid] = 0;
        __syncthreads();
        for (int tp = wid; tp < TPB / 2; tp += NWAVES) {
            const int ti0 = 2 * tp, tk0 = item * TPB + ti0, mv = tok_mv(tk0);
            f32x4 hv[2][4];
            const float* ng = p.in[I_N2G] + l * D; const float* md = MOD + ((size_t)l * 5 + mv) * 6144;
#pragma unroll
            for (int t2 = 0; t2 < 2; ++t2) { const int tk = tk0 + t2;
                f32x4 v[4]; float ss = 0.f;
#pragma unroll
                for (int j = 0; j < 4; ++j) { v[j] = *(const f32x4*)(X + (size_t)tk * D + 256 * j + 4 * lane); ss += v[j].x * v[j].x + v[j].y * v[j].y + v[j].z * v[j].z + v[j].w * v[j].w; }
                const float rstd = __builtin_amdgcn_rsqf(wave_sum(ss) * (1.f / D) + 1e-6f);
                float am = 0.f;
#pragma unroll
                for (int j = 0; j < 4; ++j) { const int c = 256 * j + 4 * lane; const f32x4 g = *(const f32x4*)(ng + c), sh = *(const f32x4*)(md + 3072 + c), sc = *(const f32x4*)(md + 4096 + c);
                    hv[t2][j] = v[j] * rstd * g * (sc + 1.0f) + sh;
                    am = fmaxf(am, fmaxf(fmaxf(fabsf(hv[t2][j].x), fabsf(hv[t2][j].y)), fmaxf(fabsf(hv[t2][j].z), fabsf(hv[t2][j].w)))); }
                { const float amax = wave_max(am), inv = amax > 0.f ? 127.0f / amax : 0.f;
                  if (lane == 0) SH[tk] = amax * (1.0f / 127.0f);
#pragma unroll
                  for (int j = 0; j < 4; ++j) *(unsigned*)(H8 + (size_t)tk * D + 256 * j + 4 * lane) = q8x4(hv[t2][j] * inv); }
                }
            float A16[2][16];
#pragma unroll
            for (int cq = 0; cq < 4; ++cq) { float acc[2][8];
#pragma unroll
                for (int q = 0; q < 8; ++q) { acc[0][q] = 0.f; acc[1][q] = 0.f; }
#pragma unroll
                for (int j = 0; j < 4; ++j) { const int c = 256 * j + 4 * lane;
#pragma unroll
                    for (int q = 0; q < 8; ++q) { const int e = 4 * cq + (q & 3) + 16 * (q >> 2); const f32x4 w = *(const LAS f32x4*)(rw + e * 1024 + c);
                        acc[0][q] += hv[0][j].x * w.x + hv[0][j].y * w.y + hv[0][j].z * w.z + hv[0][j].w * w.w;
                        acc[1][q] += hv[1][j].x * w.x + hv[1][j].y * w.y + hv[1][j].z * w.z + hv[1][j].w * w.w; } }
#pragma unroll
                for (int t2 = 0; t2 < 2; ++t2)
#pragma unroll
                    for (int q = 0; q < 4; ++q) { auto rr = __builtin_amdgcn_permlane32_swap(__float_as_uint(acc[t2][q]), __float_as_uint(acc[t2][q + 4]), false, false); A16[t2][4 * cq + q] = __uint_as_float(rr[0]) + __uint_as_float(rr[1]); }
                asm volatile("" ::: "memory"); }
            const int myE = lane >> 1; const float rbias = p.in[I_RB][l * 32 + myE];
            const bool b3 = (lane & 8) != 0, b2 = (lane & 4) != 0, b1 = (lane & 2) != 0;
#pragma unroll
            for (int t2 = 0; t2 < 2; ++t2) {
                float B8[8], C4[4], D2[2];
#pragma unroll
                for (int e = 0; e < 8; ++e) { auto rr = __builtin_amdgcn_permlane16_swap(__float_as_uint(A16[t2][e]), __float_as_uint(A16[t2][e + 8]), false, false); B8[e] = __uint_as_float(rr[0]) + __uint_as_float(rr[1]); }
#pragma unroll
                for (int e = 0; e < 4; ++e) { const float keep = b3 ? B8[e + 4] : B8[e], send = b3 ? B8[e] : B8[e + 4]; C4[e] = keep + dppf<0x140>(send); }
#pragma unroll
                for (int e = 0; e < 2; ++e) { const float keep = b2 ? C4[e + 2] : C4[e], send = b2 ? C4[e] : C4[e + 2]; D2[e] = keep + dppf<0x141>(send); }
                float v; { const float keep = b1 ? D2[1] : D2[0], send = b1 ? D2[0] : D2[1]; v = keep + dppf<0x1B>(send); }
                v += dppf<0xB1>(v); v += rbias;
                int cnt = 0;
#pragma unroll
                for (int e = 0; e < 32; ++e) { const float s = __int_as_float(__builtin_amdgcn_readlane(__float_as_int(v), 2 * e)); cnt += ((s > v) || (s == v && e < myE)) ? 1 : 0; }
                const bool sel = (cnt < 4) && ((lane & 1) == 0);
                const unsigned long long top = __ballot(sel && cnt == 0);
                const float m0 = __int_as_float(__builtin_amdgcn_readlane(__float_as_int(v), (int)__builtin_ctzll(top)));
                const float ex = sel ? fexp(v - m0) : 0.f;
                float tot = row16_sum(ex); { auto rr = __builtin_amdgcn_permlane16_swap(__float_as_uint(tot), __float_as_uint(tot), false, false); tot = __uint_as_float(rr[0]) + __uint_as_float(rr[1]); }
                { auto rr = __builtin_amdgcn_permlane32_swap(__float_as_uint(tot), __float_as_uint(tot), false, false); tot = __uint_as_float(rr[0]) + __uint_as_float(rr[1]); }
                if (sel) { const int tk = tk0 + t2, ti = ti0 + t2;
                    TW[tk * 4 + cnt] = ex / tot; TE[tk * 4 + cnt] = myE;
                    const int rk = atomicAdd((int*)&hist[myE], 1); lrec[ti * 4 + cnt] = (myE << 16) | rk; }
            }
        }
        __syncthreads();
        if (tid < 32) base[tid] = (int)__hip_atomic_fetch_add(gcnt + tid, (unsigned)hist[tid], __ATOMIC_RELAXED, __HIP_MEMORY_SCOPE_AGENT);
        __syncthreads();
        for (int i = tid; i < TPB * 4; i += NTHR) { const int rec = lrec[i]; PS[(size_t)item * TPB * 4 + i] = base[rec >> 16] + (rec & 0xffff); }
        __syncthreads();
    }
}

__device__ __forceinline__ void phase_gather(const PView& p, int l, LAS unsigned char* lds, int bid, int G) {
    const int tid = ltid(), wid = __builtin_amdgcn_readfirstlane(tid >> 6), lane = tid & 63;
    unsigned char* ws = p.ws;
    const unsigned* gcnt = (const unsigned*)(ws + OFF_CTL) + CW_CNT + l * 32;
    int* tst = (int*)(ws + OFF_CTL) + CW_TST + l * 64;
    LAS int* off = (LAS int*)(lds + MISC_OFF + 64);
    if (tid == 0) { int acc = 0; for (int e = 0; e < 32; ++e) { off[e] = acc * 256; if (bid == 0) tst[e] = acc; acc += ((int)gcnt[e] + 255) >> 8; } if (bid == 0) tst[32] = acc; }
    __syncthreads();
    const signed char* H8 = (const signed char*)(ws + OFF_H); signed char* XG = (signed char*)(ws + OFF_R1); const float* SH = (const float*)(ws + OFF_SH); float* SX = (float*)(ws + OFF_SX);
    const int* TE = (const int*)(ws + OFF_TOPE); const int* PS = (const int*)(ws + OFF_POS); int* SL = (int*)(ws + OFF_SLOT);
    for (int tk = bid * NWAVES + wid; tk < T; tk += G * NWAVES) {
        int dst[4];
#pragma unroll
        for (int k = 0; k < 4; ++k) dst[k] = off[TE[tk * 4 + k]] + PS[tk * 4 + k];
        const u32x4 r0 = ((const u32x4*)(H8 + (size_t)tk * D))[lane]; const float sc = SH[tk];
        if (lane < 4) { const int d = dst[0] * (lane == 0) + dst[1] * (lane == 1) + dst[2] * (lane == 2) + dst[3] * (lane == 3); SL[tk * 4 + lane] = d; SX[d] = sc; }
#pragma unroll
        for (int k = 0; k < 4; ++k) ((u32x4*)(XG + (size_t)dst[k] * D))[lane] = r0;
    }
}

template <class SrcFn>
__device__ __forceinline__ void transpose64x128(LAS unsigned char* lds, int tid, SrcFn srcp, bf16* dst_hd0  ) {
    LAS bf16* tl = (LAS bf16*)lds;
#pragma unroll
    for (int q = 0; q < 2; ++q) { const int ch = tid + 512 * q, ti = ch >> 4, cc = ch & 15; *(LAS u32x4*)(tl + ti * 136 + 8 * cc) = *(const u32x4*)srcp(ti, cc); }
    __syncthreads();
#pragma unroll
    for (int q = 0; q < 2; ++q) { const int hd = tid & 127, c8 = (tid >> 7) + 4 * q; unsigned w[4];
#pragma unroll
        for (int e = 0; e < 4; ++e) { const unsigned lo = tl[(8 * c8 + 2 * e) * 136 + hd], hi = tl[(8 * c8 + 2 * e + 1) * 136 + hd]; w[e] = lo | (hi << 16); }
        *(u32x4*)(dst_hd0 + (size_t)hd * TB + 8 * c8) = (u32x4){w[0], w[1], w[2], w[3]}; }
    __syncthreads();
}
template <class SrcFn>
__device__ __forceinline__ void transpose64x128_f8(LAS unsigned char* lds, int tid, SrcFn srcp, unsigned char* dst_hd0) {
    LAS bf16* tl = (LAS bf16*)lds;
#pragma unroll
    for (int q = 0; q < 2; ++q) { const int ch = tid + 512 * q, ti = ch >> 4, cc = ch & 15; *(LAS u32x4*)(tl + ti * 136 + 8 * cc) = *(const u32x4*)srcp(ti, cc); }
    __syncthreads();
    { const int hd = tid & 127, c4 = tid >> 7; int w[4] = {0, 0, 0, 0};
#pragma unroll
      for (int q = 0; q < 4; ++q) { const float x0 = bf2f(tl[(16 * c4 + 4 * q) * 136 + hd]), x1 = bf2f(tl[(16 * c4 + 4 * q + 1) * 136 + hd]), x2 = bf2f(tl[(16 * c4 + 4 * q + 2) * 136 + hd]), x3 = bf2f(tl[(16 * c4 + 4 * q + 3) * 136 + hd]);
          w[q] = __builtin_amdgcn_cvt_pk_fp8_f32(x0, x1, w[q], false); w[q] = __builtin_amdgcn_cvt_pk_fp8_f32(x2, x3, w[q], true); }
      *(u32x4*)(dst_hd0 + (size_t)hd * TB + 16 * c4) = (u32x4){(unsigned)w[0], (unsigned)w[1], (unsigned)w[2], (unsigned)w[3]}; }
    __syncthreads();
}
__device__ __forceinline__ void phase_prep(const PView& p, int l, LAS unsigned char* lds, int bid, int G) {
    const int tid = ltid(), wid = __builtin_amdgcn_readfirstlane(tid >> 6), lane = tid & 63;
    unsigned char* ws = p.ws;
    const bf16* P = (const bf16*)(ws + OFF_R1);
    bf16* GQ = (bf16*)(ws + OFF_GQKV); const float* GT = (const float*)(ws + OFF_GATES);
    bf16* AQ = (bf16*)(ws + OFF_AQ); bf16* VTN = (bf16*)(ws + OFF_VTN);
    const float* cw = p.in[I_CONVW] + (size_t)l * 3 * 1536;
    { const int NT_ = G * NTHR, NCH = T * 192;
      for (int ch0 = bid * NTHR + tid; ch0 < NCH; ch0 += 4 * NT_) {
          u32x4 r0[4], rm[4], rp[4];
#pragma unroll
          for (int u = 0; u < 4; ++u) { const int ch = ch0 + u * NT_;
              if (ch < NCH) { const int tk = ch / 192, cc = ch - tk * 192, b = tk / TB, s = tk - b * TB; const bool c_ = s < CTX; const int lo = c_ ? 0 : CTX, hi = c_ ? CTX : TB;
                  const bf16* pr = P + (size_t)tk * LDP + PC_GQKV + 8 * cc;
                  r0[u] = *(const u32x4*)pr;
                  rm[u] = (s - 1 >= lo) ? *(const u32x4*)(pr - LDP) : (u32x4){0u, 0u, 0u, 0u};
                  rp[u] = (s + 1 < hi) ? *(const u32x4*)(pr + LDP) : (u32x4){0u, 0u, 0u, 0u}; } }
#pragma unroll
          for (int u = 0; u < 4; ++u) { const int ch = ch0 + u * NT_;
              if (ch < NCH) { const int tk = ch / 192, cc = ch - tk * 192;
                  float xm[8], x0[8], xp[8]; unpack8(r0[u], x0); unpack8(rm[u], xm); unpack8(rp[u], xp);
                  float y[8]; float ss = 0.f;
#pragma unroll
                  for (int i = 0; i < 8; ++i) { const int c = 8 * cc + i; const float z = xm[i] * cw[c] + x0[i] * cw[1536 + c] + xp[i] * cw[3072 + c]; y[i] = z * fsigmoid(z); ss += y[i] * y[i]; }
                  ss = row16_sum(ss);
                  if (cc < 128) { const float sc = __builtin_amdgcn_rsqf(ss + 1e-6f) * ((cc < 64) ? 0.08838834764831845f : 1.0f);
#pragma unroll
                      for (int i = 0; i < 8; ++i) y[i] *= sc; }
                  *(u32x4*)(GQ + (size_t)tk * 1536 + 8 * cc) = pack8(y); } } } }
    { float* GC = (float*)(ws + OFF_GC); float* MC = (float*)(ws + OFF_MC);
      for (int it = (wid * 64 + lane) * G + bid; it < (T / 64) * 16; it += G * NTHR) {
          const int tile = it >> 4, sq = it & 15, dh = sq & 7, d = dh >> 2, hh = dh & 3, tk0 = tile * 64;
          const bool isg = sq < 8;
          const float c0_ = isg ? p.in[I_DTB][l * 8 + dh] : p.in[I_BIF][((l * 2 + d) * 2 + 1) * 4 + hh];
          const float c1_ = isg ? -__expf(p.in[I_ALOG][l * 8 + dh]) : p.in[I_BIF][((l * 2 + d) * 2 + 0) * 4 + hh];
          float run = 0.f;
#pragma unroll 8
          for (int n = 0; n < 64; ++n) { const int tk = tk0 + (d ? 63 - n : n); const float* g = GT + (size_t)tk * 32;
              if (isg) { const float a = g[dh] + c0_; const float sp = (a > 20.f) ? a : __logf(1.0f + __expf(a)); run += c1_ * sp;
                  GC[(size_t)tk * 24 + dh] = run; GC[(size_t)tk * 24 + 8 + dh] = fsigmoid(g[8 + dh]); }
              else { const float y = -(g[24 + dh] + c0_); run -= (y > 20.f) ? y : __logf(1.0f + __expf(y));
                  MC[(size_t)tk * 16 + dh] = run; MC[(size_t)tk * 16 + 8 + dh] = g[16 + dh] + c1_; } } } }
    for (int tk = bid * NWAVES + wid; tk < T; tk += G * NWAVES) {
        float x[8]; float ss = 0.f;
        if (lane < 48) { unpack8(*(const u32x4*)(P + (size_t)tk * LDP + PC_MQ + 8 * lane), x); for (int i = 0; i < 8; ++i) ss += x[i] * x[i]; }
        else { for (int i = 0; i < 8; ++i) x[i] = 0.f; }
        ss = row16_sum(ss); { auto rr = __builtin_amdgcn_permlane16_swap(__float_as_uint(ss), __float_as_uint(ss), false, false); ss = __uint_as_float(rr[0]) + __uint_as_float(rr[1]); }
        if (lane < 48) { const bool isq = lane < 32; const float rs = __builtin_amdgcn_rsqf(ss * (isq ? (1.f / 256.f) : (1.f / 128.f)) + 1e-6f);
            const float* g = isq ? p.in[I_MQG] + l * 256 + 8 * lane : p.in[I_MKVG] + l * 128 + 8 * (lane - 32);
#pragma unroll
            for (int i = 0; i < 8; ++i) x[i] *= rs * g[i];
            *(u32x4*)(AQ + (size_t)tk * 384 + 8 * lane) = pack8(x); } }
    for (int it = bid; it < (T / 64) * 4; it += G) { const int tile = it >> 2, hp = it & 3, tk0 = tile * 64, b = tk0 / TB, s0 = tk0 - b * TB;
        transpose64x128(lds, tid, [&](int ti, int cc) { return P + (size_t)(tk0 + ti) * LDP + PC_NAV + hp * 128 + 8 * cc; }, VTN + ((size_t)b * 512 + hp * 128) * TB + s0); }
}

__device__ __forceinline__ void rope16(float (&x)[16], float pos) {
#pragma unroll
    for (int i = 0; i < 8; ++i) { const float inv = fexp2(-1.6609640474436813f * (float)i);
        const float rev = pos * inv * 0.15915494309189535f; const float fr = rev - floorf(rev);
        const float sn = __builtin_amdgcn_sinf(fr), cs = __builtin_amdgcn_cosf(fr);
        const float a = x[i], bb = x[i + 8]; x[i] = a * cs - bb * sn; x[i + 8] = bb * cs + a * sn; }
}
__device__ __forceinline__ void phase_mlapost(const PView& p, int l, LAS unsigned char* lds, int bid, int G, bool dummy = false) {
    const int tid = ltid();
    unsigned char* ws = p.ws;
    const bf16* P = (const bf16*)(ws + OFF_R1); const bf16* QR = (const bf16*)(ws + OFF_QKVR); bf16* VTM = (bf16*)(ws + OFF_VTM);
    const int gt = bid * NTHR + tid, NT_ = G * NTHR;
    unsigned char* QM8 = ws + OFF_QM8; unsigned char* KM8 = ws + OFF_KM; (void)dummy;
    for (int it = gt; it < T * 8 * 16; it += NT_) { const int c = it & 7, isk = (it >> 3) & 1, hh = (it >> 4) & 7, tk = it >> 7, b = tk / TB, s = tk - b * TB;
        unsigned char* dst = isk ? KM8 + ((((size_t)b * 8 + hh) * TB + s) * 128 + 16 * c) : QM8 + (((size_t)tk * 8 + hh) * 128 + 16 * c);
        if (c >= 6) { *(u32x4*)dst = (u32x4){0u, 0u, 0u, 0u}; continue; }
        const bf16* sp;
        if (c < 4) sp = isk ? QR + (size_t)tk * 1792 + 768 + hh * 128 + 16 * c : QR + (size_t)tk * 1792 + hh * 96 + 16 * c;
        else sp = isk ? P + (size_t)tk * LDP + PC_MKPE + 16 * (c - 4) : QR + (size_t)tk * 1792 + hh * 96 + 64 + 16 * (c - 4);
        float x[16]; { float a8[8], c8[8]; unpack8(*(const u32x4*)sp, a8); unpack8(*(const u32x4*)(sp + 8), c8); for (int i = 0; i < 8; ++i) { x[i] = a8[i]; x[8 + i] = c8[i]; } }
        if (c >= 4 && s >= CTX) { const int t = s - CTX; rope16(x, (float)(c == 4 ? (t >> 6) : (t & 63))); }
        int w[4] = {0, 0, 0, 0};
#pragma unroll
        for (int q = 0; q < 4; ++q) { w[q] = __builtin_amdgcn_cvt_pk_fp8_f32(x[4 * q], x[4 * q + 1], w[q], false); w[q] = __builtin_amdgcn_cvt_pk_fp8_f32(x[4 * q + 2], x[4 * q + 3], w[q], true); }
        *(u32x4*)dst = (u32x4){(unsigned)w[0], (unsigned)w[1], (unsigned)w[2], (unsigned)w[3]}; }
    for (int it = bid; it < (T / 64) * 4; it += G) { const int tile = it >> 2, hp = it & 3, tk0 = tile * 64, b = tk0 / TB, s0 = tk0 - b * TB;
        transpose64x128_f8(lds, tid, [&](int ti, int cc) { return QR + (size_t)(tk0 + ti) * 1792 + 768 + (2 * hp + (cc >> 3)) * 128 + 64 + 8 * (cc & 7); }, (unsigned char*)VTM + ((size_t)b * 512 + hp * 128) * TB + s0); }
}

__device__ __forceinline__ void phase_attn(const PView& p, int l, LAS unsigned char* lds, int bid, int G) {
    const int tid = ltid(), wid = __builtin_amdgcn_readfirstlane(tid >> 6), lane = tid & 63;
    unsigned char* ws = p.ws;
    const bf16* P = (const bf16*)(ws + OFF_R1); const unsigned char* QM8 = ws + OFF_QM8; const unsigned char* KM8 = ws + OFF_KM;
    const bf16* VTM = (const bf16*)(ws + OFF_VTM); const bf16* VTN = (const bf16*)(ws + OFF_VTN); bf16* Y = (bf16*)(ws + OFF_Y);
    LAS float* btab = (LAS float*)(lds + 90112);
    for (int i = tid; i < 8 * 465; i += NTHR) btab[i] = p.in[I_RPB][(size_t)l * 8 * 465 + i] * 1.4426950408889634f;
    __syncthreads();
    const float c_mla = 0.10206207261596577f * 1.4426950408889634f, c_na = 0.125f * 1.4426950408889634f;
    for (int u = bid; u < 2112; u += G) {
        AttnJob J; J.bias = btab; J.kr_lo = 0; J.r_w = 0; J.c_q = 0; J.s0_first_n = 1 << 30; J.s0_jump = 0;
        if (u < 1024) {
            const int b = u >> 8, hh = u & 7, qb = (u >> 3) & 31; const size_t tq = (size_t)b * TB + CTX + qb * 256;
            J.Q = (const bf16*)(QM8 + (tq * 8 + hh) * 128); J.qpitch = 1024; J.K = (const bf16*)(KM8 + ((size_t)b * 8 + hh) * TB * 128); J.kpitch = 128; J.VT = (const bf16*)((const unsigned char*)VTM + ((size_t)b * 8 + hh) * 64 * TB);
            J.O = Y + tq * 2048 + 1024 + hh * 64; J.opitch = 2048; J.ntiles = TB / 64; J.c = c_mla;
            attn_unit_dense<96>(lds, J);
        } else if (u < 2048) {
            const int v = u - 1024, b = v >> 8, hh = v & 7, rq = (v >> 3) & 31; const size_t tq = (size_t)b * TB + CTX + rq * 256;
            const int kr_lo = min(max(4 * rq - 4, 0), 120), kr_hi = min(max(4 * rq + 3 - 4, 0), 120) + 7;
            J.Q = P + tq * LDP + PC_NAQ + hh * 64; J.qpitch = LDP; J.K = P + (size_t)b * TB * LDP + PC_NAK + hh * 64; J.kpitch = LDP; J.VT = VTN + ((size_t)b * 8 + hh) * 64 * TB;
            J.O = Y + tq * 2048 + hh * 64; J.opitch = 2048; J.ntiles = 4 + (kr_hi - kr_lo + 1); J.c = c_na;
            J.s0_first_n = 4; J.s0_jump = CTX + kr_lo * 64; J.kr_lo = kr_lo; J.r_w = 4 * rq + (wid >> 1); J.c_q = 32 * (wid & 1) + (lane & 31); J.bias = btab + hh * 465;
            for (int rp = 0; rp < NREP(55); ++rp) attn_unit<64, true>(lds, J);
        } else if (u < 2080) {
            const int v = u - 2048, b = v >> 3, hh = v & 7; const size_t tq = (size_t)b * TB;
            J.Q = (const bf16*)(QM8 + (tq * 8 + hh) * 128); J.qpitch = 1024; J.K = (const bf16*)(KM8 + ((size_t)b * 8 + hh) * TB * 128); J.kpitch = 128; J.VT = (const bf16*)((const unsigned char*)VTM + ((size_t)b * 8 + hh) * 64 * TB);
            J.O = Y + tq * 2048 + 1024 + hh * 64; J.opitch = 2048; J.ntiles = 4; J.c = c_mla;
            attn_unit_dense<96>(lds, J);
        } else {
            const int v = u - 2080, b = v >> 3, hh = v & 7; const size_t tq = (size_t)b * TB;
            J.Q = P + tq * LDP + PC_NAQ + hh * 64; J.qpitch = LDP; J.K = P + (size_t)b * TB * LDP + PC_NAK + hh * 64; J.kpitch = LDP; J.VT = VTN + ((size_t)b * 8 + hh) * 64 * TB;
            J.O = Y + tq * 2048 + hh * 64; J.opitch = 2048; J.ntiles = 4; J.c = c_na;
            attn_unit<64, false>(lds, J);
        }
    }
}


__device__ __forceinline__ unsigned lds_u16(const LAS unsigned char* p) { return (unsigned)*(const LAS unsigned short*)p; }
__device__ __forceinline__ void mlstm_chunk_item(const PView& p, LAS unsigned char* lds, int chain, int vq) {
    const int tid = ltid(), wid = __builtin_amdgcn_readfirstlane(tid >> 6), lane = tid & 63, r = lane & 31, h = lane >> 5;
    const int b = chain >> 3, hh = (chain >> 1) & 3, dir = chain & 1, dh = dir * 4 + hh;
    unsigned char* ws = p.ws;
    const bf16* P = (const bf16*)(ws + OFF_R1); const float* MC = (const float*)(ws + OFF_MC);
    float* OM = (float*)(ws + OFF_OML) + (size_t)dir * T * 512;
    constexpr int KT = 0, QT = 9216, VT_ = 18432, FC = 23552, AO_ = FC + 256, BO_ = AO_ + 256, CHB = 24576;
    constexpr int CBO = 2 * CHB, CBS = 4608, NSO = CBO + 2 * CBS;
    for (int i = tid; i < (2 * CBS + 512) / 4; i += NTHR) ((LAS unsigned*)(lds + CBO))[i] = 0u;
    f32x16 cacc;
#pragma unroll
    for (int i = 0; i < 16; ++i) cacc[i] = 0.f;
    const int srow = tid >> 3, sc8 = tid & 7, vrow = tid >> 2, vc = tid & 3;
    struct Stg { u32x4 k, q, v; float fc, ip, fm, vfc, vip; };
    Stg sA, sB; sA.fc = sA.ip = sA.fm = sA.vfc = sA.vip = 0.f; sB = sA;
    auto s0_of = [&](int c) { return (dir == 0) ? 64 * c : (c < 4 ? 192 - 64 * c : TB - 64 - 64 * (c - 4)); };
    auto gload = [&](Stg& g, int c) { const size_t tk0 = (size_t)b * TB + s0_of(c);
        const size_t tkr = tk0 + (dir ? 63 - srow : srow);
        g.k = *(const u32x4*)(P + tkr * LDP + PC_LK + hh * 64 + 8 * sc8); g.q = *(const u32x4*)(P + tkr * LDP + PC_LQ + hh * 64 + 8 * sc8);
        g.fm = MC[(tk0 + (dir ? 32 : 31)) * 16 + dh];
        if (tid < 256) { const size_t tkv = tk0 + (dir ? 63 - vrow : vrow); g.v = *(const u32x4*)(P + tkv * LDP + PC_LV + hh * 128 + vq * 32 + 8 * vc); g.vfc = MC[tkv * 16 + dh]; g.vip = MC[tkv * 16 + 8 + dh]; }
        if (tid < 64) { const size_t tkg = tk0 + (dir ? 63 - tid : tid); g.fc = MC[tkg * 16 + dh]; g.ip = MC[tkg * 16 + 8 + dh]; } };
    auto lstore = [&](const Stg& g, int nb) { LAS unsigned char* cb = lds + nb * CHB;
        *(LAS u32x4*)(cb + KT + srow * 144 + 16 * sc8) = g.k;
        { float q8[8]; unpack8(g.q, q8);
#pragma unroll
          for (int e = 0; e < 8; ++e) q8[e] *= 0.125f;
          *(LAS u32x4*)(cb + QT + srow * 144 + 16 * sc8) = pack8(q8); }
        if (tid < 256) { float v8[8]; unpack8(g.v, v8); const float bj = __expf(g.vip - g.vfc + g.fm);
#pragma unroll
            for (int e = 0; e < 8; ++e) v8[e] *= bj;
            *(LAS u32x4*)(cb + VT_ + vrow * 80 + 16 * vc) = pack8(v8); }
        if (tid < 64) { ((LAS float*)(cb + FC))[tid] = g.fc; ((LAS float*)(cb + AO_))[tid] = __expf(g.fc - g.fm); ((LAS float*)(cb + BO_))[tid] = __expf(g.ip - g.fc + g.fm); }
        if (tid == 64) ((LAS float*)(cb + FC + 768))[0] = g.fm; };
    gload(sA, 0); lstore(sA, 0); gload(sB, 1);
    __syncthreads();
    auto compute = [&](const int c, const int cur) {
        const int nxt = cur ^ 1;
        const LAS unsigned char* cb = lds + cur * CHB;
        const LAS float* fcS = (const LAS float*)(cb + FC); const LAS float* aS = (const LAS float*)(cb + AO_); const LAS float* bS = (const LAS float*)(cb + BO_);
        const float fend = fcS[63], dec = __expf(fend), cw = __expf(fend - fcS[192]);
        if (wid < 2) {
            const int ib = wid, i = 32 * ib + r;
            bf16x8 qf[4];
#pragma unroll
            for (int s = 0; s < 4; ++s) qf[s] = *(const LAS bf16x8*)(cb + QT + i * 144 + 32 * s + 16 * h);
            f32x16 s0v, s1v, nacc, iacc;
#pragma unroll
            for (int q = 0; q < 16; ++q) { s0v[q] = 0.f; s1v[q] = 0.f; nacc[q] = 0.f; iacc[q] = 0.f; }
#pragma unroll
            for (int s = 0; s < 4; ++s) { const bf16x8 a0 = *(const LAS bf16x8*)(cb + KT + r * 144 + 32 * s + 16 * h); s0v = __builtin_amdgcn_mfma_f32_32x32x16_bf16(a0, qf[s], s0v, 0, 0, 0); }
            float den = 0.f;
            if (ib == 0) {
#pragma unroll
                for (int g4 = 0; g4 < 4; ++g4) { const f32x4 B0 = *(const LAS f32x4*)(bS + 8 * g4 + 4 * h);
#pragma unroll
                    for (int q = 0; q < 4; ++q) { const int reg = 4 * g4 + q, j0 = 8 * g4 + 4 * h + q; const float p0 = (j0 <= r) ? s0v[reg] : 0.f; s0v[reg] = p0; den += p0 * B0[q]; } }
            } else {
#pragma unroll
                for (int s = 0; s < 4; ++s) { const bf16x8 a1 = *(const LAS bf16x8*)(cb + KT + (32 + r) * 144 + 32 * s + 16 * h); s1v = __builtin_amdgcn_mfma_f32_32x32x16_bf16(a1, qf[s], s1v, 0, 0, 0); }
#pragma unroll
                for (int g4 = 0; g4 < 4; ++g4) { const f32x4 B0 = *(const LAS f32x4*)(bS + 8 * g4 + 4 * h), B1 = *(const LAS f32x4*)(bS + 32 + 8 * g4 + 4 * h);
#pragma unroll
                    for (int q = 0; q < 4; ++q) { const int reg = 4 * g4 + q, j0 = 8 * g4 + 4 * h + q; den += s0v[reg] * B0[q];
                        const float p1 = (j0 <= r) ? s1v[reg] : 0.f; s1v[reg] = p1; den += p1 * B1[q]; } }
            }
#pragma unroll
            for (int st = 0; st < 4; ++st) { if (st < 2 || ib == 1) {
                u32x4 pw;
#pragma unroll
                for (int q = 0; q < 4; ++q) { const int reg = 8 * (st & 1) + 2 * q; pw[q] = (st < 2) ? cvtpk(s0v[reg], s0v[reg + 1]) : cvtpk(s1v[reg], s1v[reg + 1]); }
                u32x4 vw;
#pragma unroll
                for (int q = 0; q < 4; ++q) { const int t0 = 16 * st + 8 * (q >> 1) + 4 * h + 2 * (q & 1);
                    vw[q] = lds_u16(cb + VT_ + t0 * 80 + 2 * r) | (lds_u16(cb + VT_ + (t0 + 1) * 80 + 2 * r) << 16); }
                nacc = __builtin_amdgcn_mfma_f32_32x32x16_bf16(__builtin_bit_cast(bf16x8, vw), __builtin_bit_cast(bf16x8, pw), nacc, 0, 0, 0); } }
            const LAS unsigned char* cbt = lds + CBO + cur * CBS; const LAS float* nS = (const LAS float*)(lds + NSO + cur * 256);
            float dint = 0.f;
#pragma unroll
            for (int s = 0; s < 4; ++s) { const bf16x8 ca = *(const LAS bf16x8*)(cbt + r * 144 + 32 * s + 16 * h); iacc = __builtin_amdgcn_mfma_f32_32x32x16_bf16(ca, qf[s], iacc, 0, 0, 0);
                float q8[8]; unpack8(__builtin_bit_cast(u32x4, qf[s]), q8); const f32x4 n0 = *(const LAS f32x4*)(nS + 16 * s + 8 * h), n1 = *(const LAS f32x4*)(nS + 16 * s + 8 * h + 4);
                dint += q8[0] * n0.x + q8[1] * n0.y + q8[2] * n0.z + q8[3] * n0.w + q8[4] * n1.x + q8[5] * n1.y + q8[6] * n1.z + q8[7] * n1.w; }
            { auto rr = __builtin_amdgcn_permlane32_swap(__float_as_uint(den), __float_as_uint(den), false, false); den = __uint_as_float(rr[0]) + __uint_as_float(rr[1]); }
            { auto rr = __builtin_amdgcn_permlane32_swap(__float_as_uint(dint), __float_as_uint(dint), false, false); dint = __uint_as_float(rr[0]) + __uint_as_float(rr[1]); }
            const float ai = aS[i], egi = __expf(fcS[i]), dtot = ai * den + egi * dint, inv = 1.0f / fmaxf(fabsf(dtot), 1.0f), ka = ai * inv, ke_ = egi * inv;
            const size_t tko = (size_t)b * TB + s0_of(c) + (dir ? 63 - i : i);
            float* op = OM + tko * 512 + hh * 128 + vq * 32 + 4 * h;
#pragma unroll
            for (int g4 = 0; g4 < 4; ++g4) { f32x4 o;
#pragma unroll
                for (int q = 0; q < 4; ++q) o[q] = nacc[4 * g4 + q] * ka + iacc[4 * g4 + q] * ke_;
                *(f32x4*)(op + 8 * g4) = o; }
        } else if (wid < 4) {
            const int cbk = wid - 2;
            f32x16 tacc;
#pragma unroll
            for (int q = 0; q < 16; ++q) tacc[q] = 0.f;
#pragma unroll
            for (int s = 0; s < 4; ++s) { const int t0 = 16 * s + 8 * h;
                u32x4 vw, kw;
#pragma unroll
                for (int q = 0; q < 4; ++q) { const int ta = t0 + 2 * q;
                    vw[q] = lds_u16(cb + VT_ + ta * 80 + 2 * r) | (lds_u16(cb + VT_ + (ta + 1) * 80 + 2 * r) << 16);
                    kw[q] = lds_u16(cb + KT + ta * 144 + 2 * (r + 32 * cbk)) | (lds_u16(cb + KT + (ta + 1) * 144 + 2 * (r + 32 * cbk)) << 16); }
                tacc = __builtin_amdgcn_mfma_f32_32x32x16_bf16(__builtin_bit_cast(bf16x8, vw), __builtin_bit_cast(bf16x8, kw), tacc, 0, 0, 0); }
            LAS unsigned char* cbn = lds + CBO + nxt * CBS;
#pragma unroll
            for (int q = 0; q < 16; ++q) { cacc[q] = dec * cacc[q] + cw * tacc[q]; const int v = (q & 3) + 8 * (q >> 2) + 4 * h; *(LAS unsigned short*)(cbn + v * 144 + 2 * (r + 32 * cbk)) = (unsigned short)(cvtpk(cacc[q], 0.f) & 0xffffu); }
        } else if (wid == 4) {
            float s0 = 0.f, s1 = 0.f;
#pragma unroll 8
            for (int j = 0; j < 64; j += 2) { s0 += bS[j] * bf2f((bf16)lds_u16(cb + KT + j * 144 + 2 * lane)); s1 += bS[j + 1] * bf2f((bf16)lds_u16(cb + KT + (j + 1) * 144 + 2 * lane)); }
            const LAS float* nc = (const LAS float*)(lds + NSO + cur * 256); LAS float* nn = (LAS float*)(lds + NSO + nxt * 256);
            nn[lane] = dec * nc[lane] + cw * (s0 + s1);
        }
    };
    for (int c = 0; c < TB / 64; c += 2) {
        gload(sA, min(c + 2, TB / 64 - 1)); compute(c, 0); lstore(sB, 1); LDS_BAR();
        gload(sB, min(c + 3, TB / 64 - 1)); compute(c + 1, 1); lstore(sA, 0); LDS_BAR();
    }
}

constexpr int GF_WM = 0, GF_QD = 16384, GF_QK = 32768, GF_KE = 40960, GF_U0 = 57344, GF_EE = 90112, GF_ITEM = 90368, NCHUNK = TB / 64;
__device__ __forceinline__ int chunk_s0(int dir, int c) { return (dir == 0) ? 64 * c : (c < 4 ? 192 - 64 * c : TB - 64 - 64 * (c - 4)); }
__device__ __forceinline__ void phase_gdnpre(const PView& p, int l, LAS unsigned char* lds, int bid, int G) {
    const int tid = ltid(), wid = __builtin_amdgcn_readfirstlane(tid >> 6), lane = tid & 63, r = lane & 31, h = lane >> 5;
    unsigned char* ws = p.ws;
    const bf16* GQ = (const bf16*)(ws + OFF_GQKV); const float* GC = (const float*)(ws + OFF_GC);
    constexpr int KO = 0, QO = 17408, VO = 34816, AO = 52224, GSO = 69632, BSO = GSO + 256, XO = 70400, UO = 87808;
    const LAS float* gS = (const LAS float*)(lds + GSO); const LAS float* bS = (const LAS float*)(lds + BSO);
    for (int it = bid; it < 32 * NCHUNK; it += G) {
        const int chain = it / NCHUNK, c = it % NCHUNK, b = chain >> 3, hh = (chain >> 1) & 3, dir = chain & 1, dh = dir * 4 + hh;
        const size_t tk0 = (size_t)b * TB + chunk_s0(dir, c);
        unsigned char* gf = ws + OFF_GF + (size_t)it * GF_ITEM;
#pragma unroll
        for (int rep = 0; rep < 6; ++rep) { const int ch = tid + 512 * rep, tile = ch >> 10, row = (ch & 1023) >> 4, c8 = ch & 15;
            const size_t tk = tk0 + (dir ? 63 - row : row);
            const int col = (tile == 0 ? 512 : (tile == 1 ? 0 : 1024)) + hh * 128 + 8 * c8;
            *(LAS u32x4*)(lds + tile * 17408 + row * 272 + 16 * c8) = *(const u32x4*)(GQ + tk * 1536 + col); }
        if (tid < 64) { const size_t tk = tk0 + (dir ? 63 - tid : tid); const float gg = GC[tk * 24 + dh], bb = GC[tk * 24 + 8 + dh];
            ((LAS float*)(lds + GSO))[tid] = gg; ((LAS float*)(lds + BSO))[tid] = bb; ((LAS float*)(lds + BSO + 256))[tid] = bb * __expf(gg); }
        __syncthreads();
        { const int w4 = wid & 3, jb = w4 >> 1, ib = w4 & 1, i = 32 * ib + r;
          f32x16 acc;
#pragma unroll
          for (int q = 0; q < 16; ++q) acc[q] = 0.f;
          const LAS unsigned char* bsrc = lds + ((wid < 4) ? KO : QO) + i * 272 + 16 * h;
#pragma unroll
          for (int s = 0; s < 8; ++s) { const bf16x8 a = *(const LAS bf16x8*)(lds + KO + (32 * jb + r) * 272 + 32 * s + 16 * h), bq = *(const LAS bf16x8*)(bsrc + 32 * s);
              acc = __builtin_amdgcn_mfma_f32_32x32x16_bf16(a, bq, acc, 0, 0, 0); }
          const float gi = gS[i], bi = bS[i];
          if (wid < 4) {
#pragma unroll
              for (int g4 = 0; g4 < 4; ++g4) { const int j0 = 32 * jb + 8 * g4 + 4 * h; const f32x4 gj = *(const LAS f32x4*)(gS + j0); f32x4 o;
#pragma unroll
                  for (int q = 0; q < 4; ++q) o[q] = (i > j0 + q) ? bi * __expf(gi - gj[q]) * acc[4 * g4 + q] : 0.f;
                  *(LAS f32x4*)(lds + AO + i * 272 + 4 * j0) = o; }
          } else {
#pragma unroll
              for (int g4 = 0; g4 < 4; ++g4) { const int j0 = 32 * jb + 8 * g4 + 4 * h; const f32x4 gj = *(const LAS f32x4*)(gS + j0);
#pragma unroll
                  for (int q = 0; q < 4; ++q) acc[4 * g4 + q] = (i >= j0 + q) ? __expf(gi - gj[q]) * acc[4 * g4 + q] : 0.f; }
#pragma unroll
              for (int s2 = 0; s2 < 2; ++s2) { u32x4 w;
#pragma unroll
                  for (int q = 0; q < 4; ++q) w[q] = cvtpk(acc[8 * s2 + 2 * q], acc[8 * s2 + 2 * q + 1]);
                  *(u32x4*)(gf + GF_QK + (size_t)((ib * 4 + 2 * jb + s2) * 64 + lane) * 16) = w; }
          } }
        __syncthreads();
        constexpr int TO = UO;
        if (wid == 0) {
            float t[32];
#pragma unroll
            for (int i = 0; i < 32; ++i) {
                float acc0 = (i == r) ? 1.0f : 0.0f, acc1 = 0.f;
#pragma unroll
                for (int j4 = 0; j4 < (i + 3) / 4; ++j4) { const f32x4 a4 = *(const LAS f32x4*)(lds + AO + (32 * h + i) * 272 + (32 * h + 4 * j4) * 4);
#pragma unroll
                    for (int q = 0; q < 4; ++q) if (4 * j4 + q < i) { if (q & 1) acc1 -= a4[q] * t[4 * j4 + q]; else acc0 -= a4[q] * t[4 * j4 + q]; } }
                t[i] = acc0 + acc1;
                *(LAS unsigned short*)(lds + TO + h * 2048 + i * 64 + 2 * r) = (unsigned short)(cvtpk(t[i], 0.f) & 0xffffu);
                if ((i & 3) == 3) asm volatile("" ::: "memory");
            }
        } else if (wid >= 4) {
            const int w4 = wid - 4; const float gend = gS[63];
#pragma unroll
            for (int k = 0; k < 4; ++k) { const int f = w4 * 4 + k, ib = f >> 3, s = f & 7, i = 32 * ib + r;
                float q8[8]; unpack8(*(const LAS u32x4*)(lds + QO + i * 272 + 32 * s + 16 * h), q8); const float e = __expf(gS[i]);
#pragma unroll
                for (int q = 0; q < 8; ++q) q8[q] *= e;
                *(u32x4*)(gf + GF_QD + (size_t)(f * 64 + lane) * 16) = pack8(q8); }
#pragma unroll
            for (int k = 0; k < 4; ++k) { const int f = w4 * 4 + k, db = f >> 2, st = f & 3, dk = 32 * db + r;
                u32x4 w;
#pragma unroll
                for (int q = 0; q < 4; ++q) { const int t0 = 16 * st + 8 * (q >> 1) + 4 * h + 2 * (q & 1);
                    const float ka = bf2f((bf16)lds_u16(lds + KO + t0 * 272 + 2 * dk)) * __expf(gend - gS[t0]), kb = bf2f((bf16)lds_u16(lds + KO + (t0 + 1) * 272 + 2 * dk)) * __expf(gend - gS[t0 + 1]);
                    w[q] = cvtpk(ka, kb); }
                *(u32x4*)(gf + GF_KE + (size_t)(f * 64 + lane) * 16) = w; }
            if (tid == 256) *(float*)(gf + GF_EE) = __expf(gend);
        }
        __syncthreads();
        { const bool isv = wid < 4; const int c = 32 * (wid & 3) + r;
          const LAS unsigned char* srcp = lds + (isv ? VO : KO) + 2 * c; const LAS float* fS = (const LAS float*)(lds + (isv ? BSO : BSO + 256));
          f32x16 x0, x1;
#pragma unroll
          for (int q = 0; q < 16; ++q) { x0[q] = 0.f; const int tok = 32 + (q & 3) + 8 * (q >> 2) + 4 * h; x1[q] = fS[tok] * bf2f((bf16)lds_u16(srcp + tok * 272)); }
#pragma unroll
          for (int s = 0; s < 2; ++s) { u32x4 rw_;
#pragma unroll
              for (int q = 0; q < 4; ++q) { const int t0 = 16 * s + 8 * h + 2 * q; rw_[q] = cvtpk(fS[t0] * bf2f((bf16)lds_u16(srcp + t0 * 272)), fS[t0 + 1] * bf2f((bf16)lds_u16(srcp + (t0 + 1) * 272))); }
              const bf16x8 ta = *(const LAS bf16x8*)(lds + TO + r * 64 + 32 * s + 16 * h);
              x0 = __builtin_amdgcn_mfma_f32_32x32x16_bf16(ta, __builtin_bit_cast(bf16x8, rw_), x0, 0, 0, 0); }
#pragma unroll
          for (int s2 = 0; s2 < 2; ++s2) { u32x4 xb, aw;
#pragma unroll
              for (int q = 0; q < 4; ++q) xb[q] = cvtpk(x0[8 * s2 + 2 * q], x0[8 * s2 + 2 * q + 1]);
              const f32x4 a0 = *(const LAS f32x4*)(lds + AO + (32 + r) * 272 + (16 * s2 + 4 * h) * 4), a1 = *(const LAS f32x4*)(lds + AO + (32 + r) * 272 + (16 * s2 + 8 + 4 * h) * 4);
              aw[0] = cvtpk(-a0.x, -a0.y); aw[1] = cvtpk(-a0.z, -a0.w); aw[2] = cvtpk(-a1.x, -a1.y); aw[3] = cvtpk(-a1.z, -a1.w);
              x1 = __builtin_amdgcn_mfma_f32_32x32x16_bf16(__builtin_bit_cast(bf16x8, aw), __builtin_bit_cast(bf16x8, xb), x1, 0, 0, 0); }
          f32x16 y1;
#pragma unroll
          for (int q = 0; q < 16; ++q) y1[q] = 0.f;
#pragma unroll
          for (int s2 = 0; s2 < 2; ++s2) { u32x4 rb;
#pragma unroll
              for (int q = 0; q < 4; ++q) rb[q] = cvtpk(x1[8 * s2 + 2 * q], x1[8 * s2 + 2 * q + 1]);
              const u32x2 t0 = *(const LAS u32x2*)(lds + TO + 2048 + r * 64 + (16 * s2 + 4 * h) * 2), t1 = *(const LAS u32x2*)(lds + TO + 2048 + r * 64 + (16 * s2 + 8 + 4 * h) * 2);
              y1 = __builtin_amdgcn_mfma_f32_32x32x16_bf16(__builtin_bit_cast(bf16x8, (u32x4){t0.x, t0.y, t1.x, t1.y}), __builtin_bit_cast(bf16x8, rb), y1, 0, 0, 0); }
          if (isv) {
              f32x4* d0 = (f32x4*)(gf + GF_U0 + (size_t)((wid * 2 + 0) * 64 + lane) * 64); f32x4* d1 = (f32x4*)(gf + GF_U0 + (size_t)((wid * 2 + 1) * 64 + lane) * 64);
#pragma unroll
              for (int q = 0; q < 4; ++q) { d0[q] = (f32x4){x0[4 * q], x0[4 * q + 1], x0[4 * q + 2], x0[4 * q + 3]}; d1[q] = (f32x4){y1[4 * q], y1[4 * q + 1], y1[4 * q + 2], y1[4 * q + 3]}; }
          } else {
              const int dk = 32 * (wid - 4) + r;
#pragma unroll
              for (int q = 0; q < 16; ++q) { const int tok = (q & 3) + 8 * (q >> 2) + 4 * h;
                  *(LAS unsigned short*)(lds + XO + tok * 272 + 2 * dk) = (unsigned short)(cvtpk(-x0[q], 0.f) & 0xffffu);
                  *(LAS unsigned short*)(lds + XO + (32 + tok) * 272 + 2 * dk) = (unsigned short)(cvtpk(-y1[q], 0.f) & 0xffffu); }
          } }
        __syncthreads();
#pragma unroll
        for (int k = 0; k < 2; ++k) { const int f = wid * 2 + k, tb = f >> 3, s = f & 7;
            *(u32x4*)(gf + GF_WM + (size_t)(f * 64 + lane) * 16) = *(const LAS u32x4*)(lds + XO + (32 * tb + r) * 272 + 32 * s + 16 * h); }
        __syncthreads();
    }
}

__device__ __forceinline__ void gdn_seq_item(const PView& p, LAS unsigned char* lds, int chain, int vq) {
    const int tid = ltid(), wid = __builtin_amdgcn_readfirstlane(tid >> 6), lane = tid & 63, r = lane & 31, h = lane >> 5;
    const int b = chain >> 3, hh = (chain >> 1) & 3, dir = chain & 1;
    unsigned char* ws = p.ws;
    const unsigned char* gfc = ws + OFF_GF + (size_t)chain * NCHUNK * GF_ITEM;
    constexpr int SBS = 8704, UFO = 17408;
    for (int i = tid; i < SBS / 4; i += NTHR) ((LAS unsigned*)lds)[i] = 0u;
    __syncthreads();
    if (wid < 2) {
        u32x4 wm[3][8]; f32x4 uu[3][4];
#define LD_A(SET, C) do { const unsigned char* gf_ = gfc + (size_t)(C) * GF_ITEM; \
            _Pragma("unroll") for (int s = 0; s < 8; ++s) wm[SET][s] = *(const u32x4*)(gf_ + GF_WM + (size_t)((wid * 8 + s) * 64 + lane) * 16); \
            const f32x4* up_ = (const f32x4*)(gf_ + GF_U0 + (size_t)((vq * 2 + wid) * 64 + lane) * 64); \
            _Pragma("unroll") for (int q = 0; q < 4; ++q) uu[SET][q] = up_[q]; } while (0)
#define ST_A(SET, C) do { const LAS unsigned char* sb_ = lds + ((C) & 1) * SBS; f32x16 acc_; \
            _Pragma("unroll") for (int q = 0; q < 4; ++q) { acc_[4 * q] = uu[SET][q].x; acc_[4 * q + 1] = uu[SET][q].y; acc_[4 * q + 2] = uu[SET][q].z; acc_[4 * q + 3] = uu[SET][q].w; } \
            _Pragma("unroll") for (int s = 0; s < 8; ++s) { const bf16x8 sf_ = *(const LAS bf16x8*)(sb_ + r * 272 + 32 * s + 16 * h); \
                acc_ = __builtin_amdgcn_mfma_f32_32x32x16_bf16(__builtin_bit_cast(bf16x8, wm[SET][s]), sf_, acc_, 0, 0, 0); } \
            _Pragma("unroll") for (int s2 = 0; s2 < 2; ++s2) { u32x4 w_; _Pragma("unroll") for (int q = 0; q < 4; ++q) w_[q] = cvtpk(acc_[8 * s2 + 2 * q], acc_[8 * s2 + 2 * q + 1]); \
                *(LAS u32x4*)(lds + UFO + ((2 * wid + s2) * 64 + lane) * 16) = w_; } \
            LDS_BAR(); LDS_BAR(); } while (0)
        LD_A(0, 0); LD_A(1, 1);
        for (int c = 0; c < NCHUNK; c += 3) { LD_A(2, c + 2); ST_A(0, c); LD_A(0, min(c + 3, NCHUNK - 1)); ST_A(1, c + 1); LD_A(1, min(c + 4, NCHUNK - 1)); ST_A(2, c + 2); }
#undef LD_A
#undef ST_A
    } else if (wid < 4) {
        const int ib = wid - 2;
        char* OGu = (char*)((float*)(ws + OFF_OGD) + (size_t)dir * T * 512 + hh * 128 + vq * 32);
        const int ostep = dir ? -2048 : 2048, ot0 = 32 * ib + 4 * h;
        u32x4 qd[3][8], qk[3][4];
#define LD_B(SET, C) do { const unsigned char* gf_ = gfc + (size_t)(C) * GF_ITEM; \
            _Pragma("unroll") for (int s = 0; s < 8; ++s) qd[SET][s] = *(const u32x4*)(gf_ + GF_QD + (size_t)((ib * 8 + s) * 64 + lane) * 16); \
            _Pragma("unroll") for (int s = 0; s < 4; ++s) qk[SET][s] = *(const u32x4*)(gf_ + GF_QK + (size_t)((ib * 4 + s) * 64 + lane) * 16); } while (0)
#define ST_B(SET, C) do { const LAS unsigned char* sb_ = lds + ((C) & 1) * SBS; f32x16 acc_; \
            _Pragma("unroll") for (int q = 0; q < 16; ++q) acc_[q] = 0.f; \
            _Pragma("unroll") for (int s = 0; s < 8; ++s) { const bf16x8 sf_ = *(const LAS bf16x8*)(sb_ + r * 272 + 32 * s + 16 * h); \
                acc_ = __builtin_amdgcn_mfma_f32_32x32x16_bf16(__builtin_bit_cast(bf16x8, qd[SET][s]), sf_, acc_, 0, 0, 0); } \
            LDS_BAR(); \
            _Pragma("unroll") for (int s = 0; s < 4; ++s) { const bf16x8 uf_ = *(const LAS bf16x8*)(lds + UFO + (s * 64 + lane) * 16); \
                acc_ = __builtin_amdgcn_mfma_f32_32x32x16_bf16(__builtin_bit_cast(bf16x8, qk[SET][s]), uf_, acc_, 0, 0, 0); } \
            const unsigned ob_ = (unsigned)(((b * TB + chunk_s0(dir, (C)) + (dir ? 63 - ot0 : ot0)) * 512 + r) * 4); \
            _Pragma("unroll") for (int q = 0; q < 16; ++q) { *(float*)(OGu + (ob_ + (unsigned)(((q & 3) + 8 * (q >> 2)) * ostep))) = acc_[q]; } \
            LDS_BAR(); } while (0)
        LD_B(0, 0); LD_B(1, 1);
        for (int c = 0; c < NCHUNK; c += 3) { LD_B(2, c + 2); ST_B(0, c); LD_B(0, min(c + 3, NCHUNK - 1)); ST_B(1, c + 1); LD_B(1, min(c + 4, NCHUNK - 1)); ST_B(2, c + 2); }
#undef LD_B
#undef ST_B
    } else {
        const int db = wid - 4;
        u32x4 ke[3][4]; float ee[3];
        f32x16 sacc;
#pragma unroll
        for (int q = 0; q < 16; ++q) sacc[q] = 0.f;
#define LD_C(SET, C) do { const unsigned char* gf_ = gfc + (size_t)(C) * GF_ITEM; \
            _Pragma("unroll") for (int s = 0; s < 4; ++s) ke[SET][s] = *(const u32x4*)(gf_ + GF_KE + (size_t)((db * 4 + s) * 64 + lane) * 16); ee[SET] = *(const float*)(gf_ + GF_EE); } while (0)
#define ST_C(SET, C) do { LAS unsigned char* sn_ = lds + (((C) & 1) ^ 1) * SBS; \
            _Pragma("unroll") for (int q = 0; q < 16; ++q) sacc[q] *= ee[SET]; \
            LDS_BAR(); \
            _Pragma("unroll") for (int s = 0; s < 4; ++s) { const bf16x8 uf_ = *(const LAS bf16x8*)(lds + UFO + (s * 64 + lane) * 16); \
                sacc = __builtin_amdgcn_mfma_f32_32x32x16_bf16(__builtin_bit_cast(bf16x8, ke[SET][s]), uf_, sacc, 0, 0, 0); } \
            _Pragma("unroll") for (int g4 = 0; g4 < 4; ++g4) *(LAS u32x2*)(sn_ + r * 272 + 2 * (32 * db + 8 * g4 + 4 * h)) = (u32x2){cvtpk(sacc[4 * g4], sacc[4 * g4 + 1]), cvtpk(sacc[4 * g4 + 2], sacc[4 * g4 + 3])}; \
            LDS_BAR(); } while (0)
        LD_C(0, 0); LD_C(1, 1);
        for (int c = 0; c < NCHUNK; c += 3) { LD_C(2, c + 2); ST_C(0, c); LD_C(0, min(c + 3, NCHUNK - 1)); ST_C(1, c + 1); LD_C(1, min(c + 4, NCHUNK - 1)); ST_C(2, c + 2); }
#undef LD_C
#undef ST_C
    }
}

__device__ __forceinline__ void phase_scan(const PView& p, int l, LAS unsigned char* lds, int bid, int G) {
    for (int wi = bid; wi < 256; wi += G) {
        const int x = wi & 7, k = wi >> 3, item = ((k >> 4) << 7) + x * 16 + (k & 15);
        const int it = item & 127, chain = it >> 2, vq = it & 3;
        if (item < 128) { for (int rp = 0; rp < NREP(53); ++rp) { gdn_seq_item(p, lds, chain, vq); __syncthreads(); } }
        else { for (int rp = 0; rp < NREP(54); ++rp) { mlstm_chunk_item(p, lds, chain, vq); __syncthreads(); } }
        __syncthreads();
    }
}

__device__ __forceinline__ void phase_scanout(const PView& p, int l, int bid, int G) {
    const int tid = ltid(), wid = __builtin_amdgcn_readfirstlane(tid >> 6), lane = tid & 63;
    unsigned char* ws = p.ws;
    const bf16* P = (const bf16*)(ws + OFF_R1); const bf16* Y = (const bf16*)(ws + OFF_Y);
    signed char* Y8 = (signed char*)(ws + OFF_Y8); float* SY = (float*)(ws + OFF_SY);
    const float* OG = (const float*)(ws + OFF_OGD); const float* OM = (const float*)(ws + OFF_OML);
    for (int tp = bid * NWAVES + wid; tp < T / 2; tp += G * NWAVES) {
        f32x4 oa[2][2][2], ob[2][2][2]; u32x4 gw[2][2], ya[2][2];
#pragma unroll
        for (int u = 0; u < 2; ++u)
#pragma unroll
            for (int which = 0; which < 2; ++which) { const int tk = 2 * tp + u;
                const float* o0 = (which ? OM : OG) + (size_t)tk * 512 + 8 * lane; const float* o1 = o0 + (size_t)T * 512;
                oa[u][which][0] = *(const f32x4*)o0; oa[u][which][1] = *(const f32x4*)(o0 + 4); ob[u][which][0] = *(const f32x4*)o1; ob[u][which][1] = *(const f32x4*)(o1 + 4);
                gw[u][which] = *(const u32x4*)(P + (size_t)tk * LDP + (which ? PC_LO : PC_GG) + 8 * lane);
                ya[u][which] = *(const u32x4*)(Y + (size_t)tk * 2048 + which * 1024 + 8 * lane); }
#pragma unroll
        for (int u = 0; u < 2; ++u)
#pragma unroll
            for (int br = 0; br < 4; ++br) { const int tk = 2 * tp + u, which = br >> 1;
                float y[8];
                if (br & 1) {
                    float x[8]; { const f32x4 a0 = oa[u][which][0], a1 = oa[u][which][1], b0 = ob[u][which][0], b1 = ob[u][which][1];
                        x[0] = a0.x + b0.x; x[1] = a0.y + b0.y; x[2] = a0.z + b0.z; x[3] = a0.w + b0.w; x[4] = a1.x + b1.x; x[5] = a1.y + b1.y; x[6] = a1.z + b1.z; x[7] = a1.w + b1.w; }
                    float ss = 0.f;
#pragma unroll
                    for (int i = 0; i < 8; ++i) ss += x[i] * x[i];
                    ss = row16_sum(ss);
                    const float rs = __builtin_amdgcn_rsqf(ss * (1.f / 128.f) + 1e-6f);
                    const float* ng = (which ? p.in[I_MLG] : p.in[I_GNG]) + l * 128 + 8 * (lane & 15);
                    float gt[8]; unpack8(gw[u][which], gt);
#pragma unroll
                    for (int i = 0; i < 8; ++i) { const float sg = fsigmoid(gt[i]); y[i] = x[i] * rs * ng[i] * (which ? sg : gt[i] * sg); }
                } else unpack8(ya[u][which], y);
                float am = 0.f;
#pragma unroll
                for (int i = 0; i < 8; ++i) am = fmaxf(am, fabsf(y[i]));
                const float amax = wave_max(am), inv = amax > 0.f ? 127.0f / amax : 0.f;
                if (lane == 0) SY[tk * 4 + br] = amax * (1.0f / 127.0f);
                *(u32x2*)(Y8 + (size_t)tk * 2048 + br * 512 + 8 * lane) = (u32x2){q8x4((f32x4){y[0], y[1], y[2], y[3]} * inv), q8x4((f32x4){y[4], y[5], y[6], y[7]} * inv)}; }
    }
}

constexpr int NPH_L = 14, PH_L0 = 1, PH_FINAL = PH_L0 + DEPTH * NPH_L, NPHASES = PH_FINAL + 1;
__global__ void __launch_bounds__(NTHR, 2) fwd_kernel(Params kp) {
    extern __shared__ __attribute__((aligned(16))) unsigned char lds_raw[];
    LAS unsigned char* lds = (LAS unsigned char*)lds_raw;
    volatile LAS unsigned* MISC = (volatile LAS unsigned*)(lds + MISC_OFF);
    const int tid = threadIdx.x;
    for (int u = tid; u < (LDS_BYTES - MISC_OFF) / 4; u += NTHR) ((LAS unsigned*)(lds + MISC_OFF))[u] = 0u;
    __syncthreads();
    const int lo = kp.ph_lo, hi = kp.ph_hi;
    XcdBarrier bar; bar.bar = (unsigned*)(kp.ws + OFF_CTL) + CW_BAR; bar.x = 0; bar.st = MISC + 8;
    if (hi - lo > 1) bar = xcd_barrier_post((unsigned*)(kp.ws + OFF_CTL) + CW_BAR, MISC + 8);
#define IN(k) (lo <= (k) && (k) < hi)
#define SEAM(k) do { if ((k) + 1 < hi) xcd_barrier(bar); } while (0)

    if (IN(0)) { const PView p = pview(); phase_prologue(p, lds, p.bid, p.G); SEAM(0); }
    for (int l = 0; l < DEPTH; ++l) {
        const int pb = PH_L0 + l * NPH_L;
        if (IN(pb + 0)) { const PView p = pview(); if (NREP(60) == 2) { phase_norm1<0>(p, l, p.bid, p.G, true); __syncthreads(); } phase_norm1<0>(p, l, p.bid, p.G); SEAM(pb + 0); }
        if (IN(pb + 1)) {
            const PView p = pview(); unsigned char* ws = p.ws;
            ProbPlain pr{(const char*)(ws + OFF_H), (const char*)(ws + OFF_WIN) + (size_t)l * NIN * 1024, 1024u, 1024u, 8};
            pg8::Order S; S.init(T / 256, NIN / 256, p.G, p.bid);
            EpiIn8 E{(bf16*)(ws + OFF_R1), (bf16*)(ws + OFF_R2), (float*)(ws + OFF_GATES), p.in[I_BMG] + (size_t)l * NGATE, (const float*)(ws + OFF_SH), (const float*)(ws + OFF_CMIN) + (size_t)l * NIN};
            for (int rp = 0; rp < NREP(1); ++rp) pg8::gemm_phase(lds, pr, S, E); SEAM(pb + 1); }
        if (IN(pb + 2)) { const PView p = pview(); if (NREP(2) == 2) { phase_prep(p, l, lds, p.bid, p.G); __syncthreads(); } phase_prep(p, l, lds, p.bid, p.G); SEAM(pb + 2); }
        if (IN(pb + 3)) {
            const PView p = pview(); unsigned char* ws = p.ws;
            ProbPlain pr{(const char*)(ws + OFF_AQ), (const char*)(ws + OFF_WUQKV) + (size_t)l * 1792 * 384 * 2, 768u, 768u, 6};
            pg8::Order S; S.init(T / 256, 7, p.G, p.bid);
            EpiStore E{(bf16*)(ws + OFF_QKVR), 1792, nullptr, 0};
            for (int rp = 0; rp < NREP(3); ++rp) pg8::gemm_phase(lds, pr, S, E); SEAM(pb + 3); }
        if (IN(pb + 4)) { const PView p = pview(); if (NREP(62) == 2) { phase_mlapost(p, l, lds, p.bid, p.G, true); __syncthreads(); } phase_mlapost(p, l, lds, p.bid, p.G); SEAM(pb + 4); }
        if (IN(pb + 5)) { for (int rp = 0; rp < NREP(50); ++rp) { const PView p = pview(); phase_attn(p, l, lds, p.bid, p.G); __syncthreads(); }
                          for (int rp = 0; rp < NREP(52); ++rp) { const PView p = pview(); phase_gdnpre(p, l, lds, p.bid, p.G); __syncthreads(); } SEAM(pb + 5); }
        if (IN(pb + 6)) { for (int rp = 0; rp < NREP(51); ++rp) { const PView p = pview(); phase_scan(p, l, lds, p.bid, p.G); __syncthreads(); } SEAM(pb + 6); }
        if (IN(pb + 7)) { const PView p = pview(); for (int rp = 0; rp < NREP(6); ++rp) phase_scanout(p, l, p.bid, p.G); SEAM(pb + 7); }
        if (IN(pb + 8)) {
            const PView p = pview(); unsigned char* ws = p.ws;
            ProbBO pr{(const char*)(ws + OFF_Y8), (const char*)(ws + OFF_WBO) + (size_t)l * 4096 * 512, 2048u, 512u, 4};
            pg8::Order S; if (l == DEPTH - 1) S.init(NB * SEQ / 256, 4, p.G, p.bid, 4, 1); else S.init(T / 256, 4, p.G, p.bid, 4);
            EpiBO E{(bf16*)(ws + OFF_R3), (const bf16*)(ws + OFF_R2), (const float*)(ws + OFF_SY), (const float*)(ws + OFF_CMBO) + (size_t)l * 4096};
            for (int rp = 0; rp < NREP(7); ++rp) pg8::gemm_phase(lds, pr, S, E); SEAM(pb + 8); }
        if (IN(pb + 9)) {
            const PView p = pview(); unsigned char* ws = p.ws;
            ProbPlain pr{(const char*)(ws + OFF_R3), (const char*)(ws + OFF_WOUT4) + (size_t)l * 1024 * 4096 * 2, 2048u, 8192u, 16};
            pg8::Order S; if (l == DEPTH - 1) S.init(NB * SEQ / 256, 4, p.G, p.bid, 1, 1); else S.init(T / 256, 4, p.G, p.bid);
            EpiOut E{(float*)(ws + OFF_X), (const float*)(ws + OFF_MOD) + (size_t)l * 5 * 6144};
            pg8::gemm_phase(lds, pr, S, E); SEAM(pb + 9); }
        if (IN(pb + 10)) { const PView p = pview(); if (NREP(61) == 2) { phase_router(p, l, lds, p.bid, p.G, true); __syncthreads(); } phase_router(p, l, lds, p.bid, p.G); SEAM(pb + 10); }
        if (IN(pb + 11)) { const PView p = pview(); for (int rp = 0; rp < NREP(10); ++rp) { phase_gather(p, l, lds, p.bid, p.G); __syncthreads(); } SEAM(pb + 11); }
        if (IN(pb + 12)) {
            const PView p = pview(); unsigned char* ws = p.ws; const int* tst = (const int*)(ws + OFF_CTL) + CW_TST + l * 64;
            ProbMoE pr{(const char*)(ws + OFF_R1), (const char*)(ws + OFF_WGU) + (size_t)l * 32 * 2048 * 1024, 1024u, 1024u, 8, tst, (size_t)2048 * 1024};
            pg8::Order S; S.init(tst[32], 8, p.G, p.bid);
            EpiMoE18 E{(bf16*)(ws + OFF_R2), p.in[I_BGU] + (size_t)l * 32 * 2048, (const float*)(ws + OFF_SX), (const float*)(ws + OFF_CMGU) + (size_t)l * 32 * 2048};
            for (int rp = 0; rp < NREP(11); ++rp) pg8::gemm_phase(lds, pr, S, E); SEAM(pb + 12); }
        if (IN(pb + 13)) {
            const PView p = pview(); unsigned char* ws = p.ws; const int* tst = (const int*)(ws + OFF_CTL) + CW_TST + l * 64;
            ProbMoE pr{(const char*)(ws + OFF_R2), (const char*)(ws + OFF_WDN) + (size_t)l * 32 * 1024 * 1024, 1024u, 1024u, 8, tst, (size_t)1024 * 1024};
            pg8::Order S; S.init(tst[32], 4, p.G, p.bid);
            EpiStoreF8 E{(bf16*)(ws + OFF_R3), 1024, p.in[I_BDN] + (size_t)l * 32 * 1024, 1024};
            for (int rp = 0; rp < NREP(12); ++rp) pg8::gemm_phase(lds, pr, S, E); SEAM(pb + 13); }
    }
    if (IN(PH_FINAL)) { const PView p = pview(); phase_norm1<2>(p, DEPTH, p.bid, p.G); }
#undef IN
#undef SEAM
}

extern "C" void kernel_launch(void* const* d_in, const int* in_sizes, int n_in, void* d_out, int out_size, void* d_ws, size_t ws_size, hipStream_t stream) {
    static int grid = 0;
    if (!grid) {
        if (n_in != 31 || ws_size < WS_END) { fprintf(stderr, "kernel_launch: expected 31 inputs and >= %zu bytes of workspace (got %d, %zu)\n", (size_t)WS_END, n_in, ws_size); grid = -1; return; }
        int dev = 0, cus = 0, per_cu = 0;
        hipGetDevice(&dev); hipDeviceGetAttribute(&cus, hipDeviceAttributeMultiprocessorCount, dev);
        hipFuncSetAttribute((const void*)fwd_kernel, hipFuncAttributeMaxDynamicSharedMemorySize, LDS_BYTES);
        hipOccupancyMaxActiveBlocksPerMultiprocessor(&per_cu, (const void*)fwd_kernel, NTHR, LDS_BYTES);
        if (per_cu < 1) fprintf(stderr, "kernel_launch: occupancy query reports %d blocks per CU\n", per_cu);
        grid = cus;
    }
    if (grid < 0) return;
    hipMemsetAsync((char*)d_ws + OFF_CTL, 0, CTL_BYTES, stream);
    Params p{};
    for (int i = 0; i < 31; ++i) p.in[i] = (const float*)d_in[i];
    p.out = (float*)d_out; p.ws = (unsigned char*)d_ws;
#if MK_N_LAUNCHES == 1
    p.ph_lo = 0; p.ph_hi = NPHASES;
    hipLaunchKernelGGL(fwd_kernel, dim3(grid), dim3(NTHR), LDS_BYTES, stream, p);
#else
    for (int ph = 0; ph < NPHASES; ++ph) { p.ph_lo = ph; p.ph_hi = ph + 1; hipLaunchKernelGGL(fwd_kernel, dim3(grid), dim3(NTHR), LDS_BYTES, stream, p); }
#endif
}
```

```cpp
#include <hip/hip_runtime.h>
#include <cstdio>
#include <cstdint>

#ifndef MK_N_LAUNCHES
#define MK_N_LAUNCHES 1
#endif

#ifndef PROBE_DUP
#define PROBE_DUP -1
#endif
#define NREP(k) ((PROBE_DUP == (k)) ? 2 : 1)
#define GAS __attribute__((address_space(1)))
#define LAS __attribute__((address_space(3)))
typedef unsigned short bf16;
typedef short bf16x8 __attribute__((ext_vector_type(8)));
typedef short s16x4 __attribute__((ext_vector_type(4)));
typedef float f32x4 __attribute__((ext_vector_type(4)));
typedef float f32x2 __attribute__((ext_vector_type(2)));
typedef float f32x16 __attribute__((ext_vector_type(16)));
typedef unsigned u32x4 __attribute__((ext_vector_type(4)));
typedef unsigned u32x2 __attribute__((ext_vector_type(2)));
typedef int i32x4 __attribute__((ext_vector_type(4)));
typedef int i32x8 __attribute__((ext_vector_type(8)));
typedef __bf16 bf16x2_t __attribute__((ext_vector_type(2)));

constexpr int D = 1024, NB = 4, SEQ = 8192, CTX = 256, TB = SEQ + CTX, T = NB * TB, DEPTH = 4;
constexpr int DIN = 5568, LDP = 5632, NGATE = 4096, NIN = LDP + NGATE;
constexpr int NE = 32, TOPK = 4, DFF = 1024;
constexpr int NSLOT = 143360;
constexpr int NWAVES = 8, NTHR = 512;
constexpr int PC_NAQ = 0, PC_NAK = 512, PC_NAV = 1024, PC_GQKV = 1536, PC_GG = 3072, PC_MQ = 3600, PC_MKV = 3856, PC_MKPE = 3984,
              PC_LQ = 4016, PC_LK = 4272, PC_LV = 4528, PC_LO = 5040;

constexpr size_t MiB = (size_t)1 << 20;
constexpr size_t OFF_CTL = 0, CTL_BYTES = 1 * MiB;
constexpr size_t OFF_MOD = 1 * MiB;
constexpr size_t OFF_X = 2 * MiB;
constexpr size_t OFF_H = 134 * MiB;
constexpr size_t OFF_SH = OFF_H + 40 * MiB;
constexpr size_t OFF_SX = 200 * MiB + 300 * MiB;
constexpr size_t OFF_R1 = 200 * MiB;
constexpr size_t OFF_R2 = 563 * MiB;
constexpr size_t OFF_R3 = 843 * MiB;
constexpr size_t OFF_GQKV = 1123 * MiB;
constexpr size_t OFF_GATES = 1222 * MiB;
constexpr size_t OFF_GDNG = 1227 * MiB;
constexpr size_t OFF_MLG = 1230 * MiB;
constexpr size_t OFF_AQ = 1233 * MiB;
constexpr size_t OFF_QKVR = 1258 * MiB;
constexpr size_t OFF_KM = 1374 * MiB;
constexpr size_t OFF_VTM = 1424 * MiB;
constexpr size_t OFF_VTN = 1457 * MiB;
constexpr size_t OFF_OGD = 1490 * MiB;
constexpr size_t OFF_OML = 1622 * MiB;
constexpr size_t OFF_Y = 1754 * MiB;
constexpr size_t OFF_TOPW = 1886 * MiB;
constexpr size_t OFF_TOPE = OFF_TOPW + 768 * 1024;
constexpr size_t OFF_POS = OFF_TOPE + 768 * 1024;
constexpr size_t OFF_SLOT = OFF_POS + 768 * 1024;
constexpr size_t OFF_WIN = 1889 * MiB;
constexpr size_t OFF_CMIN = OFF_WIN + 40 * MiB;
constexpr size_t OFF_WUQKV = 1965 * MiB;
constexpr size_t OFF_WBO = 1971 * MiB;
constexpr size_t OFF_CMBO = OFF_WBO + 10 * MiB;
constexpr size_t OFF_WOUT4 = 1987 * MiB;
constexpr size_t OFF_WGU = 2019 * MiB;
constexpr size_t OFF_CMGU = OFF_WGU + 260 * MiB;
constexpr size_t OFF_WDN = 2531 * MiB;
constexpr size_t OFF_GC = 2787 * MiB;
constexpr size_t OFF_MC = 2791 * MiB;
constexpr size_t OFF_GF = 2794 * MiB;
constexpr size_t OFF_Y8 = 3200 * MiB;
constexpr size_t OFF_SY = 3270 * MiB;
constexpr size_t OFF_QM8 = 3272 * MiB;
constexpr size_t WS_END = 3306 * MiB;
constexpr int CW_BAR = 4096, CW_CNT = 8192  , CW_TST = 8448  ;

constexpr int RING_BYTES = 131072, MISC_OFF = RING_BYTES, LDS_BYTES = 147456;

__device__ __forceinline__ unsigned cvtpk(float lo, float hi) { f32x2 v = {lo, hi}; bf16x2_t b = __builtin_convertvector(v, bf16x2_t); return __builtin_bit_cast(unsigned, b); }
__device__ __forceinline__ float bflo(unsigned w) { return __uint_as_float(w << 16); }
__device__ __forceinline__ float bfhi(unsigned w) { return __uint_as_float(w & 0xffff0000u); }
__device__ __forceinline__ float bf2f(bf16 b) { return __uint_as_float(((unsigned)b) << 16); }
__device__ __forceinline__ float fexp2(float x) { return __builtin_amdgcn_exp2f(x); }
__device__ __forceinline__ float fexp(float x) { return __builtin_amdgcn_exp2f(x * 1.4426950408889634f); }
__device__ __forceinline__ float frcp(float x) { return __builtin_amdgcn_rcpf(x); }
__device__ __forceinline__ float fsigmoid(float x) { return frcp(1.0f + fexp(-x)); }
#define LDS_BAR() do { asm volatile("s_waitcnt lgkmcnt(0)" ::: "memory"); __builtin_amdgcn_s_barrier(); asm volatile("" ::: "memory"); } while (0)
__device__ __forceinline__ int ltid() { int t = threadIdx.x; asm volatile("" : "+v"(t)); return t; }
template <int CTRL> __device__ __forceinline__ float dppf(float v) { return __int_as_float(__builtin_amdgcn_update_dpp(0, __float_as_int(v), CTRL, 0xf, 0xf, true)); }
__device__ __forceinline__ float row16_sum(float v) { v += dppf<0xB1>(v); v += dppf<0x4E>(v); v += dppf<0x141>(v); v += dppf<0x140>(v); return v; }
__device__ __forceinline__ float wave_sum(float v) { v = row16_sum(v);
    { auto rr = __builtin_amdgcn_permlane16_swap(__float_as_uint(v), __float_as_uint(v), false, false); v = __uint_as_float(rr[0]) + __uint_as_float(rr[1]); }
    { auto rr = __builtin_amdgcn_permlane32_swap(__float_as_uint(v), __float_as_uint(v), false, false); v = __uint_as_float(rr[0]) + __uint_as_float(rr[1]); } return v; }
__device__ __forceinline__ float wave_max(float v) { v = fmaxf(v, dppf<0xB1>(v)); v = fmaxf(v, dppf<0x4E>(v)); v = fmaxf(v, dppf<0x141>(v)); v = fmaxf(v, dppf<0x140>(v));
    { auto rr = __builtin_amdgcn_permlane16_swap(__float_as_uint(v), __float_as_uint(v), false, false); v = fmaxf(__uint_as_float(rr[0]), __uint_as_float(rr[1])); }
    { auto rr = __builtin_amdgcn_permlane32_swap(__float_as_uint(v), __float_as_uint(v), false, false); v = fmaxf(__uint_as_float(rr[0]), __uint_as_float(rr[1])); } return v; }
__device__ __forceinline__ unsigned q8x4(const f32x4 x) {
    const int a = (int)__builtin_rintf(x.x), b = (int)__builtin_rintf(x.y), c = (int)__builtin_rintf(x.z), d = (int)__builtin_rintf(x.w);
    return ((unsigned)a & 0xffu) | (((unsigned)b & 0xffu) << 8) | (((unsigned)c & 0xffu) << 16) | (((unsigned)d & 0xffu) << 24);
}
__device__ __forceinline__ void unpack8(const u32x4 w, float (&f)[8]) { f[0] = bflo(w.x); f[1] = bfhi(w.x); f[2] = bflo(w.y); f[3] = bfhi(w.y); f[4] = bflo(w.z); f[5] = bfhi(w.z); f[6] = bflo(w.w); f[7] = bfhi(w.w); }
__device__ __forceinline__ u32x4 pack8(const float (&f)[8]) { u32x4 w; w.x = cvtpk(f[0], f[1]); w.y = cvtpk(f[2], f[3]); w.z = cvtpk(f[4], f[5]); w.w = cvtpk(f[6], f[7]); return w; }

#define XB_TMO      128
#define XB_XCNT(j)  (256  + 64 * (j))
#define XB_XSUB(j)  (1280 + 64 * (j))
#define XB_XGEN(j)  (2304 + 64 * (j))
#define XB_TOP      3328
#define XB_TOPGEN   3392
#define XCD_BAR_WORDS 3456
#define XB_SPIN_CAP (1u << 25)
__device__ __forceinline__ unsigned xb_ld(unsigned* p)              { return __hip_atomic_load(p, __ATOMIC_RELAXED, __HIP_MEMORY_SCOPE_AGENT); }
__device__ __forceinline__ unsigned xb_add(unsigned* p, unsigned v) { return __hip_atomic_fetch_add(p, v, __ATOMIC_RELAXED, __HIP_MEMORY_SCOPE_AGENT); }
__device__ __forceinline__ unsigned xb_xcc_id() { return (unsigned)__builtin_amdgcn_s_getreg((3 << 11) | 20) & 0xFu; }
#define XB_SPIN(cond, bar) do { unsigned _sp = 0; while (cond) { __builtin_amdgcn_s_sleep(1); \
    if ((++_sp & 255u) == 0u) { if (xb_ld(&(bar)[XB_TMO])) break; if (_sp > XB_SPIN_CAP) { atomicAdd(&(bar)[XB_TMO], 1u); break; } } } } while (0)
struct XcdBarrier { unsigned* bar; unsigned x; volatile LAS unsigned* st; };
__device__ __forceinline__ XcdBarrier xcd_barrier_post(unsigned* bar, volatile LAS unsigned* st) {
    XcdBarrier b; b.bar = bar; b.x = xb_xcc_id(); b.st = st;
    if (threadIdx.x == 0) (void)xb_add(&bar[XB_XCNT(b.x)], 1u);
    return b;
}
__device__ __forceinline__ void xcd_barrier_complete(unsigned* bar, unsigned x, unsigned& nloc, unsigned& nx) {
    const unsigned G = gridDim.x * gridDim.y * gridDim.z;
    unsigned sum, cnt, mine, sp = 0u;
    for (;;) {
        sum = 0u; cnt = 0u; mine = 0u;
#pragma unroll
        for (unsigned j = 0; j < 16; ++j) { const unsigned c = xb_ld(&bar[XB_XCNT(j)]); sum += c; cnt += (c > 0u) ? 1u : 0u; mine = (j == x) ? c : mine; }
        if (sum == G) break;
        __builtin_amdgcn_s_sleep(1);
        if ((++sp & 255u) == 0u) { if (xb_ld(&bar[XB_TMO])) break; if (sp > XB_SPIN_CAP) { atomicAdd(&bar[XB_TMO], 1u); break; } }
    }
    nloc = mine > 0u ? mine : 1u; nx = cnt > 0u ? cnt : 1u;
}
__device__ __forceinline__ void xcd_barrier(const XcdBarrier& b) {
    asm volatile("s_waitcnt vmcnt(0)" ::: "memory");
    __syncthreads();
    if (threadIdx.x == 0) {
        unsigned* bar = b.bar;
        __builtin_amdgcn_s_waitcnt(0);
        unsigned nloc = b.st[0], nx = b.st[1];
        if (nloc == 0u) { xcd_barrier_complete(bar, b.x, nloc, nx); b.st[0] = nloc; b.st[1] = nx; }
        const unsigned old = xb_add(&bar[XB_XSUB(b.x)], 1u);
        const unsigned gen = old / nloc;
        if (old + 1u == (gen + 1u) * nloc) {
            __builtin_amdgcn_fence(__ATOMIC_RELEASE, "agent");
            asm volatile("s_waitcnt vmcnt(0)" ::: "memory");
            const unsigned og = xb_add(&bar[XB_TOP], 1u);
            const unsigned tg = og / nx;
            if (og + 1u == (tg + 1u) * nx) xb_add(&bar[XB_TOPGEN], 1u);
            else XB_SPIN(xb_ld(&bar[XB_TOPGEN]) == tg, bar);
            __builtin_amdgcn_fence(__ATOMIC_ACQUIRE, "agent");
            xb_add(&bar[XB_XGEN(b.x)], 1u);
            asm volatile("s_waitcnt vmcnt(0)" ::: "memory");
        } else {
            XB_SPIN(xb_ld(&bar[XB_XGEN(b.x)]) == gen, bar);
            __builtin_amdgcn_fence(__ATOMIC_ACQUIRE, "agent");
            asm volatile("s_waitcnt vmcnt(0)" ::: "memory");
        }
    }
    __syncthreads();
}

namespace pg8 {
constexpr int BM = 256, BK = 64, HALF = 128, HTB = HALF * BK * 2, STAGE_BYTES = 8 * HTB, NXCD = 8, WGM = 8;
__device__ __forceinline__ int lds_byte(int r, int c) { const int st = (r >> 4) * 2 + (c >> 5), rr = r & 15, cc = c & 31, ob = rr * 64 + cc * 2; return st * 1024 + (ob ^ (((ob >> 9) & 1) << 5)); }
__device__ __forceinline__ void stage_rc(int b, int& R, int& C) { const int st = b / 1024, sb = b % 1024, swz = sb ^ (((sb >> 9) & 1) << 5); R = (st >> 1) * 16 + swz / 64; C = (st & 1) * 32 + (swz % 64) / 2; }
__device__ __forceinline__ int perm32(int rho) { const int n = rho >> 4, i = rho & 15; return 8 * (i >> 2) + 4 * n + (i & 3); }
struct Unit { int pm, pn, aux; };
struct Order {
    int nM, nN, nwg, G, c, br, skipctx;
    __device__ void init(int nM_, int nN_, int G_, int c_, int br_ = 1, int skipctx_ = 0) { nM = nM_; nN = nN_; nwg = nM * nN; G = G_; c = c_; br = br_; skipctx = skipctx_; }
    __device__ bool next(int i, Unit& u) const {
        const int it = i / br, ia = i - it * br;
        const long L = (long)it * G + c; if (L >= nwg) return false;
        int wgid = (int)L; { const int q = nwg / NXCD, r = nwg % NXCD, xcd = wgid % NXCD, off = wgid / NXCD; wgid = (xcd < r ? xcd * (q + 1) : r * (q + 1) + (xcd - r) * q) + off; }
        const int nig = WGM * nN, gid = wgid / nig, fm = gid * WGM, gsz = (nM - fm) < WGM ? (nM - fm) : WGM;
        u.pm = fm + ((wgid % nig) % gsz); u.pn = (wgid % nig) / gsz + ia * nN; u.aux = ia;
        if (skipctx) u.pm += (u.pm >> 5) + 1;
        return true;
    }
};
template <class Prob, class Epi>
__device__ __forceinline__ void gemm_phase(LAS unsigned char* lds, const Prob& P, const Order& S, const Epi& E) {
    const int tid = ltid(), wid = __builtin_amdgcn_readfirstlane(tid >> 6), lane = tid & 63, wr = wid >> 2, wc = wid & 3, fr = lane & 15, fq = lane >> 4;
    const int nt = P.nt;
    unsigned voffA[2], voffB[2];
#pragma unroll
    for (int i = 0; i < 2; ++i) { int R, C; stage_rc(tid * 16 + i * 8192, R, C); const int Rb = Epi::PERM ? ((R & ~31) + perm32(R & 31)) : R;
        voffA[i] = (unsigned)R * P.lda + (unsigned)C * 2u; voffB[i] = (unsigned)Rb * P.ldb + (unsigned)C * 2u; }
    const size_t kstep = (size_t)(BK * 2);
    const size_t hA = (size_t)HALF * P.lda, hB = (size_t)HALF * P.ldb;
    const unsigned ldsw = (unsigned)wid * 1024u;
    const int aoff = lds_byte(wr * 64 + fr, fq * 8), boff = lds_byte(wc * 32 + fr, fq * 8);
#define PG8_SA(b, h) (((b) * 2 + (h)) * HTB)
#define PG8_SB(b, h) ((4 + (b) * 2 + (h)) * HTB)
#define PG8_STAGE(bufoff, gbase, voff) do { _Pragma("unroll") for (int _i = 0; _i < 2; ++_i) \
        __builtin_amdgcn_global_load_lds((const unsigned*)((const char*)(gbase) + (voff)[_i]), (LAS unsigned*)(lds + (bufoff) + ldsw + _i * 8192), 16, 0, 0); } while (0)
#define PG8_LDA(dst, b, h) do { _Pragma("unroll") for (int m = 0; m < 4; ++m) { \
        if constexpr (Epi::F8) { const i32x4 lo_ = *(const LAS i32x4*)(lds + PG8_SA(b, h) + aoff + m * 2048), hi_ = *(const LAS i32x4*)(lds + PG8_SA(b, h) + aoff + m * 2048 + 1024); \
            dst##8[m] = __builtin_shufflevector(lo_, hi_, 0, 1, 2, 3, 4, 5, 6, 7); } \
        else { _Pragma("unroll") for (int k = 0; k < 2; ++k) dst[m][k] = *(const LAS bf16x8*)(lds + PG8_SA(b, h) + aoff + m * 2048 + k * 1024); } } } while (0)
#define PG8_LDB(dst, b, h) do { _Pragma("unroll") for (int n = 0; n < 2; ++n) { \
        if constexpr (Epi::F8) { const i32x4 lo_ = *(const LAS i32x4*)(lds + PG8_SB(b, h) + boff + n * 2048), hi_ = *(const LAS i32x4*)(lds + PG8_SB(b, h) + boff + n * 2048 + 1024); \
            dst##8[n] = __builtin_shufflevector(lo_, hi_, 0, 1, 2, 3, 4, 5, 6, 7); } \
        else { _Pragma("unroll") for (int k = 0; k < 2; ++k) dst[n][k] = *(const LAS bf16x8*)(lds + PG8_SB(b, h) + boff + n * 2048 + k * 1024); } } } while (0)
#define PG8_MMA(ai, bj, At, Bt) do { __builtin_amdgcn_s_setprio(1); _Pragma("unroll") for (int m = 0; m < 4; ++m) _Pragma("unroll") for (int n = 0; n < 2; ++n) { \
        if constexpr (Epi::F8) asm volatile("v_mfma_scale_f32_16x16x128_f8f6f4 %0, %1, %2, %0, %3, %3 op_sel_hi:[0,0,0]" : "+v"(acc[ai][bj][m][n]) : "v"(Bt##8[n]), "v"(At##8[m]), "v"(f8scale));   \
        else { _Pragma("unroll") for (int k = 0; k < 2; ++k) { \
        if constexpr (Epi::I8) acc[ai][bj][m][n] = __builtin_bit_cast(f32x4, __builtin_amdgcn_mfma_i32_16x16x64_i8(__builtin_bit_cast(i32x4, Bt[n][k]), __builtin_bit_cast(i32x4, At[m][k]), __builtin_bit_cast(i32x4, acc[ai][bj][m][n]), 0, 0, 0)); \
        else acc[ai][bj][m][n] = __builtin_amdgcn_mfma_f32_16x16x32_bf16(Bt[n][k], At[m][k], acc[ai][bj][m][n], 0, 0, 0); } } } __builtin_amdgcn_s_setprio(0); } while (0)
#define PG8_WAIT_V(n) asm volatile("s_waitcnt vmcnt(" #n ")" ::: "memory")
#define PG8_WAIT_L(n) asm volatile("s_waitcnt lgkmcnt(" #n ")" ::: "memory")
#define PG8_BAR __builtin_amdgcn_s_barrier()
#define PG8_SCHED __builtin_amdgcn_sched_barrier(0)
    Unit cur, nxt; int ui = 0;
    if (!S.next(0, cur)) return;
    f32x4 acc[2][2][4][2];
#pragma unroll
    for (int a = 0; a < 2; ++a)
#pragma unroll
        for (int b = 0; b < 2; ++b)
#pragma unroll
            for (int m = 0; m < 4; ++m)
#pragma unroll
                for (int n = 0; n < 2; ++n) acc[a][b][m][n] = (f32x4){0.f, 0.f, 0.f, 0.f};
    bf16x8 At[4][2], B0[2][2], B1[2][2];
    const int f8scale = 0x7f7f7f7f;
    i32x8 At8[4], B08[2], B18[2];
    const char* cA; const char* cB; P.setup(cur, cA, cB);
    PG8_STAGE(PG8_SB(0, 0), cB, voffB); PG8_STAGE(PG8_SB(0, 1), cB + hB, voffB); PG8_STAGE(PG8_SA(0, 0), cA, voffA); PG8_STAGE(PG8_SA(0, 1), cA + hA, voffA);
    if (wr == 1) PG8_BAR;
    PG8_WAIT_V(2); PG8_BAR;
    PG8_STAGE(PG8_SB(1, 0), cB + kstep, voffB); PG8_STAGE(PG8_SA(1, 0), cA + kstep, voffA); PG8_STAGE(PG8_SB(1, 1), cB + hB + kstep, voffB);
    PG8_WAIT_V(6); PG8_BAR;
    for (;;) {
        const bool has_next = S.next(ui + 1, nxt);
        const char* nA = cA; const char* nB = cB;
        if (has_next) P.setup(nxt, nA, nB);
        for (int t = 0; t < nt; t += 2) {
            const bool last = (t == nt - 2);
            const char* a1 = cA + (size_t)(t + 1) * kstep;
            const char* a2 = last ? nA : cA + (size_t)(t + 2) * kstep; const char* b2 = last ? nB : cB + (size_t)(t + 2) * kstep;
            const char* a3 = a2 + kstep; const char* b3 = b2 + kstep;
            PG8_LDB(B0, 0, 0); PG8_LDB(B1, 0, 1); PG8_SCHED; PG8_LDA(At, 0, 0); PG8_STAGE(PG8_SA(1, 1), a1 + hA, voffA);
            PG8_WAIT_V(8); PG8_WAIT_L(0); PG8_BAR; PG8_MMA(0, 0, At, B0); PG8_MMA(0, 1, At, B1); PG8_BAR; PG8_SCHED;
            PG8_LDA(At, 0, 1); PG8_STAGE(PG8_SB(0, 0), b2, voffB); PG8_STAGE(PG8_SB(0, 1), b2 + hB, voffB); PG8_STAGE(PG8_SA(0, 0), a2, voffA);
            PG8_WAIT_V(8); PG8_WAIT_L(0); PG8_BAR; PG8_MMA(1, 0, At, B0); PG8_MMA(1, 1, At, B1); PG8_BAR; PG8_SCHED;
            PG8_LDB(B0, 1, 0); PG8_LDB(B1, 1, 1); PG8_SCHED; PG8_LDA(At, 1, 0); PG8_STAGE(PG8_SA(0, 1), a2 + hA, voffA);
            PG8_WAIT_V(8); PG8_WAIT_L(0); PG8_BAR; PG8_MMA(0, 0, At, B0); PG8_MMA(0, 1, At, B1); PG8_BAR; PG8_SCHED;
            PG8_LDA(At, 1, 1); PG8_STAGE(PG8_SB(1, 0), b3, voffB); PG8_STAGE(PG8_SB(1, 1), b3 + hB, voffB); PG8_STAGE(PG8_SA(1, 0), a3, voffA);
            PG8_WAIT_V(8); PG8_WAIT_L(0); PG8_BAR; PG8_MMA(1, 0, At, B0); PG8_MMA(1, 1, At, B1); PG8_BAR; PG8_SCHED;
        }
        if (wr == 0) PG8_BAR;
        if constexpr (Epi::F8) asm volatile("s_nop 15\n\ts_nop 7" ::: "memory");
        E(acc, cur, wr, wc, fr, fq);
        if (!has_next) break;
#pragma unroll
        for (int a = 0; a < 2; ++a)
#pragma unroll
            for (int b = 0; b < 2; ++b)
#pragma unroll
                for (int m = 0; m < 4; ++m)
#pragma unroll
                    for (int n = 0; n < 2; ++n) acc[a][b][m][n] = (f32x4){0.f, 0.f, 0.f, 0.f};
        cur = nxt; cA = nA; cB = nB; ++ui;
        if (wr == 1) PG8_BAR;
    }
    PG8_WAIT_V(0);
    PG8_BAR;
#undef PG8_SA
#undef PG8_SB
#undef PG8_STAGE
#undef PG8_LDA
#undef PG8_LDB
#undef PG8_MMA
#undef PG8_WAIT_V
#undef PG8_WAIT_L
#undef PG8_BAR
#undef PG8_SCHED
}
}

struct ProbPlain { const char* A; const char* B; unsigned lda, ldb; int nt;
    __device__ __forceinline__ void setup(pg8::Unit& u, const char*& a, const char*& b) const { a = A + (size_t)u.pm * 256 * lda; b = B + (size_t)u.pn * 256 * ldb; } };
struct ProbBO { const char* A; const char* B; unsigned lda, ldb; int nt;
    __device__ __forceinline__ void setup(pg8::Unit& u, const char*& a, const char*& b) const { a = A + (size_t)u.pm * 256 * lda + (size_t)(u.pn >> 2) * 512; b = B + (size_t)u.pn * 256 * ldb; } };
struct ProbMoE { const char* A; const char* B; unsigned lda, ldb; int nt; const int* tstart; size_t bstride;
    __device__ __forceinline__ void setup(pg8::Unit& u, const char*& a, const char*& b) const {
        int e = 0;
#pragma unroll 1
        for (int j = 1; j < NE; ++j) e += (u.pm >= tstart[j]) ? 1 : 0;
        u.aux = e; a = A + (size_t)u.pm * 256 * lda; b = B + (size_t)e * bstride + (size_t)u.pn * 256 * ldb; } };

__device__ __forceinline__ f32x4 i2f4(const f32x4 a) { const i32x4 i = __builtin_bit_cast(i32x4, a); return (f32x4){(float)i.x, (float)i.y, (float)i.z, (float)i.w}; }
typedef const f32x4 (&AccRef)[2][2][4][2];
struct EpiIn {
    static constexpr bool PERM = true, I8 = false, F8 = false;
    bf16* Pb; bf16* Gb; float* gates; const float* bmg;
    __device__ __forceinline__ void operator()(AccRef acc, const pg8::Unit& u, int wr, int wc, int fr, int fq) const {
        const int row0 = u.pm * 256 + wr * 64 + fr;
        if (u.pn < 22) {
            const int col0 = u.pn * 256 + wc * 32 + 8 * fq;
#pragma unroll
            for (int ai = 0; ai < 2; ++ai)
#pragma unroll
                for (int m = 0; m < 4; ++m) { const int row = row0 + ai * 128 + m * 16; bf16* rowp = Pb + (size_t)row * LDP + col0;
#pragma unroll
                    for (int bj = 0; bj < 2; ++bj) { const f32x4 v0 = acc[ai][bj][m][0], v1 = acc[ai][bj][m][1];
                        u32x4 w; w.x = cvtpk(v0[0], v0[1]); w.y = cvtpk(v0[2], v0[3]); w.z = cvtpk(v1[0], v1[1]); w.w = cvtpk(v1[2], v1[3]);
                        *(u32x4*)(rowp + bj * 128) = w;
                        if (bj == 0 && u.pn == 14 && wc == 0 && fq < 2) { float* g = gates + (size_t)row * 32 + 8 * fq; *(f32x4*)g = v0; *(f32x4*)(g + 4) = v1; }
                        if (bj == 1 && u.pn == 21 && wc == 1 && fq >= 2) { float* g = gates + (size_t)row * 32 + 16 + 8 * (fq - 2); *(f32x4*)g = v0; *(f32x4*)(g + 4) = v1; } } }
        } else {
            const int col0 = (u.pn - 22) * 256 + wc * 32 + 8 * fq;
            f32x4 bv[2][2];
#pragma unroll
            for (int bj = 0; bj < 2; ++bj)
#pragma unroll
                for (int n = 0; n < 2; ++n) bv[bj][n] = *(const f32x4*)(bmg + col0 + bj * 128 + 4 * n);
#pragma unroll
            for (int ai = 0; ai < 2; ++ai)
#pragma unroll
                for (int m = 0; m < 4; ++m) { bf16* rowp = Gb + (size_t)(row0 + ai * 128 + m * 16) * NGATE + col0;
#pragma unroll
                    for (int bj = 0; bj < 2; ++bj) { f32x4 v0 = acc[ai][bj][m][0] + bv[bj][0], v1 = acc[ai][bj][m][1] + bv[bj][1];
#pragma unroll
                        for (int j = 0; j < 4; ++j) { v0[j] = fsigmoid(v0[j]); v1[j] = fsigmoid(v1[j]); }
                        u32x4 w; w.x = cvtpk(v0[0], v0[1]); w.y = cvtpk(v0[2], v0[3]); w.z = cvtpk(v1[0], v1[1]); w.w = cvtpk(v1[2], v1[3]);
                        *(u32x4*)(rowp + bj * 128) = w; } }
        }
    }
};
struct EpiStore {
    static constexpr bool PERM = true, I8 = false, F8 = false;
    bf16* O; int ldc; const float* bias; int bias_stride;
    __device__ __forceinline__ void operator()(AccRef acc, const pg8::Unit& u, int wr, int wc, int fr, int fq) const {
        const int row0 = u.pm * 256 + wr * 64 + fr, col0 = u.pn * 256 + wc * 32 + 8 * fq;
        f32x4 bv[2][2];
#pragma unroll
        for (int bj = 0; bj < 2; ++bj)
#pragma unroll
            for (int n = 0; n < 2; ++n) bv[bj][n] = bias ? *(const f32x4*)(bias + (size_t)u.aux * bias_stride + col0 + bj * 128 + 4 * n) : (f32x4){0.f, 0.f, 0.f, 0.f};
#pragma unroll
        for (int ai = 0; ai < 2; ++ai)
#pragma unroll
            for (int m = 0; m < 4; ++m) { bf16* rowp = O + (size_t)(row0 + ai * 128 + m * 16) * ldc + col0;
#pragma unroll
                for (int bj = 0; bj < 2; ++bj) { const f32x4 v0 = acc[ai][bj][m][0] + bv[bj][0], v1 = acc[ai][bj][m][1] + bv[bj][1];
                    u32x4 w; w.x = cvtpk(v0[0], v0[1]); w.y = cvtpk(v0[2], v0[3]); w.z = cvtpk(v1[0], v1[1]); w.w = cvtpk(v1[2], v1[3]);
                    *(u32x4*)(rowp + bj * 128) = w; } }
    }
};
struct EpiStoreF8 {
    static constexpr bool PERM = true, I8 = false, F8 = true; static constexpr int SCALE_A = 0x7f7f7f7f, SCALE_B = 0x7f7f7f7f;
    bf16* O; int ldc; const float* bias; int bias_stride;
    __device__ __forceinline__ void operator()(AccRef acc, const pg8::Unit& u, int wr, int wc, int fr, int fq) const {
        const int row0 = u.pm * 256 + wr * 64 + fr, col0 = u.pn * 256 + wc * 32 + 8 * fq;
        f32x4 bv[2][2];
#pragma unroll
        for (int bj = 0; bj < 2; ++bj)
#pragma unroll
            for (int n = 0; n < 2; ++n) bv[bj][n] = *(const f32x4*)(bias + (size_t)u.aux * bias_stride + col0 + bj * 128 + 4 * n);
#pragma unroll
        for (int ai = 0; ai < 2; ++ai)
#pragma unroll
            for (int m = 0; m < 4; ++m) { bf16* rowp = O + (size_t)(row0 + ai * 128 + m * 16) * ldc + col0;
#pragma unroll
                for (int bj = 0; bj < 2; ++bj) { const f32x4 v0 = acc[ai][bj][m][0] * 0.015625f + bv[bj][0], v1 = acc[ai][bj][m][1] * 0.015625f + bv[bj][1];
                    u32x4 w; w.x = cvtpk(v0[0], v0[1]); w.y = cvtpk(v0[2], v0[3]); w.z = cvtpk(v1[0], v1[1]); w.w = cvtpk(v1[2], v1[3]);
                    *(u32x4*)(rowp + bj * 128) = w; } }
    }
};
struct EpiBO {
    static constexpr bool PERM = true, I8 = true, F8 = false;
    bf16* Z; const bf16* G; const float* sY; const float* cmB;
    __device__ __forceinline__ void operator()(AccRef acc, const pg8::Unit& u, int wr, int wc, int fr, int fq) const {
        const int row0 = u.pm * 256 + wr * 64 + fr, colg = u.pn * 256 + wc * 32 + 8 * fq, colz = (u.pn & 3) * 256 + wc * 32 + 8 * fq;
        const bool first = u.aux == 0;
        f32x4 sw[2][2];
#pragma unroll
        for (int bj = 0; bj < 2; ++bj)
#pragma unroll
            for (int n = 0; n < 2; ++n) sw[bj][n] = *(const f32x4*)(cmB + colg + bj * 128 + 4 * n) * (1.0f / 127.0f);
#pragma unroll
        for (int ai = 0; ai < 2; ++ai)
#pragma unroll
            for (int m = 0; m < 4; ++m) { const int row = row0 + ai * 128 + m * 16; const float sa = sY[row * 4 + u.aux];
#pragma unroll
                for (int bj = 0; bj < 2; ++bj) { const u32x4 gw = *(const u32x4*)(G + (size_t)row * NGATE + colg + bj * 128); float g[8]; unpack8(gw, g);
                    bf16* zp = Z + (size_t)row * D + colz + bj * 128;
                    float z[8];
                    if (first) {
#pragma unroll
                        for (int j = 0; j < 8; ++j) z[j] = 0.f;
                    } else unpack8(*(const u32x4*)zp, z);
                    const f32x4 v0 = i2f4(acc[ai][bj][m][0]) * sw[bj][0] * sa, v1 = i2f4(acc[ai][bj][m][1]) * sw[bj][1] * sa;
#pragma unroll
                    for (int j = 0; j < 4; ++j) { z[j] += v0[j] * g[j]; z[4 + j] += v1[j] * g[4 + j]; }
                    *(u32x4*)zp = pack8(z); } }
    }
};
struct EpiOut {
    static constexpr bool PERM = false, I8 = false, F8 = false;
    float* X; const float* modl;
    __device__ __forceinline__ void operator()(AccRef acc, const pg8::Unit& u, int wr, int wc, int fr, int fq) const {
        const int row0 = u.pm * 256 + wr * 64 + fr, col0 = u.pn * 256 + wc * 32 + 4 * fq;
        const int mv = (u.pm % 33 == 0) ? 4 : u.pm / 33;
        const float* g1 = modl + mv * 6144 + 2048;
        f32x4 gv[2][2];
#pragma unroll
        for (int bj = 0; bj < 2; ++bj)
#pragma unroll
            for (int n = 0; n < 2; ++n) gv[bj][n] = *(const f32x4*)(g1 + col0 + bj * 128 + n * 16);
#pragma unroll
        for (int ai = 0; ai < 2; ++ai)
#pragma unroll
            for (int m = 0; m < 4; ++m) { float* rowp = X + (size_t)(row0 + ai * 128 + m * 16) * D + col0;
#pragma unroll
                for (int bj = 0; bj < 2; ++bj)
#pragma unroll
                    for (int n = 0; n < 2; ++n) { f32x4* p = (f32x4*)(rowp + bj * 128 + n * 16); *p = *p + gv[bj][n] * acc[ai][bj][m][n]; } }
    }
};
struct EpiMoE1 {
    static constexpr bool PERM = true, I8 = false, F8 = false;
    bf16* ACT; const float* bgu;
    __device__ __forceinline__ void operator()(AccRef acc, const pg8::Unit& u, int wr, int wc, int fr, int fq) const {
        const int row0 = u.pm * 256 + wr * 64 + fr, c0 = u.pn * 128 + wc * 32 + 8 * fq;
        const float* bg = bgu + (size_t)u.aux * 2048 + c0;
        f32x4 bgt[2], bup[2];
#pragma unroll
        for (int n = 0; n < 2; ++n) { bgt[n] = *(const f32x4*)(bg + 4 * n); bup[n] = *(const f32x4*)(bg + 1024 + 4 * n); }
#pragma unroll
        for (int ai = 0; ai < 2; ++ai)
#pragma unroll
            for (int m = 0; m < 4; ++m) { float o[8];
#pragma unroll
                for (int n = 0; n < 2; ++n)
#pragma unroll
                    for (int j = 0; j < 4; ++j) { const float gate = fminf(acc[ai][0][m][n][j] + bgt[n][j], 7.0f); const float up = fminf(fmaxf(acc[ai][1][m][n][j] + bup[n][j], -7.0f), 7.0f);
                        o[4 * n + j] = (up + 1.0f) * gate * fsigmoid(1.702f * gate); }
                *(u32x4*)(ACT + (size_t)(row0 + ai * 128 + m * 16) * DFF + c0) = pack8(o); }
    }
};

struct EpiIn8 {
    static constexpr bool PERM = true, I8 = true, F8 = false;
    bf16* Pb; bf16* Gb; float* gates; const float* bmg; const float* sA; const float* cmB;
    __device__ __forceinline__ void operator()(AccRef acc, const pg8::Unit& u, int wr, int wc, int fr, int fq) const {
        const int row0 = u.pm * 256 + wr * 64 + fr, cb0 = u.pn * 256 + wc * 32 + 8 * fq;
        f32x4 sw[2][2];
#pragma unroll
        for (int bj = 0; bj < 2; ++bj)
#pragma unroll
            for (int n = 0; n < 2; ++n) sw[bj][n] = *(const f32x4*)(cmB + cb0 + bj * 128 + 4 * n) * (1.0f / 127.0f);
        if (u.pn < 22) {
#pragma unroll
            for (int ai = 0; ai < 2; ++ai)
#pragma unroll
                for (int m = 0; m < 4; ++m) { const int row = row0 + ai * 128 + m * 16; bf16* rowp = Pb + (size_t)row * LDP + cb0; const float sa = sA[row];
#pragma unroll
                    for (int bj = 0; bj < 2; ++bj) { const f32x4 v0 = i2f4(acc[ai][bj][m][0]) * sw[bj][0] * sa, v1 = i2f4(acc[ai][bj][m][1]) * sw[bj][1] * sa;
                        u32x4 w; w.x = cvtpk(v0[0], v0[1]); w.y = cvtpk(v0[2], v0[3]); w.z = cvtpk(v1[0], v1[1]); w.w = cvtpk(v1[2], v1[3]);
                        *(u32x4*)(rowp + bj * 128) = w;
                        if (bj == 0 && u.pn == 14 && wc == 0 && fq < 2) { float* g = gates + (size_t)row * 32 + 8 * fq; *(f32x4*)g = v0; *(f32x4*)(g + 4) = v1; }
                        if (bj == 1 && u.pn == 21 && wc == 1 && fq >= 2) { float* g = gates + (size_t)row * 32 + 16 + 8 * (fq - 2); *(f32x4*)g = v0; *(f32x4*)(g + 4) = v1; } } }
        } else {
            const int col0 = cb0 - LDP;
            f32x4 bv[2][2];
#pragma unroll
            for (int bj = 0; bj < 2; ++bj)
#pragma unroll
                for (int n = 0; n < 2; ++n) bv[bj][n] = *(const f32x4*)(bmg + col0 + bj * 128 + 4 * n);
#pragma unroll
            for (int ai = 0; ai < 2; ++ai)
#pragma unroll
                for (int m = 0; m < 4; ++m) { const int row = row0 + ai * 128 + m * 16; bf16* rowp = Gb + (size_t)row * NGATE + col0; const float sa = sA[row];
#pragma unroll
                    for (int bj = 0; bj < 2; ++bj) { f32x4 v0 = i2f4(acc[ai][bj][m][0]) * sw[bj][0] * sa + bv[bj][0], v1 = i2f4(acc[ai][bj][m][1]) * sw[bj][1] * sa + bv[bj][1];
#pragma unroll
                        for (int j = 0; j < 4; ++j) { v0[j] = fsigmoid(v0[j]); v1[j] = fsigmoid(v1[j]); }
                        u32x4 w; w.x = cvtpk(v0[0], v0[1]); w.y = cvtpk(v0[2], v0[3]); w.z = cvtpk(v1[0], v1[1]); w.w = cvtpk(v1[2], v1[3]);
                        *(u32x4*)(rowp + bj * 128) = w; } }
        }
    }
};
struct EpiMoE18 {
    static constexpr bool PERM = true, I8 = true, F8 = false;
    bf16* ACT; const float* bgu; const float* sA; const float* cmB;
    __device__ __forceinline__ void operator()(AccRef acc, const pg8::Unit& u, int wr, int wc, int fr, int fq) const {
        const int row0 = u.pm * 256 + wr * 64 + fr, c0 = u.pn * 128 + wc * 32 + 8 * fq;
        const float* bg = bgu + (size_t)u.aux * 2048 + c0;
        const float* cm = cmB + (size_t)u.aux * 2048 + u.pn * 256 + wc * 32 + 8 * fq;
        f32x4 bgt[2], bup[2], sg[2], su[2];
#pragma unroll
        for (int n = 0; n < 2; ++n) { bgt[n] = *(const f32x4*)(bg + 4 * n); bup[n] = *(const f32x4*)(bg + 1024 + 4 * n); sg[n] = *(const f32x4*)(cm + 4 * n) * (1.0f / 127.0f); su[n] = *(const f32x4*)(cm + 128 + 4 * n) * (1.0f / 127.0f); }
#pragma unroll
        for (int ai = 0; ai < 2; ++ai)
#pragma unroll
            for (int m = 0; m < 4; ++m) { const int row = row0 + ai * 128 + m * 16; const float sa = sA[row]; float o[8];
#pragma unroll
                for (int n = 0; n < 2; ++n) { const f32x4 ga = i2f4(acc[ai][0][m][n]) * sg[n] * sa + bgt[n], ua = i2f4(acc[ai][1][m][n]) * su[n] * sa + bup[n];
#pragma unroll
                    for (int j = 0; j < 4; ++j) { const float gate = fminf(ga[j], 7.0f); const float up = fminf(fmaxf(ua[j], -7.0f), 7.0f);
                        o[4 * n + j] = (up + 1.0f) * gate * fsigmoid(1.702f * gate); } }
                int w0 = 0, w1 = 0;
                w0 = __builtin_amdgcn_cvt_pk_fp8_f32(o[0], o[1], w0, false); w0 = __builtin_amdgcn_cvt_pk_fp8_f32(o[2], o[3], w0, true);
                w1 = __builtin_amdgcn_cvt_pk_fp8_f32(o[4], o[5], w1, false); w1 = __builtin_amdgcn_cvt_pk_fp8_f32(o[6], o[7], w1, true);
                *(u32x2*)((unsigned char*)ACT + (size_t)row * DFF + c0) = (u32x2){(unsigned)w0, (unsigned)w1}; }
    }
};

struct AttnJob {
    const bf16* Q; int qpitch;
    const bf16* K; int kpitch;
    const bf16* VT;
    bf16* O; int opitch;
    int ntiles; float c;
    int s0_first_n, s0_jump;
    int kr_lo, r_w, c_q;
    const LAS float* bias;
};
template <int DQK, bool NA>
__device__ __forceinline__ void attn_unit(LAS unsigned char* lds, const AttnJob& J) {
    constexpr int KPB = (DQK == 96) ? 208 : 144, VPB = 136, NS = DQK / 16, KCH = DQK / 8;
    constexpr int KBUF = 64 * KPB, VBUF = 64 * VPB;
    const int tid = ltid(), wid = __builtin_amdgcn_readfirstlane(tid >> 6), lane = tid & 63, r = lane & 31, h = lane >> 5;
    LAS unsigned char* kb0 = lds; LAS unsigned char* vb0 = lds + 2 * KBUF;
    bf16x8 qf[NS];
    { const bf16* qrow = J.Q + (size_t)(wid * 32 + r) * J.qpitch + 8 * h;
#pragma unroll
      for (int s = 0; s < NS; ++s) qf[s] = *(const bf16x8*)(qrow + 16 * s); }
    f32x16 o0, o1;
#pragma unroll
    for (int i = 0; i < 16; ++i) { o0[i] = 0.f; o1[i] = 0.f; }
    float mrun = -1e30f, lsum = 0.f;
    const int k0r = tid / KCH, k0c = tid % KCH, k1r = (tid + 512) / KCH, k1c = (tid + 512) % KCH;
    const bool k1 = (tid + 512) < 64 * KCH;
    const int vd = tid >> 3, vc = tid & 7;
    u32x4 kr0, kr1, vr;
    auto s0_of = [&](int j) { return j < J.s0_first_n ? 64 * j : J.s0_jump + 64 * (j - J.s0_first_n); };
    auto gload = [&](int j) { const int s0 = s0_of(j);
        kr0 = *(const u32x4*)(J.K + (size_t)(s0 + k0r) * J.kpitch + 8 * k0c);
        if (k1) kr1 = *(const u32x4*)(J.K + (size_t)(s0 + k1r) * J.kpitch + 8 * k1c);
        vr = *(const u32x4*)(J.VT + (size_t)vd * TB + s0 + 8 * vc); };
    auto lstore = [&](int buf) {
        *(LAS u32x4*)(kb0 + buf * KBUF + k0r * KPB + 16 * k0c) = kr0;
        if (k1) *(LAS u32x4*)(kb0 + buf * KBUF + k1r * KPB + 16 * k1c) = kr1;
        LAS unsigned char* vp = vb0 + buf * VBUF + vd * VPB + 16 * vc;
        *(LAS u32x2*)vp = (u32x2){vr.x, vr.y}; *(LAS u32x2*)(vp + 8) = (u32x2){vr.z, vr.w}; };
    gload(0); lstore(0);
    __syncthreads();
    const int r0w = NA ? min(max(J.r_w - 4, 0), 120) : 0;
    const int c0 = NA ? min(max(J.c_q - 8, 0), 48) : 0;
    for (int j = 0; j < J.ntiles; ++j) {
        const int buf = j & 1;
        if (j + 1 < J.ntiles) gload(j + 1);
        bool active = true; int dr = 0;
        if (NA && j >= 4) { const int kr = J.kr_lo + j - 4; active = (kr >= r0w) && (kr < r0w + 8); dr = kr - J.r_w + 7; }
        if (active) {
            f32x16 s0v, s1v;
#pragma unroll
            for (int i = 0; i < 16; ++i) { s0v[i] = 0.f; s1v[i] = 0.f; }
            const LAS unsigned char* kp = kb0 + buf * KBUF + r * KPB + 16 * h;
#pragma unroll
            for (int s = 0; s < NS; ++s) {
                const bf16x8 a0 = *(const LAS bf16x8*)(kp + 32 * s), a1 = *(const LAS bf16x8*)(kp + 32 * KPB + 32 * s);
                s0v = __builtin_amdgcn_mfma_f32_32x32x16_bf16(a0, qf[s], s0v, 0, 0, 0);
                s1v = __builtin_amdgcn_mfma_f32_32x32x16_bf16(a1, qf[s], s1v, 0, 0, 0);
            }
            float mx;
            if (NA && j >= 4) {
                const LAS float* bp = J.bias + dr * 31 + 15 - J.c_q;
#pragma unroll
                for (int i = 0; i < 16; ++i) { const int kc = (i & 3) + 8 * (i >> 2) + 4 * h;
                    { const bool ok = (unsigned)(kc - c0) < 16u; const float bz = bp[ok ? kc : c0]; s0v[i] = ok ? s0v[i] * J.c + bz : -1e30f; }
                    { const int kc1 = kc + 32; const bool ok = (unsigned)(kc1 - c0) < 16u; const float bz = bp[ok ? kc1 : c0]; s1v[i] = ok ? s1v[i] * J.c + bz : -1e30f; } }
                mx = -1e30f;
#pragma unroll
                for (int i = 0; i < 16; ++i) mx = fmaxf(mx, fmaxf(s0v[i], s1v[i]));
                { auto rr = __builtin_amdgcn_permlane32_swap(__float_as_uint(mx), __float_as_uint(mx), false, false); mx = fmaxf(__uint_as_float(rr[0]), __uint_as_float(rr[1])); }
            } else {
                float ma = fmaxf(s0v[0], s1v[0]), mb = fmaxf(s0v[1], s1v[1]);
#pragma unroll
                for (int i = 2; i < 16; i += 2) { ma = fmaxf(fmaxf(ma, s0v[i]), s1v[i]); mb = fmaxf(fmaxf(mb, s0v[i + 1]), s1v[i + 1]); }
                mx = fmaxf(ma, mb); { auto rr = __builtin_amdgcn_permlane32_swap(__float_as_uint(mx), __float_as_uint(mx), false, false); mx = fmaxf(__uint_as_float(rr[0]), __uint_as_float(rr[1])); } mx *= J.c;
            }
            if (__any(mx > mrun + 8.0f)) {
                const float mnew = fmaxf(mrun, mx), alpha = fexp2(mrun - mnew); mrun = mnew; lsum *= alpha;
#pragma unroll
                for (int i = 0; i < 16; ++i) { o0[i] *= alpha; o1[i] *= alpha; }
            }
            float ps = 0.f;
            if (NA && j >= 4) {
#pragma unroll
                for (int i = 0; i < 16; ++i) { s0v[i] = fexp2(s0v[i] - mrun); s1v[i] = fexp2(s1v[i] - mrun); ps += s0v[i] + s1v[i]; }
            } else {
                const float nm = -mrun;
#pragma unroll
                for (int i = 0; i < 16; ++i) { s0v[i] = fexp2(__builtin_fmaf(s0v[i], J.c, nm)); s1v[i] = fexp2(__builtin_fmaf(s1v[i], J.c, nm)); ps += s0v[i] + s1v[i]; }
            }
            lsum += ps;
            bf16x8 pf[4];
#pragma unroll
            for (int st = 0; st < 4; ++st) { u32x4 w;
#pragma unroll
                for (int q = 0; q < 4; ++q) { const int i = 8 * (st & 1) + 2 * q; w[q] = (st < 2) ? cvtpk(s0v[i], s0v[i + 1]) : cvtpk(s1v[i], s1v[i + 1]); }
                pf[st] = __builtin_bit_cast(bf16x8, w); }
            const LAS unsigned char* vp = vb0 + buf * VBUF + r * VPB + 8 * h;
#pragma unroll
            for (int st = 0; st < 4; ++st) {
                const u32x2 a0l = *(const LAS u32x2*)(vp + 32 * st), a0h = *(const LAS u32x2*)(vp + 32 * st + 16);
                const u32x2 a1l = *(const LAS u32x2*)(vp + 32 * VPB + 32 * st), a1h = *(const LAS u32x2*)(vp + 32 * VPB + 32 * st + 16);
                const bf16x8 va0 = __builtin_bit_cast(bf16x8, (u32x4){a0l.x, a0l.y, a0h.x, a0h.y}), va1 = __builtin_bit_cast(bf16x8, (u32x4){a1l.x, a1l.y, a1h.x, a1h.y});
                o0 = __builtin_amdgcn_mfma_f32_32x32x16_bf16(va0, pf[st], o0, 0, 0, 0);
                o1 = __builtin_amdgcn_mfma_f32_32x32x16_bf16(va1, pf[st], o1, 0, 0, 0);
            }
        }
        if (j + 1 < J.ntiles) lstore(buf ^ 1);
        __syncthreads();
    }
    { auto rr = __builtin_amdgcn_permlane32_swap(__float_as_uint(lsum), __float_as_uint(lsum), false, false); lsum = __uint_as_float(rr[0]) + __uint_as_float(rr[1]); }
    const float inv = frcp(lsum);
    bf16* orow = J.O + (size_t)(wid * 32 + r) * J.opitch + 4 * h;
#pragma unroll
    for (int g = 0; g < 4; ++g) {
        *(u32x2*)(orow + 8 * g) = (u32x2){cvtpk(o0[4 * g] * inv, o0[4 * g + 1] * inv), cvtpk(o0[4 * g + 2] * inv, o0[4 * g + 3] * inv)};
        *(u32x2*)(orow + 32 + 8 * g) = (u32x2){cvtpk(o1[4 * g] * inv, o1[4 * g + 1] * inv), cvtpk(o1[4 * g + 2] * inv, o1[4 * g + 3] * inv)};
    }
}

template <int DQK>
__device__ __forceinline__ void attn_unit_dense(LAS unsigned char* lds, const AttnJob& J) {
    static_assert(DQK == 96, "fp8 score path: rows are 128 bytes (64 nope | 32 rotary | 32 zero)");
    constexpr int KPB = 144, VPB = 144, KCH = 8, NKC = 2;
    constexpr int KBUF = 128 * KPB, VBUF = 64 * VPB;
    const int tid = ltid(), wid = __builtin_amdgcn_readfirstlane(tid >> 6), lane = tid & 63, r = lane & 31, h = lane >> 5;
    LAS unsigned char* kb0 = lds; LAS unsigned char* vb0 = lds + 2 * KBUF;
    i32x8 qf[2];
    { const unsigned char* qrow = (const unsigned char*)J.Q + (size_t)(wid * 32 + r) * J.qpitch + 32 * h;
#pragma unroll
      for (int i = 0; i < 2; ++i) { const i32x4 lo_ = *(const i32x4*)(qrow + 64 * i), hi_ = *(const i32x4*)(qrow + 64 * i + 16); qf[i] = __builtin_shufflevector(lo_, hi_, 0, 1, 2, 3, 4, 5, 6, 7); } }
    f32x16 o0, o1, o2;
#pragma unroll
    for (int i = 0; i < 16; ++i) { o0[i] = 0.f; o1[i] = 0.f; o2[i] = 0.f; }
    const int onev = (r == 0) ? 0x38383838 : 0;
    const i32x8 ones = {onev, onev, onev, onev, onev, onev, onev, onev};
    float mrun = -1e30f;
    u32x4 kr[NKC], vr;
    const int vd = tid >> 3, vc = tid & 7;
    auto gload = [&](int j) { const int s0 = 128 * j;
#pragma unroll
        for (int q = 0; q < NKC; ++q) { const int ch = tid + 512 * q; kr[q] = *(const u32x4*)((const unsigned char*)J.K + (size_t)(s0 + ch / KCH) * J.kpitch + 16 * (ch % KCH)); }
        vr = *(const u32x4*)((const unsigned char*)J.VT + (size_t)vd * TB + s0 + 16 * vc); };
    auto lstore = [&](int buf) {
#pragma unroll
        for (int q = 0; q < NKC; ++q) { const int ch = tid + 512 * q; *(LAS u32x4*)(kb0 + buf * KBUF + (ch / KCH) * KPB + 16 * (ch % KCH)) = kr[q]; }
        LAS unsigned char* vp = vb0 + buf * VBUF + vd * VPB + 64 * (vc >> 2) + 8 * (vc & 3);
        *(LAS u32x2*)vp = (u32x2){vr.x, vr.z}; *(LAS u32x2*)(vp + 32) = (u32x2){vr.y, vr.w}; };
    const int nst = J.ntiles >> 1;
    const int grp = wid >> 2;
    gload(0); lstore(0);
    __syncthreads();
    if (nst > 1) gload(1);
    if (grp == 1) LDS_BAR();
    for (int j = 0; j < nst; ++j) {
        const int buf = j & 1;
        f32x16 sv[4];
#pragma unroll
        for (int bk = 0; bk < 4; ++bk)
#pragma unroll
            for (int i = 0; i < 16; ++i) sv[bk][i] = 0.f;
        { const LAS unsigned char* kq = kb0 + buf * KBUF + r * KPB + 32 * h;
          i32x8 ka[2][4];
#pragma unroll
          for (int bk = 0; bk < 4; ++bk) { const i32x4 lo_ = *(const LAS i32x4*)(kq + bk * 32 * KPB), hi_ = *(const LAS i32x4*)(kq + bk * 32 * KPB + 16); ka[0][bk] = __builtin_shufflevector(lo_, hi_, 0, 1, 2, 3, 4, 5, 6, 7); }
#pragma unroll
          for (int bk = 0; bk < 4; ++bk) { const i32x4 lo_ = *(const LAS i32x4*)(kq + bk * 32 * KPB + 64), hi_ = *(const LAS i32x4*)(kq + bk * 32 * KPB + 80); ka[1][bk] = __builtin_shufflevector(lo_, hi_, 0, 1, 2, 3, 4, 5, 6, 7); }
          __builtin_amdgcn_sched_barrier(0);
#pragma unroll
          for (int i = 0; i < 2; ++i)
#pragma unroll
              for (int bk = 0; bk < 4; ++bk) sv[bk] = __builtin_amdgcn_mfma_scale_f32_32x32x64_f8f6f4(ka[i][bk], qf[i], sv[bk], 0, 0, 0, 0x7f7f7f7f, 0, 0x7f7f7f7f);
          __builtin_amdgcn_sched_barrier(0); }
        if (grp == 1 && j + 1 < nst) lstore(buf ^ 1);
        LDS_BAR();
        if (grp == 1 && j + 2 < nst) gload(j + 2);
        float ma = fmaxf(sv[0][0], sv[1][0]), mb = fmaxf(sv[2][0], sv[3][0]);
#pragma unroll
        for (int i = 1; i < 16; ++i) { ma = fmaxf(fmaxf(ma, sv[0][i]), sv[1][i]); mb = fmaxf(fmaxf(mb, sv[2][i]), sv[3][i]); }
        float mx = fmaxf(ma, mb) * J.c;
        { auto rr = __builtin_amdgcn_permlane32_swap(__float_as_uint(mx), __float_as_uint(mx), false, false); mx = fmaxf(__uint_as_float(rr[0]), __uint_as_float(rr[1])); }
        if (__any(mx > mrun + 8.0f)) {
            const float mnew = fmaxf(mrun, mx), alpha = fexp2(mrun - mnew); mrun = mnew; o2[0] *= alpha;
#pragma unroll
            for (int i = 0; i < 16; ++i) { o0[i] *= alpha; o1[i] *= alpha; }
        }
        const float nm = -mrun;
#pragma unroll
        for (int bk = 0; bk < 4; ++bk)
#pragma unroll
            for (int i = 0; i < 16; ++i) sv[bk][i] = fexp2(__builtin_fmaf(sv[bk][i], J.c, nm));
        { const LAS unsigned char* vp = vb0 + buf * VBUF + r * VPB + 32 * h;
          i32x8 va[2][2];
#pragma unroll
          for (int t = 0; t < 2; ++t)
#pragma unroll
              for (int db = 0; db < 2; ++db) { const i32x4 lo_ = *(const LAS i32x4*)(vp + db * 32 * VPB + 64 * t), hi_ = *(const LAS i32x4*)(vp + db * 32 * VPB + 64 * t + 16); va[t][db] = __builtin_shufflevector(lo_, hi_, 0, 1, 2, 3, 4, 5, 6, 7); }
#pragma unroll
          for (int t = 0; t < 2; ++t) { i32x8 pf;
#pragma unroll
              for (int q = 0; q < 8; ++q) { const int bk = 2 * t + (q >> 2), i = 4 * (q & 3); int w = 0;
                  w = __builtin_amdgcn_cvt_pk_fp8_f32(sv[bk][i], sv[bk][i + 1], w, false); w = __builtin_amdgcn_cvt_pk_fp8_f32(sv[bk][i + 2], sv[bk][i + 3], w, true); pf[q] = w; }
              o0 = __builtin_amdgcn_mfma_scale_f32_32x32x64_f8f6f4(va[t][0], pf, o0, 0, 0, 0, 0x7f7f7f7f, 0, 0x7f7f7f7f);
              o1 = __builtin_amdgcn_mfma_scale_f32_32x32x64_f8f6f4(va[t][1], pf, o1, 0, 0, 0, 0x7f7f7f7f, 0, 0x7f7f7f7f);
              o2 = __builtin_amdgcn_mfma_scale_f32_32x32x64_f8f6f4(ones, pf, o2, 0, 0, 0, 0x7f7f7f7f, 0, 0x7f7f7f7f); } }
        if (grp == 0 && j + 1 < nst) lstore(buf ^ 1);
        LDS_BAR();
        if (grp == 0 && j + 2 < nst) gload(j + 2);
    }
    if (grp == 0) LDS_BAR();
    __syncthreads();
    float lsum = h ? 0.f : o2[0];
    { auto rr = __builtin_amdgcn_permlane32_swap(__float_as_uint(lsum), __float_as_uint(lsum), false, false); lsum = __uint_as_float(rr[0]) + __uint_as_float(rr[1]); }
    const float inv = frcp(lsum);
    bf16* orow = J.O + (size_t)(wid * 32 + r) * J.opitch + 4 * h;
#pragma unroll
    for (int g = 0; g < 4; ++g) {
        *(u32x2*)(orow + 8 * g) = (u32x2){cvtpk(o0[4 * g] * inv, o0[4 * g + 1] * inv), cvtpk(o0[4 * g + 2] * inv, o0[4 * g + 3] * inv)};
        *(u32x2*)(orow + 32 + 8 * g) = (u32x2){cvtpk(o1[4 * g] * inv, o1[4 * g + 1] * inv), cvtpk(o1[4 * g + 2] * inv, o1[4 * g + 3] * inv)};
    }
}

struct Params { const float* in[31]; float* out; unsigned char* ws; int ph_lo, ph_hi; };
typedef const __attribute__((address_space(4))) unsigned char* kaptr_t;
struct PView {
    kaptr_t ka; unsigned char* ws; float* out; int bid, G;
    struct InArr { kaptr_t ka; __device__ __forceinline__ const float* operator[](int i) const { return *(const float* const __attribute__((address_space(4)))*)(ka + 8 * i); } } in;
};
__device__ __forceinline__ PView pview() {
    kaptr_t k = (kaptr_t)__builtin_amdgcn_kernarg_segment_ptr(); asm volatile("" : "+s"(k));
    PView v; v.ka = k; v.in.ka = k; v.out = *(float* const __attribute__((address_space(4)))*)(k + 248); v.ws = *(unsigned char* const __attribute__((address_space(4)))*)(k + 256);
    int b = blockIdx.x, g = gridDim.x; asm volatile("" : "+s"(b), "+s"(g)); v.bid = b; v.G = g; return v;
}
enum { I_X = 0, I_C, I_CTX, I_CCTX, I_WADA, I_BADA, I_N1G, I_N2G, I_WIN, I_RPB, I_CONVW, I_ALOG, I_DTB, I_GNG, I_MQG, I_WUQ, I_MKVG, I_WUKV, I_BIF, I_MLG,
       I_WMG, I_BMG, I_WBO, I_WOUT, I_RW, I_RB, I_WGU, I_BGU, I_WDN, I_BDN, I_FG };

__device__ __forceinline__ void transpose_item(const float* W, int N, int k0, int n0, bf16* dst_row0, int ldd, LAS float* scr, int lane) {
#pragma unroll 8
    for (int i = 0; i < 32; ++i) { const int kk = 2 * i + (lane >> 5); scr[kk * 33 + (lane & 31)] = W[(size_t)(k0 + kk) * N + n0 + (lane & 31)]; }
    asm volatile("s_waitcnt lgkmcnt(0)" ::: "memory");
    const int c = lane & 7;
#pragma unroll
    for (int j = 0; j < 4; ++j) { const int n = (lane >> 3) + 8 * j; const LAS float* s = scr + (8 * c) * 33 + n;
        u32x4 o; o.x = cvtpk(s[0 * 33], s[1 * 33]); o.y = cvtpk(s[2 * 33], s[3 * 33]); o.z = cvtpk(s[4 * 33], s[5 * 33]); o.w = cvtpk(s[6 * 33], s[7 * 33]);
        *(u32x4*)(dst_row0 + (size_t)n * ldd + k0 + 8 * c) = o; }
    asm volatile("s_waitcnt lgkmcnt(0)" ::: "memory");
}
__device__ __forceinline__ void transpose_item8(const float* W, int N, int k0, int n0, signed char* dst_row0, int ldd, const float* cm_row0, LAS float* scr, int lane) {
#pragma unroll 8
    for (int i = 0; i < 32; ++i) { const int kk = 2 * i + (lane >> 5); scr[kk * 33 + (lane & 31)] = W[(size_t)(k0 + kk) * N + n0 + (lane & 31)]; }
    asm volatile("s_waitcnt lgkmcnt(0)" ::: "memory");
    const int c = lane & 7;
#pragma unroll
    for (int j = 0; j < 4; ++j) { const int n = (lane >> 3) + 8 * j; const LAS float* s = scr + (8 * c) * 33 + n;
        const float cm = cm_row0[n], inv = cm > 0.f ? 127.0f / cm : 0.f;
        unsigned w0 = 0u, w1 = 0u;
#pragma unroll
        for (int e = 0; e < 4; ++e) { const int q0 = (int)__builtin_rintf(s[e * 33] * inv), q1 = (int)__builtin_rintf(s[(4 + e) * 33] * inv); w0 |= ((unsigned)q0 & 0xffu) << (8 * e); w1 |= ((unsigned)q1 & 0xffu) << (8 * e); }
        *(u32x2*)(dst_row0 + (size_t)n * ldd + k0 + 8 * c) = (u32x2){w0, w1}; }
    asm volatile("s_waitcnt lgkmcnt(0)" ::: "memory");
}
__device__ __forceinline__ void transpose_item_f8(const float* W, int N, int k0, int n0, unsigned char* dst_row0, int ldd, LAS float* scr, int lane) {
#pragma unroll 8
    for (int i = 0; i < 32; ++i) { const int kk = 2 * i + (lane >> 5); scr[kk * 33 + (lane & 31)] = W[(size_t)(k0 + kk) * N + n0 + (lane & 31)]; }
    asm volatile("s_waitcnt lgkmcnt(0)" ::: "memory");
    const int c = lane & 7;
#pragma unroll
    for (int j = 0; j < 4; ++j) { const int n = (lane >> 3) + 8 * j; const LAS float* s = scr + (8 * c) * 33 + n;
        int w0 = 0, w1 = 0;
        w0 = __builtin_amdgcn_cvt_pk_fp8_f32(s[0 * 33] * 64.f, s[1 * 33] * 64.f, w0, false); w0 = __builtin_amdgcn_cvt_pk_fp8_f32(s[2 * 33] * 64.f, s[3 * 33] * 64.f, w0, true);
        w1 = __builtin_amdgcn_cvt_pk_fp8_f32(s[4 * 33] * 64.f, s[5 * 33] * 64.f, w1, false); w1 = __builtin_amdgcn_cvt_pk_fp8_f32(s[6 * 33] * 64.f, s[7 * 33] * 64.f, w1, true);
        *(u32x2*)(dst_row0 + (size_t)n * ldd + k0 + 8 * c) = (u32x2){(unsigned)w0, (unsigned)w1}; }
    asm volatile("s_waitcnt lgkmcnt(0)" ::: "memory");
}
struct TJob { int cnt, K, N; };
__device__ __forceinline__ void phase_prologue(const PView& p, LAS unsigned char* lds, int bid, int G) {
    const int tid = ltid(), wid = __builtin_amdgcn_readfirstlane(tid >> 6), lane = tid & 63;
    unsigned char* ws = p.ws;
    LAS float* scr = (LAS float*)(lds + wid * 16384);
    const int gw = bid * NWAVES + wid, NGW = G * NWAVES;
    constexpr int I0 = 4 * 16 * 174, I1 = 4 * 16 * 128, I2 = 16 * 8 * 32, I3 = 16 * 16 * 32, I4 = 4 * 4 * 24, I5 = 4 * 2 * 32, I6 = 128 * 16 * 64, I7 = 128 * 16 * 32;
    constexpr int NIT = I0 + I1 + I2 + I3 + I4 + I5 + I6 + I7;
    for (int it = gw; it < NIT; it += NGW) {
        int r = it;
        if (r < I0 + I1) continue; r -= I0 + I1;
        if (r < I2) continue; r -= I2;
        if (r < I3) { const int c = r / (16 * 32), q = r % (16 * 32), kb = q / 32, nb = q % 32, l = c >> 2, rep = c & 3;
            transpose_item(p.in[I_WOUT] + (size_t)l * 1024 * 1024, 1024, 64 * kb, 32 * nb, (bf16*)(ws + OFF_WOUT4) + ((size_t)l * 1024 + 32 * nb) * 4096 + rep * 1024, 4096, scr, lane); continue; } r -= I3;
        if (r < I4) { const int l = r / (4 * 24), q = r % (4 * 24), kb = q / 24, nb = q % 24;
            transpose_item(p.in[I_WUQ] + (size_t)l * 256 * 768, 768, 64 * kb, 32 * nb, (bf16*)(ws + OFF_WUQKV) + ((size_t)l * 1792 + 32 * nb) * 384, 384, scr, lane); continue; } r -= I4;
        if (r < I5) { const int l = r / (2 * 32), q = r % (2 * 32), kb = q / 32, nb = q % 32;
            transpose_item(p.in[I_WUKV] + (size_t)l * 128 * 1024, 1024, 64 * kb, 32 * nb, (bf16*)(ws + OFF_WUQKV) + ((size_t)l * 1792 + 768 + 32 * nb) * 384 + 256, 384, scr, lane); continue; } r -= I5;
        if (r < I6) { continue; } r -= I6;
        { const int c = r / (16 * 32), q = r % (16 * 32), kb = q / 32, nb = q % 32;
            transpose_item_f8(p.in[I_WDN] + (size_t)c * 1024 * 1024, 1024, 64 * kb, 32 * nb, (unsigned char*)(ws + OFF_WDN) + ((size_t)c * 1024 + 32 * nb) * 1024, 1024, scr, lane); }
    }
    { const int gt = bid * NTHR + tid, NT_ = G * NTHR;
      for (int i = gt; i < 4 * 64 * 64; i += NT_) { const int l = i / (64 * 64), q = i % (64 * 64), rr = q / 64, cc = q % 64;
          *(u32x4*)((signed char*)(ws + OFF_WIN) + ((size_t)l * NIN + DIN + rr) * 1024 + 16 * cc) = (u32x4){0u, 0u, 0u, 0u}; }
      for (int i = gt; i < 4 * 64; i += NT_) ((float*)(ws + OFF_CMIN))[(size_t)(i >> 6) * NIN + DIN + (i & 63)] = 0.f;
      for (int i = gt; i < 4 * 768 * 16; i += NT_) { const int l = i / (768 * 16), q = i % (768 * 16), rr = q / 16, cc = q % 16;
          *(u32x4*)((bf16*)(ws + OFF_WUQKV) + ((size_t)l * 1792 + rr) * 384 + 256 + 8 * cc) = (u32x4){0u, 0u, 0u, 0u}; }
      for (int i = gt; i < 4 * 1024 * 32; i += NT_) { const int l = i / (1024 * 32), q = i % (1024 * 32), rr = q / 32, cc = q % 32;
          *(u32x4*)((bf16*)(ws + OFF_WUQKV) + ((size_t)l * 1792 + 768 + rr) * 384 + 8 * cc) = (u32x4){0u, 0u, 0u, 0u}; } }
    __syncthreads();
    { LAS float* sc = (LAS float*)lds;
      for (int i = tid; i < 5 * 1024; i += NTHR) { const float v = (i < 4096) ? p.in[I_C][i] : p.in[I_CCTX][i - 4096]; sc[i] = v * fsigmoid(v); }
      LAS float* part = (LAS float*)(lds + 32768);
      __syncthreads();
      for (int item = bid; item < 4 * 96; item += G) { const int l = item / 96, cb = item % 96, col = cb * 64 + lane;
          const float* w = p.in[I_WADA] + (size_t)l * 1024 * 6144 + col;
          float a0 = 0.f, a1 = 0.f, a2 = 0.f, a3 = 0.f, a4 = 0.f;
#pragma unroll 8
          for (int k = wid * 128; k < wid * 128 + 128; ++k) { const float wv = w[(size_t)k * 6144];
              a0 += sc[k] * wv; a1 += sc[1024 + k] * wv; a2 += sc[2048 + k] * wv; a3 += sc[3072 + k] * wv; a4 += sc[4096 + k] * wv; }
          LAS float* pp = part + (wid * 64 + lane) * 5; pp[0] = a0; pp[1] = a1; pp[2] = a2; pp[3] = a3; pp[4] = a4;
          __syncthreads();
          if (tid < 320) { const int c = tid % 64, rr = tid / 64; float s = 0.f;
#pragma unroll
              for (int w8 = 0; w8 < 8; ++w8) s += part[(w8 * 64 + c) * 5 + rr];
              ((float*)(ws + OFF_MOD))[((size_t)l * 5 + rr) * 6144 + cb * 64 + c] = s + p.in[I_BADA][l * 6144 + cb * 64 + c]; }
          __syncthreads(); } }
    { LAS float* part = (LAS float*)(lds + 65536);
      LAS unsigned char* t8 = lds;
      constexpr int NI0 = 4 * 174, NI1 = 4 * 128, NI2 = 128 * 64, NI3 = 16 * 32;
      const int n = lane & 31, k2 = lane >> 5;
      for (int item = bid; item < NI3; item += G) { const int c = item >> 5, cb = item & 31, n0 = 32 * cb;
          const float* w = p.in[I_WBO] + (size_t)c * 512 * 1024; float* cmd = (float*)(ws + OFF_CMBO) + (size_t)c * 1024; signed char* dst = (signed char*)(ws + OFF_WBO) + (size_t)c * 1024 * 512;
          float x[8][4]; float m = 0.f;
#pragma unroll
          for (int i = 0; i < 8; ++i)
#pragma unroll
              for (int e = 0; e < 4; ++e) { x[i][e] = w[(size_t)(64 * i + 8 * wid + 4 * k2 + e) * 1024 + n0 + n]; m = fmaxf(m, fabsf(x[i][e])); }
          part[(wid * 2 + k2) * 32 + n] = m;
          __syncthreads();
          if (tid < 32) { float mm = part[tid];
#pragma unroll
              for (int q = 1; q < 16; ++q) mm = fmaxf(mm, part[q * 32 + tid]);
              part[512 + tid] = mm; cmd[n0 + tid] = mm; }
          __syncthreads();
          { const float cm = part[512 + n], inv = cm > 0.f ? 127.0f / cm : 0.f;
#pragma unroll
            for (int i = 0; i < 8; ++i) *(LAS unsigned*)(t8 + n * 516 + 64 * i + 8 * wid + 4 * k2) = q8x4((f32x4){x[i][0], x[i][1], x[i][2], x[i][3]} * inv); }
          __syncthreads();
#pragma unroll
          for (int q = 0; q < 2; ++q) { const int ch = tid + 512 * q, rr = ch >> 5, cc = ch & 31; const LAS unsigned* s = (const LAS unsigned*)(t8 + rr * 516 + 16 * cc);
              *(u32x4*)(dst + (size_t)(n0 + rr) * 512 + 16 * cc) = (u32x4){s[0], s[1], s[2], s[3]}; }
          __syncthreads(); }
      for (int item = bid; item < NI0 + NI1 + NI2; item += G) {
          const float* w; int N, n0; float* cmd; signed char* dst; int drow0;
          if (item < NI0) { const int l = item / 174, cb = item % 174; N = DIN; n0 = 32 * cb; w = p.in[I_WIN] + (size_t)l * 1024 * DIN; drow0 = n0; cmd = (float*)(ws + OFF_CMIN) + (size_t)l * NIN; dst = (signed char*)(ws + OFF_WIN) + (size_t)l * NIN * 1024; }
          else if (item < NI0 + NI1) { const int r = item - NI0, l = r / 128, cb = r % 128; N = NGATE; n0 = 32 * cb; w = p.in[I_WMG] + (size_t)l * 1024 * NGATE; drow0 = LDP + n0; cmd = (float*)(ws + OFF_CMIN) + (size_t)l * NIN; dst = (signed char*)(ws + OFF_WIN) + (size_t)l * NIN * 1024; }
          else { const int r = item - NI0 - NI1, c = r / 64, cb = r % 64; N = 2048; n0 = 32 * cb; w = p.in[I_WGU] + (size_t)c * 1024 * 2048; const int j = n0 & 1023; drow0 = (j >> 7) * 256 + ((n0 >= 1024) ? 128 : 0) + (j & 127);
                 cmd = (float*)(ws + OFF_CMGU) + (size_t)c * 2048; dst = (signed char*)(ws + OFF_WGU) + (size_t)c * 2048 * 1024; }
          float x[16][4]; float m = 0.f;
#pragma unroll
          for (int i = 0; i < 16; ++i)
#pragma unroll
              for (int e = 0; e < 4; ++e) { x[i][e] = w[(size_t)(64 * i + 8 * wid + 4 * k2 + e) * N + n0 + n]; }
#pragma unroll
          for (int i = 0; i < 16; ++i)
#pragma unroll
              for (int e = 0; e < 4; ++e) m = fmaxf(m, fabsf(x[i][e]));
          part[(wid * 2 + k2) * 32 + n] = m;
          __syncthreads();
          if (tid < 32) { float mm = part[tid];
#pragma unroll
              for (int q = 1; q < 16; ++q) mm = fmaxf(mm, part[q * 32 + tid]);
              part[512 + tid] = mm; cmd[drow0 + tid] = mm; }
          __syncthreads();
          { const float cm = part[512 + n], inv = cm > 0.f ? 127.0f / cm : 0.f;
#pragma unroll
            for (int i = 0; i < 16; ++i) *(LAS unsigned*)(t8 + n * 1028 + 64 * i + 8 * wid + 4 * k2) = q8x4((f32x4){x[i][0], x[i][1], x[i][2], x[i][3]} * inv); }
          __syncthreads();
#pragma unroll
          for (int q = 0; q < 4; ++q) { const int ch = tid + 512 * q, rr = ch >> 6, cc = ch & 63; const LAS unsigned* s = (const LAS unsigned*)(t8 + rr * 1028 + 16 * cc);
              *(u32x4*)(dst + (size_t)(drow0 + rr) * 1024 + 16 * cc) = (u32x4){s[0], s[1], s[2], s[3]}; }
          __syncthreads(); } }
}

__device__ __forceinline__ int tok_mv(int tk) { const int b = tk / TB, s = tk - b * TB; return s < CTX ? 4 : b; }
template <int MODE>
__device__ __forceinline__ void phase_norm1(const PView& p, int l, int bid, int G, bool dummy = false) {
    const int tid = ltid(), wid = __builtin_amdgcn_readfirstlane(tid >> 6), lane = tid & 63;
    unsigned char* ws = p.ws;
    float* X = (float*)(ws + OFF_X); signed char* H8 = (signed char*)(ws + OFF_H); float* SH = (float*)(ws + OFF_SH);
    float* Xw = dummy ? (float*)(ws + OFF_GF) : X;
    const float* MOD = (const float*)(ws + OFF_MOD);
    const bf16* YS = (const bf16*)(ws + OFF_R3);
    const float* TW = (const float*)(ws + OFF_TOPW); const int* SL = (const int*)(ws + OFF_SLOT);
    for (int tp = bid * NWAVES + wid; tp < T / 2; tp += G * NWAVES) {
        const int tk0 = 2 * tp, b = tk0 / TB, s = tk0 - b * TB, mv = s < CTX ? 4 : b;
        if (MODE == 2 && s < CTX) continue;
        f32x4 v[2][4];
        if (l == 0) { const float* src = (s < CTX) ? p.in[I_CTX] + ((size_t)b * CTX + s) * D : p.in[I_X] + ((size_t)b * SEQ + (s - CTX)) * D;
#pragma unroll
            for (int u = 0; u < 2; ++u)
#pragma unroll
                for (int j = 0; j < 4; ++j) v[u][j] = *(const f32x4*)(src + u * D + 256 * j + 4 * lane);
        } else {
            float w[2][4]; int sl[2][4];
#pragma unroll
            for (int u = 0; u < 2; ++u)
#pragma unroll
                for (int k = 0; k < 4; ++k) { w[u][k] = TW[(tk0 + u) * 4 + k]; sl[u][k] = SL[(tk0 + u) * 4 + k]; }
#pragma unroll
            for (int u = 0; u < 2; ++u)
#pragma unroll
                for (int j = 0; j < 4; ++j) v[u][j] = *(const f32x4*)(X + (size_t)(tk0 + u) * D + 256 * j + 4 * lane);
            u32x2 y[2][4][4];
#pragma unroll
            for (int u = 0; u < 2; ++u)
#pragma unroll
                for (int k = 0; k < 4; ++k)
#pragma unroll
                    for (int j = 0; j < 4; ++j) y[u][k][j] = *(const u32x2*)(YS + (size_t)sl[u][k] * D + 256 * j + 4 * lane);
            const float* g2 = MOD + ((size_t)(l - 1) * 5 + mv) * 6144 + 5120;
#pragma unroll
            for (int j = 0; j < 4; ++j) { const f32x4 g2v = *(const f32x4*)(g2 + 256 * j + 4 * lane);
#pragma unroll
                for (int u = 0; u < 2; ++u) { f32x4 f = (f32x4){0.f, 0.f, 0.f, 0.f};
#pragma unroll
                    for (int k = 0; k < 4; ++k) f += w[u][k] * (f32x4){bflo(y[u][k][j].x), bfhi(y[u][k][j].x), bflo(y[u][k][j].y), bfhi(y[u][k][j].y)};
                    v[u][j] += g2v * f; } }
        }
        if (MODE != 2) {
#pragma unroll
            for (int u = 0; u < 2; ++u)
#pragma unroll
                for (int j = 0; j < 4; ++j) *(f32x4*)(Xw + (size_t)(tk0 + u) * D + 256 * j + 4 * lane) = v[u][j];
        }
        float rstd[2];
#pragma unroll
        for (int u = 0; u < 2; ++u) { float ss = 0.f;
#pragma unroll
            for (int j = 0; j < 4; ++j) ss += v[u][j].x * v[u][j].x + v[u][j].y * v[u][j].y + v[u][j].z * v[u][j].z + v[u][j].w * v[u][j].w;
            rstd[u] = __builtin_amdgcn_rsqf(wave_sum(ss) * (1.f / D) + 1e-6f); }
        if (MODE == 2) {
            float* o = p.out + ((size_t)b * SEQ + (s - CTX)) * D;
#pragma unroll
            for (int j = 0; j < 4; ++j) { const f32x4 g = *(const f32x4*)(p.in[I_FG] + 256 * j + 4 * lane);
#pragma unroll
                for (int u = 0; u < 2; ++u) *(f32x4*)(o + u * D + 256 * j + 4 * lane) = v[u][j] * rstd[u] * g; }
        } else {
            const float* ng = p.in[I_N1G] + l * D; const float* md = MOD + ((size_t)l * 5 + mv) * 6144;
            float am[2] = {0.f, 0.f};
#pragma unroll
            for (int j = 0; j < 4; ++j) { const int c = 256 * j + 4 * lane; const f32x4 g = *(const f32x4*)(ng + c), sh = *(const f32x4*)(md + c), sc = *(const f32x4*)(md + 1024 + c);
#pragma unroll
                for (int u = 0; u < 2; ++u) { v[u][j] = v[u][j] * rstd[u] * g * (sc + 1.0f) + sh;
                    am[u] = fmaxf(am[u], fmaxf(fmaxf(fabsf(v[u][j].x), fabsf(v[u][j].y)), fmaxf(fabsf(v[u][j].z), fabsf(v[u][j].w)))); } }
#pragma unroll
            for (int u = 0; u < 2; ++u) { const float amax = wave_max(am[u]), inv = amax > 0.f ? 127.0f / amax : 0.f;
                if (lane == 0) SH[tk0 + u] = amax * (1.0f / 127.0f);
#pragma unroll
                for (int j = 0; j < 4; ++j) *(unsigned*)(H8 + (size_t)(tk0 + u) * D + 256 * j + 4 * lane) = q8x4(v[u][j] * inv); }
        }
    }
}

__device__ __forceinline__ void phase_router(const PView& p, int l, LAS unsigned char* lds, int bid, int G, bool dummy = false) {
    const int tid = ltid(), wid = __builtin_amdgcn_readfirstlane(tid >> 6), lane = tid & 63;
    unsigned char* ws = p.ws;
    const float* X = (const float*)(ws + OFF_X); signed char* H8 = (signed char*)(ws + OFF_H); float* SH = (float*)(ws + OFF_SH);
    const float* MOD = (const float*)(ws + OFF_MOD);
    float* TW = (float*)(ws + OFF_TOPW); int* TE = (int*)(ws + OFF_TOPE); int* PS = (int*)(ws + OFF_POS);
    unsigned* gcnt = (unsigned*)(ws + OFF_CTL) + CW_CNT + l * 32 + (dummy ? 1024 : 0);
    LAS float* rw = (LAS float*)lds;
    LAS int* hist = (LAS int*)(lds + MISC_OFF + 64);
    LAS int* base = hist + 32;
    LAS int* lrec = base + 32;
    { const float* rg = p.in[I_RW] + (size_t)l * 1024 * 32;
      for (int i = tid; i < 1024 * 32; i += NTHR) rw[(i & 31) * 1024 + (i >> 5)] = rg[i]; }
    constexpr int TPB = 132;
    for (int item = bid; item < T / TPB; item += G) {
        if (tid < 32) hist[tid] = 0;
        __syncthreads();
        for (int tp = wid; tp < TPB / 2; tp += NWAVES) {
            const int ti0 = 2 * tp, tk0 = item * TPB + ti0, mv = tok_mv(tk0);
            f32x4 hv[2][4];
            const float* ng = p.in[I_N2G] + l * D; const float* md = MOD + ((size_t)l * 5 + mv) * 6144;
#pragma unroll
            for (int t2 = 0; t2 < 2; ++t2) { const int tk = tk0 + t2;
                f32x4 v[4]; float ss = 0.f;
#pragma unroll
                for (int j = 0; j < 4; ++j) { v[j] = *(const f32x4*)(X + (size_t)tk * D + 256 * j + 4 * lane); ss += v[j].x * v[j].x + v[j].y * v[j].y + v[j].z * v[j].z + v[j].w * v[j].w; }
                const float rstd = __builtin_amdgcn_rsqf(wave_sum(ss) * (1.f / D) + 1e-6f);
                float am = 0.f;
#pragma unroll
                for (int j = 0; j < 4; ++j) { const int c = 256 * j + 4 * lane; const f32x4 g = *(const f32x4*)(ng + c), sh = *(const f32x4*)(md + 3072 + c), sc = *(const f32x4*)(md + 4096 + c);
                    hv[t2][j] = v[j] * rstd * g * (sc + 1.0f) + sh;
                    am = fmaxf(am, fmaxf(fmaxf(fabsf(hv[t2][j].x), fabsf(hv[t2][j].y)), fmaxf(fabsf(hv[t2][j].z), fabsf(hv[t2][j].w)))); }
                { const float amax = wave_max(am), inv = amax > 0.f ? 127.0f / amax : 0.f;
                  if (lane == 0) SH[tk] = amax * (1.0f / 127.0f);
#pragma unroll
                  for (int j = 0; j < 4; ++j) *(unsigned*)(H8 + (size_t)tk * D + 256 * j + 4 * lane) = q8x4(hv[t2][j] * inv); }
                }
            float A16[2][16];
#pragma unroll
            for (int cq = 0; cq < 4; ++cq) { float acc[2][8];
#pragma unroll
                for (int q = 0; q < 8; ++q) { acc[0][q] = 0.f; acc[1][q] = 0.f; }
#pragma unroll
                for (int j = 0; j < 4; ++j) { const int c = 256 * j + 4 * lane;
#pragma unroll
                    for (int q = 0; q < 8; ++q) { const int e = 4 * cq + (q & 3) + 16 * (q >> 2); const f32x4 w = *(const LAS f32x4*)(rw + e * 1024 + c);
                        acc[0][q] += hv[0][j].x * w.x + hv[0][j].y * w.y + hv[0][j].z * w.z + hv[0][j].w * w.w;
                        acc[1][q] += hv[1][j].x * w.x + hv[1][j].y * w.y + hv[1][j].z * w.z + hv[1][j].w * w.w; } }
#pragma unroll
                for (int t2 = 0; t2 < 2; ++t2)
#pragma unroll
                    for (int q = 0; q < 4; ++q) { auto rr = __builtin_amdgcn_permlane32_swap(__float_as_uint(acc[t2][q]), __float_as_uint(acc[t2][q + 4]), false, false); A16[t2][4 * cq + q] = __uint_as_float(rr[0]) + __uint_as_float(rr[1]); }
                asm volatile("" ::: "memory"); }
            const int myE = lane >> 1; const float rbias = p.in[I_RB][l * 32 + myE];
            const bool b3 = (lane & 8) != 0, b2 = (lane & 4) != 0, b1 = (lane & 2) != 0;
#pragma unroll
            for (int t2 = 0; t2 < 2; ++t2) {
                float B8[8], C4[4], D2[2];
#pragma unroll
                for (int e = 0; e < 8; ++e) { auto rr = __builtin_amdgcn_permlane16_swap(__float_as_uint(A16[t2][e]), __float_as_uint(A16[t2][e + 8]), false, false); B8[e] = __uint_as_float(rr[0]) + __uint_as_float(rr[1]); }
#pragma unroll
                for (int e = 0; e < 4; ++e) { const float keep = b3 ? B8[e + 4] : B8[e], send = b3 ? B8[e] : B8[e + 4]; C4[e] = keep + dppf<0x140>(send); }
#pragma unroll
                for (int e = 0; e < 2; ++e) { const float keep = b2 ? C4[e + 2] : C4[e], send = b2 ? C4[e] : C4[e + 2]; D2[e] = keep + dppf<0x141>(send); }
                float v; { const float keep = b1 ? D2[1] : D2[0], send = b1 ? D2[0] : D2[1]; v = keep + dppf<0x1B>(send); }
                v += dppf<0xB1>(v); v += rbias;
                int cnt = 0;
#pragma unroll
                for (int e = 0; e < 32; ++e) { const float s = __int_as_float(__builtin_amdgcn_readlane(__float_as_int(v), 2 * e)); cnt += ((s > v) || (s == v && e < myE)) ? 1 : 0; }
                const bool sel = (cnt < 4) && ((lane & 1) == 0);
                const unsigned long long top = __ballot(sel && cnt == 0);
                const float m0 = __int_as_float(__builtin_amdgcn_readlane(__float_as_int(v), (int)__builtin_ctzll(top)));
                const float ex = sel ? fexp(v - m0) : 0.f;
                float tot = row16_sum(ex); { auto rr = __builtin_amdgcn_permlane16_swap(__float_as_uint(tot), __float_as_uint(tot), false, false); tot = __uint_as_float(rr[0]) + __uint_as_float(rr[1]); }
                { auto rr = __builtin_amdgcn_permlane32_swap(__float_as_uint(tot), __float_as_uint(tot), false, false); tot = __uint_as_float(rr[0]) + __uint_as_float(rr[1]); }
                if (sel) { const int tk = tk0 + t2, ti = ti0 + t2;
                    TW[tk * 4 + cnt] = ex / tot; TE[tk * 4 + cnt] = myE;
                    const int rk = atomicAdd((int*)&hist[myE], 1); lrec[ti * 4 + cnt] = (myE << 16) | rk; }
            }
        }
        __syncthreads();
        if (tid < 32) base[tid] = (int)__hip_atomic_fetch_add(gcnt + tid, (unsigned)hist[tid], __ATOMIC_RELAXED, __HIP_MEMORY_SCOPE_AGENT);
        __syncthreads();
        for (int i = tid; i < TPB * 4; i += NTHR) { const int rec = lrec[i]; PS[(size_t)item * TPB * 4 + i] = base[rec >> 16] + (rec & 0xffff); }
        __syncthreads();
    }
}

__device__ __forceinline__ void phase_gather(const PView& p, int l, LAS unsigned char* lds, int bid, int G) {
    const int tid = ltid(), wid = __builtin_amdgcn_readfirstlane(tid >> 6), lane = tid & 63;
    unsigned char* ws = p.ws;
    const unsigned* gcnt = (const unsigned*)(ws + OFF_CTL) + CW_CNT + l * 32;
    int* tst = (int*)(ws + OFF_CTL) + CW_TST + l * 64;
    LAS int* off = (LAS int*)(lds + MISC_OFF + 64);
    if (tid == 0) { int acc = 0; for (int e = 0; e < 32; ++e) { off[e] = acc * 256; if (bid == 0) tst[e] = acc; acc += ((int)gcnt[e] + 255) >> 8; } if (bid == 0) tst[32] = acc; }
    __syncthreads();
    const signed char* H8 = (const signed char*)(ws + OFF_H); signed char* XG = (signed char*)(ws + OFF_R1); const float* SH = (const float*)(ws + OFF_SH); float* SX = (float*)(ws + OFF_SX);
    const int* TE = (const int*)(ws + OFF_TOPE); const int* PS = (const int*)(ws + OFF_POS); int* SL = (int*)(ws + OFF_SLOT);
    for (int tk = bid * NWAVES + wid; tk < T; tk += G * NWAVES) {
        int dst[4];
#pragma unroll
        for (int k = 0; k < 4; ++k) dst[k] = off[TE[tk * 4 + k]] + PS[tk * 4 + k];
        const u32x4 r0 = ((const u32x4*)(H8 + (size_t)tk * D))[lane]; const float sc = SH[tk];
        if (lane < 4) { const int d = dst[0] * (lane == 0) + dst[1] * (lane == 1) + dst[2] * (lane == 2) + dst[3] * (lane == 3); SL[tk * 4 + lane] = d; SX[d] = sc; }
#pragma unroll
        for (int k = 0; k < 4; ++k) ((u32x4*)(XG + (size_t)dst[k] * D))[lane] = r0;
    }
}

template <class SrcFn>
__device__ __forceinline__ void transpose64x128(LAS unsigned char* lds, int tid, SrcFn srcp, bf16* dst_hd0  ) {
    LAS bf16* tl = (LAS bf16*)lds;
#pragma unroll
    for (int q = 0; q < 2; ++q) { const int ch = tid + 512 * q, ti = ch >> 4, cc = ch & 15; *(LAS u32x4*)(tl + ti * 136 + 8 * cc) = *(const u32x4*)srcp(ti, cc); }
    __syncthreads();
#pragma unroll
    for (int q = 0; q < 2; ++q) { const int hd = tid & 127, c8 = (tid >> 7) + 4 * q; unsigned w[4];
#pragma unroll
        for (int e = 0; e < 4; ++e) { const unsigned lo = tl[(8 * c8 + 2 * e) * 136 + hd], hi = tl[(8 * c8 + 2 * e + 1) * 136 + hd]; w[e] = lo | (hi << 16); }
        *(u32x4*)(dst_hd0 + (size_t)hd * TB + 8 * c8) = (u32x4){w[0], w[1], w[2], w[3]}; }
    __syncthreads();
}
template <class SrcFn>
__device__ __forceinline__ void transpose64x128_f8(LAS unsigned char* lds, int tid, SrcFn srcp, unsigned char* dst_hd0) {
    LAS bf16* tl = (LAS bf16*)lds;
#pragma unroll
    for (int q = 0; q < 2; ++q) { const int ch = tid + 512 * q, ti = ch >> 4, cc = ch & 15; *(LAS u32x4*)(tl + ti * 136 + 8 * cc) = *(const u32x4*)srcp(ti, cc); }
    __syncthreads();
    { const int hd = tid & 127, c4 = tid >> 7; int w[4] = {0, 0, 0, 0};
#pragma unroll
      for (int q = 0; q < 4; ++q) { const float x0 = bf2f(tl[(16 * c4 + 4 * q) * 136 + hd]), x1 = bf2f(tl[(16 * c4 + 4 * q + 1) * 136 + hd]), x2 = bf2f(tl[(16 * c4 + 4 * q + 2) * 136 + hd]), x3 = bf2f(tl[(16 * c4 + 4 * q + 3) * 136 + hd]);
          w[q] = __builtin_amdgcn_cvt_pk_fp8_f32(x0, x1, w[q], false); w[q] = __builtin_amdgcn_cvt_pk_fp8_f32(x2, x3, w[q], true); }
      *(u32x4*)(dst_hd0 + (size_t)hd * TB + 16 * c4) = (u32x4){(unsigned)w[0], (unsigned)w[1], (unsigned)w[2], (unsigned)w[3]}; }
    __syncthreads();
}
__device__ __forceinline__ void phase_prep(const PView& p, int l, LAS unsigned char* lds, int bid, int G) {
    const int tid = ltid(), wid = __builtin_amdgcn_readfirstlane(tid >> 6), lane = tid & 63;
    unsigned char* ws = p.ws;
    const bf16* P = (const bf16*)(ws + OFF_R1);
    bf16* GQ = (bf16*)(ws + OFF_GQKV); const float* GT = (const float*)(ws + OFF_GATES);
    bf16* AQ = (bf16*)(ws + OFF_AQ); bf16* VTN = (bf16*)(ws + OFF_VTN);
    const float* cw = p.in[I_CONVW] + (size_t)l * 3 * 1536;
    { const int NT_ = G * NTHR, NCH = T * 192;
      for (int ch0 = bid * NTHR + tid; ch0 < NCH; ch0 += 4 * NT_) {
          u32x4 r0[4], rm[4], rp[4];
#pragma unroll
          for (int u = 0; u < 4; ++u) { const int ch = ch0 + u * NT_;
              if (ch < NCH) { const int tk = ch / 192, cc = ch - tk * 192, b = tk / TB, s = tk - b * TB; const bool c_ = s < CTX; const int lo = c_ ? 0 : CTX, hi = c_ ? CTX : TB;
                  const bf16* pr = P + (size_t)tk * LDP + PC_GQKV + 8 * cc;
                  r0[u] = *(const u32x4*)pr;
                  rm[u] = (s - 1 >= lo) ? *(const u32x4*)(pr - LDP) : (u32x4){0u, 0u, 0u, 0u};
                  rp[u] = (s + 1 < hi) ? *(const u32x4*)(pr + LDP) : (u32x4){0u, 0u, 0u, 0u}; } }
#pragma unroll
          for (int u = 0; u < 4; ++u) { const int ch = ch0 + u * NT_;
              if (ch < NCH) { const int tk = ch / 192, cc = ch - tk * 192;
                  float xm[8], x0[8], xp[8]; unpack8(r0[u], x0); unpack8(rm[u], xm); unpack8(rp[u], xp);
                  float y[8]; float ss = 0.f;
#pragma unroll
                  for (int i = 0; i < 8; ++i) { const int c = 8 * cc + i; const float z = xm[i] * cw[c] + x0[i] * cw[1536 + c] + xp[i] * cw[3072 + c]; y[i] = z * fsigmoid(z); ss += y[i] * y[i]; }
                  ss = row16_sum(ss);
                  if (cc < 128) { const float sc = __builtin_amdgcn_rsqf(ss + 1e-6f) * ((cc < 64) ? 0.08838834764831845f : 1.0f);
#pragma unroll
                      for (int i = 0; i < 8; ++i) y[i] *= sc; }
                  *(u32x4*)(GQ + (size_t)tk * 1536 + 8 * cc) = pack8(y); } } } }
    { float* GC = (float*)(ws + OFF_GC); float* MC = (float*)(ws + OFF_MC);
      for (int it = (wid * 64 + lane) * G + bid; it < (T / 64) * 16; it += G * NTHR) {
          const int tile = it >> 4, sq = it & 15, dh = sq & 7, d = dh >> 2, hh = dh & 3, tk0 = tile * 64;
          const bool isg = sq < 8;
          const float c0_ = isg ? p.in[I_DTB][l * 8 + dh] : p.in[I_BIF][((l * 2 + d) * 2 + 1) * 4 + hh];
          const float c1_ = isg ? -__expf(p.in[I_ALOG][l * 8 + dh]) : p.in[I_BIF][((l * 2 + d) * 2 + 0) * 4 + hh];
          float run = 0.f;
#pragma unroll 8
          for (int n = 0; n < 64; ++n) { const int tk = tk0 + (d ? 63 - n : n); const float* g = GT + (size_t)tk * 32;
              if (isg) { const float a = g[dh] + c0_; const float sp = (a > 20.f) ? a : __logf(1.0f + __expf(a)); run += c1_ * sp;
                  GC[(size_t)tk * 24 + dh] = run; GC[(size_t)tk * 24 + 8 + dh] = fsigmoid(g[8 + dh]); }
              else { const float y = -(g[24 + dh] + c0_); run -= (y > 20.f) ? y : __logf(1.0f + __expf(y));
                  MC[(size_t)tk * 16 + dh] = run; MC[(size_t)tk * 16 + 8 + dh] = g[16 + dh] + c1_; } } } }
    for (int tk = bid * NWAVES + wid; tk < T; tk += G * NWAVES) {
        float x[8]; float ss = 0.f;
        if (lane < 48) { unpack8(*(const u32x4*)(P + (size_t)tk * LDP + PC_MQ + 8 * lane), x); for (int i = 0; i < 8; ++i) ss += x[i] * x[i]; }
        else { for (int i = 0; i < 8; ++i) x[i] = 0.f; }
        ss = row16_sum(ss); { auto rr = __builtin_amdgcn_permlane16_swap(__float_as_uint(ss), __float_as_uint(ss), false, false); ss = __uint_as_float(rr[0]) + __uint_as_float(rr[1]); }
        if (lane < 48) { const bool isq = lane < 32; const float rs = __builtin_amdgcn_rsqf(ss * (isq ? (1.f / 256.f) : (1.f / 128.f)) + 1e-6f);
            const float* g = isq ? p.in[I_MQG] + l * 256 + 8 * lane : p.in[I_MKVG] + l * 128 + 8 * (lane - 32);
#pragma unroll
            for (int i = 0; i < 8; ++i) x[i] *= rs * g[i];
            *(u32x4*)(AQ + (size_t)tk * 384 + 8 * lane) = pack8(x); } }
    for (int it = bid; it < (T / 64) * 4; it += G) { const int tile = it >> 2, hp = it & 3, tk0 = tile * 64, b = tk0 / TB, s0 = tk0 - b * TB;
        transpose64x128(lds, tid, [&](int ti, int cc) { return P + (size_t)(tk0 + ti) * LDP + PC_NAV + hp * 128 + 8 * cc; }, VTN + ((size_t)b * 512 + hp * 128) * TB + s0); }
}

__device__ __forceinline__ void rope16(float (&x)[16], float pos) {
#pragma unroll
    for (int i = 0; i < 8; ++i) { const float inv = fexp2(-1.6609640474436813f * (float)i);
        const float rev = pos * inv * 0.15915494309189535f; const float fr = rev - floorf(rev);
        const float sn = __builtin_amdgcn_sinf(fr), cs = __builtin_amdgcn_cosf(fr);
        const float a = x[i], bb = x[i + 8]; x[i] = a * cs - bb * sn; x[i + 8] = bb * cs + a * sn; }
}
__device__ __forceinline__ void phase_mlapost(const PView& p, int l, LAS unsigned char* lds, int bid, int G, bool dummy = false) {
    const int tid = ltid();
    unsigned char* ws = p.ws;
    const bf16* P = (const bf16*)(ws + OFF_R1); const bf16* QR = (const bf16*)(ws + OFF_QKVR); bf16* VTM = (bf16*)(ws + OFF_VTM);
    const int gt = bid * NTHR + tid, NT_ = G * NTHR;
    unsigned char* QM8 = ws + OFF_QM8; unsigned char* KM8 = ws + OFF_KM; (void)dummy;
    for (int it = gt; it < T * 8 * 16; it += NT_) { const int c = it & 7, isk = (it >> 3) & 1, hh = (it >> 4) & 7, tk = it >> 7, b = tk / TB, s = tk - b * TB;
        unsigned char* dst = isk ? KM8 + ((((size_t)b * 8 + hh) * TB + s) * 128 + 16 * c) : QM8 + (((size_t)tk * 8 + hh) * 128 + 16 * c);
        if (c >= 6) { *(u32x4*)dst = (u32x4){0u, 0u, 0u, 0u}; continue; }
        const bf16* sp;
        if (c < 4) sp = isk ? QR + (size_t)tk * 1792 + 768 + hh * 128 + 16 * c : QR + (size_t)tk * 1792 + hh * 96 + 16 * c;
        else sp = isk ? P + (size_t)tk * LDP + PC_MKPE + 16 * (c - 4) : QR + (size_t)tk * 1792 + hh * 96 + 64 + 16 * (c - 4);
        float x[16]; { float a8[8], c8[8]; unpack8(*(const u32x4*)sp, a8); unpack8(*(const u32x4*)(sp + 8), c8); for (int i = 0; i < 8; ++i) { x[i] = a8[i]; x[8 + i] = c8[i]; } }
        if (c >= 4 && s >= CTX) { const int t = s - CTX; rope16(x, (float)(c == 4 ? (t >> 6) : (t & 63))); }
        int w[4] = {0, 0, 0, 0};
#pragma unroll
        for (int q = 0; q < 4; ++q) { w[q] = __builtin_amdgcn_cvt_pk_fp8_f32(x[4 * q], x[4 * q + 1], w[q], false); w[q] = __builtin_amdgcn_cvt_pk_fp8_f32(x[4 * q + 2], x[4 * q + 3], w[q], true); }
        *(u32x4*)dst = (u32x4){(unsigned)w[0], (unsigned)w[1], (unsigned)w[2], (unsigned)w[3]}; }
    for (int it = bid; it < (T / 64) * 4; it += G) { const int tile = it >> 2, hp = it & 3, tk0 = tile * 64, b = tk0 / TB, s0 = tk0 - b * TB;
        transpose64x128_f8(lds, tid, [&](int ti, int cc) { return QR + (size_t)(tk0 + ti) * 1792 + 768 + (2 * hp + (cc >> 3)) * 128 + 64 + 8 * (cc & 7); }, (unsigned char*)VTM + ((size_t)b * 512 + hp * 128) * TB + s0); }
}

__device__ __forceinline__ void phase_attn(const PView& p, int l, LAS unsigned char* lds, int bid, int G) {
    const int tid = ltid(), wid = __builtin_amdgcn_readfirstlane(tid >> 6), lane = tid & 63;
    unsigned char* ws = p.ws;
    const bf16* P = (const bf16*)(ws + OFF_R1); const unsigned char* QM8 = ws + OFF_QM8; const unsigned char* KM8 = ws + OFF_KM;
    const bf16* VTM = (const bf16*)(ws + OFF_VTM); const bf16* VTN = (const bf16*)(ws + OFF_VTN); bf16* Y = (bf16*)(ws + OFF_Y);
    LAS float* btab = (LAS float*)(lds + 90112);
    for (int i = tid; i < 8 * 465; i += NTHR) btab[i] = p.in[I_RPB][(size_t)l * 8 * 465 + i] * 1.4426950408889634f;
    __syncthreads();
    const float c_mla = 0.10206207261596577f * 1.4426950408889634f, c_na = 0.125f * 1.4426950408889634f;
    for (int u = bid; u < 2112; u += G) {
        AttnJob J; J.bias = btab; J.kr_lo = 0; J.r_w = 0; J.c_q = 0; J.s0_first_n = 1 << 30; J.s0_jump = 0;
        if (u < 1024) {
            const int b = u >> 8, hh = u & 7, qb = (u >> 3) & 31; const size_t tq = (size_t)b * TB + CTX + qb * 256;
            J.Q = (const bf16*)(QM8 + (tq * 8 + hh) * 128); J.qpitch = 1024; J.K = (const bf16*)(KM8 + ((size_t)b * 8 + hh) * TB * 128); J.kpitch = 128; J.VT = (const bf16*)((const unsigned char*)VTM + ((size_t)b * 8 + hh) * 64 * TB);
            J.O = Y + tq * 2048 + 1024 + hh * 64; J.opitch = 2048; J.ntiles = TB / 64; J.c = c_mla;
            attn_unit_dense<96>(lds, J);
        } else if (u < 2048) {
            const int v = u - 1024, b = v >> 8, hh = v & 7, rq = (v >> 3) & 31; const size_t tq = (size_t)b * TB + CTX + rq * 256;
            const int kr_lo = min(max(4 * rq - 4, 0), 120), kr_hi = min(max(4 * rq + 3 - 4, 0), 120) + 7;
            J.Q = P + tq * LDP + PC_NAQ + hh * 64; J.qpitch = LDP; J.K = P + (size_t)b * TB * LDP + PC_NAK + hh * 64; J.kpitch = LDP; J.VT = VTN + ((size_t)b * 8 + hh) * 64 * TB;
            J.O = Y + tq * 2048 + hh * 64; J.opitch = 2048; J.ntiles = 4 + (kr_hi - kr_lo + 1); J.c = c_na;
            J.s0_first_n = 4; J.s0_jump = CTX + kr_lo * 64; J.kr_lo = kr_lo; J.r_w = 4 * rq + (wid >> 1); J.c_q = 32 * (wid & 1) + (lane & 31); J.bias = btab + hh * 465;
            for (int rp = 0; rp < NREP(55); ++rp) attn_unit<64, true>(lds, J);
        } else if (u < 2080) {
            const int v = u - 2048, b = v >> 3, hh = v & 7; const size_t tq = (size_t)b * TB;
            J.Q = (const bf16*)(QM8 + (tq * 8 + hh) * 128); J.qpitch = 1024; J.K = (const bf16*)(KM8 + ((size_t)b * 8 + hh) * TB * 128); J.kpitch = 128; J.VT = (const bf16*)((const unsigned char*)VTM + ((size_t)b * 8 + hh) * 64 * TB);
            J.O = Y + tq * 2048 + 1024 + hh * 64; J.opitch = 2048; J.ntiles = 4; J.c = c_mla;
            attn_unit_dense<96>(lds, J);
        } else {
            const int v = u - 2080, b = v >> 3, hh = v & 7; const size_t tq = (size_t)b * TB;
            J.Q = P + tq * LDP + PC_NAQ + hh * 64; J.qpitch = LDP; J.K = P + (size_t)b * TB * LDP + PC_NAK + hh * 64; J.kpitch = LDP; J.VT = VTN + ((size_t)b * 8 + hh) * 64 * TB;
            J.O = Y + tq * 2048 + hh * 64; J.opitch = 2048; J.ntiles = 4; J.c = c_na;
            attn_unit<64, false>(lds, J);
        }
    }
}


__device__ __forceinline__ unsigned lds_u16(const LAS unsigned char* p) { return (unsigned)*(const LAS unsigned short*)p; }
__device__ __forceinline__ void mlstm_finish(LAS unsigned char* part, int par, int ib, int lane, int h, const f32x16& iacc, float dint, float ai, float egi, float* op) {
    const LAS float* pp = (const LAS float*)part + ((par * 2 + ib) * 64 + lane) * 20;
    const float den = pp[16], dtot = ai * den + egi * dint, inv = 1.0f / fmaxf(fabsf(dtot), 1.0f), ka = ai * inv, ke_ = egi * inv;
#pragma unroll
    for (int g4 = 0; g4 < 4; ++g4) { const f32x4 na = *(const LAS f32x4*)(pp + 4 * g4); f32x4 o;
#pragma unroll
        for (int q = 0; q < 4; ++q) o[q] = na[q] * ka + iacc[4 * g4 + q] * ke_;
        *(f32x4*)(op + 8 * g4) = o; }
}
__device__ __forceinline__ void mlstm_chunk_item(const PView& p, LAS unsigned char* lds, int chain, int vq) {
    const int tid = ltid(), wid = __builtin_amdgcn_readfirstlane(tid >> 6), lane = tid & 63, r = lane & 31, h = lane >> 5;
    const int b = chain >> 3, hh = (chain >> 1) & 3, dir = chain & 1, dh = dir * 4 + hh;
    unsigned char* ws = p.ws;
    const bf16* P = (const bf16*)(ws + OFF_R1); const float* MC = (const float*)(ws + OFF_MC);
    float* OM = (float*)(ws + OFF_OML) + (size_t)dir * T * 512;
    constexpr int KT = 0, QT = 9216, KTT = 18432, VTT = 27648, FC = 32256, AO_ = FC + 256, BO_ = AO_ + 256, CHB = 33280;
    constexpr int CBO = 2 * CHB, CBS = 4608, NSO = CBO + 2 * CBS, PARTO = NSO + 512;
    for (int i = tid; i < (2 * CBS + 512) / 4; i += NTHR) ((LAS unsigned*)(lds + CBO))[i] = 0u;
    f32x16 cacc;
#pragma unroll
    for (int i = 0; i < 16; ++i) cacc[i] = 0.f;
    f32x16 iprev; float dprev = 0.f, aprev = 0.f, eprev = 0.f;
#pragma unroll
    for (int i = 0; i < 16; ++i) iprev[i] = 0.f;
    const int srow = tid >> 3, sc8 = tid & 7, vrow = tid >> 2, vc = tid & 3;
    struct Stg { u32x4 k, q, v; float fc, ip, fm, vfc, vip; };
    Stg sA, sB; sA.fc = sA.ip = sA.fm = sA.vfc = sA.vip = 0.f; sB = sA;
    auto s0_of = [&](int c) { return (dir == 0) ? 64 * c : (c < 4 ? 192 - 64 * c : TB - 64 - 64 * (c - 4)); };
    auto gload = [&](Stg& g, int c) { const size_t tk0 = (size_t)b * TB + s0_of(c);
        const size_t tkr = tk0 + (dir ? 63 - srow : srow);
        g.k = *(const u32x4*)(P + tkr * LDP + PC_LK + hh * 64 + 8 * sc8); g.q = *(const u32x4*)(P + tkr * LDP + PC_LQ + hh * 64 + 8 * sc8);
        g.fm = MC[(tk0 + (dir ? 32 : 31)) * 16 + dh];
        if (tid < 256) { const size_t tkv = tk0 + (dir ? 63 - vrow : vrow); g.v = *(const u32x4*)(P + tkv * LDP + PC_LV + hh * 128 + vq * 32 + 8 * vc); g.vfc = MC[tkv * 16 + dh]; g.vip = MC[tkv * 16 + 8 + dh]; }
        if (tid < 64) { const size_t tkg = tk0 + (dir ? 63 - tid : tid); g.fc = MC[tkg * 16 + dh]; g.ip = MC[tkg * 16 + 8 + dh]; } };
    auto lstore = [&](const Stg& g, int nb) { LAS unsigned char* cb = lds + nb * CHB;
        *(LAS u32x4*)(cb + KT + srow * 144 + 16 * sc8) = g.k;
        { LAS unsigned char* kt_ = cb + KTT + (8 * sc8) * 144 + 2 * srow;
          *(LAS unsigned short*)(kt_) = (unsigned short)(g.k.x & 0xffffu); *(LAS unsigned short*)(kt_ + 144) = (unsigned short)(g.k.x >> 16);
          *(LAS unsigned short*)(kt_ + 288) = (unsigned short)(g.k.y & 0xffffu); *(LAS unsigned short*)(kt_ + 432) = (unsigned short)(g.k.y >> 16);
          *(LAS unsigned short*)(kt_ + 576) = (unsigned short)(g.k.z & 0xffffu); *(LAS unsigned short*)(kt_ + 720) = (unsigned short)(g.k.z >> 16);
          *(LAS unsigned short*)(kt_ + 864) = (unsigned short)(g.k.w & 0xffffu); *(LAS unsigned short*)(kt_ + 1008) = (unsigned short)(g.k.w >> 16); }
        { float q8[8]; unpack8(g.q, q8);
#pragma unroll
          for (int e = 0; e < 8; ++e) q8[e] *= 0.125f;
          *(LAS u32x4*)(cb + QT + srow * 144 + 16 * sc8) = pack8(q8); }
        if (tid < 256) { float v8[8]; unpack8(g.v, v8); const float bj = __expf(g.vip - g.vfc + g.fm);
#pragma unroll
            for (int e = 0; e < 8; ++e) v8[e] *= bj;
#pragma unroll
            for (int e = 0; e < 8; e += 2) { const unsigned w_ = cvtpk(v8[e], v8[e + 1]);
                *(LAS unsigned short*)(cb + VTT + (8 * vc + e) * 144 + 2 * vrow) = (unsigned short)(w_ & 0xffffu); *(LAS unsigned short*)(cb + VTT + (8 * vc + e + 1) * 144 + 2 * vrow) = (unsigned short)(w_ >> 16); } }
        if (tid < 64) { ((LAS float*)(cb + FC))[tid] = g.fc; ((LAS float*)(cb + AO_))[tid] = __expf(g.fc - g.fm); ((LAS float*)(cb + BO_))[tid] = __expf(g.ip - g.fc + g.fm); }
        if (tid == 64) ((LAS float*)(cb + FC + 768))[0] = g.fm; };
    gload(sA, 0); lstore(sA, 0); gload(sB, 1);
    __syncthreads();
    auto compute = [&](const int c, const int cur) {
        const int nxt = cur ^ 1;
        const LAS unsigned char* cb = lds + cur * CHB;
        const LAS float* fcS = (const LAS float*)(cb + FC); const LAS float* aS = (const LAS float*)(cb + AO_); const LAS float* bS = (const LAS float*)(cb + BO_);
        const float fend = fcS[63], dec = __expf(fend), cw = __expf(fend - fcS[192]);
        if (wid < 2) {
            const int ib = wid, i = 32 * ib + r;
            bf16x8 qf[4];
#pragma unroll
            for (int s = 0; s < 4; ++s) qf[s] = *(const LAS bf16x8*)(cb + QT + i * 144 + 32 * s + 16 * h);
            f32x16 s0v, s1v, nacc;
#pragma unroll
            for (int q = 0; q < 16; ++q) { s0v[q] = 0.f; s1v[q] = 0.f; nacc[q] = 0.f; }
#pragma unroll
            for (int s = 0; s < 4; ++s) { const bf16x8 a0 = *(const LAS bf16x8*)(cb + KT + r * 144 + 32 * s + 16 * h); s0v = __builtin_amdgcn_mfma_f32_32x32x16_bf16(a0, qf[s], s0v, 0, 0, 0); }
            float den = 0.f;
            if (ib == 0) {
#pragma unroll
                for (int g4 = 0; g4 < 4; ++g4) { const f32x4 B0 = *(const LAS f32x4*)(bS + 8 * g4 + 4 * h);
#pragma unroll
                    for (int q = 0; q < 4; ++q) { const int reg = 4 * g4 + q, j0 = 8 * g4 + 4 * h + q; const float p0 = (j0 <= r) ? s0v[reg] : 0.f; s0v[reg] = p0; den += p0 * B0[q]; } }
            } else {
#pragma unroll
                for (int s = 0; s < 4; ++s) { const bf16x8 a1 = *(const LAS bf16x8*)(cb + KT + (32 + r) * 144 + 32 * s + 16 * h); s1v = __builtin_amdgcn_mfma_f32_32x32x16_bf16(a1, qf[s], s1v, 0, 0, 0); }
#pragma unroll
                for (int g4 = 0; g4 < 4; ++g4) { const f32x4 B0 = *(const LAS f32x4*)(bS + 8 * g4 + 4 * h), B1 = *(const LAS f32x4*)(bS + 32 + 8 * g4 + 4 * h);
#pragma unroll
                    for (int q = 0; q < 4; ++q) { const int reg = 4 * g4 + q, j0 = 8 * g4 + 4 * h + q; den += s0v[reg] * B0[q];
                        const float p1 = (j0 <= r) ? s1v[reg] : 0.f; s1v[reg] = p1; den += p1 * B1[q]; } }
            }
#pragma unroll
            for (int st = 0; st < 4; ++st) { if (st < 2 || ib == 1) {
                u32x4 pw;
#pragma unroll
                for (int q = 0; q < 4; ++q) { const int reg = 8 * (st & 1) + 2 * q; pw[q] = (st < 2) ? cvtpk(s0v[reg], s0v[reg + 1]) : cvtpk(s1v[reg], s1v[reg + 1]); }
                const u32x2 v0_ = *(const LAS u32x2*)(cb + VTT + r * 144 + 2 * (16 * st + 4 * h)), v1_ = *(const LAS u32x2*)(cb + VTT + r * 144 + 2 * (16 * st + 8 + 4 * h));
                nacc = __builtin_amdgcn_mfma_f32_32x32x16_bf16(__builtin_bit_cast(bf16x8, (u32x4){v0_.x, v0_.y, v1_.x, v1_.y}), __builtin_bit_cast(bf16x8, pw), nacc, 0, 0, 0); } }
            { auto rr = __builtin_amdgcn_permlane32_swap(__float_as_uint(den), __float_as_uint(den), false, false); den = __uint_as_float(rr[0]) + __uint_as_float(rr[1]); }
            LAS float* pp = (LAS float*)(lds + PARTO) + ((cur * 2 + ib) * 64 + lane) * 20;
#pragma unroll
            for (int g4 = 0; g4 < 4; ++g4) *(LAS f32x4*)(pp + 4 * g4) = (f32x4){nacc[4 * g4], nacc[4 * g4 + 1], nacc[4 * g4 + 2], nacc[4 * g4 + 3]};
            pp[16] = den;
        } else if (wid < 4) {
            const int cbk = wid - 2;
            f32x16 tacc;
#pragma unroll
            for (int q = 0; q < 16; ++q) tacc[q] = 0.f;
#pragma unroll
            for (int s = 0; s < 4; ++s) { const bf16x8 vw = *(const LAS bf16x8*)(cb + VTT + r * 144 + 32 * s + 16 * h), kw = *(const LAS bf16x8*)(cb + KTT + (r + 32 * cbk) * 144 + 32 * s + 16 * h);
                tacc = __builtin_amdgcn_mfma_f32_32x32x16_bf16(vw, kw, tacc, 0, 0, 0); }
            LAS unsigned char* cbn = lds + CBO + nxt * CBS;
#pragma unroll
            for (int q = 0; q < 16; ++q) { cacc[q] = dec * cacc[q] + cw * tacc[q]; const int v = (q & 3) + 8 * (q >> 2) + 4 * h; *(LAS unsigned short*)(cbn + v * 144 + 2 * (r + 32 * cbk)) = (unsigned short)(cvtpk(cacc[q], 0.f) & 0xffffu); }
        } else if (wid == 5 || wid == 6) {
            const int ib = wid - 5, i = 32 * ib + r;
            if (c > 0) mlstm_finish(lds + PARTO, (cur ^ 1), ib, lane, h, iprev, dprev, aprev, eprev, OM + ((size_t)b * TB + s0_of(c - 1) + (dir ? 63 - i : i)) * 512 + hh * 128 + vq * 32 + 4 * h);
            bf16x8 qf[4];
#pragma unroll
            for (int s = 0; s < 4; ++s) qf[s] = *(const LAS bf16x8*)(cb + QT + i * 144 + 32 * s + 16 * h);
            const LAS unsigned char* cbt = lds + CBO + cur * CBS; const LAS float* nS = (const LAS float*)(lds + NSO + cur * 256);
            f32x16 iacc;
#pragma unroll
            for (int q = 0; q < 16; ++q) iacc[q] = 0.f;
            float dint = 0.f;
#pragma unroll
            for (int s = 0; s < 4; ++s) { const bf16x8 ca = *(const LAS bf16x8*)(cbt + r * 144 + 32 * s + 16 * h); iacc = __builtin_amdgcn_mfma_f32_32x32x16_bf16(ca, qf[s], iacc, 0, 0, 0);
                float q8[8]; unpack8(__builtin_bit_cast(u32x4, qf[s]), q8); const f32x4 n0 = *(const LAS f32x4*)(nS + 16 * s + 8 * h), n1 = *(const LAS f32x4*)(nS + 16 * s + 8 * h + 4);
                dint += q8[0] * n0.x + q8[1] * n0.y + q8[2] * n0.z + q8[3] * n0.w + q8[4] * n1.x + q8[5] * n1.y + q8[6] * n1.z + q8[7] * n1.w; }
            { auto rr = __builtin_amdgcn_permlane32_swap(__float_as_uint(dint), __float_as_uint(dint), false, false); dint = __uint_as_float(rr[0]) + __uint_as_float(rr[1]); }
            iprev = iacc; dprev = dint; aprev = aS[i]; eprev = __expf(fcS[i]);
        } else if (wid == 4) {
            float s0 = 0.f, s1 = 0.f;
#pragma unroll
            for (int j8 = 0; j8 < 8; ++j8) { float k8[8]; unpack8(*(const LAS u32x4*)(cb + KTT + lane * 144 + 16 * j8), k8); const f32x4 b0 = *(const LAS f32x4*)(bS + 8 * j8), b1 = *(const LAS f32x4*)(bS + 8 * j8 + 4);
                s0 += k8[0] * b0.x + k8[1] * b0.y + k8[2] * b0.z + k8[3] * b0.w; s1 += k8[4] * b1.x + k8[5] * b1.y + k8[6] * b1.z + k8[7] * b1.w; }
            const LAS float* nc = (const LAS float*)(lds + NSO + cur * 256); LAS float* nn = (LAS float*)(lds + NSO + nxt * 256);
            nn[lane] = dec * nc[lane] + cw * (s0 + s1);
        }
    };
    for (int c = 0; c < TB / 64; c += 2) {
        gload(sA, min(c + 2, TB / 64 - 1)); compute(c, 0); lstore(sB, 1); LDS_BAR();
        gload(sB, min(c + 3, TB / 64 - 1)); compute(c + 1, 1); lstore(sA, 0); LDS_BAR();
    }
    if (wid == 5 || wid == 6) { const int ib = wid - 5, i = 32 * ib + r, cl = TB / 64 - 1;
        mlstm_finish(lds + PARTO, cl & 1, ib, lane, h, iprev, dprev, aprev, eprev, OM + ((size_t)b * TB + s0_of(cl) + (dir ? 63 - i : i)) * 512 + hh * 128 + vq * 32 + 4 * h); }
}

constexpr int GF_WM = 0, GF_QD = 16384, GF_QK = 32768, GF_KE = 40960, GF_U0 = 57344, GF_EE = 90112, GF_ITEM = 90368, NCHUNK = TB / 64;
__device__ __forceinline__ int chunk_s0(int dir, int c) { return (dir == 0) ? 64 * c : (c < 4 ? 192 - 64 * c : TB - 64 - 64 * (c - 4)); }
__device__ __forceinline__ void phase_gdnpre(const PView& p, int l, LAS unsigned char* lds, int bid, int G) {
    const int tid = ltid(), wid = __builtin_amdgcn_readfirstlane(tid >> 6), lane = tid & 63, r = lane & 31, h = lane >> 5;
    unsigned char* ws = p.ws;
    const bf16* GQ = (const bf16*)(ws + OFF_GQKV); const float* GC = (const float*)(ws + OFF_GC);
    constexpr int KO = 0, QO = 17408, VO = 34816, AO = 52224, GSO = 69632, BSO = GSO + 256, XO = 70400, UO = 87808;
    const LAS float* gS = (const LAS float*)(lds + GSO); const LAS float* bS = (const LAS float*)(lds + BSO);
    for (int it = bid; it < 32 * NCHUNK; it += G) {
        const int chain = it / NCHUNK, c = it % NCHUNK, b = chain >> 3, hh = (chain >> 1) & 3, dir = chain & 1, dh = dir * 4 + hh;
        const size_t tk0 = (size_t)b * TB + chunk_s0(dir, c);
        unsigned char* gf = ws + OFF_GF + (size_t)it * GF_ITEM;
#pragma unroll
        for (int rep = 0; rep < 6; ++rep) { const int ch = tid + 512 * rep, tile = ch >> 10, row = (ch & 1023) >> 4, c8 = ch & 15;
            const size_t tk = tk0 + (dir ? 63 - row : row);
            const int col = (tile == 0 ? 512 : (tile == 1 ? 0 : 1024)) + hh * 128 + 8 * c8;
            *(LAS u32x4*)(lds + tile * 17408 + row * 272 + 16 * c8) = *(const u32x4*)(GQ + tk * 1536 + col); }
        if (tid < 64) { const size_t tk = tk0 + (dir ? 63 - tid : tid); const float gg = GC[tk * 24 + dh], bb = GC[tk * 24 + 8 + dh];
            ((LAS float*)(lds + GSO))[tid] = gg; ((LAS float*)(lds + BSO))[tid] = bb; ((LAS float*)(lds + BSO + 256))[tid] = bb * __expf(gg); }
        __syncthreads();
        { const int w4 = wid & 3, jb = w4 >> 1, ib = w4 & 1, i = 32 * ib + r;
          f32x16 acc;
#pragma unroll
          for (int q = 0; q < 16; ++q) acc[q] = 0.f;
          const LAS unsigned char* bsrc = lds + ((wid < 4) ? KO : QO) + i * 272 + 16 * h;
#pragma unroll
          for (int s = 0; s < 8; ++s) { const bf16x8 a = *(const LAS bf16x8*)(lds + KO + (32 * jb + r) * 272 + 32 * s + 16 * h), bq = *(const LAS bf16x8*)(bsrc + 32 * s);
              acc = __builtin_amdgcn_mfma_f32_32x32x16_bf16(a, bq, acc, 0, 0, 0); }
          const float gi = gS[i], bi = bS[i];
          if (wid < 4) {
#pragma unroll
              for (int g4 = 0; g4 < 4; ++g4) { const int j0 = 32 * jb + 8 * g4 + 4 * h; const f32x4 gj = *(const LAS f32x4*)(gS + j0); f32x4 o;
#pragma unroll
                  for (int q = 0; q < 4; ++q) o[q] = (i > j0 + q) ? bi * __expf(gi - gj[q]) * acc[4 * g4 + q] : 0.f;
                  *(LAS f32x4*)(lds + AO + i * 272 + 4 * j0) = o; }
          } else {
#pragma unroll
              for (int g4 = 0; g4 < 4; ++g4) { const int j0 = 32 * jb + 8 * g4 + 4 * h; const f32x4 gj = *(const LAS f32x4*)(gS + j0);
#pragma unroll
                  for (int q = 0; q < 4; ++q) acc[4 * g4 + q] = (i >= j0 + q) ? __expf(gi - gj[q]) * acc[4 * g4 + q] : 0.f; }
#pragma unroll
              for (int s2 = 0; s2 < 2; ++s2) { u32x4 w;
#pragma unroll
                  for (int q = 0; q < 4; ++q) w[q] = cvtpk(acc[8 * s2 + 2 * q], acc[8 * s2 + 2 * q + 1]);
                  *(u32x4*)(gf + GF_QK + (size_t)((ib * 4 + 2 * jb + s2) * 64 + lane) * 16) = w; }
          } }
        __syncthreads();
        constexpr int TO = UO;
        if (wid == 0) {
            float t[32];
#pragma unroll
            for (int i = 0; i < 32; ++i) {
                float acc0 = (i == r) ? 1.0f : 0.0f, acc1 = 0.f;
#pragma unroll
                for (int j4 = 0; j4 < (i + 3) / 4; ++j4) { const f32x4 a4 = *(const LAS f32x4*)(lds + AO + (32 * h + i) * 272 + (32 * h + 4 * j4) * 4);
#pragma unroll
                    for (int q = 0; q < 4; ++q) if (4 * j4 + q < i) { if (q & 1) acc1 -= a4[q] * t[4 * j4 + q]; else acc0 -= a4[q] * t[4 * j4 + q]; } }
                t[i] = acc0 + acc1;
                *(LAS unsigned short*)(lds + TO + h * 2048 + i * 64 + 2 * r) = (unsigned short)(cvtpk(t[i], 0.f) & 0xffffu);
                if ((i & 3) == 3) asm volatile("" ::: "memory");
            }
        } else if (wid >= 4) {
            const int w4 = wid - 4; const float gend = gS[63];
#pragma unroll
            for (int k = 0; k < 4; ++k) { const int f = w4 * 4 + k, ib = f >> 3, s = f & 7, i = 32 * ib + r;
                float q8[8]; unpack8(*(const LAS u32x4*)(lds + QO + i * 272 + 32 * s + 16 * h), q8); const float e = __expf(gS[i]);
#pragma unroll
                for (int q = 0; q < 8; ++q) q8[q] *= e;
                *(u32x4*)(gf + GF_QD + (size_t)(f * 64 + lane) * 16) = pack8(q8); }
#pragma unroll
            for (int k = 0; k < 4; ++k) { const int f = w4 * 4 + k, db = f >> 2, st = f & 3, dk = 32 * db + r;
                u32x4 w;
#pragma unroll
                for (int q = 0; q < 4; ++q) { const int t0 = 16 * st + 8 * (q >> 1) + 4 * h + 2 * (q & 1);
                    const float ka = bf2f((bf16)lds_u16(lds + KO + t0 * 272 + 2 * dk)) * __expf(gend - gS[t0]), kb = bf2f((bf16)lds_u16(lds + KO + (t0 + 1) * 272 + 2 * dk)) * __expf(gend - gS[t0 + 1]);
                    w[q] = cvtpk(ka, kb); }
                *(u32x4*)(gf + GF_KE + (size_t)(f * 64 + lane) * 16) = w; }
            if (tid == 256) *(float*)(gf + GF_EE) = __expf(gend);
        }
        __syncthreads();
        { const bool isv = wid < 4; const int c = 32 * (wid & 3) + r;
          const LAS unsigned char* srcp = lds + (isv ? VO : KO) + 2 * c; const LAS float* fS = (const LAS float*)(lds + (isv ? BSO : BSO + 256));
          f32x16 x0, x1;
#pragma unroll
          for (int q = 0; q < 16; ++q) { x0[q] = 0.f; const int tok = 32 + (q & 3) + 8 * (q >> 2) + 4 * h; x1[q] = fS[tok] * bf2f((bf16)lds_u16(srcp + tok * 272)); }
#pragma unroll
          for (int s = 0; s < 2; ++s) { u32x4 rw_;
#pragma unroll
              for (int q = 0; q < 4; ++q) { const int t0 = 16 * s + 8 * h + 2 * q; rw_[q] = cvtpk(fS[t0] * bf2f((bf16)lds_u16(srcp + t0 * 272)), fS[t0 + 1] * bf2f((bf16)lds_u16(srcp + (t0 + 1) * 272))); }
              const bf16x8 ta = *(const LAS bf16x8*)(lds + TO + r * 64 + 32 * s + 16 * h);
              x0 = __builtin_amdgcn_mfma_f32_32x32x16_bf16(ta, __builtin_bit_cast(bf16x8, rw_), x0, 0, 0, 0); }
#pragma unroll
          for (int s2 = 0; s2 < 2; ++s2) { u32x4 xb, aw;
#pragma unroll
              for (int q = 0; q < 4; ++q) xb[q] = cvtpk(x0[8 * s2 + 2 * q], x0[8 * s2 + 2 * q + 1]);
              const f32x4 a0 = *(const LAS f32x4*)(lds + AO + (32 + r) * 272 + (16 * s2 + 4 * h) * 4), a1 = *(const LAS f32x4*)(lds + AO + (32 + r) * 272 + (16 * s2 + 8 + 4 * h) * 4);
              aw[0] = cvtpk(-a0.x, -a0.y); aw[1] = cvtpk(-a0.z, -a0.w); aw[2] = cvtpk(-a1.x, -a1.y); aw[3] = cvtpk(-a1.z, -a1.w);
              x1 = __builtin_amdgcn_mfma_f32_32x32x16_bf16(__builtin_bit_cast(bf16x8, aw), __builtin_bit_cast(bf16x8, xb), x1, 0, 0, 0); }
          f32x16 y1;
#pragma unroll
          for (int q = 0; q < 16; ++q) y1[q] = 0.f;
#pragma unroll
          for (int s2 = 0; s2 < 2; ++s2) { u32x4 rb;
#pragma unroll
              for (int q = 0; q < 4; ++q) rb[q] = cvtpk(x1[8 * s2 + 2 * q], x1[8 * s2 + 2 * q + 1]);
              const u32x2 t0 = *(const LAS u32x2*)(lds + TO + 2048 + r * 64 + (16 * s2 + 4 * h) * 2), t1 = *(const LAS u32x2*)(lds + TO + 2048 + r * 64 + (16 * s2 + 8 + 4 * h) * 2);
              y1 = __builtin_amdgcn_mfma_f32_32x32x16_bf16(__builtin_bit_cast(bf16x8, (u32x4){t0.x, t0.y, t1.x, t1.y}), __builtin_bit_cast(bf16x8, rb), y1, 0, 0, 0); }
          if (isv) {
              f32x4* d0 = (f32x4*)(gf + GF_U0 + (size_t)((wid * 2 + 0) * 64 + lane) * 64); f32x4* d1 = (f32x4*)(gf + GF_U0 + (size_t)((wid * 2 + 1) * 64 + lane) * 64);
#pragma unroll
              for (int q = 0; q < 4; ++q) { d0[q] = (f32x4){x0[4 * q], x0[4 * q + 1], x0[4 * q + 2], x0[4 * q + 3]}; d1[q] = (f32x4){y1[4 * q], y1[4 * q + 1], y1[4 * q + 2], y1[4 * q + 3]}; }
          } else {
              const int dk = 32 * (wid - 4) + r;
#pragma unroll
              for (int q = 0; q < 16; ++q) { const int tok = (q & 3) + 8 * (q >> 2) + 4 * h;
                  *(LAS unsigned short*)(lds + XO + tok * 272 + 2 * dk) = (unsigned short)(cvtpk(-x0[q], 0.f) & 0xffffu);
                  *(LAS unsigned short*)(lds + XO + (32 + tok) * 272 + 2 * dk) = (unsigned short)(cvtpk(-y1[q], 0.f) & 0xffffu); }
          } }
        __syncthreads();
#pragma unroll
        for (int k = 0; k < 2; ++k) { const int f = wid * 2 + k, tb = f >> 3, s = f & 7;
            *(u32x4*)(gf + GF_WM + (size_t)(f * 64 + lane) * 16) = *(const LAS u32x4*)(lds + XO + (32 * tb + r) * 272 + 32 * s + 16 * h); }
        __syncthreads();
    }
}

__device__ __forceinline__ void gdn_seq_item(const PView& p, LAS unsigned char* lds, int chain, int vq) {
    const int tid = ltid(), wid = __builtin_amdgcn_readfirstlane(tid >> 6), lane = tid & 63, r = lane & 31, h = lane >> 5;
    const int b = chain >> 3, hh = (chain >> 1) & 3, dir = chain & 1;
    unsigned char* ws = p.ws;
    const unsigned char* gfc = ws + OFF_GF + (size_t)chain * NCHUNK * GF_ITEM;
    constexpr int SBS = 8704, UFO = 17408;
    for (int i = tid; i < SBS / 4; i += NTHR) ((LAS unsigned*)lds)[i] = 0u;
    __syncthreads();
    if (wid < 2) {
        u32x4 wm[3][8]; f32x4 uu[3][4];
#define LD_A(SET, C) do { const unsigned char* gf_ = gfc + (size_t)(C) * GF_ITEM; \
            _Pragma("unroll") for (int s = 0; s < 8; ++s) wm[SET][s] = *(const u32x4*)(gf_ + GF_WM + (size_t)((wid * 8 + s) * 64 + lane) * 16); \
            const f32x4* up_ = (const f32x4*)(gf_ + GF_U0 + (size_t)((vq * 2 + wid) * 64 + lane) * 64); \
            _Pragma("unroll") for (int q = 0; q < 4; ++q) uu[SET][q] = up_[q]; } while (0)
#define ST_A(SET, C) do { const LAS unsigned char* sb_ = lds + ((C) & 1) * SBS; f32x16 acc_; \
            _Pragma("unroll") for (int q = 0; q < 4; ++q) { acc_[4 * q] = uu[SET][q].x; acc_[4 * q + 1] = uu[SET][q].y; acc_[4 * q + 2] = uu[SET][q].z; acc_[4 * q + 3] = uu[SET][q].w; } \
            _Pragma("unroll") for (int s = 0; s < 8; ++s) { const bf16x8 sf_ = *(const LAS bf16x8*)(sb_ + r * 272 + 32 * s + 16 * h); \
                acc_ = __builtin_amdgcn_mfma_f32_32x32x16_bf16(__builtin_bit_cast(bf16x8, wm[SET][s]), sf_, acc_, 0, 0, 0); } \
            _Pragma("unroll") for (int s2 = 0; s2 < 2; ++s2) { u32x4 w_; _Pragma("unroll") for (int q = 0; q < 4; ++q) w_[q] = cvtpk(acc_[8 * s2 + 2 * q], acc_[8 * s2 + 2 * q + 1]); \
                *(LAS u32x4*)(lds + UFO + ((2 * wid + s2) * 64 + lane) * 16) = w_; } \
            LDS_BAR(); LDS_BAR(); } while (0)
        LD_A(0, 0); LD_A(1, 1);
        for (int c = 0; c < NCHUNK; c += 3) { LD_A(2, c + 2); ST_A(0, c); LD_A(0, min(c + 3, NCHUNK - 1)); ST_A(1, c + 1); LD_A(1, min(c + 4, NCHUNK - 1)); ST_A(2, c + 2); }
#undef LD_A
#undef ST_A
    } else if (wid < 4) {
        const int ib = wid - 2;
        char* OGu = (char*)((float*)(ws + OFF_OGD) + (size_t)dir * T * 512 + hh * 128 + vq * 32);
        const int ostep = dir ? -2048 : 2048, ot0 = 32 * ib + 4 * h;
        u32x4 qd[3][8], qk[3][4];
#define LD_B(SET, C) do { const unsigned char* gf_ = gfc + (size_t)(C) * GF_ITEM; \
            _Pragma("unroll") for (int s = 0; s < 8; ++s) qd[SET][s] = *(const u32x4*)(gf_ + GF_QD + (size_t)((ib * 8 + s) * 64 + lane) * 16); \
            _Pragma("unroll") for (int s = 0; s < 4; ++s) qk[SET][s] = *(const u32x4*)(gf_ + GF_QK + (size_t)((ib * 4 + s) * 64 + lane) * 16); } while (0)
#define ST_B(SET, C) do { const LAS unsigned char* sb_ = lds + ((C) & 1) * SBS; f32x16 acc_; \
            _Pragma("unroll") for (int q = 0; q < 16; ++q) acc_[q] = 0.f; \
            _Pragma("unroll") for (int s = 0; s < 8; ++s) { const bf16x8 sf_ = *(const LAS bf16x8*)(sb_ + r * 272 + 32 * s + 16 * h); \
                acc_ = __builtin_amdgcn_mfma_f32_32x32x16_bf16(__builtin_bit_cast(bf16x8, qd[SET][s]), sf_, acc_, 0, 0, 0); } \
            LDS_BAR(); \
            _Pragma("unroll") for (int s = 0; s < 4; ++s) { const bf16x8 uf_ = *(const LAS bf16x8*)(lds + UFO + (s * 64 + lane) * 16); \
                acc_ = __builtin_amdgcn_mfma_f32_32x32x16_bf16(__builtin_bit_cast(bf16x8, qk[SET][s]), uf_, acc_, 0, 0, 0); } \
            const unsigned ob_ = (unsigned)(((b * TB + chunk_s0(dir, (C)) + (dir ? 63 - ot0 : ot0)) * 512 + r) * 4); \
            _Pragma("unroll") for (int q = 0; q < 16; ++q) { *(float*)(OGu + (ob_ + (unsigned)(((q & 3) + 8 * (q >> 2)) * ostep))) = acc_[q]; } \
            LDS_BAR(); } while (0)
        LD_B(0, 0); LD_B(1, 1);
        for (int c = 0; c < NCHUNK; c += 3) { LD_B(2, c + 2); ST_B(0, c); LD_B(0, min(c + 3, NCHUNK - 1)); ST_B(1, c + 1); LD_B(1, min(c + 4, NCHUNK - 1)); ST_B(2, c + 2); }
#undef LD_B
#undef ST_B
    } else {
        const int db = wid - 4;
        u32x4 ke[3][4]; float ee[3];
        f32x16 sacc;
#pragma unroll
        for (int q = 0; q < 16; ++q) sacc[q] = 0.f;
#define LD_C(SET, C) do { const unsigned char* gf_ = gfc + (size_t)(C) * GF_ITEM; \
            _Pragma("unroll") for (int s = 0; s < 4; ++s) ke[SET][s] = *(const u32x4*)(gf_ + GF_KE + (size_t)((db * 4 + s) * 64 + lane) * 16); ee[SET] = *(const float*)(gf_ + GF_EE); } while (0)
#define ST_C(SET, C) do { LAS unsigned char* sn_ = lds + (((C) & 1) ^ 1) * SBS; \
            _Pragma("unroll") for (int q = 0; q < 16; ++q) sacc[q] *= ee[SET]; \
            LDS_BAR(); \
            _Pragma("unroll") for (int s = 0; s < 4; ++s) { const bf16x8 uf_ = *(const LAS bf16x8*)(lds + UFO + (s * 64 + lane) * 16); \
                sacc = __builtin_amdgcn_mfma_f32_32x32x16_bf16(__builtin_bit_cast(bf16x8, ke[SET][s]), uf_, sacc, 0, 0, 0); } \
            _Pragma("unroll") for (int g4 = 0; g4 < 4; ++g4) *(LAS u32x2*)(sn_ + r * 272 + 2 * (32 * db + 8 * g4 + 4 * h)) = (u32x2){cvtpk(sacc[4 * g4], sacc[4 * g4 + 1]), cvtpk(sacc[4 * g4 + 2], sacc[4 * g4 + 3])}; \
            LDS_BAR(); } while (0)
        LD_C(0, 0); LD_C(1, 1);
        for (int c = 0; c < NCHUNK; c += 3) { LD_C(2, c + 2); ST_C(0, c); LD_C(0, min(c + 3, NCHUNK - 1)); ST_C(1, c + 1); LD_C(1, min(c + 4, NCHUNK - 1)); ST_C(2, c + 2); }
#undef LD_C
#undef ST_C
    }
}

__device__ __forceinline__ void phase_scan(const PView& p, int l, LAS unsigned char* lds, int bid, int G) {
    for (int wi = bid; wi < 256; wi += G) {
        const int x = wi & 7, k = wi >> 3, item = ((k >> 4) << 7) + x * 16 + (k & 15);
        const int it = item & 127, chain = it >> 2, vq = it & 3;
        if (item < 128) { for (int rp = 0; rp < NREP(53); ++rp) { gdn_seq_item(p, lds, chain, vq); __syncthreads(); } }
        else { for (int rp = 0; rp < NREP(54); ++rp) { mlstm_chunk_item(p, lds, chain, vq); __syncthreads(); } }
        __syncthreads();
    }
}

__device__ __forceinline__ void phase_scanout(const PView& p, int l, int bid, int G) {
    const int tid = ltid(), wid = __builtin_amdgcn_readfirstlane(tid >> 6), lane = tid & 63;
    unsigned char* ws = p.ws;
    const bf16* P = (const bf16*)(ws + OFF_R1); const bf16* Y = (const bf16*)(ws + OFF_Y);
    signed char* Y8 = (signed char*)(ws + OFF_Y8); float* SY = (float*)(ws + OFF_SY);
    const float* OG = (const float*)(ws + OFF_OGD); const float* OM = (const float*)(ws + OFF_OML);
    for (int tp = bid * NWAVES + wid; tp < T / 2; tp += G * NWAVES) {
        f32x4 oa[2][2][2], ob[2][2][2]; u32x4 gw[2][2], ya[2][2];
#pragma unroll
        for (int u = 0; u < 2; ++u)
#pragma unroll
            for (int which = 0; which < 2; ++which) { const int tk = 2 * tp + u;
                const float* o0 = (which ? OM : OG) + (size_t)tk * 512 + 8 * lane; const float* o1 = o0 + (size_t)T * 512;
                oa[u][which][0] = *(const f32x4*)o0; oa[u][which][1] = *(const f32x4*)(o0 + 4); ob[u][which][0] = *(const f32x4*)o1; ob[u][which][1] = *(const f32x4*)(o1 + 4);
                gw[u][which] = *(const u32x4*)(P + (size_t)tk * LDP + (which ? PC_LO : PC_GG) + 8 * lane);
                ya[u][which] = *(const u32x4*)(Y + (size_t)tk * 2048 + which * 1024 + 8 * lane); }
#pragma unroll
        for (int u = 0; u < 2; ++u)
#pragma unroll
            for (int br = 0; br < 4; ++br) { const int tk = 2 * tp + u, which = br >> 1;
                float y[8];
                if (br & 1) {
                    float x[8]; { const f32x4 a0 = oa[u][which][0], a1 = oa[u][which][1], b0 = ob[u][which][0], b1 = ob[u][which][1];
                        x[0] = a0.x + b0.x; x[1] = a0.y + b0.y; x[2] = a0.z + b0.z; x[3] = a0.w + b0.w; x[4] = a1.x + b1.x; x[5] = a1.y + b1.y; x[6] = a1.z + b1.z; x[7] = a1.w + b1.w; }
                    float ss = 0.f;
#pragma unroll
                    for (int i = 0; i < 8; ++i) ss += x[i] * x[i];
                    ss = row16_sum(ss);
                    const float rs = __builtin_amdgcn_rsqf(ss * (1.f / 128.f) + 1e-6f);
                    const float* ng = (which ? p.in[I_MLG] : p.in[I_GNG]) + l * 128 + 8 * (lane & 15);
                    float gt[8]; unpack8(gw[u][which], gt);
#pragma unroll
                    for (int i = 0; i < 8; ++i) { const float sg = fsigmoid(gt[i]); y[i] = x[i] * rs * ng[i] * (which ? sg : gt[i] * sg); }
                } else unpack8(ya[u][which], y);
                float am = 0.f;
#pragma unroll
                for (int i = 0; i < 8; ++i) am = fmaxf(am, fabsf(y[i]));
                const float amax = wave_max(am), inv = amax > 0.f ? 127.0f / amax : 0.f;
                if (lane == 0) SY[tk * 4 + br] = amax * (1.0f / 127.0f);
                *(u32x2*)(Y8 + (size_t)tk * 2048 + br * 512 + 8 * lane) = (u32x2){q8x4((f32x4){y[0], y[1], y[2], y[3]} * inv), q8x4((f32x4){y[4], y[5], y[6], y[7]} * inv)}; }
    }
}

constexpr int NPH_L = 14, PH_L0 = 1, PH_FINAL = PH_L0 + DEPTH * NPH_L, NPHASES = PH_FINAL + 1;
__global__ void __launch_bounds__(NTHR, 2) fwd_kernel(Params kp) {
    extern __shared__ __attribute__((aligned(16))) unsigned char lds_raw[];
    LAS unsigned char* lds = (LAS unsigned char*)lds_raw;
    volatile LAS unsigned* MISC = (volatile LAS unsigned*)(lds + MISC_OFF);
    const int tid = threadIdx.x;
    for (int u = tid; u < (LDS_BYTES - MISC_OFF) / 4; u += NTHR) ((LAS unsigned*)(lds + MISC_OFF))[u] = 0u;
    __syncthreads();
    const int lo = kp.ph_lo, hi = kp.ph_hi;
    XcdBarrier bar; bar.bar = (unsigned*)(kp.ws + OFF_CTL) + CW_BAR; bar.x = 0; bar.st = MISC + 8;
    if (hi - lo > 1) bar = xcd_barrier_post((unsigned*)(kp.ws + OFF_CTL) + CW_BAR, MISC + 8);
#define IN(k) (lo <= (k) && (k) < hi)
#define SEAM(k) do { if ((k) + 1 < hi) xcd_barrier(bar); } while (0)

    if (IN(0)) { const PView p = pview(); phase_prologue(p, lds, p.bid, p.G); SEAM(0); }
    for (int l = 0; l < DEPTH; ++l) {
        const int pb = PH_L0 + l * NPH_L;
        if (IN(pb + 0)) { const PView p = pview(); if (NREP(60) == 2) { phase_norm1<0>(p, l, p.bid, p.G, true); __syncthreads(); } phase_norm1<0>(p, l, p.bid, p.G); SEAM(pb + 0); }
        if (IN(pb + 1)) {
            const PView p = pview(); unsigned char* ws = p.ws;
            ProbPlain pr{(const char*)(ws + OFF_H), (const char*)(ws + OFF_WIN) + (size_t)l * NIN * 1024, 1024u, 1024u, 8};
            pg8::Order S; S.init(T / 256, NIN / 256, p.G, p.bid);
            EpiIn8 E{(bf16*)(ws + OFF_R1), (bf16*)(ws + OFF_R2), (float*)(ws + OFF_GATES), p.in[I_BMG] + (size_t)l * NGATE, (const float*)(ws + OFF_SH), (const float*)(ws + OFF_CMIN) + (size_t)l * NIN};
            for (int rp = 0; rp < NREP(1); ++rp) pg8::gemm_phase(lds, pr, S, E); SEAM(pb + 1); }
        if (IN(pb + 2)) { const PView p = pview(); if (NREP(2) == 2) { phase_prep(p, l, lds, p.bid, p.G); __syncthreads(); } phase_prep(p, l, lds, p.bid, p.G); SEAM(pb + 2); }
        if (IN(pb + 3)) {
            const PView p = pview(); unsigned char* ws = p.ws;
            ProbPlain pr{(const char*)(ws + OFF_AQ), (const char*)(ws + OFF_WUQKV) + (size_t)l * 1792 * 384 * 2, 768u, 768u, 6};
            pg8::Order S; S.init(T / 256, 7, p.G, p.bid);
            EpiStore E{(bf16*)(ws + OFF_QKVR), 1792, nullptr, 0};
            for (int rp = 0; rp < NREP(3); ++rp) pg8::gemm_phase(lds, pr, S, E); SEAM(pb + 3); }
        if (IN(pb + 4)) { const PView p = pview(); if (NREP(62) == 2) { phase_mlapost(p, l, lds, p.bid, p.G, true); __syncthreads(); } phase_mlapost(p, l, lds, p.bid, p.G); SEAM(pb + 4); }
        if (IN(pb + 5)) { for (int rp = 0; rp < NREP(50); ++rp) { const PView p = pview(); phase_attn(p, l, lds, p.bid, p.G); __syncthreads(); }
                          for (int rp = 0; rp < NREP(52); ++rp) { const PView p = pview(); phase_gdnpre(p, l, lds, p.bid, p.G); __syncthreads(); } SEAM(pb + 5); }
        if (IN(pb + 6)) { for (int rp = 0; rp < NREP(51); ++rp) { const PView p = pview(); phase_scan(p, l, lds, p.bid, p.G); __syncthreads(); } SEAM(pb + 6); }
        if (IN(pb + 7)) { const PView p = pview(); for (int rp = 0; rp < NREP(6); ++rp) phase_scanout(p, l, p.bid, p.G); SEAM(pb + 7); }
        if (IN(pb + 8)) {
            const PView p = pview(); unsigned char* ws = p.ws;
            ProbBO pr{(const char*)(ws + OFF_Y8), (const char*)(ws + OFF_WBO) + (size_t)l * 4096 * 512, 2048u, 512u, 4};
            pg8::Order S; if (l == DEPTH - 1) S.init(NB * SEQ / 256, 4, p.G, p.bid, 4, 1); else S.init(T / 256, 4, p.G, p.bid, 4);
            EpiBO E{(bf16*)(ws + OFF_R3), (const bf16*)(ws + OFF_R2), (const float*)(ws + OFF_SY), (const float*)(ws + OFF_CMBO) + (size_t)l * 4096};
            for (int rp = 0; rp < NREP(7); ++rp) pg8::gemm_phase(lds, pr, S, E); SEAM(pb + 8); }
        if (IN(pb + 9)) {
            const PView p = pview(); unsigned char* ws = p.ws;
            ProbPlain pr{(const char*)(ws + OFF_R3), (const char*)(ws + OFF_WOUT4) + (size_t)l * 1024 * 4096 * 2, 2048u, 8192u, 16};
            pg8::Order S; if (l == DEPTH - 1) S.init(NB * SEQ / 256, 4, p.G, p.bid, 1, 1); else S.init(T / 256, 4, p.G, p.bid);
            EpiOut E{(float*)(ws + OFF_X), (const float*)(ws + OFF_MOD) + (size_t)l * 5 * 6144};
            pg8::gemm_phase(lds, pr, S, E); SEAM(pb + 9); }
        if (IN(pb + 10)) { const PView p = pview(); if (NREP(61) == 2) { phase_router(p, l, lds, p.bid, p.G, true); __syncthreads(); } phase_router(p, l, lds, p.bid, p.G); SEAM(pb + 10); }
        if (IN(pb + 11)) { const PView p = pview(); for (int rp = 0; rp < NREP(10); ++rp) { phase_gather(p, l, lds, p.bid, p.G); __syncthreads(); } SEAM(pb + 11); }
        if (IN(pb + 12)) {
            const PView p = pview(); unsigned char* ws = p.ws; const int* tst = (const int*)(ws + OFF_CTL) + CW_TST + l * 64;
            ProbMoE pr{(const char*)(ws + OFF_R1), (const char*)(ws + OFF_WGU) + (size_t)l * 32 * 2048 * 1024, 1024u, 1024u, 8, tst, (size_t)2048 * 1024};
            pg8::Order S; S.init(tst[32], 8, p.G, p.bid);
            EpiMoE18 E{(bf16*)(ws + OFF_R2), p.in[I_BGU] + (size_t)l * 32 * 2048, (const float*)(ws + OFF_SX), (const float*)(ws + OFF_CMGU) + (size_t)l * 32 * 2048};
            for (int rp = 0; rp < NREP(11); ++rp) pg8::gemm_phase(lds, pr, S, E); SEAM(pb + 12); }
        if (IN(pb + 13)) {
            const PView p = pview(); unsigned char* ws = p.ws; const int* tst = (const int*)(ws + OFF_CTL) + CW_TST + l * 64;
            ProbMoE pr{(const char*)(ws + OFF_R2), (const char*)(ws + OFF_WDN) + (size_t)l * 32 * 1024 * 1024, 1024u, 1024u, 8, tst, (size_t)1024 * 1024};
            pg8::Order S; S.init(tst[32], 4, p.G, p.bid);
            EpiStoreF8 E{(bf16*)(ws + OFF_R3), 1024, p.in[I_BDN] + (size_t)l * 32 * 1024, 1024};
            for (int rp = 0; rp < NREP(12); ++rp) pg8::gemm_phase(lds, pr, S, E); SEAM(pb + 13); }
    }
    if (IN(PH_FINAL)) { const PView p = pview(); phase_norm1<2>(p, DEPTH, p.bid, p.G); }
#undef IN
#undef SEAM
}

extern "C" void kernel_launch(void* const* d_in, const int* in_sizes, int n_in, void* d_out, int out_size, void* d_ws, size_t ws_size, hipStream_t stream) {
    static int grid = 0;
    if (!grid) {
        if (n_in != 31 || ws_size < WS_END) { fprintf(stderr, "kernel_launch: expected 31 inputs and >= %zu bytes of workspace (got %d, %zu)\n", (size_t)WS_END, n_in, ws_size); grid = -1; return; }
        int dev = 0, cus = 0, per_cu = 0;
        hipGetDevice(&dev); hipDeviceGetAttribute(&cus, hipDeviceAttributeMultiprocessorCount, dev);
        hipFuncSetAttribute((const void*)fwd_kernel, hipFuncAttributeMaxDynamicSharedMemorySize, LDS_BYTES);
        hipOccupancyMaxActiveBlocksPerMultiprocessor(&per_cu, (const void*)fwd_kernel, NTHR, LDS_BYTES);
        if (per_cu < 1) fprintf(stderr, "kernel_launch: occupancy query reports %d blocks per CU\n", per_cu);
        grid = cus;
    }
    if (grid < 0) return;
    hipMemsetAsync((char*)d_ws + OFF_CTL, 0, CTL_BYTES, stream);
    Params p{};
    for (int i = 0; i < 31; ++i) p.in[i] = (const float*)d_in[i];
    p.out = (float*)d_out; p.ws = (unsigned char*)d_ws;
#if MK_N_LAUNCHES == 1
    p.ph_lo = 0; p.ph_hi = NPHASES;
    hipLaunchKernelGGL(fwd_kernel, dim3(grid), dim3(NTHR), LDS_BYTES, stream, p);
#else
    for (int ph = 0; ph < NPHASES; ++ph) { p.ph_lo = ph; p.ph_hi = ph + 1; hipLaunchKernelGGL(fwd_kernel, dim3(grid), dim3(NTHR), LDS_BYTES, stream, p); }
#endif
}
```

```cpp
#include <hip/hip_runtime.h>
#include <cstdio>
#include <cstdint>

#ifndef MK_N_LAUNCHES
#define MK_N_LAUNCHES 1
#endif

#ifndef PROBE_DUP
#define PROBE_DUP -1
#endif
#define NREP(k) ((PROBE_DUP == (k)) ? 2 : 1)
#define GAS __attribute__((address_space(1)))
#define LAS __attribute__((address_space(3)))
typedef unsigned short bf16;
typedef short bf16x8 __attribute__((ext_vector_type(8)));
typedef short s16x4 __attribute__((ext_vector_type(4)));
typedef float f32x4 __attribute__((ext_vector_type(4)));
typedef float f32x2 __attribute__((ext_vector_type(2)));
typedef float f32x16 __attribute__((ext_vector_type(16)));
typedef unsigned u32x4 __attribute__((ext_vector_type(4)));
typedef unsigned u32x2 __attribute__((ext_vector_type(2)));
typedef int i32x4 __attribute__((ext_vector_type(4)));
typedef int i32x8 __attribute__((ext_vector_type(8)));
typedef __bf16 bf16x2_t __attribute__((ext_vector_type(2)));

constexpr int D = 1024, NB = 4, SEQ = 8192, CTX = 256, TB = SEQ + CTX, T = NB * TB, DEPTH = 4;
constexpr int DIN = 5568, LDP = 5632, NGATE = 4096, NIN = LDP + NGATE;
constexpr int NE = 32, TOPK = 4, DFF = 1024;
constexpr int NSLOT = 143360;
constexpr int NWAVES = 8, NTHR = 512;
constexpr int PC_NAQ = 0, PC_NAK = 512, PC_NAV = 1024, PC_GQKV = 1536, PC_GG = 3072, PC_MQ = 3600, PC_MKV = 3856, PC_MKPE = 3984,
              PC_LQ = 4016, PC_LK = 4272, PC_LV = 4528, PC_LO = 5040;

constexpr size_t MiB = (size_t)1 << 20;
constexpr size_t OFF_CTL = 0, CTL_BYTES = 1 * MiB;
constexpr size_t OFF_MOD = 1 * MiB;
constexpr size_t OFF_X = 2 * MiB;
constexpr size_t OFF_H = 134 * MiB;
constexpr size_t OFF_SH = OFF_H + 40 * MiB;
constexpr size_t OFF_SX = 200 * MiB + 300 * MiB;
constexpr size_t OFF_R1 = 200 * MiB;
constexpr size_t OFF_R2 = 563 * MiB;
constexpr size_t OFF_R3 = 843 * MiB;
constexpr size_t OFF_GQKV = 1123 * MiB;
constexpr size_t OFF_GATES = 1222 * MiB;
constexpr size_t OFF_GDNG = 1227 * MiB;
constexpr size_t OFF_MLG = 1230 * MiB;
constexpr size_t OFF_AQ = 1233 * MiB;
constexpr size_t OFF_QKVR = 1258 * MiB;
constexpr size_t OFF_KM = 1374 * MiB;
constexpr size_t OFF_VTM = 1424 * MiB;
constexpr size_t OFF_VTN = 1457 * MiB;
constexpr size_t OFF_OGD = 1490 * MiB;
constexpr size_t OFF_OML = 1622 * MiB;
constexpr size_t OFF_Y = 1754 * MiB;
constexpr size_t OFF_TOPW = 1886 * MiB;
constexpr size_t OFF_TOPE = OFF_TOPW + 768 * 1024;
constexpr size_t OFF_POS = OFF_TOPE + 768 * 1024;
constexpr size_t OFF_SLOT = OFF_POS + 768 * 1024;
constexpr size_t OFF_WIN = 1889 * MiB;
constexpr size_t OFF_CMIN = OFF_WIN + 40 * MiB;
constexpr size_t OFF_WUQKV = 1965 * MiB;
constexpr size_t OFF_WBO = 1971 * MiB;
constexpr size_t OFF_CMBO = OFF_WBO + 10 * MiB;
constexpr size_t OFF_WOUT4 = 1987 * MiB;
constexpr size_t OFF_WGU = 2019 * MiB;
constexpr size_t OFF_CMGU = OFF_WGU + 260 * MiB;
constexpr size_t OFF_WDN = 2531 * MiB;
constexpr size_t OFF_GC = 2787 * MiB;
constexpr size_t OFF_MC = 2791 * MiB;
constexpr size_t OFF_GF = 2794 * MiB;
constexpr size_t OFF_Y8 = 3200 * MiB;
constexpr size_t OFF_SY = 3270 * MiB;
constexpr size_t OFF_QM8 = 3272 * MiB;
constexpr size_t WS_END = 3306 * MiB;
constexpr int CW_BAR = 4096, CW_CNT = 8192  , CW_TST = 8448  ;

constexpr int RING_BYTES = 131072, MISC_OFF = RING_BYTES, LDS_BYTES = 147456;

__device__ __forceinline__ unsigned cvtpk(float lo, float hi) { f32x2 v = {lo, hi}; bf16x2_t b = __builtin_convertvector(v, bf16x2_t); return __builtin_bit_cast(unsigned, b); }
__device__ __forceinline__ float bflo(unsigned w) { return __uint_as_float(w << 16); }
__device__ __forceinline__ float bfhi(unsigned w) { return __uint_as_float(w & 0xffff0000u); }
__device__ __forceinline__ float bf2f(bf16 b) { return __uint_as_float(((unsigned)b) << 16); }
__device__ __forceinline__ float fexp2(float x) { return __builtin_amdgcn_exp2f(x); }
__device__ __forceinline__ float fexp(float x) { return __builtin_amdgcn_exp2f(x * 1.4426950408889634f); }
__device__ __forceinline__ float frcp(float x) { return __builtin_amdgcn_rcpf(x); }
__device__ __forceinline__ float fsigmoid(float x) { return frcp(1.0f + fexp(-x)); }
#define LDS_BAR() do { asm volatile("s_waitcnt lgkmcnt(0)" ::: "memory"); __builtin_amdgcn_s_barrier(); asm volatile("" ::: "memory"); } while (0)
__device__ __forceinline__ int ltid() { int t = threadIdx.x; asm volatile("" : "+v"(t)); return t; }
template <int CTRL> __device__ __forceinline__ float dppf(float v) { return __int_as_float(__builtin_amdgcn_update_dpp(0, __float_as_int(v), CTRL, 0xf, 0xf, true)); }
__device__ __forceinline__ float row16_sum(float v) { v += dppf<0xB1>(v); v += dppf<0x4E>(v); v += dppf<0x141>(v); v += dppf<0x140>(v); return v; }
__device__ __forceinline__ float wave_sum(float v) { v = row16_sum(v);
    { auto rr = __builtin_amdgcn_permlane16_swap(__float_as_uint(v), __float_as_uint(v), false, false); v = __uint_as_float(rr[0]) + __uint_as_float(rr[1]); }
    { auto rr = __builtin_amdgcn_permlane32_swap(__float_as_uint(v), __float_as_uint(v), false, false); v = __uint_as_float(rr[0]) + __uint_as_float(rr[1]); } return v; }
__device__ __forceinline__ float wave_max(float v) { v = fmaxf(v, dppf<0xB1>(v)); v = fmaxf(v, dppf<0x4E>(v)); v = fmaxf(v, dppf<0x141>(v)); v = fmaxf(v, dppf<0x140>(v));
    { auto rr = __builtin_amdgcn_permlane16_swap(__float_as_uint(v), __float_as_uint(v), false, false); v = fmaxf(__uint_as_float(rr[0]), __uint_as_float(rr[1])); }
    { auto rr = __builtin_amdgcn_permlane32_swap(__float_as_uint(v), __float_as_uint(v), false, false); v = fmaxf(__uint_as_float(rr[0]), __uint_as_float(rr[1])); } return v; }
__device__ __forceinline__ unsigned q8x4(const f32x4 x) {
    const int a = (int)__builtin_rintf(x.x), b = (int)__builtin_rintf(x.y), c = (int)__builtin_rintf(x.z), d = (int)__builtin_rintf(x.w);
    return ((unsigned)a & 0xffu) | (((unsigned)b & 0xffu) << 8) | (((unsigned)c & 0xffu) << 16) | (((unsigned)d & 0xffu) << 24);
}
__device__ __forceinline__ void unpack8(const u32x4 w, float (&f)[8]) { f[0] = bflo(w.x); f[1] = bfhi(w.x); f[2] = bflo(w.y); f[3] = bfhi(w.y); f[4] = bflo(w.z); f[5] = bfhi(w.z); f[6] = bflo(w.w); f[7] = bfhi(w.w); }
__device__ __forceinline__ u32x4 pack8(const float (&f)[8]) { u32x4 w; w.x = cvtpk(f[0], f[1]); w.y = cvtpk(f[2], f[3]); w.z = cvtpk(f[4], f[5]); w.w = cvtpk(f[6], f[7]); return w; }

#define XB_TMO      128
#define XB_XCNT(j)  (256  + 64 * (j))
#define XB_XSUB(j)  (1280 + 64 * (j))
#define XB_XGEN(j)  (2304 + 64 * (j))
#define XB_TOP      3328
#define XB_TOPGEN   3392
#define XCD_BAR_WORDS 3456
#define XB_SPIN_CAP (1u << 25)
__device__ __forceinline__ unsigned xb_ld(unsigned* p)              { return __hip_atomic_load(p, __ATOMIC_RELAXED, __HIP_MEMORY_SCOPE_AGENT); }
__device__ __forceinline__ unsigned xb_add(unsigned* p, unsigned v) { return __hip_atomic_fetch_add(p, v, __ATOMIC_RELAXED, __HIP_MEMORY_SCOPE_AGENT); }
__device__ __forceinline__ unsigned xb_xcc_id() { return (unsigned)__builtin_amdgcn_s_getreg((3 << 11) | 20) & 0xFu; }
#define XB_SPIN(cond, bar) do { unsigned _sp = 0; while (cond) { __builtin_amdgcn_s_sleep(1); \
    if ((++_sp & 255u) == 0u) { if (xb_ld(&(bar)[XB_TMO])) break; if (_sp > XB_SPIN_CAP) { atomicAdd(&(bar)[XB_TMO], 1u); break; } } } } while (0)
struct XcdBarrier { unsigned* bar; unsigned x; volatile LAS unsigned* st; };
__device__ __forceinline__ XcdBarrier xcd_barrier_post(unsigned* bar, volatile LAS unsigned* st) {
    XcdBarrier b; b.bar = bar; b.x = xb_xcc_id(); b.st = st;
    if (threadIdx.x == 0) (void)xb_add(&bar[XB_XCNT(b.x)], 1u);
    return b;
}
__device__ __forceinline__ void xcd_barrier_complete(unsigned* bar, unsigned x, unsigned& nloc, unsigned& nx) {
    const unsigned G = gridDim.x * gridDim.y * gridDim.z;
    unsigned sum, cnt, mine, sp = 0u;
    for (;;) {
        sum = 0u; cnt = 0u; mine = 0u;
#pragma unroll
        for (unsigned j = 0; j < 16; ++j) { const unsigned c = xb_ld(&bar[XB_XCNT(j)]); sum += c; cnt += (c > 0u) ? 1u : 0u; mine = (j == x) ? c : mine; }
        if (sum == G) break;
        __builtin_amdgcn_s_sleep(1);
        if ((++sp & 255u) == 0u) { if (xb_ld(&bar[XB_TMO])) break; if (sp > XB_SPIN_CAP) { atomicAdd(&bar[XB_TMO], 1u); break; } }
    }
    nloc = mine > 0u ? mine : 1u; nx = cnt > 0u ? cnt : 1u;
}
__device__ __forceinline__ void xcd_barrier(const XcdBarrier& b) {
    asm volatile("s_waitcnt vmcnt(0)" ::: "memory");
    __syncthreads();
    if (threadIdx.x == 0) {
        unsigned* bar = b.bar;
        __builtin_amdgcn_s_waitcnt(0);
        unsigned nloc = b.st[0], nx = b.st[1];
        if (nloc == 0u) { xcd_barrier_complete(bar, b.x, nloc, nx); b.st[0] = nloc; b.st[1] = nx; }
        const unsigned old = xb_add(&bar[XB_XSUB(b.x)], 1u);
        const unsigned gen = old / nloc;
        if (old + 1u == (gen + 1u) * nloc) {
            __builtin_amdgcn_fence(__ATOMIC_RELEASE, "agent");
            asm volatile("s_waitcnt vmcnt(0)" ::: "memory");
            const unsigned og = xb_add(&bar[XB_TOP], 1u);
            const unsigned tg = og / nx;
            if (og + 1u == (tg + 1u) * nx) xb_add(&bar[XB_TOPGEN], 1u);
            else XB_SPIN(xb_ld(&bar[XB_TOPGEN]) == tg, bar);
            __builtin_amdgcn_fence(__ATOMIC_ACQUIRE, "agent");
            xb_add(&bar[XB_XGEN(b.x)], 1u);
            asm volatile("s_waitcnt vmcnt(0)" ::: "memory");
        } else {
            XB_SPIN(xb_ld(&bar[XB_XGEN(b.x)]) == gen, bar);
            __builtin_amdgcn_fence(__ATOMIC_ACQUIRE, "agent");
            asm volatile("s_waitcnt vmcnt(0)" ::: "memory");
        }
    }
    __syncthreads();
}

namespace pg8 {
constexpr int BM = 256, BK = 64, HALF = 128, HTB = HALF * BK * 2, STAGE_BYTES = 8 * HTB, NXCD = 8, WGM = 8;
__device__ __forceinline__ int lds_byte(int r, int c) { const int st = (r >> 4) * 2 + (c >> 5), rr = r & 15, cc = c & 31, ob = rr * 64 + cc * 2; return st * 1024 + (ob ^ (((ob >> 9) & 1) << 5)); }
__device__ __forceinline__ void stage_rc(int b, int& R, int& C) { const int st = b / 1024, sb = b % 1024, swz = sb ^ (((sb >> 9) & 1) << 5); R = (st >> 1) * 16 + swz / 64; C = (st & 1) * 32 + (swz % 64) / 2; }
__device__ __forceinline__ int perm32(int rho) { const int n = rho >> 4, i = rho & 15; return 8 * (i >> 2) + 4 * n + (i & 3); }
struct Unit { int pm, pn, aux; };
struct Order {
    int nM, nN, nwg, G, c, br, skipctx;
    __device__ void init(int nM_, int nN_, int G_, int c_, int br_ = 1, int skipctx_ = 0) { nM = nM_; nN = nN_; nwg = nM * nN; G = G_; c = c_; br = br_; skipctx = skipctx_; }
    __device__ bool next(int i, Unit& u) const {
        const int it = i / br, ia = i - it * br;
        const long L = (long)it * G + c; if (L >= nwg) return false;
        int wgid = (int)L; { const int q = nwg / NXCD, r = nwg % NXCD, xcd = wgid % NXCD, off = wgid / NXCD; wgid = (xcd < r ? xcd * (q + 1) : r * (q + 1) + (xcd - r) * q) + off; }
        const int nig = WGM * nN, gid = wgid / nig, fm = gid * WGM, gsz = (nM - fm) < WGM ? (nM - fm) : WGM;
        u.pm = fm + ((wgid % nig) % gsz); u.pn = (wgid % nig) / gsz + ia * nN; u.aux = ia;
        if (skipctx) u.pm += (u.pm >> 5) + 1;
        return true;
    }
};
template <class Prob, class Epi>
__device__ __forceinline__ void gemm_phase(LAS unsigned char* lds, const Prob& P, const Order& S, const Epi& E) {
    const int tid = ltid(), wid = __builtin_amdgcn_readfirstlane(tid >> 6), lane = tid & 63, wr = wid >> 2, wc = wid & 3, fr = lane & 15, fq = lane >> 4;
    const int nt = P.nt;
    unsigned voffA[2], voffB[2];
#pragma unroll
    for (int i = 0; i < 2; ++i) { int R, C; stage_rc(tid * 16 + i * 8192, R, C); const int Rb = Epi::PERM ? ((R & ~31) + perm32(R & 31)) : R;
        voffA[i] = (unsigned)R * P.lda + (unsigned)C * 2u; voffB[i] = (unsigned)Rb * P.ldb + (unsigned)C * 2u; }
    const size_t kstep = (size_t)(BK * 2);
    const size_t hA = (size_t)HALF * P.lda, hB = (size_t)HALF * P.ldb;
    const unsigned ldsw = (unsigned)wid * 1024u;
    const int aoff = lds_byte(wr * 64 + fr, fq * 8), boff = lds_byte(wc * 32 + fr, fq * 8);
#define PG8_SA(b, h) (((b) * 2 + (h)) * HTB)
#define PG8_SB(b, h) ((4 + (b) * 2 + (h)) * HTB)
#define PG8_STAGE(bufoff, gbase, voff) do { _Pragma("unroll") for (int _i = 0; _i < 2; ++_i) \
        __builtin_amdgcn_global_load_lds((const unsigned*)((const char*)(gbase) + (voff)[_i]), (LAS unsigned*)(lds + (bufoff) + ldsw + _i * 8192), 16, 0, 0); } while (0)
#define PG8_LDA(dst, b, h) do { _Pragma("unroll") for (int m = 0; m < 4; ++m) { \
        if constexpr (Epi::F8) { const i32x4 lo_ = *(const LAS i32x4*)(lds + PG8_SA(b, h) + aoff + m * 2048), hi_ = *(const LAS i32x4*)(lds + PG8_SA(b, h) + aoff + m * 2048 + 1024); \
            dst##8[m] = __builtin_shufflevector(lo_, hi_, 0, 1, 2, 3, 4, 5, 6, 7); } \
        else { _Pragma("unroll") for (int k = 0; k < 2; ++k) dst[m][k] = *(const LAS bf16x8*)(lds + PG8_SA(b, h) + aoff + m * 2048 + k * 1024); } } } while (0)
#define PG8_LDB(dst, b, h) do { _Pragma("unroll") for (int n = 0; n < 2; ++n) { \
        if constexpr (Epi::F8) { const i32x4 lo_ = *(const LAS i32x4*)(lds + PG8_SB(b, h) + boff + n * 2048), hi_ = *(const LAS i32x4*)(lds + PG8_SB(b, h) + boff + n * 2048 + 1024); \
            dst##8[n] = __builtin_shufflevector(lo_, hi_, 0, 1, 2, 3, 4, 5, 6, 7); } \
        else { _Pragma("unroll") for (int k = 0; k < 2; ++k) dst[n][k] = *(const LAS bf16x8*)(lds + PG8_SB(b, h) + boff + n * 2048 + k * 1024); } } } while (0)
#define PG8_MMA(ai, bj, At, Bt) do { __builtin_amdgcn_s_setprio(1); _Pragma("unroll") for (int m = 0; m < 4; ++m) _Pragma("unroll") for (int n = 0; n < 2; ++n) { \
        if constexpr (Epi::F8) asm volatile("v_mfma_scale_f32_16x16x128_f8f6f4 %0, %1, %2, %0, %3, %3 op_sel_hi:[0,0,0]" : "+v"(acc[ai][bj][m][n]) : "v"(Bt##8[n]), "v"(At##8[m]), "v"(f8scale));   \
        else { _Pragma("unroll") for (int k = 0; k < 2; ++k) { \
        if constexpr (Epi::I8) acc[ai][bj][m][n] = __builtin_bit_cast(f32x4, __builtin_amdgcn_mfma_i32_16x16x64_i8(__builtin_bit_cast(i32x4, Bt[n][k]), __builtin_bit_cast(i32x4, At[m][k]), __builtin_bit_cast(i32x4, acc[ai][bj][m][n]), 0, 0, 0)); \
        else acc[ai][bj][m][n] = __builtin_amdgcn_mfma_f32_16x16x32_bf16(Bt[n][k], At[m][k], acc[ai][bj][m][n], 0, 0, 0); } } } __builtin_amdgcn_s_setprio(0); } while (0)
#define PG8_WAIT_V(n) asm volatile("s_waitcnt vmcnt(" #n ")" ::: "memory")
#define PG8_WAIT_L(n) asm volatile("s_waitcnt lgkmcnt(" #n ")" ::: "memory")
#define PG8_BAR __builtin_amdgcn_s_barrier()
#define PG8_SCHED __builtin_amdgcn_sched_barrier(0)
    Unit cur, nxt; int ui = 0;
    if (!S.next(0, cur)) return;
    f32x4 acc[2][2][4][2];
#pragma unroll
    for (int a = 0; a < 2; ++a)
#pragma unroll
        for (int b = 0; b < 2; ++b)
#pragma unroll
            for (int m = 0; m < 4; ++m)
#pragma unroll
                for (int n = 0; n < 2; ++n) acc[a][b][m][n] = (f32x4){0.f, 0.f, 0.f, 0.f};
    bf16x8 At[4][2], B0[2][2], B1[2][2];
    const int f8scale = 0x7f7f7f7f;
    i32x8 At8[4], B08[2], B18[2];
    const char* cA; const char* cB; P.setup(cur, cA, cB);
    PG8_STAGE(PG8_SB(0, 0), cB, voffB); PG8_STAGE(PG8_SB(0, 1), cB + hB, voffB); PG8_STAGE(PG8_SA(0, 0), cA, voffA); PG8_STAGE(PG8_SA(0, 1), cA + hA, voffA);
    if (wr == 1) PG8_BAR;
    PG8_WAIT_V(2); PG8_BAR;
    PG8_STAGE(PG8_SB(1, 0), cB + kstep, voffB); PG8_STAGE(PG8_SA(1, 0), cA + kstep, voffA); PG8_STAGE(PG8_SB(1, 1), cB + hB + kstep, voffB);
    PG8_WAIT_V(6); PG8_BAR;
    for (;;) {
        const bool has_next = S.next(ui + 1, nxt);
        const char* nA = cA; const char* nB = cB;
        if (has_next) P.setup(nxt, nA, nB);
        for (int t = 0; t < nt; t += 2) {
            const bool last = (t == nt - 2);
            const char* a1 = cA + (size_t)(t + 1) * kstep;
            const char* a2 = last ? nA : cA + (size_t)(t + 2) * kstep; const char* b2 = last ? nB : cB + (size_t)(t + 2) * kstep;
            const char* a3 = a2 + kstep; const char* b3 = b2 + kstep;
            PG8_LDB(B0, 0, 0); PG8_LDB(B1, 0, 1); PG8_SCHED; PG8_LDA(At, 0, 0); PG8_STAGE(PG8_SA(1, 1), a1 + hA, voffA);
            PG8_WAIT_V(8); PG8_WAIT_L(0); PG8_BAR; PG8_MMA(0, 0, At, B0); PG8_MMA(0, 1, At, B1); PG8_BAR; PG8_SCHED;
            PG8_LDA(At, 0, 1); PG8_STAGE(PG8_SB(0, 0), b2, voffB); PG8_STAGE(PG8_SB(0, 1), b2 + hB, voffB); PG8_STAGE(PG8_SA(0, 0), a2, voffA);
            PG8_WAIT_V(8); PG8_WAIT_L(0); PG8_BAR; PG8_MMA(1, 0, At, B0); PG8_MMA(1, 1, At, B1); PG8_BAR; PG8_SCHED;
            PG8_LDB(B0, 1, 0); PG8_LDB(B1, 1, 1); PG8_SCHED; PG8_LDA(At, 1, 0); PG8_STAGE(PG8_SA(0, 1), a2 + hA, voffA);
            PG8_WAIT_V(8); PG8_WAIT_L(0); PG8_BAR; PG8_MMA(0, 0, At, B0); PG8_MMA(0, 1, At, B1); PG8_BAR; PG8_SCHED;
            PG8_LDA(At, 1, 1); PG8_STAGE(PG8_SB(1, 0), b3, voffB); PG8_STAGE(PG8_SB(1, 1), b3 + hB, voffB); PG8_STAGE(PG8_SA(1, 0), a3, voffA);
            PG8_WAIT_V(8); PG8_WAIT_L(0); PG8_BAR; PG8_MMA(1, 0, At, B0); PG8_MMA(1, 1, At, B1); PG8_BAR; PG8_SCHED;
        }
        if (wr == 0) PG8_BAR;
        if constexpr (Epi::F8) asm volatile("s_nop 15\n\ts_nop 7" ::: "memory");
        E(acc, cur, wr, wc, fr, fq);
        if (!has_next) break;
#pragma unroll
        for (int a = 0; a < 2; ++a)
#pragma unroll
            for (int b = 0; b < 2; ++b)
#pragma unroll
                for (int m = 0; m < 4; ++m)
#pragma unroll
                    for (int n = 0; n < 2; ++n) acc[a][b][m][n] = (f32x4){0.f, 0.f, 0.f, 0.f};
        cur = nxt; cA = nA; cB = nB; ++ui;
        if (wr == 1) PG8_BAR;
    }
    PG8_WAIT_V(0);
    PG8_BAR;
#undef PG8_SA
#undef PG8_SB
#undef PG8_STAGE
#undef PG8_LDA
#undef PG8_LDB
#undef PG8_MMA
#undef PG8_WAIT_V
#undef PG8_WAIT_L
#undef PG8_BAR
#undef PG8_SCHED
}
}

struct ProbPlain { const char* A; const char* B; unsigned lda, ldb; int nt;
    __device__ __forceinline__ void setup(pg8::Unit& u, const char*& a, const char*& b) const { a = A + (size_t)u.pm * 256 * lda; b = B + (size_t)u.pn * 256 * ldb; } };
struct ProbBO { const char* A; const char* B; unsigned lda, ldb; int nt;
    __device__ __forceinline__ void setup(pg8::Unit& u, const char*& a, const char*& b) const { a = A + (size_t)u.pm * 256 * lda + (size_t)(u.pn >> 2) * 512; b = B + (size_t)u.pn * 256 * ldb; } };
struct ProbMoE { const char* A; const char* B; unsigned lda, ldb; int nt; const int* tstart; size_t bstride;
    __device__ __forceinline__ void setup(pg8::Unit& u, const char*& a, const char*& b) const {
        int e = 0;
#pragma unroll 1
        for (int j = 1; j < NE; ++j) e += (u.pm >= tstart[j]) ? 1 : 0;
        u.aux = e; a = A + (size_t)u.pm * 256 * lda; b = B + (size_t)e * bstride + (size_t)u.pn * 256 * ldb; } };

__device__ __forceinline__ f32x4 i2f4(const f32x4 a) { const i32x4 i = __builtin_bit_cast(i32x4, a); return (f32x4){(float)i.x, (float)i.y, (float)i.z, (float)i.w}; }
typedef const f32x4 (&AccRef)[2][2][4][2];
struct EpiIn {
    static constexpr bool PERM = true, I8 = false, F8 = false;
    bf16* Pb; bf16* Gb; float* gates; const float* bmg;
    __device__ __forceinline__ void operator()(AccRef acc, const pg8::Unit& u, int wr, int wc, int fr, int fq) const {
        const int row0 = u.pm * 256 + wr * 64 + fr;
        if (u.pn < 22) {
            const int col0 = u.pn * 256 + wc * 32 + 8 * fq;
#pragma unroll
            for (int ai = 0; ai < 2; ++ai)
#pragma unroll
                for (int m = 0; m < 4; ++m) { const int row = row0 + ai * 128 + m * 16; bf16* rowp = Pb + (size_t)row * LDP + col0;
#pragma unroll
                    for (int bj = 0; bj < 2; ++bj) { const f32x4 v0 = acc[ai][bj][m][0], v1 = acc[ai][bj][m][1];
                        u32x4 w; w.x = cvtpk(v0[0], v0[1]); w.y = cvtpk(v0[2], v0[3]); w.z = cvtpk(v1[0], v1[1]); w.w = cvtpk(v1[2], v1[3]);
                        *(u32x4*)(rowp + bj * 128) = w;
                        if (bj == 0 && u.pn == 14 && wc == 0 && fq < 2) { float* g = gates + (size_t)row * 32 + 8 * fq; *(f32x4*)g = v0; *(f32x4*)(g + 4) = v1; }
                        if (bj == 1 && u.pn == 21 && wc == 1 && fq >= 2) { float* g = gates + (size_t)row * 32 + 16 + 8 * (fq - 2); *(f32x4*)g = v0; *(f32x4*)(g + 4) = v1; } } }
        } else {
            const int col0 = (u.pn - 22) * 256 + wc * 32 + 8 * fq;
            f32x4 bv[2][2];
#pragma unroll
            for (int bj = 0; bj < 2; ++bj)
#pragma unroll
                for (int n = 0; n < 2; ++n) bv[bj][n] = *(const f32x4*)(bmg + col0 + bj * 128 + 4 * n);
#pragma unroll
            for (int ai = 0; ai < 2; ++ai)
#pragma unroll
                for (int m = 0; m < 4; ++m) { bf16* rowp = Gb + (size_t)(row0 + ai * 128 + m * 16) * NGATE + col0;
#pragma unroll
                    for (int bj = 0; bj < 2; ++bj) { f32x4 v0 = acc[ai][bj][m][0] + bv[bj][0], v1 = acc[ai][bj][m][1] + bv[bj][1];
#pragma unroll
                        for (int j = 0; j < 4; ++j) { v0[j] = fsigmoid(v0[j]); v1[j] = fsigmoid(v1[j]); }
                        u32x4 w; w.x = cvtpk(v0[0], v0[1]); w.y = cvtpk(v0[2], v0[3]); w.z = cvtpk(v1[0], v1[1]); w.w = cvtpk(v1[2], v1[3]);
                        *(u32x4*)(rowp + bj * 128) = w; } }
        }
    }
};
struct EpiStore {
    static constexpr bool PERM = true, I8 = false, F8 = false;
    bf16* O; int ldc; const float* bias; int bias_stride;
    __device__ __forceinline__ void operator()(AccRef acc, const pg8::Unit& u, int wr, int wc, int fr, int fq) const {
        const int row0 = u.pm * 256 + wr * 64 + fr, col0 = u.pn * 256 + wc * 32 + 8 * fq;
        f32x4 bv[2][2];
#pragma unroll
        for (int bj = 0; bj < 2; ++bj)
#pragma unroll
            for (int n = 0; n < 2; ++n) bv[bj][n] = bias ? *(const f32x4*)(bias + (size_t)u.aux * bias_stride + col0 + bj * 128 + 4 * n) : (f32x4){0.f, 0.f, 0.f, 0.f};
#pragma unroll
        for (int ai = 0; ai < 2; ++ai)
#pragma unroll
            for (int m = 0; m < 4; ++m) { bf16* rowp = O + (size_t)(row0 + ai * 128 + m * 16) * ldc + col0;
#pragma unroll
                for (int bj = 0; bj < 2; ++bj) { const f32x4 v0 = acc[ai][bj][m][0] + bv[bj][0], v1 = acc[ai][bj][m][1] + bv[bj][1];
                    u32x4 w; w.x = cvtpk(v0[0], v0[1]); w.y = cvtpk(v0[2], v0[3]); w.z = cvtpk(v1[0], v1[1]); w.w = cvtpk(v1[2], v1[3]);
                    *(u32x4*)(rowp + bj * 128) = w; } }
    }
};
struct EpiStoreF8 {
    static constexpr bool PERM = true, I8 = false, F8 = true; static constexpr int SCALE_A = 0x7f7f7f7f, SCALE_B = 0x7f7f7f7f;
    bf16* O; int ldc; const float* bias; int bias_stride;
    __device__ __forceinline__ void operator()(AccRef acc, const pg8::Unit& u, int wr, int wc, int fr, int fq) const {
        const int row0 = u.pm * 256 + wr * 64 + fr, col0 = u.pn * 256 + wc * 32 + 8 * fq;
        f32x4 bv[2][2];
#pragma unroll
        for (int bj = 0; bj < 2; ++bj)
#pragma unroll
            for (int n = 0; n < 2; ++n) bv[bj][n] = *(const f32x4*)(bias + (size_t)u.aux * bias_stride + col0 + bj * 128 + 4 * n);
#pragma unroll
        for (int ai = 0; ai < 2; ++ai)
#pragma unroll
            for (int m = 0; m < 4; ++m) { bf16* rowp = O + (size_t)(row0 + ai * 128 + m * 16) * ldc + col0;
#pragma unroll
                for (int bj = 0; bj < 2; ++bj) { const f32x4 v0 = acc[ai][bj][m][0] * 0.015625f + bv[bj][0], v1 = acc[ai][bj][m][1] * 0.015625f + bv[bj][1];
                    u32x4 w; w.x = cvtpk(v0[0], v0[1]); w.y = cvtpk(v0[2], v0[3]); w.z = cvtpk(v1[0], v1[1]); w.w = cvtpk(v1[2], v1[3]);
                    *(u32x4*)(rowp + bj * 128) = w; } }
    }
};
struct EpiBO {
    static constexpr bool PERM = true, I8 = true, F8 = false;
    bf16* Z; const bf16* G; const float* sY; const float* cmB;
    __device__ __forceinline__ void operator()(AccRef acc, const pg8::Unit& u, int wr, int wc, int fr, int fq) const {
        const int row0 = u.pm * 256 + wr * 64 + fr, colg = u.pn * 256 + wc * 32 + 8 * fq, colz = (u.pn & 3) * 256 + wc * 32 + 8 * fq;
        const bool first = u.aux == 0;
        f32x4 sw[2][2];
#pragma unroll
        for (int bj = 0; bj < 2; ++bj)
#pragma unroll
            for (int n = 0; n < 2; ++n) sw[bj][n] = *(const f32x4*)(cmB + colg + bj * 128 + 4 * n) * (1.0f / 127.0f);
#pragma unroll
        for (int ai = 0; ai < 2; ++ai)
#pragma unroll
            for (int m = 0; m < 4; ++m) { const int row = row0 + ai * 128 + m * 16; const float sa = sY[row * 4 + u.aux];
#pragma unroll
                for (int bj = 0; bj < 2; ++bj) { const u32x4 gw = *(const u32x4*)(G + (size_t)row * NGATE + colg + bj * 128); float g[8]; unpack8(gw, g);
                    bf16* zp = Z + (size_t)row * D + colz + bj * 128;
                    float z[8];
                    if (first) {
#pragma unroll
                        for (int j = 0; j < 8; ++j) z[j] = 0.f;
                    } else unpack8(*(const u32x4*)zp, z);
                    const f32x4 v0 = i2f4(acc[ai][bj][m][0]) * sw[bj][0] * sa, v1 = i2f4(acc[ai][bj][m][1]) * sw[bj][1] * sa;
#pragma unroll
                    for (int j = 0; j < 4; ++j) { z[j] += v0[j] * g[j]; z[4 + j] += v1[j] * g[4 + j]; }
                    *(u32x4*)zp = pack8(z); } }
    }
};
struct EpiOut {
    static constexpr bool PERM = false, I8 = false, F8 = false;
    float* X; const float* modl;
    __device__ __forceinline__ void operator()(AccRef acc, const pg8::Unit& u, int wr, int wc, int fr, int fq) const {
        const int row0 = u.pm * 256 + wr * 64 + fr, col0 = u.pn * 256 + wc * 32 + 4 * fq;
        const int mv = (u.pm % 33 == 0) ? 4 : u.pm / 33;
        const float* g1 = modl + mv * 6144 + 2048;
        f32x4 gv[2][2];
#pragma unroll
        for (int bj = 0; bj < 2; ++bj)
#pragma unroll
            for (int n = 0; n < 2; ++n) gv[bj][n] = *(const f32x4*)(g1 + col0 + bj * 128 + n * 16);
#pragma unroll
        for (int ai = 0; ai < 2; ++ai)
#pragma unroll
            for (int m = 0; m < 4; ++m) { float* rowp = X + (size_t)(row0 + ai * 128 + m * 16) * D + col0;
#pragma unroll
                for (int bj = 0; bj < 2; ++bj)
#pragma unroll
                    for (int n = 0; n < 2; ++n) { f32x4* p = (f32x4*)(rowp + bj * 128 + n * 16); *p = *p + gv[bj][n] * acc[ai][bj][m][n]; } }
    }
};
struct EpiMoE1 {
    static constexpr bool PERM = true, I8 = false, F8 = false;
    bf16* ACT; const float* bgu;
    __device__ __forceinline__ void operator()(AccRef acc, const pg8::Unit& u, int wr, int wc, int fr, int fq) const {
        const int row0 = u.pm * 256 + wr * 64 + fr, c0 = u.pn * 128 + wc * 32 + 8 * fq;
        const float* bg = bgu + (size_t)u.aux * 2048 + c0;
        f32x4 bgt[2], bup[2];
#pragma unroll
        for (int n = 0; n < 2; ++n) { bgt[n] = *(const f32x4*)(bg + 4 * n); bup[n] = *(const f32x4*)(bg + 1024 + 4 * n); }
#pragma unroll
        for (int ai = 0; ai < 2; ++ai)
#pragma unroll
            for (int m = 0; m < 4; ++m) { float o[8];
#pragma unroll
                for (int n = 0; n < 2; ++n)
#pragma unroll
                    for (int j = 0; j < 4; ++j) { const float gate = fminf(acc[ai][0][m][n][j] + bgt[n][j], 7.0f); const float up = fminf(fmaxf(acc[ai][1][m][n][j] + bup[n][j], -7.0f), 7.0f);
                        o[4 * n + j] = (up + 1.0f) * gate * fsigmoid(1.702f * gate); }
                *(u32x4*)(ACT + (size_t)(row0 + ai * 128 + m * 16) * DFF + c0) = pack8(o); }
    }
};

struct EpiIn8 {
    static constexpr bool PERM = true, I8 = true, F8 = false;
    bf16* Pb; bf16* Gb; float* gates; const float* bmg; const float* sA; const float* cmB;
    __device__ __forceinline__ void operator()(AccRef acc, const pg8::Unit& u, int wr, int wc, int fr, int fq) const {
        const int row0 = u.pm * 256 + wr * 64 + fr, cb0 = u.pn * 256 + wc * 32 + 8 * fq;
        f32x4 sw[2][2];
#pragma unroll
        for (int bj = 0; bj < 2; ++bj)
#pragma unroll
            for (int n = 0; n < 2; ++n) sw[bj][n] = *(const f32x4*)(cmB + cb0 + bj * 128 + 4 * n) * (1.0f / 127.0f);
        if (u.pn < 22) {
#pragma unroll
            for (int ai = 0; ai < 2; ++ai)
#pragma unroll
                for (int m = 0; m < 4; ++m) { const int row = row0 + ai * 128 + m * 16; bf16* rowp = Pb + (size_t)row * LDP + cb0; const float sa = sA[row];
#pragma unroll
                    for (int bj = 0; bj < 2; ++bj) { const f32x4 v0 = i2f4(acc[ai][bj][m][0]) * sw[bj][0] * sa, v1 = i2f4(acc[ai][bj][m][1]) * sw[bj][1] * sa;
                        u32x4 w; w.x = cvtpk(v0[0], v0[1]); w.y = cvtpk(v0[2], v0[3]); w.z = cvtpk(v1[0], v1[1]); w.w = cvtpk(v1[2], v1[3]);
                        *(u32x4*)(rowp + bj * 128) = w;
                        if (bj == 0 && u.pn == 14 && wc == 0 && fq < 2) { float* g = gates + (size_t)row * 32 + 8 * fq; *(f32x4*)g = v0; *(f32x4*)(g + 4) = v1; }
                        if (bj == 1 && u.pn == 21 && wc == 1 && fq >= 2) { float* g = gates + (size_t)row * 32 + 16 + 8 * (fq - 2); *(f32x4*)g = v0; *(f32x4*)(g + 4) = v1; } } }
        } else {
            const int col0 = cb0 - LDP;
            f32x4 bv[2][2];
#pragma unroll
            for (int bj = 0; bj < 2; ++bj)
#pragma unroll
                for (int n = 0; n < 2; ++n) bv[bj][n] = *(const f32x4*)(bmg + col0 + bj * 128 + 4 * n);
#pragma unroll
            for (int ai = 0; ai < 2; ++ai)
#pragma unroll
                for (int m = 0; m < 4; ++m) { const int row = row0 + ai * 128 + m * 16; bf16* rowp = Gb + (size_t)row * NGATE + col0; const float sa = sA[row];
#pragma unroll
                    for (int bj = 0; bj < 2; ++bj) { f32x4 v0 = i2f4(acc[ai][bj][m][0]) * sw[bj][0] * sa + bv[bj][0], v1 = i2f4(acc[ai][bj][m][1]) * sw[bj][1] * sa + bv[bj][1];
#pragma unroll
                        for (int j = 0; j < 4; ++j) { v0[j] = fsigmoid(v0[j]); v1[j] = fsigmoid(v1[j]); }
                        u32x4 w; w.x = cvtpk(v0[0], v0[1]); w.y = cvtpk(v0[2], v0[3]); w.z = cvtpk(v1[0], v1[1]); w.w = cvtpk(v1[2], v1[3]);
                        *(u32x4*)(rowp + bj * 128) = w; } }
        }
    }
};
struct EpiMoE18 {
    static constexpr bool PERM = true, I8 = true, F8 = false;
    bf16* ACT; const float* bgu; const float* sA; const float* cmB;
    __device__ __forceinline__ void operator()(AccRef acc, const pg8::Unit& u, int wr, int wc, int fr, int fq) const {
        const int row0 = u.pm * 256 + wr * 64 + fr, c0 = u.pn * 128 + wc * 32 + 8 * fq;
        const float* bg = bgu + (size_t)u.aux * 2048 + c0;
        const float* cm = cmB + (size_t)u.aux * 2048 + u.pn * 256 + wc * 32 + 8 * fq;
        f32x4 bgt[2], bup[2], sg[2], su[2];
#pragma unroll
        for (int n = 0; n < 2; ++n) { bgt[n] = *(const f32x4*)(bg + 4 * n); bup[n] = *(const f32x4*)(bg + 1024 + 4 * n); sg[n] = *(const f32x4*)(cm + 4 * n) * (1.0f / 127.0f); su[n] = *(const f32x4*)(cm + 128 + 4 * n) * (1.0f / 127.0f); }
#pragma unroll
        for (int ai = 0; ai < 2; ++ai)
#pragma unroll
            for (int m = 0; m < 4; ++m) { const int row = row0 + ai * 128 + m * 16; const float sa = sA[row]; float o[8];
#pragma unroll
                for (int n = 0; n < 2; ++n) { const f32x4 ga = i2f4(acc[ai][0][m][n]) * sg[n] * sa + bgt[n], ua = i2f4(acc[ai][1][m][n]) * su[n] * sa + bup[n];
#pragma unroll
                    for (int j = 0; j < 4; ++j) { const float gate = fminf(ga[j], 7.0f); const float up = fminf(fmaxf(ua[j], -7.0f), 7.0f);
                        o[4 * n + j] = (up + 1.0f) * gate * fsigmoid(1.702f * gate); } }
                int w0 = 0, w1 = 0;
                w0 = __builtin_amdgcn_cvt_pk_fp8_f32(o[0], o[1], w0, false); w0 = __builtin_amdgcn_cvt_pk_fp8_f32(o[2], o[3], w0, true);
                w1 = __builtin_amdgcn_cvt_pk_fp8_f32(o[4], o[5], w1, false); w1 = __builtin_amdgcn_cvt_pk_fp8_f32(o[6], o[7], w1, true);
                *(u32x2*)((unsigned char*)ACT + (size_t)row * DFF + c0) = (u32x2){(unsigned)w0, (unsigned)w1}; }
    }
};

struct AttnJob {
    const bf16* Q; int qpitch;
    const bf16* K; int kpitch;
    const bf16* VT;
    bf16* O; int opitch;
    int ntiles; float c;
    int s0_first_n, s0_jump;
    int kr_lo, r_w, c_q;
    const LAS float* bias;
};
template <int DQK, bool NA>
__device__ __forceinline__ void attn_unit(LAS unsigned char* lds, const AttnJob& J) {
    constexpr int KPB = (DQK == 96) ? 208 : 144, VPB = 136, NS = DQK / 16, KCH = DQK / 8;
    constexpr int KBUF = 64 * KPB, VBUF = 64 * VPB;
    const int tid = ltid(), wid = __builtin_amdgcn_readfirstlane(tid >> 6), lane = tid & 63, r = lane & 31, h = lane >> 5;
    LAS unsigned char* kb0 = lds; LAS unsigned char* vb0 = lds + 2 * KBUF;
    bf16x8 qf[NS];
    { const bf16* qrow = J.Q + (size_t)(wid * 32 + r) * J.qpitch + 8 * h;
#pragma unroll
      for (int s = 0; s < NS; ++s) qf[s] = *(const bf16x8*)(qrow + 16 * s); }
    f32x16 o0, o1;
#pragma unroll
    for (int i = 0; i < 16; ++i) { o0[i] = 0.f; o1[i] = 0.f; }
    float mrun = -1e30f, lsum = 0.f;
    const int k0r = tid / KCH, k0c = tid % KCH, k1r = (tid + 512) / KCH, k1c = (tid + 512) % KCH;
    const bool k1 = (tid + 512) < 64 * KCH;
    const int vd = tid >> 3, vc = tid & 7;
    u32x4 kr0, kr1, vr;
    auto s0_of = [&](int j) { return j < J.s0_first_n ? 64 * j : J.s0_jump + 64 * (j - J.s0_first_n); };
    auto gload = [&](int j) { const int s0 = s0_of(j);
        kr0 = *(const u32x4*)(J.K + (size_t)(s0 + k0r) * J.kpitch + 8 * k0c);
        if (k1) kr1 = *(const u32x4*)(J.K + (size_t)(s0 + k1r) * J.kpitch + 8 * k1c);
        vr = *(const u32x4*)(J.VT + (size_t)vd * TB + s0 + 8 * vc); };
    auto lstore = [&](int buf) {
        *(LAS u32x4*)(kb0 + buf * KBUF + k0r * KPB + 16 * k0c) = kr0;
        if (k1) *(LAS u32x4*)(kb0 + buf * KBUF + k1r * KPB + 16 * k1c) = kr1;
        LAS unsigned char* vp = vb0 + buf * VBUF + vd * VPB + 16 * vc;
        *(LAS u32x2*)vp = (u32x2){vr.x, vr.y}; *(LAS u32x2*)(vp + 8) = (u32x2){vr.z, vr.w}; };
    gload(0); lstore(0);
    __syncthreads();
    const int r0w = NA ? min(max(J.r_w - 4, 0), 120) : 0;
    const int c0 = NA ? min(max(J.c_q - 8, 0), 48) : 0;
    for (int j = 0; j < J.ntiles; ++j) {
        const int buf = j & 1;
        if (j + 1 < J.ntiles) gload(j + 1);
        bool active = true; int dr = 0;
        if (NA && j >= 4) { const int kr = J.kr_lo + j - 4; active = (kr >= r0w) && (kr < r0w + 8); dr = kr - J.r_w + 7; }
        if (active) {
            f32x16 s0v, s1v;
#pragma unroll
            for (int i = 0; i < 16; ++i) { s0v[i] = 0.f; s1v[i] = 0.f; }
            const LAS unsigned char* kp = kb0 + buf * KBUF + r * KPB + 16 * h;
#pragma unroll
            for (int s = 0; s < NS; ++s) {
                const bf16x8 a0 = *(const LAS bf16x8*)(kp + 32 * s), a1 = *(const LAS bf16x8*)(kp + 32 * KPB + 32 * s);
                s0v = __builtin_amdgcn_mfma_f32_32x32x16_bf16(a0, qf[s], s0v, 0, 0, 0);
                s1v = __builtin_amdgcn_mfma_f32_32x32x16_bf16(a1, qf[s], s1v, 0, 0, 0);
            }
            float mx;
            if (NA && j >= 4) {
                const LAS float* bp = J.bias + dr * 31 + 15 - J.c_q;
#pragma unroll
                for (int i = 0; i < 16; ++i) { const int kc = (i & 3) + 8 * (i >> 2) + 4 * h;
                    { const bool ok = (unsigned)(kc - c0) < 16u; const float bz = bp[ok ? kc : c0]; s0v[i] = ok ? s0v[i] * J.c + bz : -1e30f; }
                    { const int kc1 = kc + 32; const bool ok = (unsigned)(kc1 - c0) < 16u; const float bz = bp[ok ? kc1 : c0]; s1v[i] = ok ? s1v[i] * J.c + bz : -1e30f; } }
                mx = -1e30f;
#pragma unroll
                for (int i = 0; i < 16; ++i) mx = fmaxf(mx, fmaxf(s0v[i], s1v[i]));
                { auto rr = __builtin_amdgcn_permlane32_swap(__float_as_uint(mx), __float_as_uint(mx), false, false); mx = fmaxf(__uint_as_float(rr[0]), __uint_as_float(rr[1])); }
            } else {
                float ma = fmaxf(s0v[0], s1v[0]), mb = fmaxf(s0v[1], s1v[1]);
#pragma unroll
                for (int i = 2; i < 16; i += 2) { ma = fmaxf(fmaxf(ma, s0v[i]), s1v[i]); mb = fmaxf(fmaxf(mb, s0v[i + 1]), s1v[i + 1]); }
                mx = fmaxf(ma, mb); { auto rr = __builtin_amdgcn_permlane32_swap(__float_as_uint(mx), __float_as_uint(mx), false, false); mx = fmaxf(__uint_as_float(rr[0]), __uint_as_float(rr[1])); } mx *= J.c;
            }
            if (__any(mx > mrun + 8.0f)) {
                const float mnew = fmaxf(mrun, mx), alpha = fexp2(mrun - mnew); mrun = mnew; lsum *= alpha;
#pragma unroll
                for (int i = 0; i < 16; ++i) { o0[i] *= alpha; o1[i] *= alpha; }
            }
            float ps = 0.f;
            if (NA && j >= 4) {
#pragma unroll
                for (int i = 0; i < 16; ++i) { s0v[i] = fexp2(s0v[i] - mrun); s1v[i] = fexp2(s1v[i] - mrun); ps += s0v[i] + s1v[i]; }
            } else {
                const float nm = -mrun;
#pragma unroll
                for (int i = 0; i < 16; ++i) { s0v[i] = fexp2(__builtin_fmaf(s0v[i], J.c, nm)); s1v[i] = fexp2(__builtin_fmaf(s1v[i], J.c, nm)); ps += s0v[i] + s1v[i]; }
            }
            lsum += ps;
            bf16x8 pf[4];
#pragma unroll
            for (int st = 0; st < 4; ++st) { u32x4 w;
#pragma unroll
                for (int q = 0; q < 4; ++q) { const int i = 8 * (st & 1) + 2 * q; w[q] = (st < 2) ? cvtpk(s0v[i], s0v[i + 1]) : cvtpk(s1v[i], s1v[i + 1]); }
                pf[st] = __builtin_bit_cast(bf16x8, w); }
            const LAS unsigned char* vp = vb0 + buf * VBUF + r * VPB + 8 * h;
#pragma unroll
            for (int st = 0; st < 4; ++st) {
                const u32x2 a0l = *(const LAS u32x2*)(vp + 32 * st), a0h = *(const LAS u32x2*)(vp + 32 * st + 16);
                const u32x2 a1l = *(const LAS u32x2*)(vp + 32 * VPB + 32 * st), a1h = *(const LAS u32x2*)(vp + 32 * VPB + 32 * st + 16);
                const bf16x8 va0 = __builtin_bit_cast(bf16x8, (u32x4){a0l.x, a0l.y, a0h.x, a0h.y}), va1 = __builtin_bit_cast(bf16x8, (u32x4){a1l.x, a1l.y, a1h.x, a1h.y});
                o0 = __builtin_amdgcn_mfma_f32_32x32x16_bf16(va0, pf[st], o0, 0, 0, 0);
                o1 = __builtin_amdgcn_mfma_f32_32x32x16_bf16(va1, pf[st], o1, 0, 0, 0);
            }
        }
        if (j + 1 < J.ntiles) lstore(buf ^ 1);
        __syncthreads();
    }
    { auto rr = __builtin_amdgcn_permlane32_swap(__float_as_uint(lsum), __float_as_uint(lsum), false, false); lsum = __uint_as_float(rr[0]) + __uint_as_float(rr[1]); }
    const float inv = frcp(lsum);
    bf16* orow = J.O + (size_t)(wid * 32 + r) * J.opitch + 4 * h;
#pragma unroll
    for (int g = 0; g < 4; ++g) {
        *(u32x2*)(orow + 8 * g) = (u32x2){cvtpk(o0[4 * g] * inv, o0[4 * g + 1] * inv), cvtpk(o0[4 * g + 2] * inv, o0[4 * g + 3] * inv)};
        *(u32x2*)(orow + 32 + 8 * g) = (u32x2){cvtpk(o1[4 * g] * inv, o1[4 * g + 1] * inv), cvtpk(o1[4 * g + 2] * inv, o1[4 * g + 3] * inv)};
    }
}

template <int DQK>
__device__ __forceinline__ void attn_unit_dense(LAS unsigned char* lds, const AttnJob& J) {
    static_assert(DQK == 96, "fp8 score path: rows are 128 bytes (64 nope | 32 rotary | 32 zero)");
    constexpr int KPB = 144, VPB = 144, KCH = 8, NKC = 2;
    constexpr int KBUF = 128 * KPB, VBUF = 64 * VPB;
    const int tid = ltid(), wid = __builtin_amdgcn_readfirstlane(tid >> 6), lane = tid & 63, r = lane & 31, h = lane >> 5;
    LAS unsigned char* kb0 = lds; LAS unsigned char* vb0 = lds + 2 * KBUF;
    i32x8 qf[2];
    { const unsigned char* qrow = (const unsigned char*)J.Q + (size_t)(wid * 32 + r) * J.qpitch + 32 * h;
#pragma unroll
      for (int i = 0; i < 2; ++i) { const i32x4 lo_ = *(const i32x4*)(qrow + 64 * i), hi_ = *(const i32x4*)(qrow + 64 * i + 16); qf[i] = __builtin_shufflevector(lo_, hi_, 0, 1, 2, 3, 4, 5, 6, 7); } }
    f32x16 o0, o1, o2;
#pragma unroll
    for (int i = 0; i < 16; ++i) { o0[i] = 0.f; o1[i] = 0.f; o2[i] = 0.f; }
    const int onev = (r == 0) ? 0x38383838 : 0;
    const i32x8 ones = {onev, onev, onev, onev, onev, onev, onev, onev};
    float mrun = 0.f;
    u32x4 kr[NKC], vr;
    const int vd = tid >> 3, vc = tid & 7;
    auto gload = [&](int j) { const int s0 = 128 * j;
#pragma unroll
        for (int q = 0; q < NKC; ++q) { const int ch = tid + 512 * q; kr[q] = *(const u32x4*)((const unsigned char*)J.K + (size_t)(s0 + ch / KCH) * J.kpitch + 16 * (ch % KCH)); }
        vr = *(const u32x4*)((const unsigned char*)J.VT + (size_t)vd * TB + s0 + 16 * vc); };
    auto lstore = [&](int buf) {
#pragma unroll
        for (int q = 0; q < NKC; ++q) { const int ch = tid + 512 * q; *(LAS u32x4*)(kb0 + buf * KBUF + (ch / KCH) * KPB + 16 * (ch % KCH)) = kr[q]; }
        LAS unsigned char* vp = vb0 + buf * VBUF + vd * VPB + 64 * (vc >> 2) + 8 * (vc & 3);
        *(LAS u32x2*)vp = (u32x2){vr.x, vr.z}; *(LAS u32x2*)(vp + 32) = (u32x2){vr.y, vr.w}; };
    const int nst = J.ntiles >> 1;
    const int grp = wid >> 2;
    gload(0); lstore(0);
    __syncthreads();
    if (nst > 1) gload(1);
    if (grp == 1) LDS_BAR();
    for (int j = 0; j < nst; ++j) {
        const int buf = j & 1;
        f32x16 sv[4];
#pragma unroll
        for (int bk = 0; bk < 4; ++bk)
#pragma unroll
            for (int i = 0; i < 16; ++i) sv[bk][i] = 0.f;
        { const LAS unsigned char* kq = kb0 + buf * KBUF + r * KPB + 32 * h;
          i32x8 ka[2][4];
#pragma unroll
          for (int bk = 0; bk < 4; ++bk) { const i32x4 lo_ = *(const LAS i32x4*)(kq + bk * 32 * KPB), hi_ = *(const LAS i32x4*)(kq + bk * 32 * KPB + 16); ka[0][bk] = __builtin_shufflevector(lo_, hi_, 0, 1, 2, 3, 4, 5, 6, 7); }
#pragma unroll
          for (int bk = 0; bk < 4; ++bk) { const i32x4 lo_ = *(const LAS i32x4*)(kq + bk * 32 * KPB + 64), hi_ = *(const LAS i32x4*)(kq + bk * 32 * KPB + 80); ka[1][bk] = __builtin_shufflevector(lo_, hi_, 0, 1, 2, 3, 4, 5, 6, 7); }
          __builtin_amdgcn_sched_barrier(0);
#pragma unroll
          for (int i = 0; i < 2; ++i)
#pragma unroll
              for (int bk = 0; bk < 4; ++bk) sv[bk] = __builtin_amdgcn_mfma_scale_f32_32x32x64_f8f6f4(ka[i][bk], qf[i], sv[bk], 0, 0, 0, 0x7f7f7f7f, 0, 0x7f7f7f7f);
          __builtin_amdgcn_sched_barrier(0); }
        if (grp == 1 && j + 1 < nst) lstore(buf ^ 1);
        LDS_BAR();
        if (grp == 1 && j + 2 < nst) gload(j + 2);
        float ma = fmaxf(sv[0][0], sv[1][0]), mb = fmaxf(sv[2][0], sv[3][0]);
#pragma unroll
        for (int i = 1; i < 16; ++i) { ma = fmaxf(fmaxf(ma, sv[0][i]), sv[1][i]); mb = fmaxf(fmaxf(mb, sv[2][i]), sv[3][i]); }
        float mx = fmaxf(ma, mb);
        { auto rr = __builtin_amdgcn_permlane32_swap(__float_as_uint(mx), __float_as_uint(mx), false, false); mx = fmaxf(__uint_as_float(rr[0]), __uint_as_float(rr[1])); }
        if (j == 0 || __any(mx > 8.0f)) {
            float dl = (j == 0 || mx > 8.0f) ? __builtin_ceilf(mx) : 0.f;
            const float mnew = fminf(fmaxf(mrun + dl, -496.f), 496.f); dl = mnew - mrun; mrun = mnew;
            if (j != 0) { const float alpha = fexp2(-dl); o2[0] *= alpha;
#pragma unroll
                for (int i = 0; i < 16; ++i) { o0[i] *= alpha; o1[i] *= alpha; } }
#pragma unroll
            for (int bk = 0; bk < 4; ++bk)
#pragma unroll
                for (int i = 0; i < 16; ++i) sv[bk][i] -= dl;
            const float pa = mrun > 248.f ? 256.f : (mrun < -248.f ? -256.f : 0.f), rem = mrun - pa, pb = 16.f * __builtin_rintf(rem * 0.0625f), pc = rem - pb;
            int w = 0; w = __builtin_amdgcn_cvt_pk_fp8_f32(-pa, -pb, w, false); w = __builtin_amdgcn_cvt_pk_fp8_f32(-pc, 0.f, w, true);
            if (h) qf[1][0] = w;
        }
#pragma unroll
        for (int bk = 0; bk < 4; ++bk)
#pragma unroll
            for (int i = 0; i < 16; ++i) sv[bk][i] = fexp2(sv[bk][i]);
        { const LAS unsigned char* vp = vb0 + buf * VBUF + r * VPB + 32 * h;
          i32x8 va[2][2];
#pragma unroll
          for (int t = 0; t < 2; ++t)
#pragma unroll
              for (int db = 0; db < 2; ++db) { const i32x4 lo_ = *(const LAS i32x4*)(vp + db * 32 * VPB + 64 * t), hi_ = *(const LAS i32x4*)(vp + db * 32 * VPB + 64 * t + 16); va[t][db] = __builtin_shufflevector(lo_, hi_, 0, 1, 2, 3, 4, 5, 6, 7); }
#pragma unroll
          for (int t = 0; t < 2; ++t) { i32x8 pf;
#pragma unroll
              for (int q = 0; q < 8; ++q) { const int bk = 2 * t + (q >> 2), i = 4 * (q & 3); int w = 0;
                  w = __builtin_amdgcn_cvt_pk_fp8_f32(sv[bk][i], sv[bk][i + 1], w, false); w = __builtin_amdgcn_cvt_pk_fp8_f32(sv[bk][i + 2], sv[bk][i + 3], w, true); pf[q] = w; }
              o0 = __builtin_amdgcn_mfma_scale_f32_32x32x64_f8f6f4(va[t][0], pf, o0, 0, 0, 0, 0x7f7f7f7f, 0, 0x7f7f7f7f);
              o1 = __builtin_amdgcn_mfma_scale_f32_32x32x64_f8f6f4(va[t][1], pf, o1, 0, 0, 0, 0x7f7f7f7f, 0, 0x7f7f7f7f);
              o2 = __builtin_amdgcn_mfma_scale_f32_32x32x64_f8f6f4(ones, pf, o2, 0, 0, 0, 0x7f7f7f7f, 0, 0x7f7f7f7f); } }
        if (grp == 0 && j + 1 < nst) lstore(buf ^ 1);
        LDS_BAR();
        if (grp == 0 && j + 2 < nst) gload(j + 2);
    }
    if (grp == 0) LDS_BAR();
    __syncthreads();
    float lsum = h ? 0.f : o2[0];
    { auto rr = __builtin_amdgcn_permlane32_swap(__float_as_uint(lsum), __float_as_uint(lsum), false, false); lsum = __uint_as_float(rr[0]) + __uint_as_float(rr[1]); }
    const float inv = frcp(lsum);
    bf16* orow = J.O + (size_t)(wid * 32 + r) * J.opitch + 4 * h;
#pragma unroll
    for (int g = 0; g < 4; ++g) {
        *(u32x2*)(orow + 8 * g) = (u32x2){cvtpk(o0[4 * g] * inv, o0[4 * g + 1] * inv), cvtpk(o0[4 * g + 2] * inv, o0[4 * g + 3] * inv)};
        *(u32x2*)(orow + 32 + 8 * g) = (u32x2){cvtpk(o1[4 * g] * inv, o1[4 * g + 1] * inv), cvtpk(o1[4 * g + 2] * inv, o1[4 * g + 3] * inv)};
    }
}

struct Params { const float* in[31]; float* out; unsigned char* ws; int ph_lo, ph_hi; };
typedef const __attribute__((address_space(4))) unsigned char* kaptr_t;
struct PView {
    kaptr_t ka; unsigned char* ws; float* out; int bid, G;
    struct InArr { kaptr_t ka; __device__ __forceinline__ const float* operator[](int i) const { return *(const float* const __attribute__((address_space(4)))*)(ka + 8 * i); } } in;
};
__device__ __forceinline__ PView pview() {
    kaptr_t k = (kaptr_t)__builtin_amdgcn_kernarg_segment_ptr(); asm volatile("" : "+s"(k));
    PView v; v.ka = k; v.in.ka = k; v.out = *(float* const __attribute__((address_space(4)))*)(k + 248); v.ws = *(unsigned char* const __attribute__((address_space(4)))*)(k + 256);
    int b = blockIdx.x, g = gridDim.x; asm volatile("" : "+s"(b), "+s"(g)); v.bid = b; v.G = g; return v;
}
enum { I_X = 0, I_C, I_CTX, I_CCTX, I_WADA, I_BADA, I_N1G, I_N2G, I_WIN, I_RPB, I_CONVW, I_ALOG, I_DTB, I_GNG, I_MQG, I_WUQ, I_MKVG, I_WUKV, I_BIF, I_MLG,
       I_WMG, I_BMG, I_WBO, I_WOUT, I_RW, I_RB, I_WGU, I_BGU, I_WDN, I_BDN, I_FG };

__device__ __forceinline__ void transpose_item(const float* W, int N, int k0, int n0, bf16* dst_row0, int ldd, LAS float* scr, int lane) {
#pragma unroll 8
    for (int i = 0; i < 32; ++i) { const int kk = 2 * i + (lane >> 5); scr[kk * 33 + (lane & 31)] = W[(size_t)(k0 + kk) * N + n0 + (lane & 31)]; }
    asm volatile("s_waitcnt lgkmcnt(0)" ::: "memory");
    const int c = lane & 7;
#pragma unroll
    for (int j = 0; j < 4; ++j) { const int n = (lane >> 3) + 8 * j; const LAS float* s = scr + (8 * c) * 33 + n;
        u32x4 o; o.x = cvtpk(s[0 * 33], s[1 * 33]); o.y = cvtpk(s[2 * 33], s[3 * 33]); o.z = cvtpk(s[4 * 33], s[5 * 33]); o.w = cvtpk(s[6 * 33], s[7 * 33]);
        *(u32x4*)(dst_row0 + (size_t)n * ldd + k0 + 8 * c) = o; }
    asm volatile("s_waitcnt lgkmcnt(0)" ::: "memory");
}
__device__ __forceinline__ void transpose_item8(const float* W, int N, int k0, int n0, signed char* dst_row0, int ldd, const float* cm_row0, LAS float* scr, int lane) {
#pragma unroll 8
    for (int i = 0; i < 32; ++i) { const int kk = 2 * i + (lane >> 5); scr[kk * 33 + (lane & 31)] = W[(size_t)(k0 + kk) * N + n0 + (lane & 31)]; }
    asm volatile("s_waitcnt lgkmcnt(0)" ::: "memory");
    const int c = lane & 7;
#pragma unroll
    for (int j = 0; j < 4; ++j) { const int n = (lane >> 3) + 8 * j; const LAS float* s = scr + (8 * c) * 33 + n;
        const float cm = cm_row0[n], inv = cm > 0.f ? 127.0f / cm : 0.f;
        unsigned w0 = 0u, w1 = 0u;
#pragma unroll
        for (int e = 0; e < 4; ++e) { const int q0 = (int)__builtin_rintf(s[e * 33] * inv), q1 = (int)__builtin_rintf(s[(4 + e) * 33] * inv); w0 |= ((unsigned)q0 & 0xffu) << (8 * e); w1 |= ((unsigned)q1 & 0xffu) << (8 * e); }
        *(u32x2*)(dst_row0 + (size_t)n * ldd + k0 + 8 * c) = (u32x2){w0, w1}; }
    asm volatile("s_waitcnt lgkmcnt(0)" ::: "memory");
}
__device__ __forceinline__ void transpose_item_f8(const float* W, int N, int k0, int n0, unsigned char* dst_row0, int ldd, LAS float* scr, int lane) {
#pragma unroll 8
    for (int i = 0; i < 32; ++i) { const int kk = 2 * i + (lane >> 5); scr[kk * 33 + (lane & 31)] = W[(size_t)(k0 + kk) * N + n0 + (lane & 31)]; }
    asm volatile("s_waitcnt lgkmcnt(0)" ::: "memory");
    const int c = lane & 7;
#pragma unroll
    for (int j = 0; j < 4; ++j) { const int n = (lane >> 3) + 8 * j; const LAS float* s = scr + (8 * c) * 33 + n;
        int w0 = 0, w1 = 0;
        w0 = __builtin_amdgcn_cvt_pk_fp8_f32(s[0 * 33] * 64.f, s[1 * 33] * 64.f, w0, false); w0 = __builtin_amdgcn_cvt_pk_fp8_f32(s[2 * 33] * 64.f, s[3 * 33] * 64.f, w0, true);
        w1 = __builtin_amdgcn_cvt_pk_fp8_f32(s[4 * 33] * 64.f, s[5 * 33] * 64.f, w1, false); w1 = __builtin_amdgcn_cvt_pk_fp8_f32(s[6 * 33] * 64.f, s[7 * 33] * 64.f, w1, true);
        *(u32x2*)(dst_row0 + (size_t)n * ldd + k0 + 8 * c) = (u32x2){(unsigned)w0, (unsigned)w1}; }
    asm volatile("s_waitcnt lgkmcnt(0)" ::: "memory");
}
struct TJob { int cnt, K, N; };
__device__ __forceinline__ void phase_prologue(const PView& p, LAS unsigned char* lds, int bid, int G) {
    const int tid = ltid(), wid = __builtin_amdgcn_readfirstlane(tid >> 6), lane = tid & 63;
    unsigned char* ws = p.ws;
    LAS float* scr = (LAS float*)(lds + wid * 16384);
    const int gw = bid * NWAVES + wid, NGW = G * NWAVES;
    constexpr int I0 = 4 * 16 * 174, I1 = 4 * 16 * 128, I2 = 16 * 8 * 32, I3 = 16 * 16 * 32, I4 = 4 * 4 * 24, I5 = 4 * 2 * 32, I6 = 128 * 16 * 64, I7 = 128 * 16 * 32;
    constexpr int NIT = I0 + I1 + I2 + I3 + I4 + I5 + I6 + I7;
    for (int it = gw; it < NIT; it += NGW) {
        int r = it;
        if (r < I0 + I1) continue; r -= I0 + I1;
        if (r < I2) continue; r -= I2;
        if (r < I3) { const int c = r / (16 * 32), q = r % (16 * 32), kb = q / 32, nb = q % 32, l = c >> 2, rep = c & 3;
            transpose_item(p.in[I_WOUT] + (size_t)l * 1024 * 1024, 1024, 64 * kb, 32 * nb, (bf16*)(ws + OFF_WOUT4) + ((size_t)l * 1024 + 32 * nb) * 4096 + rep * 1024, 4096, scr, lane); continue; } r -= I3;
        if (r < I4) { const int l = r / (4 * 24), q = r % (4 * 24), kb = q / 24, nb = q % 24;
            transpose_item(p.in[I_WUQ] + (size_t)l * 256 * 768, 768, 64 * kb, 32 * nb, (bf16*)(ws + OFF_WUQKV) + ((size_t)l * 1792 + 32 * nb) * 384, 384, scr, lane); continue; } r -= I4;
        if (r < I5) { const int l = r / (2 * 32), q = r % (2 * 32), kb = q / 32, nb = q % 32;
            transpose_item(p.in[I_WUKV] + (size_t)l * 128 * 1024, 1024, 64 * kb, 32 * nb, (bf16*)(ws + OFF_WUQKV) + ((size_t)l * 1792 + 768 + 32 * nb) * 384 + 256, 384, scr, lane); continue; } r -= I5;
        if (r < I6) { continue; } r -= I6;
        { const int c = r / (16 * 32), q = r % (16 * 32), kb = q / 32, nb = q % 32;
            transpose_item_f8(p.in[I_WDN] + (size_t)c * 1024 * 1024, 1024, 64 * kb, 32 * nb, (unsigned char*)(ws + OFF_WDN) + ((size_t)c * 1024 + 32 * nb) * 1024, 1024, scr, lane); }
    }
    { const int gt = bid * NTHR + tid, NT_ = G * NTHR;
      for (int i = gt; i < 4 * 64 * 64; i += NT_) { const int l = i / (64 * 64), q = i % (64 * 64), rr = q / 64, cc = q % 64;
          *(u32x4*)((signed char*)(ws + OFF_WIN) + ((size_t)l * NIN + DIN + rr) * 1024 + 16 * cc) = (u32x4){0u, 0u, 0u, 0u}; }
      for (int i = gt; i < 4 * 64; i += NT_) ((float*)(ws + OFF_CMIN))[(size_t)(i >> 6) * NIN + DIN + (i & 63)] = 0.f;
      for (int i = gt; i < 4 * 768 * 16; i += NT_) { const int l = i / (768 * 16), q = i % (768 * 16), rr = q / 16, cc = q % 16;
          *(u32x4*)((bf16*)(ws + OFF_WUQKV) + ((size_t)l * 1792 + rr) * 384 + 256 + 8 * cc) = (u32x4){0u, 0u, 0u, 0u}; }
      for (int i = gt; i < 4 * 1024 * 32; i += NT_) { const int l = i / (1024 * 32), q = i % (1024 * 32), rr = q / 32, cc = q % 32;
          *(u32x4*)((bf16*)(ws + OFF_WUQKV) + ((size_t)l * 1792 + 768 + rr) * 384 + 8 * cc) = (u32x4){0u, 0u, 0u, 0u}; } }
    __syncthreads();
    { LAS float* sc = (LAS float*)lds;
      for (int i = tid; i < 5 * 1024; i += NTHR) { const float v = (i < 4096) ? p.in[I_C][i] : p.in[I_CCTX][i - 4096]; sc[i] = v * fsigmoid(v); }
      LAS float* part = (LAS float*)(lds + 32768);
      __syncthreads();
      for (int item = bid; item < 4 * 96; item += G) { const int l = item / 96, cb = item % 96, col = cb * 64 + lane;
          const float* w = p.in[I_WADA] + (size_t)l * 1024 * 6144 + col;
          float a0 = 0.f, a1 = 0.f, a2 = 0.f, a3 = 0.f, a4 = 0.f;
#pragma unroll 8
          for (int k = wid * 128; k < wid * 128 + 128; ++k) { const float wv = w[(size_t)k * 6144];
              a0 += sc[k] * wv; a1 += sc[1024 + k] * wv; a2 += sc[2048 + k] * wv; a3 += sc[3072 + k] * wv; a4 += sc[4096 + k] * wv; }
          LAS float* pp = part + (wid * 64 + lane) * 5; pp[0] = a0; pp[1] = a1; pp[2] = a2; pp[3] = a3; pp[4] = a4;
          __syncthreads();
          if (tid < 320) { const int c = tid % 64, rr = tid / 64; float s = 0.f;
#pragma unroll
              for (int w8 = 0; w8 < 8; ++w8) s += part[(w8 * 64 + c) * 5 + rr];
              ((float*)(ws + OFF_MOD))[((size_t)l * 5 + rr) * 6144 + cb * 64 + c] = s + p.in[I_BADA][l * 6144 + cb * 64 + c]; }
          __syncthreads(); } }
    { LAS float* part = (LAS float*)(lds + 65536);
      LAS unsigned char* t8 = lds;
      constexpr int NI0 = 4 * 174, NI1 = 4 * 128, NI2 = 128 * 64, NI3 = 16 * 32;
      const int n = lane & 31, k2 = lane >> 5;
      for (int item = bid; item < NI3; item += G) { const int c = item >> 5, cb = item & 31, n0 = 32 * cb;
          const float* w = p.in[I_WBO] + (size_t)c * 512 * 1024; float* cmd = (float*)(ws + OFF_CMBO) + (size_t)c * 1024; signed char* dst = (signed char*)(ws + OFF_WBO) + (size_t)c * 1024 * 512;
          float x[8][4]; float m = 0.f;
#pragma unroll
          for (int i = 0; i < 8; ++i)
#pragma unroll
              for (int e = 0; e < 4; ++e) { x[i][e] = w[(size_t)(64 * i + 8 * wid + 4 * k2 + e) * 1024 + n0 + n]; m = fmaxf(m, fabsf(x[i][e])); }
          part[(wid * 2 + k2) * 32 + n] = m;
          __syncthreads();
          if (tid < 32) { float mm = part[tid];
#pragma unroll
              for (int q = 1; q < 16; ++q) mm = fmaxf(mm, part[q * 32 + tid]);
              part[512 + tid] = mm; cmd[n0 + tid] = mm; }
          __syncthreads();
          { const float cm = part[512 + n], inv = cm > 0.f ? 127.0f / cm : 0.f;
#pragma unroll
            for (int i = 0; i < 8; ++i) *(LAS unsigned*)(t8 + n * 516 + 64 * i + 8 * wid + 4 * k2) = q8x4((f32x4){x[i][0], x[i][1], x[i][2], x[i][3]} * inv); }
          __syncthreads();
#pragma unroll
          for (int q = 0; q < 2; ++q) { const int ch = tid + 512 * q, rr = ch >> 5, cc = ch & 31; const LAS unsigned* s = (const LAS unsigned*)(t8 + rr * 516 + 16 * cc);
              *(u32x4*)(dst + (size_t)(n0 + rr) * 512 + 16 * cc) = (u32x4){s[0], s[1], s[2], s[3]}; }
          __syncthreads(); }
      for (int item = bid; item < NI0 + NI1 + NI2; item += G) {
          const float* w; int N, n0; float* cmd; signed char* dst; int drow0;
          if (item < NI0) { const int l = item / 174, cb = item % 174; N = DIN; n0 = 32 * cb; w = p.in[I_WIN] + (size_t)l * 1024 * DIN; drow0 = n0; cmd = (float*)(ws + OFF_CMIN) + (size_t)l * NIN; dst = (signed char*)(ws + OFF_WIN) + (size_t)l * NIN * 1024; }
          else if (item < NI0 + NI1) { const int r = item - NI0, l = r / 128, cb = r % 128; N = NGATE; n0 = 32 * cb; w = p.in[I_WMG] + (size_t)l * 1024 * NGATE; drow0 = LDP + n0; cmd = (float*)(ws + OFF_CMIN) + (size_t)l * NIN; dst = (signed char*)(ws + OFF_WIN) + (size_t)l * NIN * 1024; }
          else { const int r = item - NI0 - NI1, c = r / 64, cb = r % 64; N = 2048; n0 = 32 * cb; w = p.in[I_WGU] + (size_t)c * 1024 * 2048; const int j = n0 & 1023; drow0 = (j >> 7) * 256 + ((n0 >= 1024) ? 128 : 0) + (j & 127);
                 cmd = (float*)(ws + OFF_CMGU) + (size_t)c * 2048; dst = (signed char*)(ws + OFF_WGU) + (size_t)c * 2048 * 1024; }
          float x[16][4]; float m = 0.f;
#pragma unroll
          for (int i = 0; i < 16; ++i)
#pragma unroll
              for (int e = 0; e < 4; ++e) { x[i][e] = w[(size_t)(64 * i + 8 * wid + 4 * k2 + e) * N + n0 + n]; }
#pragma unroll
          for (int i = 0; i < 16; ++i)
#pragma unroll
              for (int e = 0; e < 4; ++e) m = fmaxf(m, fabsf(x[i][e]));
          part[(wid * 2 + k2) * 32 + n] = m;
          __syncthreads();
          if (tid < 32) { float mm = part[tid];
#pragma unroll
              for (int q = 1; q < 16; ++q) mm = fmaxf(mm, part[q * 32 + tid]);
              part[512 + tid] = mm; cmd[drow0 + tid] = mm; }
          __syncthreads();
          { const float cm = part[512 + n], inv = cm > 0.f ? 127.0f / cm : 0.f;
#pragma unroll
            for (int i = 0; i < 16; ++i) *(LAS unsigned*)(t8 + n * 1028 + 64 * i + 8 * wid + 4 * k2) = q8x4((f32x4){x[i][0], x[i][1], x[i][2], x[i][3]} * inv); }
          __syncthreads();
#pragma unroll
          for (int q = 0; q < 4; ++q) { const int ch = tid + 512 * q, rr = ch >> 6, cc = ch & 63; const LAS unsigned* s = (const LAS unsigned*)(t8 + rr * 1028 + 16 * cc);
              *(u32x4*)(dst + (size_t)(drow0 + rr) * 1024 + 16 * cc) = (u32x4){s[0], s[1], s[2], s[3]}; }
          __syncthreads(); } }
}

__device__ __forceinline__ int tok_mv(int tk) { const int b = tk / TB, s = tk - b * TB; return s < CTX ? 4 : b; }
template <int MODE>
__device__ __forceinline__ void phase_norm1(const PView& p, int l, int bid, int G, bool dummy = false) {
    const int tid = ltid(), wid = __builtin_amdgcn_readfirstlane(tid >> 6), lane = tid & 63;
    unsigned char* ws = p.ws;
    float* X = (float*)(ws + OFF_X); signed char* H8 = (signed char*)(ws + OFF_H); float* SH = (float*)(ws + OFF_SH);
    float* Xw = dummy ? (float*)(ws + OFF_GF) : X;
    const float* MOD = (const float*)(ws + OFF_MOD);
    const bf16* YS = (const bf16*)(ws + OFF_R3);
    const float* TW = (const float*)(ws + OFF_TOPW); const int* SL = (const int*)(ws + OFF_SLOT);
    for (int tp = bid * NWAVES + wid; tp < T / 2; tp += G * NWAVES) {
        const int tk0 = 2 * tp, b = tk0 / TB, s = tk0 - b * TB, mv = s < CTX ? 4 : b;
        if (MODE == 2 && s < CTX) continue;
        f32x4 v[2][4];
        if (l == 0) { const float* src = (s < CTX) ? p.in[I_CTX] + ((size_t)b * CTX + s) * D : p.in[I_X] + ((size_t)b * SEQ + (s - CTX)) * D;
#pragma unroll
            for (int u = 0; u < 2; ++u)
#pragma unroll
                for (int j = 0; j < 4; ++j) v[u][j] = *(const f32x4*)(src + u * D + 256 * j + 4 * lane);
        } else {
            float w[2][4]; int sl[2][4];
#pragma unroll
            for (int u = 0; u < 2; ++u)
#pragma unroll
                for (int k = 0; k < 4; ++k) { w[u][k] = TW[(tk0 + u) * 4 + k]; sl[u][k] = SL[(tk0 + u) * 4 + k]; }
#pragma unroll
            for (int u = 0; u < 2; ++u)
#pragma unroll
                for (int j = 0; j < 4; ++j) v[u][j] = *(const f32x4*)(X + (size_t)(tk0 + u) * D + 256 * j + 4 * lane);
            u32x2 y[2][4][4];
#pragma unroll
            for (int u = 0; u < 2; ++u)
#pragma unroll
                for (int k = 0; k < 4; ++k)
#pragma unroll
                    for (int j = 0; j < 4; ++j) y[u][k][j] = *(const u32x2*)(YS + (size_t)sl[u][k] * D + 256 * j + 4 * lane);
            const float* g2 = MOD + ((size_t)(l - 1) * 5 + mv) * 6144 + 5120;
#pragma unroll
            for (int j = 0; j < 4; ++j) { const f32x4 g2v = *(const f32x4*)(g2 + 256 * j + 4 * lane);
#pragma unroll
                for (int u = 0; u < 2; ++u) { f32x4 f = (f32x4){0.f, 0.f, 0.f, 0.f};
#pragma unroll
                    for (int k = 0; k < 4; ++k) f += w[u][k] * (f32x4){bflo(y[u][k][j].x), bfhi(y[u][k][j].x), bflo(y[u][k][j].y), bfhi(y[u][k][j].y)};
                    v[u][j] += g2v * f; } }
        }
        if (MODE != 2) {
#pragma unroll
            for (int u = 0; u < 2; ++u)
#pragma unroll
                for (int j = 0; j < 4; ++j) *(f32x4*)(Xw + (size_t)(tk0 + u) * D + 256 * j + 4 * lane) = v[u][j];
        }
        float rstd[2];
#pragma unroll
        for (int u = 0; u < 2; ++u) { float ss = 0.f;
#pragma unroll
            for (int j = 0; j < 4; ++j) ss += v[u][j].x * v[u][j].x + v[u][j].y * v[u][j].y + v[u][j].z * v[u][j].z + v[u][j].w * v[u][j].w;
            rstd[u] = __builtin_amdgcn_rsqf(wave_sum(ss) * (1.f / D) + 1e-6f); }
        if (MODE == 2) {
            float* o = p.out + ((size_t)b * SEQ + (s - CTX)) * D;
#pragma unroll
            for (int j = 0; j < 4; ++j) { const f32x4 g = *(const f32x4*)(p.in[I_FG] + 256 * j + 4 * lane);
#pragma unroll
                for (int u = 0; u < 2; ++u) *(f32x4*)(o + u * D + 256 * j + 4 * lane) = v[u][j] * rstd[u] * g; }
        } else {
            const float* ng = p.in[I_N1G] + l * D; const float* md = MOD + ((size_t)l * 5 + mv) * 6144;
            float am[2] = {0.f, 0.f};
#pragma unroll
            for (int j = 0; j < 4; ++j) { const int c = 256 * j + 4 * lane; const f32x4 g = *(const f32x4*)(ng + c), sh = *(const f32x4*)(md + c), sc = *(const f32x4*)(md + 1024 + c);
#pragma unroll
                for (int u = 0; u < 2; ++u) { v[u][j] = v[u][j] * rstd[u] * g * (sc + 1.0f) + sh;
                    am[u] = fmaxf(am[u], fmaxf(fmaxf(fabsf(v[u][j].x), fabsf(v[u][j].y)), fmaxf(fabsf(v[u][j].z), fabsf(v[u][j].w)))); } }
#pragma unroll
            for (int u = 0; u < 2; ++u) { const float amax = wave_max(am[u]), inv = amax > 0.f ? 127.0f / amax : 0.f;
                if (lane == 0) SH[tk0 + u] = amax * (1.0f / 127.0f);
#pragma unroll
                for (int j = 0; j < 4; ++j) *(unsigned*)(H8 + (size_t)(tk0 + u) * D + 256 * j + 4 * lane) = q8x4(v[u][j] * inv); }
        }
    }
}

__device__ __forceinline__ void phase_router(const PView& p, int l, LAS unsigned char* lds, int bid, int G, bool dummy = false) {
    const int tid = ltid(), wid = __builtin_amdgcn_readfirstlane(tid >> 6), lane = tid & 63;
    unsigned char* ws = p.ws;
    const float* X = (const float*)(ws + OFF_X); signed char* H8 = (signed char*)(ws + OFF_H); float* SH = (float*)(ws + OFF_SH);
    const float* MOD = (const float*)(ws + OFF_MOD);
    float* TW = (float*)(ws + OFF_TOPW); int* TE = (int*)(ws + OFF_TOPE); int* PS = (int*)(ws + OFF_POS);
    unsigned* gcnt = (unsigned*)(ws + OFF_CTL) + CW_CNT + l * 32 + (dummy ? 1024 : 0);
    LAS float* rw = (LAS float*)lds;
    LAS int* hist = (LAS int*)(lds + MISC_OFF + 64);
    LAS int* base = hist + 32;
    LAS int* lrec = base + 32;
    { const float* rg = p.in[I_RW] + (size_t)l * 1024 * 32;
      for (int i = tid; i < 1024 * 32; i += NTHR) rw[(i & 31) * 1024 + (i >> 5)] = rg[i]; }
    constexpr int TPB = 132;
    for (int item = bid; item < T / TPB; item += G) {
        if (tid < 32) hist[tid] = 0;
        __syncthreads();
        for (int tp = wid; tp < TPB / 2; tp += NWAVES) {
            const int ti0 = 2 * tp, tk0 = item * TPB + ti0, mv = tok_mv(tk0);
            f32x4 hv[2][4];
            const float* ng = p.in[I_N2G] + l * D; const float* md = MOD + ((size_t)l * 5 + mv) * 6144;
#pragma unroll
            for (int t2 = 0; t2 < 2; ++t2) { const int tk = tk0 + t2;
                f32x4 v[4]; float ss = 0.f;
#pragma unroll
                for (int j = 0; j < 4; ++j) { v[j] = *(const f32x4*)(X + (size_t)tk * D + 256 * j + 4 * lane); ss += v[j].x * v[j].x + v[j].y * v[j].y + v[j].z * v[j].z + v[j].w * v[j].w; }
                const float rstd = __builtin_amdgcn_rsqf(wave_sum(ss) * (1.f / D) + 1e-6f);
                float am = 0.f;
#pragma unroll
                for (int j = 0; j < 4; ++j) { const int c = 256 * j + 4 * lane; const f32x4 g = *(const f32x4*)(ng + c), sh = *(const f32x4*)(md + 3072 + c), sc = *(const f32x4*)(md + 4096 + c);
                    hv[t2][j] = v[j] * rstd * g * (sc + 1.0f) + sh;
                    am = fmaxf(am, fmaxf(fmaxf(fabsf(hv[t2][j].x), fabsf(hv[t2][j].y)), fmaxf(fabsf(hv[t2][j].z), fabsf(hv[t2][j].w)))); }
                { const float amax = wave_max(am), inv = amax > 0.f ? 127.0f / amax : 0.f;
                  if (lane == 0) SH[tk] = amax * (1.0f / 127.0f);
#pragma unroll
                  for (int j = 0; j < 4; ++j) *(unsigned*)(H8 + (size_t)tk * D + 256 * j + 4 * lane) = q8x4(hv[t2][j] * inv); }
                }
            float A16[2][16];
#pragma unroll
            for (int cq = 0; cq < 4; ++cq) { float acc[2][8];
#pragma unroll
                for (int q = 0; q < 8; ++q) { acc[0][q] = 0.f; acc[1][q] = 0.f; }
#pragma unroll
                for (int j = 0; j < 4; ++j) { const int c = 256 * j + 4 * lane;
#pragma unroll
                    for (int q = 0; q < 8; ++q) { const int e = 4 * cq + (q & 3) + 16 * (q >> 2); const f32x4 w = *(const LAS f32x4*)(rw + e * 1024 + c);
                        acc[0][q] += hv[0][j].x * w.x + hv[0][j].y * w.y + hv[0][j].z * w.z + hv[0][j].w * w.w;
                        acc[1][q] += hv[1][j].x * w.x + hv[1][j].y * w.y + hv[1][j].z * w.z + hv[1][j].w * w.w; } }
#pragma unroll
                for (int t2 = 0; t2 < 2; ++t2)
#pragma unroll
                    for (int q = 0; q < 4; ++q) { auto rr = __builtin_amdgcn_permlane32_swap(__float_as_uint(acc[t2][q]), __float_as_uint(acc[t2][q + 4]), false, false); A16[t2][4 * cq + q] = __uint_as_float(rr[0]) + __uint_as_float(rr[1]); }
                asm volatile("" ::: "memory"); }
            const int myE = lane >> 1; const float rbias = p.in[I_RB][l * 32 + myE];
            const bool b3 = (lane & 8) != 0, b2 = (lane & 4) != 0, b1 = (lane & 2) != 0;
#pragma unroll
            for (int t2 = 0; t2 < 2; ++t2) {
                float B8[8], C4[4], D2[2];
#pragma unroll
                for (int e = 0; e < 8; ++e) { auto rr = __builtin_amdgcn_permlane16_swap(__float_as_uint(A16[t2][e]), __float_as_uint(A16[t2][e + 8]), false, false); B8[e] = __uint_as_float(rr[0]) + __uint_as_float(rr[1]); }
#pragma unroll
                for (int e = 0; e < 4; ++e) { const float keep = b3 ? B8[e + 4] : B8[e], send = b3 ? B8[e] : B8[e + 4]; C4[e] = keep + dppf<0x140>(send); }
#pragma unroll
                for (int e = 0; e < 2; ++e) { const float keep = b2 ? C4[e + 2] : C4[e], send = b2 ? C4[e] : C4[e + 2]; D2[e] = keep + dppf<0x141>(send); }
                float v; { const float keep = b1 ? D2[1] : D2[0], send = b1 ? D2[0] : D2[1]; v = keep + dppf<0x1B>(send); }
                v += dppf<0xB1>(v); v += rbias;
                int cnt = 0;
#pragma unroll
                for (int e = 0; e < 32; ++e) { const float s = __int_as_float(__builtin_amdgcn_readlane(__float_as_int(v), 2 * e)); cnt += ((s > v) || (s == v && e < myE)) ? 1 : 0; }
                const bool sel = (cnt < 4) && ((lane & 1) == 0);
                const unsigned long long top = __ballot(sel && cnt == 0);
                const float m0 = __int_as_float(__builtin_amdgcn_readlane(__float_as_int(v), (int)__builtin_ctzll(top)));
                const float ex = sel ? fexp(v - m0) : 0.f;
                float tot = row16_sum(ex); { auto rr = __builtin_amdgcn_permlane16_swap(__float_as_uint(tot), __float_as_uint(tot), false, false); tot = __uint_as_float(rr[0]) + __uint_as_float(rr[1]); }
                { auto rr = __builtin_amdgcn_permlane32_swap(__float_as_uint(tot), __float_as_uint(tot), false, false); tot = __uint_as_float(rr[0]) + __uint_as_float(rr[1]); }
                if (sel) { const int tk = tk0 + t2, ti = ti0 + t2;
                    TW[tk * 4 + cnt] = ex / tot; TE[tk * 4 + cnt] = myE;
                    const int rk = atomicAdd((int*)&hist[myE], 1); lrec[ti * 4 + cnt] = (myE << 16) | rk; }
            }
        }
        __syncthreads();
        if (tid < 32) base[tid] = (int)__hip_atomic_fetch_add(gcnt + tid, (unsigned)hist[tid], __ATOMIC_RELAXED, __HIP_MEMORY_SCOPE_AGENT);
        __syncthreads();
        for (int i = tid; i < TPB * 4; i += NTHR) { const int rec = lrec[i]; PS[(size_t)item * TPB * 4 + i] = base[rec >> 16] + (rec & 0xffff); }
        __syncthreads();
    }
}

__device__ __forceinline__ void phase_gather(const PView& p, int l, LAS unsigned char* lds, int bid, int G) {
    const int tid = ltid(), wid = __builtin_amdgcn_readfirstlane(tid >> 6), lane = tid & 63;
    unsigned char* ws = p.ws;
    const unsigned* gcnt = (const unsigned*)(ws + OFF_CTL) + CW_CNT + l * 32;
    int* tst = (int*)(ws + OFF_CTL) + CW_TST + l * 64;
    LAS int* off = (LAS int*)(lds + MISC_OFF + 64);
    if (tid == 0) { int acc = 0; for (int e = 0; e < 32; ++e) { off[e] = acc * 256; if (bid == 0) tst[e] = acc; acc += ((int)gcnt[e] + 255) >> 8; } if (bid == 0) tst[32] = acc; }
    __syncthreads();
    const signed char* H8 = (const signed char*)(ws + OFF_H); signed char* XG = (signed char*)(ws + OFF_R1); const float* SH = (const float*)(ws + OFF_SH); float* SX = (float*)(ws + OFF_SX);
    const int* TE = (const int*)(ws + OFF_TOPE); const int* PS = (const int*)(ws + OFF_POS); int* SL = (int*)(ws + OFF_SLOT);
    for (int tk = bid * NWAVES + wid; tk < T; tk += G * NWAVES) {
        int dst[4];
#pragma unroll
        for (int k = 0; k < 4; ++k) dst[k] = off[TE[tk * 4 + k]] + PS[tk * 4 + k];
        const u32x4 r0 = ((const u32x4*)(H8 + (size_t)tk * D))[lane]; const float sc = SH[tk];
        if (lane < 4) { const int d = dst[0] * (lane == 0) + dst[1] * (lane == 1) + dst[2] * (lane == 2) + dst[3] * (lane == 3); SL[tk * 4 + lane] = d; SX[d] = sc; }
#pragma unroll
        for (int k = 0; k < 4; ++k) ((u32x4*)(XG + (size_t)dst[k] * D))[lane] = r0;
    }
}

template <class SrcFn>
__device__ __forceinline__ void transpose64x128(LAS unsigned char* lds, int tid, SrcFn srcp, bf16* dst_hd0  ) {
    LAS bf16* tl = (LAS bf16*)lds;
#pragma unroll
    for (int q = 0; q < 2; ++q) { const int ch = tid + 512 * q, ti = ch >> 4, cc = ch & 15; *(LAS u32x4*)(tl + ti * 136 + 8 * cc) = *(const u32x4*)srcp(ti, cc); }
    __syncthreads();
#pragma unroll
    for (int q = 0; q < 2; ++q) { const int hd = tid & 127, c8 = (tid >> 7) + 4 * q; unsigned w[4];
#pragma unroll
        for (int e = 0; e < 4; ++e) { const unsigned lo = tl[(8 * c8 + 2 * e) * 136 + hd], hi = tl[(8 * c8 + 2 * e + 1) * 136 + hd]; w[e] = lo | (hi << 16); }
        *(u32x4*)(dst_hd0 + (size_t)hd * TB + 8 * c8) = (u32x4){w[0], w[1], w[2], w[3]}; }
    __syncthreads();
}
template <class SrcFn>
__device__ __forceinline__ void transpose64x128_f8(LAS unsigned char* lds, int tid, SrcFn srcp, unsigned char* dst_hd0) {
    LAS bf16* tl = (LAS bf16*)lds;
#pragma unroll
    for (int q = 0; q < 2; ++q) { const int ch = tid + 512 * q, ti = ch >> 4, cc = ch & 15; *(LAS u32x4*)(tl + ti * 136 + 8 * cc) = *(const u32x4*)srcp(ti, cc); }
    __syncthreads();
    { const int hd = tid & 127, c4 = tid >> 7; int w[4] = {0, 0, 0, 0};
#pragma unroll
      for (int q = 0; q < 4; ++q) { const float x0 = bf2f(tl[(16 * c4 + 4 * q) * 136 + hd]), x1 = bf2f(tl[(16 * c4 + 4 * q + 1) * 136 + hd]), x2 = bf2f(tl[(16 * c4 + 4 * q + 2) * 136 + hd]), x3 = bf2f(tl[(16 * c4 + 4 * q + 3) * 136 + hd]);
          w[q] = __builtin_amdgcn_cvt_pk_fp8_f32(x0, x1, w[q], false); w[q] = __builtin_amdgcn_cvt_pk_fp8_f32(x2, x3, w[q], true); }
      *(u32x4*)(dst_hd0 + (size_t)hd * TB + 16 * c4) = (u32x4){(unsigned)w[0], (unsigned)w[1], (unsigned)w[2], (unsigned)w[3]}; }
    __syncthreads();
}
__device__ __forceinline__ void phase_prep(const PView& p, int l, LAS unsigned char* lds, int bid, int G) {
    const int tid = ltid(), wid = __builtin_amdgcn_readfirstlane(tid >> 6), lane = tid & 63;
    unsigned char* ws = p.ws;
    const bf16* P = (const bf16*)(ws + OFF_R1);
    bf16* GQ = (bf16*)(ws + OFF_GQKV); const float* GT = (const float*)(ws + OFF_GATES);
    bf16* AQ = (bf16*)(ws + OFF_AQ); bf16* VTN = (bf16*)(ws + OFF_VTN);
    const float* cw = p.in[I_CONVW] + (size_t)l * 3 * 1536;
    { const int NT_ = G * NTHR, NCH = T * 192;
      for (int ch0 = bid * NTHR + tid; ch0 < NCH; ch0 += 4 * NT_) {
          u32x4 r0[4], rm[4], rp[4];
#pragma unroll
          for (int u = 0; u < 4; ++u) { const int ch = ch0 + u * NT_;
              if (ch < NCH) { const int tk = ch / 192, cc = ch - tk * 192, b = tk / TB, s = tk - b * TB; const bool c_ = s < CTX; const int lo = c_ ? 0 : CTX, hi = c_ ? CTX : TB;
                  const bf16* pr = P + (size_t)tk * LDP + PC_GQKV + 8 * cc;
                  r0[u] = *(const u32x4*)pr;
                  rm[u] = (s - 1 >= lo) ? *(const u32x4*)(pr - LDP) : (u32x4){0u, 0u, 0u, 0u};
                  rp[u] = (s + 1 < hi) ? *(const u32x4*)(pr + LDP) : (u32x4){0u, 0u, 0u, 0u}; } }
#pragma unroll
          for (int u = 0; u < 4; ++u) { const int ch = ch0 + u * NT_;
              if (ch < NCH) { const int tk = ch / 192, cc = ch - tk * 192;
                  float xm[8], x0[8], xp[8]; unpack8(r0[u], x0); unpack8(rm[u], xm); unpack8(rp[u], xp);
                  float y[8]; float ss = 0.f;
#pragma unroll
                  for (int i = 0; i < 8; ++i) { const int c = 8 * cc + i; const float z = xm[i] * cw[c] + x0[i] * cw[1536 + c] + xp[i] * cw[3072 + c]; y[i] = z * fsigmoid(z); ss += y[i] * y[i]; }
                  ss = row16_sum(ss);
                  if (cc < 128) { const float sc = __builtin_amdgcn_rsqf(ss + 1e-6f) * ((cc < 64) ? 0.08838834764831845f : 1.0f);
#pragma unroll
                      for (int i = 0; i < 8; ++i) y[i] *= sc; }
                  *(u32x4*)(GQ + (size_t)tk * 1536 + 8 * cc) = pack8(y); } } } }
    { float* GC = (float*)(ws + OFF_GC); float* MC = (float*)(ws + OFF_MC);
      for (int it = (wid * 64 + lane) * G + bid; it < (T / 64) * 16; it += G * NTHR) {
          const int tile = it >> 4, sq = it & 15, dh = sq & 7, d = dh >> 2, hh = dh & 3, tk0 = tile * 64;
          const bool isg = sq < 8;
          const float c0_ = isg ? p.in[I_DTB][l * 8 + dh] : p.in[I_BIF][((l * 2 + d) * 2 + 1) * 4 + hh];
          const float c1_ = isg ? -__expf(p.in[I_ALOG][l * 8 + dh]) : p.in[I_BIF][((l * 2 + d) * 2 + 0) * 4 + hh];
          float run = 0.f;
#pragma unroll 8
          for (int n = 0; n < 64; ++n) { const int tk = tk0 + (d ? 63 - n : n); const float* g = GT + (size_t)tk * 32;
              if (isg) { const float a = g[dh] + c0_; const float sp = (a > 20.f) ? a : __logf(1.0f + __expf(a)); run += c1_ * sp;
                  GC[(size_t)tk * 24 + dh] = run; GC[(size_t)tk * 24 + 8 + dh] = fsigmoid(g[8 + dh]); }
              else { const float y = -(g[24 + dh] + c0_); run -= (y > 20.f) ? y : __logf(1.0f + __expf(y));
                  MC[(size_t)tk * 16 + dh] = run; MC[(size_t)tk * 16 + 8 + dh] = g[16 + dh] + c1_; } } } }
    for (int tk = bid * NWAVES + wid; tk < T; tk += G * NWAVES) {
        float x[8]; float ss = 0.f;
        if (lane < 48) { unpack8(*(const u32x4*)(P + (size_t)tk * LDP + PC_MQ + 8 * lane), x); for (int i = 0; i < 8; ++i) ss += x[i] * x[i]; }
        else { for (int i = 0; i < 8; ++i) x[i] = 0.f; }
        ss = row16_sum(ss); { auto rr = __builtin_amdgcn_permlane16_swap(__float_as_uint(ss), __float_as_uint(ss), false, false); ss = __uint_as_float(rr[0]) + __uint_as_float(rr[1]); }
        if (lane < 48) { const bool isq = lane < 32; const float rs = __builtin_amdgcn_rsqf(ss * (isq ? (1.f / 256.f) : (1.f / 128.f)) + 1e-6f);
            const float* g = isq ? p.in[I_MQG] + l * 256 + 8 * lane : p.in[I_MKVG] + l * 128 + 8 * (lane - 32);
#pragma unroll
            for (int i = 0; i < 8; ++i) x[i] *= rs * g[i];
            *(u32x4*)(AQ + (size_t)tk * 384 + 8 * lane) = pack8(x); } }
    for (int it = bid; it < (T / 64) * 4; it += G) { const int tile = it >> 2, hp = it & 3, tk0 = tile * 64, b = tk0 / TB, s0 = tk0 - b * TB;
        transpose64x128(lds, tid, [&](int ti, int cc) { return P + (size_t)(tk0 + ti) * LDP + PC_NAV + hp * 128 + 8 * cc; }, VTN + ((size_t)b * 512 + hp * 128) * TB + s0); }
}

__device__ __forceinline__ void rope16(float (&x)[16], float pos) {
#pragma unroll
    for (int i = 0; i < 8; ++i) { const float inv = fexp2(-1.6609640474436813f * (float)i);
        const float rev = pos * inv * 0.15915494309189535f; const float fr = rev - floorf(rev);
        const float sn = __builtin_amdgcn_sinf(fr), cs = __builtin_amdgcn_cosf(fr);
        const float a = x[i], bb = x[i + 8]; x[i] = a * cs - bb * sn; x[i + 8] = bb * cs + a * sn; }
}
__device__ __forceinline__ void phase_mlapost(const PView& p, int l, LAS unsigned char* lds, int bid, int G, bool dummy = false) {
    const int tid = ltid();
    unsigned char* ws = p.ws;
    const bf16* P = (const bf16*)(ws + OFF_R1); const bf16* QR = (const bf16*)(ws + OFF_QKVR); bf16* VTM = (bf16*)(ws + OFF_VTM);
    const int gt = bid * NTHR + tid, NT_ = G * NTHR;
    unsigned char* QM8 = ws + OFF_QM8; unsigned char* KM8 = ws + OFF_KM; (void)dummy;
    for (int it = gt; it < T * 8 * 16; it += NT_) { const int c = it & 7, isk = (it >> 3) & 1, hh = (it >> 4) & 7, tk = it >> 7, b = tk / TB, s = tk - b * TB;
        unsigned char* dst = isk ? KM8 + ((((size_t)b * 8 + hh) * TB + s) * 128 + 16 * c) : QM8 + (((size_t)tk * 8 + hh) * 128 + 16 * c);
        if (c >= 6) { *(u32x4*)dst = (u32x4){(isk && c == 6) ? 0x38383838u : 0u, 0u, 0u, 0u}; continue; }
        const bf16* sp;
        if (c < 4) sp = isk ? QR + (size_t)tk * 1792 + 768 + hh * 128 + 16 * c : QR + (size_t)tk * 1792 + hh * 96 + 16 * c;
        else sp = isk ? P + (size_t)tk * LDP + PC_MKPE + 16 * (c - 4) : QR + (size_t)tk * 1792 + hh * 96 + 64 + 16 * (c - 4);
        float x[16]; { float a8[8], c8[8]; unpack8(*(const u32x4*)sp, a8); unpack8(*(const u32x4*)(sp + 8), c8); for (int i = 0; i < 8; ++i) { x[i] = a8[i]; x[8 + i] = c8[i]; } }
        if (c >= 4 && s >= CTX) { const int t = s - CTX; rope16(x, (float)(c == 4 ? (t >> 6) : (t & 63))); }
        if (!isk) {
#pragma unroll
            for (int i = 0; i < 16; ++i) x[i] *= 0.10206207261596577f * 1.4426950408889634f; }
        int w[4] = {0, 0, 0, 0};
#pragma unroll
        for (int q = 0; q < 4; ++q) { w[q] = __builtin_amdgcn_cvt_pk_fp8_f32(x[4 * q], x[4 * q + 1], w[q], false); w[q] = __builtin_amdgcn_cvt_pk_fp8_f32(x[4 * q + 2], x[4 * q + 3], w[q], true); }
        *(u32x4*)dst = (u32x4){(unsigned)w[0], (unsigned)w[1], (unsigned)w[2], (unsigned)w[3]}; }
    for (int it = bid; it < (T / 64) * 4; it += G) { const int tile = it >> 2, hp = it & 3, tk0 = tile * 64, b = tk0 / TB, s0 = tk0 - b * TB;
        transpose64x128_f8(lds, tid, [&](int ti, int cc) { return QR + (size_t)(tk0 + ti) * 1792 + 768 + (2 * hp + (cc >> 3)) * 128 + 64 + 8 * (cc & 7); }, (unsigned char*)VTM + ((size_t)b * 512 + hp * 128) * TB + s0); }
}

__device__ __forceinline__ void phase_attn(const PView& p, int l, LAS unsigned char* lds, int bid, int G) {
    const int tid = ltid(), wid = __builtin_amdgcn_readfirstlane(tid >> 6), lane = tid & 63;
    unsigned char* ws = p.ws;
    const bf16* P = (const bf16*)(ws + OFF_R1); const unsigned char* QM8 = ws + OFF_QM8; const unsigned char* KM8 = ws + OFF_KM;
    const bf16* VTM = (const bf16*)(ws + OFF_VTM); const bf16* VTN = (const bf16*)(ws + OFF_VTN); bf16* Y = (bf16*)(ws + OFF_Y);
    LAS float* btab = (LAS float*)(lds + 90112);
    for (int i = tid; i < 8 * 465; i += NTHR) btab[i] = p.in[I_RPB][(size_t)l * 8 * 465 + i] * 1.4426950408889634f;
    __syncthreads();
    const float c_mla = 0.10206207261596577f * 1.4426950408889634f, c_na = 0.125f * 1.4426950408889634f;
    for (int u = bid; u < 2112; u += G) {
        AttnJob J; J.bias = btab; J.kr_lo = 0; J.r_w = 0; J.c_q = 0; J.s0_first_n = 1 << 30; J.s0_jump = 0;
        if (u < 1024) {
            const int b = u >> 8, hh = u & 7, qb = (u >> 3) & 31; const size_t tq = (size_t)b * TB + CTX + qb * 256;
            J.Q = (const bf16*)(QM8 + (tq * 8 + hh) * 128); J.qpitch = 1024; J.K = (const bf16*)(KM8 + ((size_t)b * 8 + hh) * TB * 128); J.kpitch = 128; J.VT = (const bf16*)((const unsigned char*)VTM + ((size_t)b * 8 + hh) * 64 * TB);
            J.O = Y + tq * 2048 + 1024 + hh * 64; J.opitch = 2048; J.ntiles = TB / 64; J.c = c_mla;
            attn_unit_dense<96>(lds, J);
        } else if (u < 2048) {
            const int v = u - 1024, b = v >> 8, hh = v & 7, rq = (v >> 3) & 31; const size_t tq = (size_t)b * TB + CTX + rq * 256;
            const int kr_lo = min(max(4 * rq - 4, 0), 120), kr_hi = min(max(4 * rq + 3 - 4, 0), 120) + 7;
            J.Q = P + tq * LDP + PC_NAQ + hh * 64; J.qpitch = LDP; J.K = P + (size_t)b * TB * LDP + PC_NAK + hh * 64; J.kpitch = LDP; J.VT = VTN + ((size_t)b * 8 + hh) * 64 * TB;
            J.O = Y + tq * 2048 + hh * 64; J.opitch = 2048; J.ntiles = 4 + (kr_hi - kr_lo + 1); J.c = c_na;
            J.s0_first_n = 4; J.s0_jump = CTX + kr_lo * 64; J.kr_lo = kr_lo; J.r_w = 4 * rq + (wid >> 1); J.c_q = 32 * (wid & 1) + (lane & 31); J.bias = btab + hh * 465;
            for (int rp = 0; rp < NREP(55); ++rp) attn_unit<64, true>(lds, J);
        } else if (u < 2080) {
            const int v = u - 2048, b = v >> 3, hh = v & 7; const size_t tq = (size_t)b * TB;
            J.Q = (const bf16*)(QM8 + (tq * 8 + hh) * 128); J.qpitch = 1024; J.K = (const bf16*)(KM8 + ((size_t)b * 8 + hh) * TB * 128); J.kpitch = 128; J.VT = (const bf16*)((const unsigned char*)VTM + ((size_t)b * 8 + hh) * 64 * TB);
            J.O = Y + tq * 2048 + 1024 + hh * 64; J.opitch = 2048; J.ntiles = 4; J.c = c_mla;
            attn_unit_dense<96>(lds, J);
        } else {
            const int v = u - 2080, b = v >> 3, hh = v & 7; const size_t tq = (size_t)b * TB;
            J.Q = P + tq * LDP + PC_NAQ + hh * 64; J.qpitch = LDP; J.K = P + (size_t)b * TB * LDP + PC_NAK + hh * 64; J.kpitch = LDP; J.VT = VTN + ((size_t)b * 8 + hh) * 64 * TB;
            J.O = Y + tq * 2048 + hh * 64; J.opitch = 2048; J.ntiles = 4; J.c = c_na;
            attn_unit<64, false>(lds, J);
        }
    }
}


__device__ __forceinline__ unsigned lds_u16(const LAS unsigned char* p) { return (unsigned)*(const LAS unsigned short*)p; }
__device__ __forceinline__ void mlstm_finish(LAS unsigned char* part, int par, int ib, int lane, int h, const f32x16& iacc, float dint, float ai, float egi, float* op) {
    const LAS float* pp = (const LAS float*)part + ((par * 2 + ib) * 64 + lane) * 20;
    const float den = pp[16], dtot = ai * den + egi * dint, inv = 1.0f / fmaxf(fabsf(dtot), 1.0f), ka = ai * inv, ke_ = egi * inv;
#pragma unroll
    for (int g4 = 0; g4 < 4; ++g4) { const f32x4 na = *(const LAS f32x4*)(pp + 4 * g4); f32x4 o;
#pragma unroll
        for (int q = 0; q < 4; ++q) o[q] = na[q] * ka + iacc[4 * g4 + q] * ke_;
        *(f32x4*)(op + 8 * g4) = o; }
}
__device__ __forceinline__ void mlstm_chunk_item(const PView& p, LAS unsigned char* lds, int chain, int vq) {
    const int tid = ltid(), wid = __builtin_amdgcn_readfirstlane(tid >> 6), lane = tid & 63, r = lane & 31, h = lane >> 5;
    const int b = chain >> 3, hh = (chain >> 1) & 3, dir = chain & 1, dh = dir * 4 + hh;
    unsigned char* ws = p.ws;
    const bf16* P = (const bf16*)(ws + OFF_R1); const float* MC = (const float*)(ws + OFF_MC);
    float* OM = (float*)(ws + OFF_OML) + (size_t)dir * T * 512;
    constexpr int KT = 0, QT = 9216, KTT = 18432, VTT = 27648, FC = 32256, AO_ = FC + 256, BO_ = AO_ + 256, CHB = 33280;
    constexpr int CBO = 2 * CHB, CBS = 4608, NSO = CBO + 2 * CBS, PARTO = NSO + 512;
    for (int i = tid; i < (2 * CBS + 512) / 4; i += NTHR) ((LAS unsigned*)(lds + CBO))[i] = 0u;
    f32x16 cacc;
#pragma unroll
    for (int i = 0; i < 16; ++i) cacc[i] = 0.f;
    f32x16 iprev; float dprev = 0.f, aprev = 0.f, eprev = 0.f;
#pragma unroll
    for (int i = 0; i < 16; ++i) iprev[i] = 0.f;
    const int srow = tid >> 3, sc8 = tid & 7, vrow = tid >> 2, vc = tid & 3;
    struct Stg { u32x4 k, q, v; float fc, ip, fm, vfc, vip; };
    Stg sA, sB; sA.fc = sA.ip = sA.fm = sA.vfc = sA.vip = 0.f; sB = sA;
    auto s0_of = [&](int c) { return (dir == 0) ? 64 * c : (c < 4 ? 192 - 64 * c : TB - 64 - 64 * (c - 4)); };
    auto gload = [&](Stg& g, int c) { const size_t tk0 = (size_t)b * TB + s0_of(c);
        const size_t tkr = tk0 + (dir ? 63 - srow : srow);
        g.k = *(const u32x4*)(P + tkr * LDP + PC_LK + hh * 64 + 8 * sc8); g.q = *(const u32x4*)(P + tkr * LDP + PC_LQ + hh * 64 + 8 * sc8);
        g.fm = MC[(tk0 + (dir ? 32 : 31)) * 16 + dh];
        if (tid < 256) { const size_t tkv = tk0 + (dir ? 63 - vrow : vrow); g.v = *(const u32x4*)(P + tkv * LDP + PC_LV + hh * 128 + vq * 32 + 8 * vc); g.vfc = MC[tkv * 16 + dh]; g.vip = MC[tkv * 16 + 8 + dh]; }
        if (tid < 64) { const size_t tkg = tk0 + (dir ? 63 - tid : tid); g.fc = MC[tkg * 16 + dh]; g.ip = MC[tkg * 16 + 8 + dh]; } };
    auto lstore = [&](const Stg& g, int nb) { LAS unsigned char* cb = lds + nb * CHB;
        *(LAS u32x4*)(cb + KT + srow * 144 + 16 * sc8) = g.k;
        { LAS unsigned char* kt_ = cb + KTT + (8 * sc8) * 144 + 2 * srow;
          *(LAS unsigned short*)(kt_) = (unsigned short)(g.k.x & 0xffffu); *(LAS unsigned short*)(kt_ + 144) = (unsigned short)(g.k.x >> 16);
          *(LAS unsigned short*)(kt_ + 288) = (unsigned short)(g.k.y & 0xffffu); *(LAS unsigned short*)(kt_ + 432) = (unsigned short)(g.k.y >> 16);
          *(LAS unsigned short*)(kt_ + 576) = (unsigned short)(g.k.z & 0xffffu); *(LAS unsigned short*)(kt_ + 720) = (unsigned short)(g.k.z >> 16);
          *(LAS unsigned short*)(kt_ + 864) = (unsigned short)(g.k.w & 0xffffu); *(LAS unsigned short*)(kt_ + 1008) = (unsigned short)(g.k.w >> 16); }
        { float q8[8]; unpack8(g.q, q8);
#pragma unroll
          for (int e = 0; e < 8; ++e) q8[e] *= 0.125f;
          *(LAS u32x4*)(cb + QT + srow * 144 + 16 * sc8) = pack8(q8); }
        if (tid < 256) { float v8[8]; unpack8(g.v, v8); const float bj = __expf(g.vip - g.vfc + g.fm);
#pragma unroll
            for (int e = 0; e < 8; ++e) v8[e] *= bj;
#pragma unroll
            for (int e = 0; e < 8; e += 2) { const unsigned w_ = cvtpk(v8[e], v8[e + 1]);
                *(LAS unsigned short*)(cb + VTT + (8 * vc + e) * 144 + 2 * vrow) = (unsigned short)(w_ & 0xffffu); *(LAS unsigned short*)(cb + VTT + (8 * vc + e + 1) * 144 + 2 * vrow) = (unsigned short)(w_ >> 16); } }
        if (tid < 64) { ((LAS float*)(cb + FC))[tid] = g.fc; ((LAS float*)(cb + AO_))[tid] = __expf(g.fc - g.fm); ((LAS float*)(cb + BO_))[tid] = __expf(g.ip - g.fc + g.fm); }
        if (tid == 64) ((LAS float*)(cb + FC + 768))[0] = g.fm; };
    gload(sA, 0); lstore(sA, 0); gload(sB, 1);
    __syncthreads();
    auto compute = [&](const int c, const int cur) {
        const int nxt = cur ^ 1;
        const LAS unsigned char* cb = lds + cur * CHB;
        const LAS float* fcS = (const LAS float*)(cb + FC); const LAS float* aS = (const LAS float*)(cb + AO_); const LAS float* bS = (const LAS float*)(cb + BO_);
        const float fend = fcS[63], dec = __expf(fend), cw = __expf(fend - fcS[192]);
        if (wid < 2) {
            const int ib = wid, i = 32 * ib + r;
            bf16x8 qf[4];
#pragma unroll
            for (int s = 0; s < 4; ++s) qf[s] = *(const LAS bf16x8*)(cb + QT + i * 144 + 32 * s + 16 * h);
            f32x16 s0v, s1v, nacc;
#pragma unroll
            for (int q = 0; q < 16; ++q) { s0v[q] = 0.f; s1v[q] = 0.f; nacc[q] = 0.f; }
#pragma unroll
            for (int s = 0; s < 4; ++s) { const bf16x8 a0 = *(const LAS bf16x8*)(cb + KT + r * 144 + 32 * s + 16 * h); s0v = __builtin_amdgcn_mfma_f32_32x32x16_bf16(a0, qf[s], s0v, 0, 0, 0); }
            float den = 0.f;
            if (ib == 0) {
#pragma unroll
                for (int g4 = 0; g4 < 4; ++g4) { const f32x4 B0 = *(const LAS f32x4*)(bS + 8 * g4 + 4 * h);
#pragma unroll
                    for (int q = 0; q < 4; ++q) { const int reg = 4 * g4 + q, j0 = 8 * g4 + 4 * h + q; const float p0 = (j0 <= r) ? s0v[reg] : 0.f; s0v[reg] = p0; den += p0 * B0[q]; } }
            } else {
#pragma unroll
                for (int s = 0; s < 4; ++s) { const bf16x8 a1 = *(const LAS bf16x8*)(cb + KT + (32 + r) * 144 + 32 * s + 16 * h); s1v = __builtin_amdgcn_mfma_f32_32x32x16_bf16(a1, qf[s], s1v, 0, 0, 0); }
#pragma unroll
                for (int g4 = 0; g4 < 4; ++g4) { const f32x4 B0 = *(const LAS f32x4*)(bS + 8 * g4 + 4 * h), B1 = *(const LAS f32x4*)(bS + 32 + 8 * g4 + 4 * h);
#pragma unroll
                    for (int q = 0; q < 4; ++q) { const int reg = 4 * g4 + q, j0 = 8 * g4 + 4 * h + q; den += s0v[reg] * B0[q];
                        const float p1 = (j0 <= r) ? s1v[reg] : 0.f; s1v[reg] = p1; den += p1 * B1[q]; } }
            }
#pragma unroll
            for (int st = 0; st < 4; ++st) { if (st < 2 || ib == 1) {
                u32x4 pw;
#pragma unroll
                for (int q = 0; q < 4; ++q) { const int reg = 8 * (st & 1) + 2 * q; pw[q] = (st < 2) ? cvtpk(s0v[reg], s0v[reg + 1]) : cvtpk(s1v[reg], s1v[reg + 1]); }
                const u32x2 v0_ = *(const LAS u32x2*)(cb + VTT + r * 144 + 2 * (16 * st + 4 * h)), v1_ = *(const LAS u32x2*)(cb + VTT + r * 144 + 2 * (16 * st + 8 + 4 * h));
                nacc = __builtin_amdgcn_mfma_f32_32x32x16_bf16(__builtin_bit_cast(bf16x8, (u32x4){v0_.x, v0_.y, v1_.x, v1_.y}), __builtin_bit_cast(bf16x8, pw), nacc, 0, 0, 0); } }
            { auto rr = __builtin_amdgcn_permlane32_swap(__float_as_uint(den), __float_as_uint(den), false, false); den = __uint_as_float(rr[0]) + __uint_as_float(rr[1]); }
            LAS float* pp = (LAS float*)(lds + PARTO) + ((cur * 2 + ib) * 64 + lane) * 20;
#pragma unroll
            for (int g4 = 0; g4 < 4; ++g4) *(LAS f32x4*)(pp + 4 * g4) = (f32x4){nacc[4 * g4], nacc[4 * g4 + 1], nacc[4 * g4 + 2], nacc[4 * g4 + 3]};
            pp[16] = den;
        } else if (wid < 4) {
            const int cbk = wid - 2;
            f32x16 tacc;
#pragma unroll
            for (int q = 0; q < 16; ++q) tacc[q] = 0.f;
#pragma unroll
            for (int s = 0; s < 4; ++s) { const bf16x8 vw = *(const LAS bf16x8*)(cb + VTT + r * 144 + 32 * s + 16 * h), kw = *(const LAS bf16x8*)(cb + KTT + (r + 32 * cbk) * 144 + 32 * s + 16 * h);
                tacc = __builtin_amdgcn_mfma_f32_32x32x16_bf16(vw, kw, tacc, 0, 0, 0); }
            LAS unsigned char* cbn = lds + CBO + nxt * CBS;
#pragma unroll
            for (int q = 0; q < 16; ++q) { cacc[q] = dec * cacc[q] + cw * tacc[q]; const int v = (q & 3) + 8 * (q >> 2) + 4 * h; *(LAS unsigned short*)(cbn + v * 144 + 2 * (r + 32 * cbk)) = (unsigned short)(cvtpk(cacc[q], 0.f) & 0xffffu); }
        } else if (wid == 5 || wid == 6) {
            const int ib = wid - 5, i = 32 * ib + r;
            if (c > 0) mlstm_finish(lds + PARTO, (cur ^ 1), ib, lane, h, iprev, dprev, aprev, eprev, OM + ((size_t)b * TB + s0_of(c - 1) + (dir ? 63 - i : i)) * 512 + hh * 128 + vq * 32 + 4 * h);
            bf16x8 qf[4];
#pragma unroll
            for (int s = 0; s < 4; ++s) qf[s] = *(const LAS bf16x8*)(cb + QT + i * 144 + 32 * s + 16 * h);
            const LAS unsigned char* cbt = lds + CBO + cur * CBS; const LAS float* nS = (const LAS float*)(lds + NSO + cur * 256);
            f32x16 iacc;
#pragma unroll
            for (int q = 0; q < 16; ++q) iacc[q] = 0.f;
            float dint = 0.f;
#pragma unroll
            for (int s = 0; s < 4; ++s) { const bf16x8 ca = *(const LAS bf16x8*)(cbt + r * 144 + 32 * s + 16 * h); iacc = __builtin_amdgcn_mfma_f32_32x32x16_bf16(ca, qf[s], iacc, 0, 0, 0);
                float q8[8]; unpack8(__builtin_bit_cast(u32x4, qf[s]), q8); const f32x4 n0 = *(const LAS f32x4*)(nS + 16 * s + 8 * h), n1 = *(const LAS f32x4*)(nS + 16 * s + 8 * h + 4);
                dint += q8[0] * n0.x + q8[1] * n0.y + q8[2] * n0.z + q8[3] * n0.w + q8[4] * n1.x + q8[5] * n1.y + q8[6] * n1.z + q8[7] * n1.w; }
            { auto rr = __builtin_amdgcn_permlane32_swap(__float_as_uint(dint), __float_as_uint(dint), false, false); dint = __uint_as_float(rr[0]) + __uint_as_float(rr[1]); }
            iprev = iacc; dprev = dint; aprev = aS[i]; eprev = __expf(fcS[i]);
        } else if (wid == 4) {
            float s0 = 0.f, s1 = 0.f;
#pragma unroll
            for (int j8 = 0; j8 < 8; ++j8) { float k8[8]; unpack8(*(const LAS u32x4*)(cb + KTT + lane * 144 + 16 * j8), k8); const f32x4 b0 = *(const LAS f32x4*)(bS + 8 * j8), b1 = *(const LAS f32x4*)(bS + 8 * j8 + 4);
                s0 += k8[0] * b0.x + k8[1] * b0.y + k8[2] * b0.z + k8[3] * b0.w; s1 += k8[4] * b1.x + k8[5] * b1.y + k8[6] * b1.z + k8[7] * b1.w; }
            const LAS float* nc = (const LAS float*)(lds + NSO + cur * 256); LAS float* nn = (LAS float*)(lds + NSO + nxt * 256);
            nn[lane] = dec * nc[lane] + cw * (s0 + s1);
        }
    };
    for (int c = 0; c < TB / 64; c += 2) {
        gload(sA, min(c + 2, TB / 64 - 1)); compute(c, 0); lstore(sB, 1); LDS_BAR();
        gload(sB, min(c + 3, TB / 64 - 1)); compute(c + 1, 1); lstore(sA, 0); LDS_BAR();
    }
    if (wid == 5 || wid == 6) { const int ib = wid - 5, i = 32 * ib + r, cl = TB / 64 - 1;
        mlstm_finish(lds + PARTO, cl & 1, ib, lane, h, iprev, dprev, aprev, eprev, OM + ((size_t)b * TB + s0_of(cl) + (dir ? 63 - i : i)) * 512 + hh * 128 + vq * 32 + 4 * h); }
}

constexpr int GF_WM = 0, GF_QD = 16384, GF_QK = 32768, GF_KE = 40960, GF_U0 = 57344, GF_EE = 90112, GF_ITEM = 90368, NCHUNK = TB / 64;
__device__ __forceinline__ int chunk_s0(int dir, int c) { return (dir == 0) ? 64 * c : (c < 4 ? 192 - 64 * c : TB - 64 - 64 * (c - 4)); }
__device__ __forceinline__ void phase_gdnpre(const PView& p, int l, LAS unsigned char* lds, int bid, int G) {
    const int tid = ltid(), wid = __builtin_amdgcn_readfirstlane(tid >> 6), lane = tid & 63, r = lane & 31, h = lane >> 5;
    unsigned char* ws = p.ws;
    const bf16* GQ = (const bf16*)(ws + OFF_GQKV); const float* GC = (const float*)(ws + OFF_GC);
    constexpr int KO = 0, QO = 17408, VTO = 34816, KTO = 53248, AO = 71680, GSO = 89088, BSO = GSO + 256, XO = 89856, UO = 107264;
    const LAS float* gS = (const LAS float*)(lds + GSO); const LAS float* bS = (const LAS float*)(lds + BSO);
    for (int it = bid; it < 32 * NCHUNK; it += G) {
        const int chain = it / NCHUNK, c = it % NCHUNK, b = chain >> 3, hh = (chain >> 1) & 3, dir = chain & 1, dh = dir * 4 + hh;
        const size_t tk0 = (size_t)b * TB + chunk_s0(dir, c);
        unsigned char* gf = ws + OFF_GF + (size_t)it * GF_ITEM;
#pragma unroll
        for (int rep = 0; rep < 6; ++rep) { const int ch = tid + 512 * rep, tile = ch >> 10, idx = ch & 1023, c8 = (idx & 7) + 8 * ((idx >> 6) & 1), row = ((idx >> 3) & 7) + 8 * (idx >> 7);
            const size_t tk = tk0 + (dir ? 63 - row : row);
            const int col = (tile == 0 ? 512 : (tile == 1 ? 0 : 1024)) + hh * 128 + 8 * c8;
            const u32x4 w_ = *(const u32x4*)(GQ + tk * 1536 + col);
            if (tile < 2) *(LAS u32x4*)(lds + tile * 17408 + row * 272 + 16 * c8) = w_;
            if (tile != 1) { LAS unsigned char* tp_ = lds + (tile == 0 ? KTO : VTO) + (8 * c8) * 144 + 16 * ((row >> 3) ^ (c8 & 7)) + 2 * (row & 7);
                *(LAS unsigned short*)(tp_) = (unsigned short)(w_.x & 0xffffu); *(LAS unsigned short*)(tp_ + 144) = (unsigned short)(w_.x >> 16);
                *(LAS unsigned short*)(tp_ + 288) = (unsigned short)(w_.y & 0xffffu); *(LAS unsigned short*)(tp_ + 432) = (unsigned short)(w_.y >> 16);
                *(LAS unsigned short*)(tp_ + 576) = (unsigned short)(w_.z & 0xffffu); *(LAS unsigned short*)(tp_ + 720) = (unsigned short)(w_.z >> 16);
                *(LAS unsigned short*)(tp_ + 864) = (unsigned short)(w_.w & 0xffffu); *(LAS unsigned short*)(tp_ + 1008) = (unsigned short)(w_.w >> 16); } }
        if (tid < 64) { const size_t tk = tk0 + (dir ? 63 - tid : tid); const float gg = GC[tk * 24 + dh], bb = GC[tk * 24 + 8 + dh];
            ((LAS float*)(lds + GSO))[tid] = gg; ((LAS float*)(lds + BSO))[tid] = bb; ((LAS float*)(lds + BSO + 256))[tid] = bb * __expf(gg); }
        __syncthreads();
        { const int w4 = wid & 3, jb = w4 >> 1, ib = w4 & 1, i = 32 * ib + r;
          f32x16 acc;
#pragma unroll
          for (int q = 0; q < 16; ++q) acc[q] = 0.f;
          const LAS unsigned char* bsrc = lds + ((wid < 4) ? KO : QO) + i * 272 + 16 * h;
#pragma unroll
          for (int s = 0; s < 8; ++s) { const bf16x8 a = *(const LAS bf16x8*)(lds + KO + (32 * jb + r) * 272 + 32 * s + 16 * h), bq = *(const LAS bf16x8*)(bsrc + 32 * s);
              acc = __builtin_amdgcn_mfma_f32_32x32x16_bf16(a, bq, acc, 0, 0, 0); }
          const float gi = gS[i], bi = bS[i];
          if (wid < 4) {
#pragma unroll
              for (int g4 = 0; g4 < 4; ++g4) { const int j0 = 32 * jb + 8 * g4 + 4 * h; const f32x4 gj = *(const LAS f32x4*)(gS + j0); f32x4 o;
#pragma unroll
                  for (int q = 0; q < 4; ++q) o[q] = (i > j0 + q) ? bi * __expf(gi - gj[q]) * acc[4 * g4 + q] : 0.f;
                  *(LAS f32x4*)(lds + AO + i * 272 + 4 * j0) = o; }
          } else {
#pragma unroll
              for (int g4 = 0; g4 < 4; ++g4) { const int j0 = 32 * jb + 8 * g4 + 4 * h; const f32x4 gj = *(const LAS f32x4*)(gS + j0);
#pragma unroll
                  for (int q = 0; q < 4; ++q) acc[4 * g4 + q] = (i >= j0 + q) ? __expf(gi - gj[q]) * acc[4 * g4 + q] : 0.f; }
#pragma unroll
              for (int s2 = 0; s2 < 2; ++s2) { u32x4 w;
#pragma unroll
                  for (int q = 0; q < 4; ++q) w[q] = cvtpk(acc[8 * s2 + 2 * q], acc[8 * s2 + 2 * q + 1]);
                  *(u32x4*)(gf + GF_QK + (size_t)((ib * 4 + 2 * jb + s2) * 64 + lane) * 16) = w; }
          } }
        __syncthreads();
        constexpr int TO = UO;
        if (wid == 0) {
            float t[32];
#pragma unroll
            for (int i = 0; i < 32; ++i) {
                float acc0 = (i == r) ? 1.0f : 0.0f, acc1 = 0.f;
#pragma unroll
                for (int j4 = 0; j4 < (i + 3) / 4; ++j4) { const f32x4 a4 = *(const LAS f32x4*)(lds + AO + (32 * h + i) * 272 + (32 * h + 4 * j4) * 4);
#pragma unroll
                    for (int q = 0; q < 4; ++q) if (4 * j4 + q < i) { if (q & 1) acc1 -= a4[q] * t[4 * j4 + q]; else acc0 -= a4[q] * t[4 * j4 + q]; } }
                t[i] = acc0 + acc1;
                *(LAS unsigned short*)(lds + TO + h * 2048 + i * 64 + 2 * r) = (unsigned short)(cvtpk(t[i], 0.f) & 0xffffu);
                if ((i & 3) == 3) asm volatile("" ::: "memory");
            }
        } else if (wid >= 4) {
            const int w4 = wid - 4; const float gend = gS[63];
#pragma unroll
            for (int k = 0; k < 4; ++k) { const int f = w4 * 4 + k, ib = f >> 3, s = f & 7, i = 32 * ib + r;
                float q8[8]; unpack8(*(const LAS u32x4*)(lds + QO + i * 272 + 32 * s + 16 * h), q8); const float e = __expf(gS[i]);
#pragma unroll
                for (int q = 0; q < 8; ++q) q8[q] *= e;
                *(u32x4*)(gf + GF_QD + (size_t)(f * 64 + lane) * 16) = pack8(q8); }
#pragma unroll
            for (int k = 0; k < 4; ++k) { const int f = w4 * 4 + k, db = f >> 2, st = f & 3, dk = 32 * db + r;
                const int xs = (dk >> 3) & 7;
                const u32x2 k0_ = *(const LAS u32x2*)(lds + KTO + dk * 144 + 16 * ((2 * st) ^ xs) + 8 * h), k1_ = *(const LAS u32x2*)(lds + KTO + dk * 144 + 16 * ((2 * st + 1) ^ xs) + 8 * h);
                const f32x4 g0_ = *(const LAS f32x4*)(gS + 16 * st + 4 * h), g1_ = *(const LAS f32x4*)(gS + 16 * st + 8 + 4 * h);
                u32x4 w;
                w[0] = cvtpk(bflo(k0_.x) * __expf(gend - g0_.x), bfhi(k0_.x) * __expf(gend - g0_.y)); w[1] = cvtpk(bflo(k0_.y) * __expf(gend - g0_.z), bfhi(k0_.y) * __expf(gend - g0_.w));
                w[2] = cvtpk(bflo(k1_.x) * __expf(gend - g1_.x), bfhi(k1_.x) * __expf(gend - g1_.y)); w[3] = cvtpk(bflo(k1_.y) * __expf(gend - g1_.z), bfhi(k1_.y) * __expf(gend - g1_.w));
                *(u32x4*)(gf + GF_KE + (size_t)(f * 64 + lane) * 16) = w; }
            if (tid == 256) *(float*)(gf + GF_EE) = __expf(gend);
        }
        __syncthreads();
        { const bool isv = wid < 4; const int c = 32 * (wid & 3) + r, xs = (c >> 3) & 7;
          const LAS unsigned char* srow = lds + (isv ? VTO : KTO) + c * 144; const LAS float* fS = (const LAS float*)(lds + (isv ? BSO : BSO + 256));
          f32x16 x0, x1;
#pragma unroll
          for (int g4 = 0; g4 < 4; ++g4) { const u32x2 rv = *(const LAS u32x2*)(srow + 16 * ((4 + g4) ^ xs) + 8 * h); const f32x4 ff = *(const LAS f32x4*)(fS + 32 + 8 * g4 + 4 * h);
              x1[4 * g4] = ff.x * bflo(rv.x); x1[4 * g4 + 1] = ff.y * bfhi(rv.x); x1[4 * g4 + 2] = ff.z * bflo(rv.y); x1[4 * g4 + 3] = ff.w * bfhi(rv.y); }
#pragma unroll
          for (int q = 0; q < 16; ++q) x0[q] = 0.f;
#pragma unroll
          for (int s = 0; s < 2; ++s) { const u32x4 rv = *(const LAS u32x4*)(srow + 16 * ((2 * s + h) ^ xs)); const f32x4 f0 = *(const LAS f32x4*)(fS + 16 * s + 8 * h), f1 = *(const LAS f32x4*)(fS + 16 * s + 8 * h + 4);
              u32x4 rw_; rw_[0] = cvtpk(f0.x * bflo(rv.x), f0.y * bfhi(rv.x)); rw_[1] = cvtpk(f0.z * bflo(rv.y), f0.w * bfhi(rv.y)); rw_[2] = cvtpk(f1.x * bflo(rv.z), f1.y * bfhi(rv.z)); rw_[3] = cvtpk(f1.z * bflo(rv.w), f1.w * bfhi(rv.w));
              const bf16x8 ta = *(const LAS bf16x8*)(lds + TO + r * 64 + 32 * s + 16 * h);
              x0 = __builtin_amdgcn_mfma_f32_32x32x16_bf16(ta, __builtin_bit_cast(bf16x8, rw_), x0, 0, 0, 0); }
#pragma unroll
          for (int s2 = 0; s2 < 2; ++s2) { u32x4 xb, aw;
#pragma unroll
              for (int q = 0; q < 4; ++q) xb[q] = cvtpk(x0[8 * s2 + 2 * q], x0[8 * s2 + 2 * q + 1]);
              const f32x4 a0 = *(const LAS f32x4*)(lds + AO + (32 + r) * 272 + (16 * s2 + 4 * h) * 4), a1 = *(const LAS f32x4*)(lds + AO + (32 + r) * 272 + (16 * s2 + 8 + 4 * h) * 4);
              aw[0] = cvtpk(-a0.x, -a0.y); aw[1] = cvtpk(-a0.z, -a0.w); aw[2] = cvtpk(-a1.x, -a1.y); aw[3] = cvtpk(-a1.z, -a1.w);
              x1 = __builtin_amdgcn_mfma_f32_32x32x16_bf16(__builtin_bit_cast(bf16x8, aw), __builtin_bit_cast(bf16x8, xb), x1, 0, 0, 0); }
          f32x16 y1;
#pragma unroll
          for (int q = 0; q < 16; ++q) y1[q] = 0.f;
#pragma unroll
          for (int s2 = 0; s2 < 2; ++s2) { u32x4 rb;
#pragma unroll
              for (int q = 0; q < 4; ++q) rb[q] = cvtpk(x1[8 * s2 + 2 * q], x1[8 * s2 + 2 * q + 1]);
              const u32x2 t0 = *(const LAS u32x2*)(lds + TO + 2048 + r * 64 + (16 * s2 + 4 * h) * 2), t1 = *(const LAS u32x2*)(lds + TO + 2048 + r * 64 + (16 * s2 + 8 + 4 * h) * 2);
              y1 = __builtin_amdgcn_mfma_f32_32x32x16_bf16(__builtin_bit_cast(bf16x8, (u32x4){t0.x, t0.y, t1.x, t1.y}), __builtin_bit_cast(bf16x8, rb), y1, 0, 0, 0); }
          if (isv) {
              f32x4* d0 = (f32x4*)(gf + GF_U0 + (size_t)((wid * 2 + 0) * 64 + lane) * 64); f32x4* d1 = (f32x4*)(gf + GF_U0 + (size_t)((wid * 2 + 1) * 64 + lane) * 64);
#pragma unroll
              for (int q = 0; q < 4; ++q) { d0[q] = (f32x4){x0[4 * q], x0[4 * q + 1], x0[4 * q + 2], x0[4 * q + 3]}; d1[q] = (f32x4){y1[4 * q], y1[4 * q + 1], y1[4 * q + 2], y1[4 * q + 3]}; }
          } else {
              const int dk = 32 * (wid - 4) + r;
#pragma unroll
              for (int q = 0; q < 16; ++q) { const int tok = (q & 3) + 8 * (q >> 2) + 4 * h;
                  *(LAS unsigned short*)(lds + XO + tok * 272 + 2 * dk) = (unsigned short)(cvtpk(-x0[q], 0.f) & 0xffffu);
                  *(LAS unsigned short*)(lds + XO + (32 + tok) * 272 + 2 * dk) = (unsigned short)(cvtpk(-y1[q], 0.f) & 0xffffu); }
          } }
        __syncthreads();
#pragma unroll
        for (int k = 0; k < 2; ++k) { const int f = wid * 2 + k, tb = f >> 3, s = f & 7;
            *(u32x4*)(gf + GF_WM + (size_t)(f * 64 + lane) * 16) = *(const LAS u32x4*)(lds + XO + (32 * tb + r) * 272 + 32 * s + 16 * h); }
        __syncthreads();
    }
}

__device__ __forceinline__ void gdn_seq_item(const PView& p, LAS unsigned char* lds, int chain, int vq) {
    const int tid = ltid(), wid = __builtin_amdgcn_readfirstlane(tid >> 6), lane = tid & 63, r = lane & 31, h = lane >> 5;
    const int b = chain >> 3, hh = (chain >> 1) & 3, dir = chain & 1;
    unsigned char* ws = p.ws;
    const unsigned char* gfc = ws + OFF_GF + (size_t)chain * NCHUNK * GF_ITEM;
    constexpr int SBS = 8704, UFO = 17408;
    for (int i = tid; i < SBS / 4; i += NTHR) ((LAS unsigned*)lds)[i] = 0u;
    __syncthreads();
    if (wid < 2) {
        u32x4 wm[3][8]; f32x4 uu[3][4];
#define LD_A(SET, C) do { const unsigned char* gf_ = gfc + (size_t)(C) * GF_ITEM; \
            _Pragma("unroll") for (int s = 0; s < 8; ++s) wm[SET][s] = *(const u32x4*)(gf_ + GF_WM + (size_t)((wid * 8 + s) * 64 + lane) * 16); \
            const f32x4* up_ = (const f32x4*)(gf_ + GF_U0 + (size_t)((vq * 2 + wid) * 64 + lane) * 64); \
            _Pragma("unroll") for (int q = 0; q < 4; ++q) uu[SET][q] = up_[q]; } while (0)
#define ST_A(SET, C) do { const LAS unsigned char* sb_ = lds + ((C) & 1) * SBS; f32x16 acc_; \
            _Pragma("unroll") for (int q = 0; q < 4; ++q) { acc_[4 * q] = uu[SET][q].x; acc_[4 * q + 1] = uu[SET][q].y; acc_[4 * q + 2] = uu[SET][q].z; acc_[4 * q + 3] = uu[SET][q].w; } \
            _Pragma("unroll") for (int s = 0; s < 8; ++s) { const bf16x8 sf_ = *(const LAS bf16x8*)(sb_ + r * 272 + 32 * s + 16 * h); \
                acc_ = __builtin_amdgcn_mfma_f32_32x32x16_bf16(__builtin_bit_cast(bf16x8, wm[SET][s]), sf_, acc_, 0, 0, 0); } \
            _Pragma("unroll") for (int s2 = 0; s2 < 2; ++s2) { u32x4 w_; _Pragma("unroll") for (int q = 0; q < 4; ++q) w_[q] = cvtpk(acc_[8 * s2 + 2 * q], acc_[8 * s2 + 2 * q + 1]); \
                *(LAS u32x4*)(lds + UFO + ((2 * wid + s2) * 64 + lane) * 16) = w_; } \
            LDS_BAR(); LDS_BAR(); } while (0)
        LD_A(0, 0); LD_A(1, 1);
        for (int c = 0; c < NCHUNK; c += 3) { LD_A(2, c + 2); ST_A(0, c); LD_A(0, min(c + 3, NCHUNK - 1)); ST_A(1, c + 1); LD_A(1, min(c + 4, NCHUNK - 1)); ST_A(2, c + 2); }
#undef LD_A
#undef ST_A
    } else if (wid < 4) {
        const int ib = wid - 2;
        char* OGu = (char*)((float*)(ws + OFF_OGD) + (size_t)dir * T * 512 + hh * 128 + vq * 32);
        const int ostep = dir ? -2048 : 2048, ot0 = 32 * ib + 4 * h;
        u32x4 qd[3][8], qk[3][4];
#define LD_B(SET, C) do { const unsigned char* gf_ = gfc + (size_t)(C) * GF_ITEM; \
            _Pragma("unroll") for (int s = 0; s < 8; ++s) qd[SET][s] = *(const u32x4*)(gf_ + GF_QD + (size_t)((ib * 8 + s) * 64 + lane) * 16); \
            _Pragma("unroll") for (int s = 0; s < 4; ++s) qk[SET][s] = *(const u32x4*)(gf_ + GF_QK + (size_t)((ib * 4 + s) * 64 + lane) * 16); } while (0)
#define ST_B(SET, C) do { const LAS unsigned char* sb_ = lds + ((C) & 1) * SBS; f32x16 acc_; \
            _Pragma("unroll") for (int q = 0; q < 16; ++q) acc_[q] = 0.f; \
            _Pragma("unroll") for (int s = 0; s < 8; ++s) { const bf16x8 sf_ = *(const LAS bf16x8*)(sb_ + r * 272 + 32 * s + 16 * h); \
                acc_ = __builtin_amdgcn_mfma_f32_32x32x16_bf16(__builtin_bit_cast(bf16x8, qd[SET][s]), sf_, acc_, 0, 0, 0); } \
            LDS_BAR(); \
            _Pragma("unroll") for (int s = 0; s < 4; ++s) { const bf16x8 uf_ = *(const LAS bf16x8*)(lds + UFO + (s * 64 + lane) * 16); \
                acc_ = __builtin_amdgcn_mfma_f32_32x32x16_bf16(__builtin_bit_cast(bf16x8, qk[SET][s]), uf_, acc_, 0, 0, 0); } \
            const unsigned ob_ = (unsigned)(((b * TB + chunk_s0(dir, (C)) + (dir ? 63 - ot0 : ot0)) * 512 + r) * 4); \
            _Pragma("unroll") for (int q = 0; q < 16; ++q) { *(float*)(OGu + (ob_ + (unsigned)(((q & 3) + 8 * (q >> 2)) * ostep))) = acc_[q]; } \
            LDS_BAR(); } while (0)
        LD_B(0, 0); LD_B(1, 1);
        for (int c = 0; c < NCHUNK; c += 3) { LD_B(2, c + 2); ST_B(0, c); LD_B(0, min(c + 3, NCHUNK - 1)); ST_B(1, c + 1); LD_B(1, min(c + 4, NCHUNK - 1)); ST_B(2, c + 2); }
#undef LD_B
#undef ST_B
    } else {
        const int db = wid - 4;
        u32x4 ke[3][4]; float ee[3];
        f32x16 sacc;
#pragma unroll
        for (int q = 0; q < 16; ++q) sacc[q] = 0.f;
#define LD_C(SET, C) do { const unsigned char* gf_ = gfc + (size_t)(C) * GF_ITEM; \
            _Pragma("unroll") for (int s = 0; s < 4; ++s) ke[SET][s] = *(const u32x4*)(gf_ + GF_KE + (size_t)((db * 4 + s) * 64 + lane) * 16); ee[SET] = *(const float*)(gf_ + GF_EE); } while (0)
#define ST_C(SET, C) do { LAS unsigned char* sn_ = lds + (((C) & 1) ^ 1) * SBS; \
            _Pragma("unroll") for (int q = 0; q < 16; ++q) sacc[q] *= ee[SET]; \
            LDS_BAR(); \
            _Pragma("unroll") for (int s = 0; s < 4; ++s) { const bf16x8 uf_ = *(const LAS bf16x8*)(lds + UFO + (s * 64 + lane) * 16); \
                sacc = __builtin_amdgcn_mfma_f32_32x32x16_bf16(__builtin_bit_cast(bf16x8, ke[SET][s]), uf_, sacc, 0, 0, 0); } \
            _Pragma("unroll") for (int g4 = 0; g4 < 4; ++g4) *(LAS u32x2*)(sn_ + r * 272 + 2 * (32 * db + 8 * g4 + 4 * h)) = (u32x2){cvtpk(sacc[4 * g4], sacc[4 * g4 + 1]), cvtpk(sacc[4 * g4 + 2], sacc[4 * g4 + 3])}; \
            LDS_BAR(); } while (0)
        LD_C(0, 0); LD_C(1, 1);
        for (int c = 0; c < NCHUNK; c += 3) { LD_C(2, c + 2); ST_C(0, c); LD_C(0, min(c + 3, NCHUNK - 1)); ST_C(1, c + 1); LD_C(1, min(c + 4, NCHUNK - 1)); ST_C(2, c + 2); }
#undef LD_C
#undef ST_C
    }
}

__device__ __forceinline__ void phase_scan(const PView& p, int l, LAS unsigned char* lds, int bid, int G) {
    for (int wi = bid; wi < 256; wi += G) {
        const int x = wi & 7, k = wi >> 3, item = ((k >> 4) << 7) + x * 16 + (k & 15);
        const int it = item & 127, chain = it >> 2, vq = it & 3;
        if (item < 128) { for (int rp = 0; rp < NREP(53); ++rp) { gdn_seq_item(p, lds, chain, vq); __syncthreads(); } }
        else { for (int rp = 0; rp < NREP(54); ++rp) { mlstm_chunk_item(p, lds, chain, vq); __syncthreads(); } }
        __syncthreads();
    }
}

__device__ __forceinline__ void phase_scanout(const PView& p, int l, int bid, int G) {
    const int tid = ltid(), wid = __builtin_amdgcn_readfirstlane(tid >> 6), lane = tid & 63;
    unsigned char* ws = p.ws;
    const bf16* P = (const bf16*)(ws + OFF_R1); const bf16* Y = (const bf16*)(ws + OFF_Y);
    signed char* Y8 = (signed char*)(ws + OFF_Y8); float* SY = (float*)(ws + OFF_SY);
    const float* OG = (const float*)(ws + OFF_OGD); const float* OM = (const float*)(ws + OFF_OML);
    for (int tp = bid * NWAVES + wid; tp < T / 2; tp += G * NWAVES) {
        f32x4 oa[2][2][2], ob[2][2][2]; u32x4 gw[2][2], ya[2][2];
#pragma unroll
        for (int u = 0; u < 2; ++u)
#pragma unroll
            for (int which = 0; which < 2; ++which) { const int tk = 2 * tp + u;
                const float* o0 = (which ? OM : OG) + (size_t)tk * 512 + 8 * lane; const float* o1 = o0 + (size_t)T * 512;
                oa[u][which][0] = *(const f32x4*)o0; oa[u][which][1] = *(const f32x4*)(o0 + 4); ob[u][which][0] = *(const f32x4*)o1; ob[u][which][1] = *(const f32x4*)(o1 + 4);
                gw[u][which] = *(const u32x4*)(P + (size_t)tk * LDP + (which ? PC_LO : PC_GG) + 8 * lane);
                ya[u][which] = *(const u32x4*)(Y + (size_t)tk * 2048 + which * 1024 + 8 * lane); }
#pragma unroll
        for (int u = 0; u < 2; ++u)
#pragma unroll
            for (int br = 0; br < 4; ++br) { const int tk = 2 * tp + u, which = br >> 1;
                float y[8];
                if (br & 1) {
                    float x[8]; { const f32x4 a0 = oa[u][which][0], a1 = oa[u][which][1], b0 = ob[u][which][0], b1 = ob[u][which][1];
                        x[0] = a0.x + b0.x; x[1] = a0.y + b0.y; x[2] = a0.z + b0.z; x[3] = a0.w + b0.w; x[4] = a1.x + b1.x; x[5] = a1.y + b1.y; x[6] = a1.z + b1.z; x[7] = a1.w + b1.w; }
                    float ss = 0.f;
#pragma unroll
                    for (int i = 0; i < 8; ++i) ss += x[i] * x[i];
                    ss = row16_sum(ss);
                    const float rs = __builtin_amdgcn_rsqf(ss * (1.f / 128.f) + 1e-6f);
                    const float* ng = (which ? p.in[I_MLG] : p.in[I_GNG]) + l * 128 + 8 * (lane & 15);
                    float gt[8]; unpack8(gw[u][which], gt);
#pragma unroll
                    for (int i = 0; i < 8; ++i) { const float sg = fsigmoid(gt[i]); y[i] = x[i] * rs * ng[i] * (which ? sg : gt[i] * sg); }
                } else unpack8(ya[u][which], y);
                float am = 0.f;
#pragma unroll
                for (int i = 0; i < 8; ++i) am = fmaxf(am, fabsf(y[i]));
                const float amax = wave_max(am), inv = amax > 0.f ? 127.0f / amax : 0.f;
                if (lane == 0) SY[tk * 4 + br] = amax * (1.0f / 127.0f);
                *(u32x2*)(Y8 + (size_t)tk * 2048 + br * 512 + 8 * lane) = (u32x2){q8x4((f32x4){y[0], y[1], y[2], y[3]} * inv), q8x4((f32x4){y[4], y[5], y[6], y[7]} * inv)}; }
    }
}

constexpr int NPH_L = 14, PH_L0 = 1, PH_FINAL = PH_L0 + DEPTH * NPH_L, NPHASES = PH_FINAL + 1;
__global__ void __launch_bounds__(NTHR, 2) fwd_kernel(Params kp) {
    extern __shared__ __attribute__((aligned(16))) unsigned char lds_raw[];
    LAS unsigned char* lds = (LAS unsigned char*)lds_raw;
    volatile LAS unsigned* MISC = (volatile LAS unsigned*)(lds + MISC_OFF);
    const int tid = threadIdx.x;
    for (int u = tid; u < (LDS_BYTES - MISC_OFF) / 4; u += NTHR) ((LAS unsigned*)(lds + MISC_OFF))[u] = 0u;
    __syncthreads();
    const int lo = kp.ph_lo, hi = kp.ph_hi;
    XcdBarrier bar; bar.bar = (unsigned*)(kp.ws + OFF_CTL) + CW_BAR; bar.x = 0; bar.st = MISC + 8;
    if (hi - lo > 1) bar = xcd_barrier_post((unsigned*)(kp.ws + OFF_CTL) + CW_BAR, MISC + 8);
#define IN(k) (lo <= (k) && (k) < hi)
#define SEAM(k) do { if ((k) + 1 < hi) xcd_barrier(bar); } while (0)

    if (IN(0)) { const PView p = pview(); phase_prologue(p, lds, p.bid, p.G); SEAM(0); }
    for (int l = 0; l < DEPTH; ++l) {
        const int pb = PH_L0 + l * NPH_L;
        if (IN(pb + 0)) { const PView p = pview(); if (NREP(60) == 2) { phase_norm1<0>(p, l, p.bid, p.G, true); __syncthreads(); } phase_norm1<0>(p, l, p.bid, p.G); SEAM(pb + 0); }
        if (IN(pb + 1)) {
            const PView p = pview(); unsigned char* ws = p.ws;
            ProbPlain pr{(const char*)(ws + OFF_H), (const char*)(ws + OFF_WIN) + (size_t)l * NIN * 1024, 1024u, 1024u, 8};
            pg8::Order S; S.init(T / 256, NIN / 256, p.G, p.bid);
            EpiIn8 E{(bf16*)(ws + OFF_R1), (bf16*)(ws + OFF_R2), (float*)(ws + OFF_GATES), p.in[I_BMG] + (size_t)l * NGATE, (const float*)(ws + OFF_SH), (const float*)(ws + OFF_CMIN) + (size_t)l * NIN};
            for (int rp = 0; rp < NREP(1); ++rp) pg8::gemm_phase(lds, pr, S, E); SEAM(pb + 1); }
        if (IN(pb + 2)) { const PView p = pview(); if (NREP(2) == 2) { phase_prep(p, l, lds, p.bid, p.G); __syncthreads(); } phase_prep(p, l, lds, p.bid, p.G); SEAM(pb + 2); }
        if (IN(pb + 3)) {
            const PView p = pview(); unsigned char* ws = p.ws;
            ProbPlain pr{(const char*)(ws + OFF_AQ), (const char*)(ws + OFF_WUQKV) + (size_t)l * 1792 * 384 * 2, 768u, 768u, 6};
            pg8::Order S; S.init(T / 256, 7, p.G, p.bid);
            EpiStore E{(bf16*)(ws + OFF_QKVR), 1792, nullptr, 0};
            for (int rp = 0; rp < NREP(3); ++rp) pg8::gemm_phase(lds, pr, S, E); SEAM(pb + 3); }
        if (IN(pb + 4)) { const PView p = pview(); if (NREP(62) == 2) { phase_mlapost(p, l, lds, p.bid, p.G, true); __syncthreads(); } phase_mlapost(p, l, lds, p.bid, p.G); SEAM(pb + 4); }
        if (IN(pb + 5)) { for (int rp = 0; rp < NREP(50); ++rp) { const PView p = pview(); phase_attn(p, l, lds, p.bid, p.G); __syncthreads(); }
                          for (int rp = 0; rp < NREP(52); ++rp) { const PView p = pview(); phase_gdnpre(p, l, lds, p.bid, p.G); __syncthreads(); } SEAM(pb + 5); }
        if (IN(pb + 6)) { for (int rp = 0; rp < NREP(51); ++rp) { const PView p = pview(); phase_scan(p, l, lds, p.bid, p.G); __syncthreads(); } SEAM(pb + 6); }
        if (IN(pb + 7)) { const PView p = pview(); for (int rp = 0; rp < NREP(6); ++rp) phase_scanout(p, l, p.bid, p.G); SEAM(pb + 7); }
        if (IN(pb + 8)) {
            const PView p = pview(); unsigned char* ws = p.ws;
            ProbBO pr{(const char*)(ws + OFF_Y8), (const char*)(ws + OFF_WBO) + (size_t)l * 4096 * 512, 2048u, 512u, 4};
            pg8::Order S; if (l == DEPTH - 1) S.init(NB * SEQ / 256, 4, p.G, p.bid, 4, 1); else S.init(T / 256, 4, p.G, p.bid, 4);
            EpiBO E{(bf16*)(ws + OFF_R3), (const bf16*)(ws + OFF_R2), (const float*)(ws + OFF_SY), (const float*)(ws + OFF_CMBO) + (size_t)l * 4096};
            for (int rp = 0; rp < NREP(7); ++rp) pg8::gemm_phase(lds, pr, S, E); SEAM(pb + 8); }
        if (IN(pb + 9)) {
            const PView p = pview(); unsigned char* ws = p.ws;
            ProbPlain pr{(const char*)(ws + OFF_R3), (const char*)(ws + OFF_WOUT4) + (size_t)l * 1024 * 4096 * 2, 2048u, 8192u, 16};
            pg8::Order S; if (l == DEPTH - 1) S.init(NB * SEQ / 256, 4, p.G, p.bid, 1, 1); else S.init(T / 256, 4, p.G, p.bid);
            EpiOut E{(float*)(ws + OFF_X), (const float*)(ws + OFF_MOD) + (size_t)l * 5 * 6144};
            pg8::gemm_phase(lds, pr, S, E); SEAM(pb + 9); }
        if (IN(pb + 10)) { const PView p = pview(); if (NREP(61) == 2) { phase_router(p, l, lds, p.bid, p.G, true); __syncthreads(); } phase_router(p, l, lds, p.bid, p.G); SEAM(pb + 10); }
        if (IN(pb + 11)) { const PView p = pview(); for (int rp = 0; rp < NREP(10); ++rp) { phase_gather(p, l, lds, p.bid, p.G); __syncthreads(); } SEAM(pb + 11); }
        if (IN(pb + 12)) {
            const PView p = pview(); unsigned char* ws = p.ws; const int* tst = (const int*)(ws + OFF_CTL) + CW_TST + l * 64;
            ProbMoE pr{(const char*)(ws + OFF_R1), (const char*)(ws + OFF_WGU) + (size_t)l * 32 * 2048 * 1024, 1024u, 1024u, 8, tst, (size_t)2048 * 1024};
            pg8::Order S; S.init(tst[32], 8, p.G, p.bid);
            EpiMoE18 E{(bf16*)(ws + OFF_R2), p.in[I_BGU] + (size_t)l * 32 * 2048, (const float*)(ws + OFF_SX), (const float*)(ws + OFF_CMGU) + (size_t)l * 32 * 2048};
            for (int rp = 0; rp < NREP(11); ++rp) pg8::gemm_phase(lds, pr, S, E); SEAM(pb + 12); }
        if (IN(pb + 13)) {
            const PView p = pview(); unsigned char* ws = p.ws; const int* tst = (const int*)(ws + OFF_CTL) + CW_TST + l * 64;
            ProbMoE pr{(const char*)(ws + OFF_R2), (const char*)(ws + OFF_WDN) + (size_t)l * 32 * 1024 * 1024, 1024u, 1024u, 8, tst, (size_t)1024 * 1024};
            pg8::Order S; S.init(tst[32], 4, p.G, p.bid);
            EpiStoreF8 E{(bf16*)(ws + OFF_R3), 1024, p.in[I_BDN] + (size_t)l * 32 * 1024, 1024};
            for (int rp = 0; rp < NREP(12); ++rp) pg8::gemm_phase(lds, pr, S, E); SEAM(pb + 13); }
    }
    if (IN(PH_FINAL)) { const PView p = pview(); phase_norm1<2>(p, DEPTH, p.bid, p.G); }
#undef IN
#undef SEAM
}

extern "C" void kernel_launch(void* const* d_in, const int* in_sizes, int n_in, void* d_out, int out_size, void* d_ws, size_t ws_size, hipStream_t stream) {
    static int grid = 0;
    if (!grid) {
        if (n_in != 31 || ws_size < WS_END) { fprintf(stderr, "kernel_launch: expected 31 inputs and >= %zu bytes of workspace (got %d, %zu)\n", (size_t)WS_END, n_in, ws_size); grid = -1; return; }
        int dev = 0, cus = 0, per_cu = 0;
        hipGetDevice(&dev); hipDeviceGetAttribute(&cus, hipDeviceAttributeMultiprocessorCount, dev);
        hipFuncSetAttribute((const void*)fwd_kernel, hipFuncAttributeMaxDynamicSharedMemorySize, LDS_BYTES);
        hipOccupancyMaxActiveBlocksPerMultiprocessor(&per_cu, (const void*)fwd_kernel, NTHR, LDS_BYTES);
        if (per_cu < 1) fprintf(stderr, "kernel_launch: occupancy query reports %d blocks per CU\n", per_cu);
        grid = cus;
    }
    if (grid < 0) return;
    hipMemsetAsync((char*)d_ws + OFF_CTL, 0, CTL_BYTES, stream);
    Params p{};
    for (int i = 0; i < 31; ++i) p.in[i] = (const float*)d_in[i];
    p.out = (float*)d_out; p.ws = (unsigned char*)d_ws;
#if MK_N_LAUNCHES == 1
    p.ph_lo = 0; p.ph_hi = NPHASES;
    hipLaunchKernelGGL(fwd_kernel, dim3(grid), dim3(NTHR), LDS_BYTES, stream, p);
#else
    for (int ph = 0; ph < NPHASES; ++ph) { p.ph_lo = ph; p.ph_hi = ph + 1; hipLaunchKernelGGL(fwd_kernel, dim3(grid), dim3(NTHR), LDS_BYTES, stream, p); }
#endif
}
```
